# Optimizing an MI355X kernel written in HIP

```python
import jax, jax.numpy as jnp
from jax import lax
import numpy as np

D_MODEL = 1024
BATCH = 2
SEQ = 16384
DEPTH = 2

N_MEM = 256
MEM_HEADS = 4
MEM_HEAD_DIM = 128
MEM_WIDTH = MEM_HEADS * MEM_HEAD_DIM
GDN_HEADS = 4
GDN_HEAD_DIM = 128
GDN_WIDTH = GDN_HEADS * GDN_HEAD_DIM
GDN_CONV = 4
GDN_CHUNK = 64
CONV_WIDTH = 512
SHORT_CONV = 3
N_BRANCH = 3
N_EXPERTS = 32
TOP_K = 4
D_FF_EXPERT = 1024
SWIGLU_LIMIT = 7.0
SWIGLU_ALPHA = 1.702
MOE_BLOCK = 256
LN_EPS = 1e-5
RMS_EPS = 1e-6
DEEPNORM_ALPHA = (2 * DEPTH) ** 0.25
DEEPNORM_BETA = (8 * DEPTH) ** -0.25

IN_SPLIT_SIZES = (3 * GDN_WIDTH, GDN_HEADS, GDN_HEADS, GDN_WIDTH,
                  CONV_WIDTH, CONV_WIDTH, CONV_WIDTH, MEM_WIDTH, N_BRANCH * D_MODEL)
D_IN_PROJ = 3 * GDN_WIDTH + 2 * GDN_HEADS + GDN_WIDTH + 3 * CONV_WIDTH + MEM_WIDTH + N_BRANCH * D_MODEL

kernel_name = 'hybrid_gdn_shortconv_memxattn_moe_deepnorm'


def layer_norm(x, g, b):
    xf = x.astype(jnp.float32)
    mu = jnp.mean(xf, axis=-1, keepdims=True)
    var = jnp.mean(jnp.square(xf - mu), axis=-1, keepdims=True)
    y = (xf - mu) * lax.rsqrt(var + LN_EPS) * g.astype(jnp.float32) + b.astype(jnp.float32)
    return y.astype(x.dtype)


def l2_normalize(x):
    return x * lax.rsqrt(jnp.sum(jnp.square(x), axis=-1, keepdims=True) + RMS_EPS)


def causal_depthwise_conv(x, w):
    k_w = w.shape[0]
    return lax.conv_general_dilated(
        x, w[:, None, :].astype(x.dtype), window_strides=(1,), padding=[(k_w - 1, 0)],
        dimension_numbers=('NWC', 'WIO', 'NWC'), feature_group_count=x.shape[-1])


def gated_delta_rule_chunked(q, k, v, g, beta):
    b_, h_, t_, dk = q.shape
    dv = v.shape[-1]
    nc = t_ // GDN_CHUNK

    def chunks(t):
        return t.reshape(b_, h_, nc, GDN_CHUNK, *t.shape[3:])

    q, k, v, g, beta = chunks(q), chunks(k), chunks(v), chunks(g), chunks(beta)
    g_cum = jnp.cumsum(g, axis=-1)
    pos = jnp.arange(GDN_CHUNK)
    causal = pos[:, None] >= pos[None, :]
    strict = pos[:, None] > pos[None, :]
    decay = jnp.exp(jnp.where(causal, g_cum[..., :, None] - g_cum[..., None, :], -jnp.inf))
    k_beta = k * beta[..., None]
    kk = jnp.where(strict, jnp.einsum('bhnid,bhnjd->bhnij', k_beta, k) * decay, 0.0)
    rhs = jnp.concatenate([v * beta[..., None], k_beta * jnp.exp(g_cum)[..., None]], axis=-1)
    sol = lax.linalg.triangular_solve(kk + jnp.eye(GDN_CHUNK, dtype=kk.dtype), rhs,
                                      left_side=True, lower=True, unit_diagonal=True)
    u, k_cum = sol[..., :dv], sol[..., dv:]
    qk = jnp.einsum('bhnid,bhnjd->bhnij', q, k) * decay
    q_dec = q * jnp.exp(g_cum)[..., None]
    k_end = k * jnp.exp(g_cum[..., -1:] - g_cum)[..., None]
    chunk_dec = jnp.exp(g_cum[..., -1])

    def step(state, inp):
        u_c, kc_c, qk_c, qd_c, ke_c, cd_c = inp
        v_new = u_c - jnp.einsum('bhcd,bhde->bhce', kc_c, state)
        o_c = jnp.einsum('bhcd,bhde->bhce', qd_c, state) + jnp.einsum('bhij,bhje->bhie', qk_c, v_new)
        state = state * cd_c[..., None, None] + jnp.einsum('bhcd,bhce->bhde', ke_c, v_new)
        return state, o_c

    xs = tuple(jnp.moveaxis(t, 2, 0) for t in (u, k_cum, qk, q_dec, k_end, chunk_dec))
    s0 = jnp.zeros((b_, h_, dk, dv), jnp.float32)
    _, o = lax.scan(step, s0, xs)
    return jnp.moveaxis(o, 0, 2).reshape(b_, h_, t_, dv)


def token_mixer(x, mem, w_in, conv_qkv, conv_mix, a_log, dt_bias, gdn_norm, w_mem_kv, w_br, w_o):
    b_, t_, _ = x.shape
    f32 = jnp.float32
    split_idx = np.cumsum(IN_SPLIT_SIZES)[:-1].tolist()
    proj = x @ w_in
    qkv, a, bt, z, xc, gb, gc, qm, gl = jnp.split(proj, split_idx, axis=-1)

    qkv = jax.nn.silu(causal_depthwise_conv(qkv, conv_qkv)).astype(f32)
    q, k, v = jnp.split(qkv, 3, axis=-1)

    def heads(t):
        return t.reshape(b_, t_, GDN_HEADS, GDN_HEAD_DIM).transpose(0, 2, 1, 3)

    q = l2_normalize(heads(q)) * (GDN_HEAD_DIM ** -0.5)
    k = l2_normalize(heads(k))
    v = heads(v)
    g = -(jnp.exp(a_log.astype(f32)) * jax.nn.softplus(a.astype(f32) + dt_bias.astype(f32)))
    g = g.transpose(0, 2, 1)
    beta = jax.nn.sigmoid(bt.astype(f32)).transpose(0, 2, 1)
    o = gated_delta_rule_chunked(q, k, v, g, beta).transpose(0, 2, 1, 3)
    o = o * lax.rsqrt(jnp.mean(jnp.square(o), axis=-1, keepdims=True) + RMS_EPS) * gdn_norm.astype(f32)
    zz = z.reshape(b_, t_, GDN_HEADS, GDN_HEAD_DIM).astype(f32)
    y_a = (o * jax.nn.silu(zz)).reshape(b_, t_, GDN_WIDTH).astype(x.dtype)

    y_b = gb * causal_depthwise_conv(gc * xc, conv_mix)

    kv = mem @ w_mem_kv
    km, vm = jnp.split(kv, 2, axis=-1)
    qh = qm.reshape(b_, t_, MEM_HEADS, MEM_HEAD_DIM)
    km = km.reshape(b_, -1, MEM_HEADS, MEM_HEAD_DIM)
    vm = vm.reshape(b_, -1, MEM_HEADS, MEM_HEAD_DIM)
    s = jnp.einsum('bthd,bmhd->bhtm', qh, km).astype(f32) * (MEM_HEAD_DIM ** -0.5)
    p = jax.nn.softmax(s, axis=-1).astype(x.dtype)
    y_m = jnp.einsum('bhtm,bmhd->bthd', p, vm).reshape(b_, t_, MEM_WIDTH)

    gates = jax.nn.sigmoid(gl.reshape(b_, t_, N_BRANCH, D_MODEL))
    merged = (gates[:, :, 0] * (y_a @ w_br[0])
              + gates[:, :, 1] * (y_b @ w_br[1])
              + gates[:, :, 2] * (y_m @ w_br[2]))
    return merged @ w_o


def moe_ffn(x, w_router, b_router, w_gate_up, b_gate_up, w_down, b_down):
    b_, t_, d_ = x.shape
    n_tok = b_ * t_
    xt = x.reshape(n_tok, d_)
    logits = (xt @ w_router + b_router).astype(jnp.float32)
    top_logits, top_idx = lax.top_k(logits, TOP_K)
    top_w = jax.nn.softmax(top_logits, axis=-1).astype(x.dtype)
    n_assign = n_tok * TOP_K
    flat_e = top_idx.reshape(n_assign)
    flat_tok = jnp.arange(n_assign, dtype=jnp.int32) // TOP_K
    flat_w = top_w.reshape(n_assign)
    order = jnp.argsort(flat_e)
    sorted_e = flat_e[order]
    counts = jnp.bincount(flat_e, length=N_EXPERTS)
    padded = (counts + MOE_BLOCK - 1) // MOE_BLOCK * MOE_BLOCK
    pad_end = jnp.cumsum(padded)
    pad_start = pad_end - padded
    start = jnp.cumsum(counts) - counts
    dest = pad_start[sorted_e] + jnp.arange(n_assign, dtype=jnp.int32) - start[sorted_e]
    n_blocks = (n_assign + N_EXPERTS * (MOE_BLOCK - 1) + MOE_BLOCK - 1) // MOE_BLOCK
    n_slots = n_blocks * MOE_BLOCK
    slot_tok = jnp.zeros((n_slots,), jnp.int32).at[dest].set(flat_tok[order])
    slot_w = jnp.zeros((n_slots,), x.dtype).at[dest].set(flat_w[order])
    block_e = jnp.minimum(jnp.searchsorted(pad_end, jnp.arange(n_blocks) * MOE_BLOCK, side='right'),
                          N_EXPERTS - 1)

    def expert_block(args):
        tok, wgt, e = args
        xb = xt[tok]
        gu = xb @ w_gate_up[e] + b_gate_up[e]
        gate, up = jnp.split(gu, 2, axis=-1)
        gate = jnp.minimum(gate, SWIGLU_LIMIT)
        up = jnp.clip(up, -SWIGLU_LIMIT, SWIGLU_LIMIT)
        h = (up + 1.0) * (gate * jax.nn.sigmoid(gate * SWIGLU_ALPHA))
        return (h @ w_down[e] + b_down[e]) * wgt[:, None]

    ys = lax.map(expert_block, (slot_tok.reshape(n_blocks, MOE_BLOCK),
                                slot_w.reshape(n_blocks, MOE_BLOCK), block_e))
    out = jax.ops.segment_sum(ys.reshape(n_slots, d_), slot_tok, num_segments=n_tok)
    return out.reshape(b_, t_, d_)


def setup_inputs(seed: int = 0) -> dict:
    key = jax.random.key(seed)
    ks = jax.random.split(key, 24)
    f32 = jnp.float32
    L = DEPTH

    def nrm(k, shape, scale):
        return jax.random.normal(k, shape, f32) * scale

    dt = jnp.exp(jax.random.uniform(ks[7], (L, GDN_HEADS), f32, float(np.log(1e-3)), float(np.log(1e-1))))
    return {
        'x': nrm(ks[0], (BATCH, SEQ, D_MODEL), 1.0),
        'mem': nrm(ks[1], (BATCH, N_MEM, D_MODEL), 1.0),
        'ln0_g': 1.0 + nrm(ks[2], (D_MODEL,), 0.02),
        'ln0_b': nrm(ks[3], (D_MODEL,), 0.02),
        'w_in': nrm(ks[4], (L, D_MODEL, D_IN_PROJ), D_MODEL ** -0.5),
        'conv_qkv': nrm(ks[5], (L, GDN_CONV, 3 * GDN_WIDTH), GDN_CONV ** -0.5),
        'conv_mix': nrm(ks[6], (L, SHORT_CONV, CONV_WIDTH), SHORT_CONV ** -0.5),
        'a_log': jnp.log(jax.random.uniform(ks[8], (L, GDN_HEADS), f32, 1.0, 16.0)),
        'dt_bias': dt + jnp.log(-jnp.expm1(-dt)),
        'gdn_norm': 1.0 + nrm(ks[9], (L, GDN_HEAD_DIM), 0.02),
        'w_mem_kv': nrm(ks[10], (L, D_MODEL, 2 * MEM_WIDTH), D_MODEL ** -0.5),
        'w_br': nrm(ks[11], (L, N_BRANCH, GDN_WIDTH, D_MODEL), GDN_WIDTH ** -0.5),
        'w_o': nrm(ks[12], (L, D_MODEL, D_MODEL), DEEPNORM_BETA * D_MODEL ** -0.5),
        'ln1_g': 1.0 + nrm(ks[13], (L, D_MODEL), 0.02),
        'ln1_b': nrm(ks[14], (L, D_MODEL), 0.02),
        'w_router': nrm(ks[15], (L, D_MODEL, N_EXPERTS), D_MODEL ** -0.5),
        'b_router': nrm(ks[16], (L, N_EXPERTS), 0.01),
        'w_gate_up': nrm(ks[17], (L, N_EXPERTS, D_MODEL, 2 * D_FF_EXPERT), D_MODEL ** -0.5),
        'b_gate_up': nrm(ks[18], (L, N_EXPERTS, 2 * D_FF_EXPERT), 0.01),
        'w_down': nrm(ks[19], (L, N_EXPERTS, D_FF_EXPERT, D_MODEL), DEEPNORM_BETA * D_FF_EXPERT ** -0.5),
        'b_down': nrm(ks[20], (L, N_EXPERTS, D_MODEL), 0.01),
        'ln2_g': 1.0 + nrm(ks[21], (L, D_MODEL), 0.02),
        'ln2_b': nrm(ks[22], (L, D_MODEL), 0.02),
    }


def reference(x, mem, ln0_g, ln0_b, w_in, conv_qkv, conv_mix, a_log, dt_bias, gdn_norm,
              w_mem_kv, w_br, w_o, ln1_g, ln1_b, w_router, b_router, w_gate_up, b_gate_up,
              w_down, b_down, ln2_g, ln2_b):
    h = layer_norm(x, ln0_g, ln0_b)
    for l in range(DEPTH):
        mix = token_mixer(h, mem, w_in[l], conv_qkv[l], conv_mix[l], a_log[l], dt_bias[l],
                          gdn_norm[l], w_mem_kv[l], w_br[l], w_o[l])
        h = layer_norm(DEEPNORM_ALPHA * h + mix, ln1_g[l], ln1_b[l])
        ffn = moe_ffn(h, w_router[l], b_router[l], w_gate_up[l], b_gate_up[l], w_down[l], b_down[l])
        h = layer_norm(DEEPNORM_ALPHA * h + ffn, ln2_g[l], ln2_b[l])
    return h
```

```cpp
#include <hip/hip_runtime.h>
#include <cstdio>
#include <cstdint>

#ifndef MK_MULTI
#define MK_MULTI 0
#endif

#define LAS __attribute__((address_space(3)))
typedef unsigned short bf16;
typedef unsigned v4u __attribute__((ext_vector_type(4)));
typedef unsigned v2u __attribute__((ext_vector_type(2)));
typedef float f32x4 __attribute__((ext_vector_type(4)));
typedef float f32x2 __attribute__((ext_vector_type(2)));
typedef short bf16x8 __attribute__((ext_vector_type(8)));

constexpr int NB = 2, T = 16384, NTOK = NB * T, D = 1024, DEPTH = 2;
constexpr int NPROJ = 7168;
constexpr int NPROJ_SRC = 7176;
constexpr int C_Q = 0, C_K = 512, C_V = 1024, C_Z = 1536, C_XC = 2048, C_GB = 2560, C_GC = 3072, C_QM = 3584, C_GL = 4096;
constexpr int NMEM = 256, NE = 32, TOPK = 4, DFF = 1024;
constexpr int NSLOT_MAX = 544 * 256;
constexpr float ALPHA = 1.41421356237309515f;
constexpr float LN_EPS = 1e-5f, RMS_EPS = 1e-6f;

constexpr size_t MiB = 1u << 20;
constexpr size_t WS_CTL = 0, CTL_ZERO_BYTES = 1 * MiB;
constexpr size_t WS_WIN = 1 * MiB;
constexpr size_t WS_WBR = WS_WIN + 28 * MiB;
constexpr size_t WS_WO = WS_WBR + 6 * MiB;
constexpr size_t WS_WKV = WS_WO + 4 * MiB;
constexpr size_t WS_WGU = WS_WKV + 4 * MiB;
constexpr size_t WS_WD = WS_WGU + 256 * MiB;
constexpr size_t WS_MEMB = WS_WD + 128 * MiB;
constexpr size_t WS_KVB = WS_MEMB + 1 * MiB;
constexpr size_t WS_HF = WS_KVB + 1 * MiB;
constexpr size_t WS_HB = WS_HF + 128 * MiB;
constexpr size_t WS_AB = WS_HB + 64 * MiB;
constexpr size_t WS_R1 = WS_AB + 1 * MiB;
constexpr size_t WS_XS = WS_R1, WS_HBUF = WS_R1 + 272 * MiB;
constexpr size_t WS_KN = WS_R1 + 544 * MiB;
constexpr size_t WS_QN = WS_KN + 32 * MiB;
constexpr size_t WS_VV = WS_QN + 32 * MiB;
constexpr size_t WS_GS = WS_VV + 32 * MiB;
constexpr size_t WS_ATF = WS_GS + 2 * MiB;
constexpr size_t WS_BC = WS_ATF + 64 * MiB;
constexpr size_t WS_QTF = WS_BC + 64 * MiB;
constexpr size_t WS_OL = WS_QTF + 32 * MiB;
constexpr size_t WS_ST = WS_OL + 64 * MiB;
constexpr size_t WS_CD = WS_ST + 64 * MiB;
constexpr size_t WS_UPK = WS_CD + 1 * MiB;
constexpr size_t WS_WPK = WS_UPK + 32 * MiB;
constexpr size_t WS_YA = WS_WPK + 32 * MiB;
constexpr size_t WS_YB = WS_YA + 32 * MiB, WS_YM = WS_YB + 32 * MiB;
constexpr size_t WS_MF = WS_YM + 32 * MiB;
constexpr size_t WS_MB = WS_MF + 128 * MiB;
constexpr size_t WS_TOKE = WS_MB + 64 * MiB;
constexpr size_t WS_TOKW = WS_TOKE + MiB / 2;
constexpr size_t WS_TOKS = WS_TOKW + MiB / 2;
constexpr size_t WS_SLOTW = WS_TOKS + MiB / 2;
constexpr size_t WS_CNT = WS_SLOTW + 1 * MiB;
constexpr size_t WS_META = WS_CNT + MiB / 4;
constexpr size_t WS_SLOTT = WS_META + MiB / 4;
constexpr size_t WS_END = WS_SLOTT + 1 * MiB;
static_assert(WS_END <= (size_t)2048 * MiB, "workspace map exceeds 2 GiB");
constexpr int CW_BAR = 4096;

constexpr int LDS_BYTES = 159744;
constexpr int MISC_OFF = LDS_BYTES - 256;

#define GAS __attribute__((address_space(1)))
template <class Tp> __device__ __forceinline__ Tp* as_global(Tp* p) { GAS Tp* g = (GAS Tp*)p; asm("" : "+s"(g)); return (Tp*)g; }
#define LDS_WAIT() asm volatile("s_waitcnt lgkmcnt(0)" ::: "memory")
#define VM_WAIT() asm volatile("s_waitcnt vmcnt(0)" ::: "memory")
__device__ __forceinline__ unsigned cvt_pk_bf16(float lo, float hi) { unsigned r; asm volatile("v_cvt_pk_bf16_f32 %0, %1, %2" : "=v"(r) : "v"(lo), "v"(hi)); return r; }
__device__ __forceinline__ unsigned cvt_pk_bf16_n(float lo, float hi) { unsigned r; asm volatile("v_cvt_pk_bf16_f32 %0, %1, %2\n\ts_nop 1" : "=v"(r) : "v"(lo), "v"(hi)); return r; }
typedef __bf16 bf16x2_t __attribute__((ext_vector_type(2)));
__device__ __forceinline__ unsigned cvt_pk_nat(float lo, float hi) { bf16x2_t v; v[0] = (__bf16)lo; v[1] = (__bf16)hi; return __builtin_bit_cast(unsigned, v); }
__device__ __forceinline__ float bf_lo(unsigned w) { return __uint_as_float(w << 16); }
__device__ __forceinline__ float bf_hi(unsigned w) { return __uint_as_float(w & 0xffff0000u); }
__device__ __forceinline__ float fast_rcp(float x) { return __builtin_amdgcn_rcpf(x); }
__device__ __forceinline__ float sigmoidf_(float x) { return fast_rcp(1.0f + __expf(-x)); }
__device__ __forceinline__ float siluf_(float x) { return x * sigmoidf_(x); }
__device__ __forceinline__ float dpp_f(float v, int ctrl_sel) {
    const int s = __builtin_bit_cast(int, v); int r;
    if (ctrl_sel == 0) r = __builtin_amdgcn_update_dpp(0, s, 0xB1, 0xF, 0xF, true);
    else if (ctrl_sel == 1) r = __builtin_amdgcn_update_dpp(0, s, 0x4E, 0xF, 0xF, true);
    else if (ctrl_sel == 2) r = __builtin_amdgcn_update_dpp(0, s, 0x141, 0xF, 0xF, true);
    else r = __builtin_amdgcn_update_dpp(0, s, 0x140, 0xF, 0xF, true);
    return __builtin_bit_cast(float, r);
}
__device__ __forceinline__ float row16_sum(float v) {
    v += dpp_f(v, 0); v += dpp_f(v, 1); v += dpp_f(v, 2); v += dpp_f(v, 3); return v;
}
__device__ __forceinline__ float rdlane(float v, int l) { return __builtin_bit_cast(float, __builtin_amdgcn_readlane(__builtin_bit_cast(int, v), l)); }
__device__ __forceinline__ float wave_sum(float v) { v = row16_sum(v); return (rdlane(v, 0) + rdlane(v, 16)) + (rdlane(v, 32) + rdlane(v, 48)); }
__device__ __forceinline__ float bperm(float v, int src_lane) { return __builtin_bit_cast(float, __builtin_amdgcn_ds_bpermute(src_lane << 2, __builtin_bit_cast(int, v))); }

#define XB_TMO      128
#define XB_XCNT(j)  (256  + 64 * (j))
#define XB_XSUB(j)  (1280 + 64 * (j))
#define XB_XGEN(j)  (2304 + 64 * (j))
#define XB_TOP      3328
#define XB_TOPGEN   3392
#define XCD_BAR_WORDS 3456
#define XB_SPIN_CAP (1u << 18)
__device__ __forceinline__ unsigned xb_ld(unsigned* p)              { return __hip_atomic_load(p, __ATOMIC_RELAXED, __HIP_MEMORY_SCOPE_AGENT); }
__device__ __forceinline__ unsigned xb_add(unsigned* p, unsigned v) { return __hip_atomic_fetch_add(p, v, __ATOMIC_RELAXED, __HIP_MEMORY_SCOPE_AGENT); }
__device__ __forceinline__ unsigned xb_xcc_id() { return (unsigned)__builtin_amdgcn_s_getreg((3 << 11) | 20) & 0xFu; }
#define XB_SPIN(cond, bar) do { unsigned _sp = 0; while (cond) { __builtin_amdgcn_s_sleep(1); \
    if ((++_sp & 255u) == 0u) { if (xb_ld(&(bar)[XB_TMO])) break; if (_sp > XB_SPIN_CAP) { atomicAdd(&(bar)[XB_TMO], 1u); break; } } } } while (0)
struct XcdBarrier { unsigned* bar; unsigned x; volatile LAS unsigned* st; };
__device__ __forceinline__ XcdBarrier xcd_barrier_post(unsigned* bar, volatile LAS unsigned* st) {
    XcdBarrier b; b.bar = bar; b.x = xb_xcc_id(); b.st = st;
    if (threadIdx.x == 0) (void)xb_add(&bar[XB_XCNT(b.x)], 1u);
    return b;
}
__device__ __forceinline__ void xcd_barrier_complete(unsigned* bar, unsigned x, unsigned& nloc, unsigned& nx) {
    const unsigned G = gridDim.x * gridDim.y * gridDim.z;
    unsigned sum, cnt, mine, sp = 0u;
    for (;;) {
        sum = 0u; cnt = 0u; mine = 0u;
#pragma unroll
        for (unsigned j = 0; j < 16; ++j) { const unsigned c = xb_ld(&bar[XB_XCNT(j)]); sum += c; cnt += (c > 0u) ? 1u : 0u; mine = (j == x) ? c : mine; }
        if (sum == G) break;
        __builtin_amdgcn_s_sleep(1);
        if ((++sp & 255u) == 0u) { if (xb_ld(&bar[XB_TMO])) break; if (sp > XB_SPIN_CAP) { atomicAdd(&bar[XB_TMO], 1u); break; } }
    }
    nloc = mine > 0u ? mine : 1u; nx = cnt > 0u ? cnt : 1u;
}
__device__ __forceinline__ void xcd_barrier(const XcdBarrier& b) {
    asm volatile("s_waitcnt vmcnt(0)" ::: "memory");
    __syncthreads();
    if (threadIdx.x == 0) {
        unsigned* bar = b.bar;
        __builtin_amdgcn_s_waitcnt(0);
        unsigned nloc = b.st[0], nx = b.st[1];
        if (nloc == 0u) { xcd_barrier_complete(bar, b.x, nloc, nx); b.st[0] = nloc; b.st[1] = nx; }
        const unsigned old = xb_add(&bar[XB_XSUB(b.x)], 1u);
        const unsigned gen = old / nloc;
        if (old + 1u == (gen + 1u) * nloc) {
            __builtin_amdgcn_fence(__ATOMIC_RELEASE, "agent");
            asm volatile("s_waitcnt vmcnt(0)" ::: "memory");
            const unsigned og = xb_add(&bar[XB_TOP], 1u);
            const unsigned tg = og / nx;
            if (og + 1u == (tg + 1u) * nx) xb_add(&bar[XB_TOPGEN], 1u);
            else XB_SPIN(xb_ld(&bar[XB_TOPGEN]) == tg, bar);
            __builtin_amdgcn_fence(__ATOMIC_ACQUIRE, "agent");
            xb_add(&bar[XB_XGEN(b.x)], 1u);
            asm volatile("s_waitcnt vmcnt(0)" ::: "memory");
        } else {
            XB_SPIN(xb_ld(&bar[XB_XGEN(b.x)]) == gen, bar);
            __builtin_amdgcn_fence(__ATOMIC_ACQUIRE, "agent");
            asm volatile("s_waitcnt vmcnt(0)" ::: "memory");
        }
    }
    __syncthreads();
}

namespace pg8 {
constexpr int BM = 256, BK = 64, HALF = 128, HTB = HALF * BK * 2, STAGE_BYTES = 8 * HTB, NXCD = 8, WGM = 8;
__host__ __device__ __forceinline__ int lds_byte(int r, int c) { const int st = (r >> 4) * 2 + (c >> 5), rr = r & 15, cc = c & 31, ob = rr * 64 + cc * 2; return st * 1024 + (ob ^ (((ob >> 9) & 1) << 5)); }
__host__ __device__ __forceinline__ void stage_rc(int b, int& R, int& C) { const int st = b / 1024, sb = b % 1024, swz = sb ^ (((sb >> 9) & 1) << 5); R = (st >> 1) * 16 + swz / 64; C = (st & 1) * 32 + (swz % 64) / 2; }
__host__ __device__ __forceinline__ int perm32(int rho) { const int n = rho >> 4, i = rho & 15; return 8 * (i >> 2) + 4 * n + (i & 3); }

struct Unit { int pm, pn, e; const char* a; const char* b; };

__device__ __forceinline__ void tile_map(int L, int nM, int nN, int& pm, int& pn) {
    const int nwg = nM * nN; int wgid = L;
    { const int q = nwg / NXCD, r = nwg % NXCD, xcd = wgid % NXCD, off = wgid / NXCD; wgid = (xcd < r ? xcd * (q + 1) : r * (q + 1) + (xcd - r) * q) + off; }
    const int nig = WGM * nN, gid = wgid / nig, fm = gid * WGM, gsz = (nM - fm) < WGM ? (nM - fm) : WGM;
    pm = fm + ((wgid % nig) % gsz); pn = (wgid % nig) / gsz;
}
struct SchedDense {
    const char* A; const char* B; int nM, nN, G, c; size_t tstep;
    __device__ __forceinline__ bool next(int i, Unit& u) const {
        const long L = (long)i * G + c; if (L >= (long)nM * nN) return false;
        tile_map((int)L, nM, nN, u.pm, u.pn); u.e = 0; u.a = A + (size_t)u.pm * tstep; u.b = B + (size_t)u.pn * tstep; return true; }
    __device__ __forceinline__ int row_of(int, int) const { return 0; }
};
struct SchedBranch {
    const char* A0; const char* A1; const char* A2; const char* B; size_t bstride; int nM, nN, G, c, nb, b0, b1; size_t tstep;
    __device__ __forceinline__ bool next(int i, Unit& u) const {
        const int nwg = nM * nN, j = i % nb; const long Lr = (long)(i / nb) * G + c; if (Lr >= nwg) return false;
        const int br = (j == 0) ? b0 : b1;
        tile_map((int)Lr, nM, nN, u.pm, u.pn); u.e = br; u.a = (br == 0 ? A0 : (br == 1 ? A1 : A2)) + (size_t)u.pm * tstep; u.b = B + (size_t)br * bstride + (size_t)u.pn * tstep; return true; }
    __device__ __forceinline__ int row_of(int, int) const { return 0; }
};
struct SchedGrouped {
    const char* A; const char* B; size_t estride; const int* tile_e; int nM, nN, G, c; size_t tstep; const int* rows;
    __device__ __forceinline__ bool next(int i, Unit& u) const {
        const long L = (long)i * G + c; if (L >= (long)nM * nN) return false;
        tile_map((int)L, nM, nN, u.pm, u.pn); u.e = __builtin_amdgcn_readfirstlane(tile_e[u.pm]); u.a = rows ? A : A + (size_t)u.pm * tstep; u.b = B + (size_t)u.e * estride + (size_t)u.pn * tstep; return true; }
    __device__ __forceinline__ int row_of(int pm, int r) const { return rows[pm * BM + r]; }
};
struct EpiStoreBf16 {
    static constexpr bool PERM = true;
    bf16* O; int ldc;
    __device__ __forceinline__ void operator()(const f32x4 (&acc)[2][2][4][2], const Unit& u, int wr, int wc, int fr, int fq) const {
        const int row0 = u.pm * BM + wr * 64 + fr, col0 = u.pn * BM + wc * 32 + 8 * fq;
#pragma unroll
        for (int ai = 0; ai < 2; ++ai)
#pragma unroll
            for (int m = 0; m < 4; ++m) { bf16* rowp = O + (size_t)(row0 + ai * HALF + m * 16) * ldc + col0;
#pragma unroll
                for (int bj = 0; bj < 2; ++bj) { const f32x4 v0 = acc[ai][bj][m][0], v1 = acc[ai][bj][m][1];
                    v4u w; w.x = cvt_pk_bf16(v0[0], v0[1]); w.y = cvt_pk_bf16(v0[2], v0[3]); w.z = cvt_pk_bf16(v1[0], v1[1]); w.w = cvt_pk_bf16(v1[2], v1[3]);
                    *(v4u*)(rowp + bj * HALF) = w; } }
    }
};
struct EpiKV {
    static constexpr bool PERM = true;
    bf16* K; bf16* VT;
    __device__ __forceinline__ void operator()(const f32x4 (&acc)[2][2][4][2], const Unit& u, int wr, int wc, int fr, int fq) const {
        const int row0 = wr * 64 + fr, colt = u.pn * BM + wc * 32 + 8 * fq;
#pragma unroll
        for (int ai = 0; ai < 2; ++ai)
#pragma unroll
            for (int m = 0; m < 4; ++m) { const int key = row0 + ai * HALF + m * 16;
#pragma unroll
                for (int bj = 0; bj < 2; ++bj) { const f32x4 v0 = acc[ai][bj][m][0], v1 = acc[ai][bj][m][1]; const int col = colt + bj * HALF;
                    v4u w; w.x = cvt_pk_bf16(v0[0], v0[1]); w.y = cvt_pk_bf16(v0[2], v0[3]); w.z = cvt_pk_bf16(v1[0], v1[1]); w.w = cvt_pk_bf16(v1[2], v1[3]);
                    if (u.pn < 2) *(v4u*)(K + (size_t)(u.pm * BM + key) * 512 + col) = w;
                    else { bf16* d = VT + ((size_t)u.pm * 512 + (col - 512)) * 256 + key;
                        d[0] = (bf16)(w.x & 0xffff); d[256] = (bf16)(w.x >> 16); d[512] = (bf16)(w.y & 0xffff); d[768] = (bf16)(w.y >> 16);
                        d[1024] = (bf16)(w.z & 0xffff); d[1280] = (bf16)(w.z >> 16); d[1536] = (bf16)(w.w & 0xffff); d[1792] = (bf16)(w.w >> 16); } } }
    }
};
struct EpiBranch {
    static constexpr bool PERM = true;
    const bf16* proj; bf16* mb; int store_br;
    __device__ __forceinline__ void operator()(const f32x4 (&acc)[2][2][4][2], const Unit& u, int wr, int wc, int fr, int fq) const {
        const int row0 = u.pm * BM + wr * 64 + fr, col0 = u.pn * BM + wc * 32 + 8 * fq; const int br = u.e; const bool accum = (br != store_br);
        const bf16* gp = proj + (size_t)row0 * NPROJ + C_GL + br * D + col0; bf16* mp = mb + (size_t)row0 * D + col0;
#pragma unroll
        for (int ai = 0; ai < 2; ++ai) {
            v4u gw[4][2], ow[4][2];
#pragma unroll
            for (int m = 0; m < 4; ++m)
#pragma unroll
                for (int bj = 0; bj < 2; ++bj) { const size_t ro = (size_t)(ai * HALF + m * 16); const int co = bj * HALF;
                    gw[m][bj] = *(const v4u*)(gp + ro * NPROJ + co); ow[m][bj] = accum ? *(const v4u*)(mp + ro * D + co) : (v4u){0u, 0u, 0u, 0u}; }
#pragma unroll
            for (int m = 0; m < 4; ++m)
#pragma unroll
                for (int bj = 0; bj < 2; ++bj) { const size_t ro = (size_t)(ai * HALF + m * 16); const int co = bj * HALF; const v4u g4 = gw[m][bj], o = ow[m][bj];
                    const f32x4 a0 = acc[ai][bj][m][0], a1 = acc[ai][bj][m][1];
                    v4u w;
                    w.x = cvt_pk_bf16(sigmoidf_(bf_lo(g4.x)) * a0[0] + bf_lo(o.x), sigmoidf_(bf_hi(g4.x)) * a0[1] + bf_hi(o.x));
                    w.y = cvt_pk_bf16(sigmoidf_(bf_lo(g4.y)) * a0[2] + bf_lo(o.y), sigmoidf_(bf_hi(g4.y)) * a0[3] + bf_hi(o.y));
                    w.z = cvt_pk_bf16(sigmoidf_(bf_lo(g4.z)) * a1[0] + bf_lo(o.z), sigmoidf_(bf_hi(g4.z)) * a1[1] + bf_hi(o.z));
                    w.w = cvt_pk_bf16(sigmoidf_(bf_lo(g4.w)) * a1[2] + bf_lo(o.w), sigmoidf_(bf_hi(g4.w)) * a1[3] + bf_hi(o.w));
                    *(v4u*)(mp + ro * D + co) = w; }
        }
    }
};
struct EpiOut {
    static constexpr bool PERM = true;
    const bf16* hb; bf16* tb;
    __device__ __forceinline__ void operator()(const f32x4 (&acc)[2][2][4][2], const Unit& u, int wr, int wc, int fr, int fq) const {
        const int row0 = u.pm * BM + wr * 64 + fr, col0 = u.pn * BM + wc * 32 + 8 * fq;
        const bf16* hp = hb + (size_t)row0 * D + col0; bf16* tp = tb + (size_t)row0 * D + col0;
#pragma unroll
        for (int ai = 0; ai < 2; ++ai) {
            v4u hw[4][2];
#pragma unroll
            for (int m = 0; m < 4; ++m)
#pragma unroll
                for (int bj = 0; bj < 2; ++bj) hw[m][bj] = *(const v4u*)(hp + (size_t)(ai * HALF + m * 16) * D + bj * HALF);
#pragma unroll
            for (int m = 0; m < 4; ++m)
#pragma unroll
                for (int bj = 0; bj < 2; ++bj) { const v4u h = hw[m][bj]; const f32x4 a0 = acc[ai][bj][m][0], a1 = acc[ai][bj][m][1];
                    v4u w; w.x = cvt_pk_bf16(bf_lo(h.x) * ALPHA + a0[0], bf_hi(h.x) * ALPHA + a0[1]); w.y = cvt_pk_bf16(bf_lo(h.y) * ALPHA + a0[2], bf_hi(h.y) * ALPHA + a0[3]);
                    w.z = cvt_pk_bf16(bf_lo(h.z) * ALPHA + a1[0], bf_hi(h.z) * ALPHA + a1[1]); w.w = cvt_pk_bf16(bf_lo(h.w) * ALPHA + a1[2], bf_hi(h.w) * ALPHA + a1[3]);
                    *(v4u*)(tp + (size_t)(ai * HALF + m * 16) * D + bj * HALF) = w; }
        }
    }
};
struct EpiSwiglu {
    static constexpr bool PERM = true;
    bf16* H; const float* bgu;
    __device__ __forceinline__ void operator()(const f32x4 (&acc)[2][2][4][2], const Unit& u, int wr, int wc, int fr, int fq) const {
        const int row0 = u.pm * BM + wr * 64 + fr, cc0 = u.pn * HALF + wc * 32 + 8 * fq;
        const float* bg = bgu + (size_t)u.e * 2048 + cc0;
        f32x4 bgv[2], buv[2];
#pragma unroll
        for (int n = 0; n < 2; ++n) { bgv[n] = *(const f32x4*)(bg + 4 * n); buv[n] = *(const f32x4*)(bg + 1024 + 4 * n); }
#pragma unroll
        for (int ai = 0; ai < 2; ++ai)
#pragma unroll
            for (int m = 0; m < 4; ++m) { float h[8];
#pragma unroll
                for (int n = 0; n < 2; ++n)
#pragma unroll
                    for (int j = 0; j < 4; ++j) { float g = acc[ai][0][m][n][j] + bgv[n][j], up = acc[ai][1][m][n][j] + buv[n][j];
                        g = fminf(g, 7.0f); up = fminf(fmaxf(up, -7.0f), 7.0f);
                        h[n * 4 + j] = (up + 1.0f) * (g * sigmoidf_(g * 1.702f)); }
                v4u w; w.x = cvt_pk_bf16(h[0], h[1]); w.y = cvt_pk_bf16(h[2], h[3]); w.z = cvt_pk_bf16(h[4], h[5]); w.w = cvt_pk_bf16(h[6], h[7]);
                *(v4u*)(H + (size_t)(row0 + ai * HALF + m * 16) * DFF + cc0) = w; }
    }
};
struct EpiDown {
    static constexpr bool PERM = true;
    bf16* Y; const float* bd; const float* slot_w;
    __device__ __forceinline__ void operator()(const f32x4 (&acc)[2][2][4][2], const Unit& u, int wr, int wc, int fr, int fq) const {
        const int row0 = u.pm * BM + wr * 64 + fr, col0 = u.pn * BM + wc * 32 + 8 * fq;
        const float* bp = bd + (size_t)u.e * D + col0;
        f32x4 bv[2][2];
#pragma unroll
        for (int bj = 0; bj < 2; ++bj)
#pragma unroll
            for (int n = 0; n < 2; ++n) bv[bj][n] = *(const f32x4*)(bp + bj * HALF + 4 * n);
#pragma unroll
        for (int ai = 0; ai < 2; ++ai)
#pragma unroll
            for (int m = 0; m < 4; ++m) { const int row = row0 + ai * HALF + m * 16; const float sw = slot_w[row]; bf16* rowp = Y + (size_t)row * D + col0;
#pragma unroll
                for (int bj = 0; bj < 2; ++bj) { const f32x4 v0 = (acc[ai][bj][m][0] + bv[bj][0]) * sw, v1 = (acc[ai][bj][m][1] + bv[bj][1]) * sw;
                    v4u w; w.x = cvt_pk_bf16(v0[0], v0[1]); w.y = cvt_pk_bf16(v0[2], v0[3]); w.z = cvt_pk_bf16(v1[0], v1[1]); w.w = cvt_pk_bf16(v1[2], v1[3]);
                    *(v4u*)(rowp + bj * HALF) = w; } }
    }
};

template <class Epi, class Sched, bool ALIGN_EPI, bool SP2, bool GATHER = false>
__device__ __forceinline__ void gemm_phase(LAS unsigned char* lds, const int K, const Sched& S, const Epi& E, int wave_id) {
    unsigned z0_ = 0u; asm volatile("" : "+s"(z0_)); int ln_ = (int)__builtin_amdgcn_mbcnt_hi(~0u, __builtin_amdgcn_mbcnt_lo(~0u, z0_)); asm volatile("" : "+v"(ln_)); asm volatile("" : "+s"(wave_id));
    const int wid = wave_id, lane = ln_, tid = wid * 64 + lane, wr = wid >> 2, wc = wid & 3, fr = lane & 15, fq = lane >> 4;
    const int nt = K / BK;
    static_assert(!GATHER || SP2, "row gather is written for the two-super-phase loop");
    unsigned voffA[2], voffB[2], gC[2]; int gR[2];
    unsigned vAc[2][2], vAn[2][2];
#define PG8_ROWS(dst, pm_) do { _Pragma("unroll") for (int h_ = 0; h_ < 2; ++h_) _Pragma("unroll") for (int i_ = 0; i_ < 2; ++i_) dst[h_][i_] = (unsigned)S.row_of(pm_, h_ * HALF + gR[i_]) * (unsigned)(K * 2) + gC[i_]; } while (0)
#define PG8_STAGE_A(bufoff, gbase, h, OFF) do { if constexpr (GATHER) { PG8_STAGE(bufoff, gbase, OFF[h]); } else { PG8_STAGE(bufoff, (gbase) + (h) * hstep, voffA); } } while (0)
#pragma unroll
    for (int i = 0; i < 2; ++i) { int R, C; stage_rc(tid * 16 + i * 8192, R, C); const int Rb = Epi::PERM ? ((R & ~31) + perm32(R & 31)) : R;
        voffA[i] = (unsigned)(R * K + C) * 2u; voffB[i] = (unsigned)(Rb * K + C) * 2u; gR[i] = R; gC[i] = (unsigned)C * 2u; }
    const size_t kstep = (size_t)(BK * 2);
    const size_t hstep = (size_t)HALF * K * 2;
    const unsigned ldsw = (unsigned)wid * 1024u;
    const int aoff = lds_byte(wr * 64 + fr, fq * 8), boff = lds_byte(wc * 32 + fr, fq * 8);
#define PG8_SA(b, h) (((b) * 2 + (h)) * HTB)
#define PG8_SB(b, h) ((4 + (b) * 2 + (h)) * HTB)
#define PG8_STAGE(bufoff, gbase, voff) do { _Pragma("unroll") for (int _i = 0; _i < 2; ++_i) \
        __builtin_amdgcn_global_load_lds((const unsigned*)((const char*)(gbase) + (voff)[_i]), (LAS unsigned*)(lds + (bufoff) + ldsw + _i * 8192), 16, 0, 0); } while (0)
#define PG8_LDA(dst, b, h) do { _Pragma("unroll") for (int m = 0; m < 4; ++m) _Pragma("unroll") for (int k = 0; k < 2; ++k) dst[m][k] = *(const LAS bf16x8*)(lds + PG8_SA(b, h) + aoff + m * 2048 + k * 1024); } while (0)
#define PG8_LDB(dst, b, h) do { _Pragma("unroll") for (int n = 0; n < 2; ++n) _Pragma("unroll") for (int k = 0; k < 2; ++k) dst[n][k] = *(const LAS bf16x8*)(lds + PG8_SB(b, h) + boff + n * 2048 + k * 1024); } while (0)
#define PG8_MMA(ai, bj, At, Bt) do { __builtin_amdgcn_s_setprio(1); _Pragma("unroll") for (int m = 0; m < 4; ++m) _Pragma("unroll") for (int n = 0; n < 2; ++n) _Pragma("unroll") for (int k = 0; k < 2; ++k) \
        acc[ai][bj][m][n] = __builtin_amdgcn_mfma_f32_16x16x32_bf16(Bt[n][k], At[m][k], acc[ai][bj][m][n], 0, 0, 0); __builtin_amdgcn_s_setprio(0); } while (0)
#define PG8_WAIT_V(n) asm volatile("s_waitcnt vmcnt(" #n ")" ::: "memory")
#define PG8_WAIT_L(n) asm volatile("s_waitcnt lgkmcnt(" #n ")" ::: "memory")
#define PG8_BAR __builtin_amdgcn_s_barrier()
#define PG8_SCHED __builtin_amdgcn_sched_barrier(0)
    Unit cur, nxt; int ui = 0;
    if (!S.next(0, cur)) return;
    f32x4 acc[2][2][4][2];
#pragma unroll
    for (int a = 0; a < 2; ++a)
#pragma unroll
        for (int b = 0; b < 2; ++b)
#pragma unroll
            for (int m = 0; m < 4; ++m)
#pragma unroll
                for (int n = 0; n < 2; ++n) acc[a][b][m][n] = (f32x4){0.f, 0.f, 0.f, 0.f};
    bf16x8 At[4][2], B0[2][2], B1[2][2];
    const char* cA = cur.a; const char* cB = cur.b;
    if constexpr (SP2) {
        if constexpr (GATHER) { PG8_ROWS(vAc, cur.pm); asm volatile("s_waitcnt vmcnt(0)" ::: "memory"); }
        PG8_STAGE(PG8_SB(0, 0), cB, voffB); PG8_STAGE(PG8_SB(0, 1), cB + hstep, voffB); PG8_STAGE_A(PG8_SA(0, 0), cA, 0, vAc); PG8_STAGE_A(PG8_SA(0, 1), cA, 1, vAc);
        if (wr == 1) PG8_BAR;
        PG8_WAIT_V(2); PG8_BAR;
        PG8_STAGE(PG8_SB(1, 0), cB + kstep, voffB); PG8_STAGE_A(PG8_SA(1, 0), cA + kstep, 0, vAc); PG8_STAGE(PG8_SB(1, 1), cB + hstep + kstep, voffB);
        PG8_WAIT_V(6); PG8_BAR;
    } else {
        PG8_STAGE(PG8_SB(0, 0), cB, voffB); PG8_STAGE(PG8_SA(0, 0), cA, voffA); PG8_STAGE(PG8_SB(0, 1), cB + hstep, voffB); PG8_STAGE(PG8_SA(0, 1), cA + hstep, voffA);
        if (wr == 1) PG8_BAR;
        PG8_WAIT_V(4); PG8_BAR;
        PG8_STAGE(PG8_SB(1, 0), cB + kstep, voffB); PG8_STAGE(PG8_SA(1, 0), cA + kstep, voffA); PG8_STAGE(PG8_SB(1, 1), cB + hstep + kstep, voffB);
        PG8_WAIT_V(6); PG8_BAR;
    }
    for (;;) {
        const bool has_next = S.next(ui + 1, nxt);
        const char* nA = has_next ? nxt.a : cA; const char* nB = has_next ? nxt.b : cB;
        if constexpr (GATHER) { if (ui == 0) { if (has_next) PG8_ROWS(vAn, nxt.pm); else { _Pragma("unroll") for (int h_ = 0; h_ < 2; ++h_) _Pragma("unroll") for (int i_ = 0; i_ < 2; ++i_) vAn[h_][i_] = vAc[h_][i_]; } } }
        for (int t = 0; t < nt; t += 2) {
            const bool last = (t == nt - 2);
            const char* a1 = cA + (size_t)(t + 1) * kstep;
            const char* a2 = last ? nA : cA + (size_t)(t + 2) * kstep; const char* b2 = last ? nB : cB + (size_t)(t + 2) * kstep;
            const char* a3 = a2 + kstep; const char* b3 = b2 + kstep;
            if constexpr (SP2) {
            unsigned o2[2][2];
            if constexpr (GATHER) { _Pragma("unroll") for (int h_ = 0; h_ < 2; ++h_) _Pragma("unroll") for (int i_ = 0; i_ < 2; ++i_) o2[h_][i_] = last ? vAn[h_][i_] : vAc[h_][i_]; }
            PG8_LDB(B0, 0, 0); PG8_LDB(B1, 0, 1); PG8_SCHED; PG8_LDA(At, 0, 0); PG8_STAGE_A(PG8_SA(1, 1), a1, 1, vAc);
            PG8_WAIT_V(8); PG8_WAIT_L(0); PG8_BAR; PG8_MMA(0, 0, At, B0); PG8_MMA(0, 1, At, B1); PG8_BAR; PG8_SCHED;
            PG8_LDA(At, 0, 1); PG8_STAGE(PG8_SB(0, 0), b2, voffB); PG8_STAGE(PG8_SB(0, 1), b2 + hstep, voffB); PG8_STAGE_A(PG8_SA(0, 0), a2, 0, o2);
            PG8_WAIT_V(8); PG8_WAIT_L(0); PG8_BAR; PG8_MMA(1, 0, At, B0); PG8_MMA(1, 1, At, B1); PG8_BAR; PG8_SCHED;
            PG8_LDB(B0, 1, 0); PG8_LDB(B1, 1, 1); PG8_SCHED; PG8_LDA(At, 1, 0); PG8_STAGE_A(PG8_SA(0, 1), a2, 1, o2);
            PG8_WAIT_V(8); PG8_WAIT_L(0); PG8_BAR; PG8_MMA(0, 0, At, B0); PG8_MMA(0, 1, At, B1); PG8_BAR; PG8_SCHED;
            PG8_LDA(At, 1, 1); PG8_STAGE(PG8_SB(1, 0), b3, voffB); PG8_STAGE(PG8_SB(1, 1), b3 + hstep, voffB); PG8_STAGE_A(PG8_SA(1, 0), a3, 0, o2);
            PG8_WAIT_V(8); PG8_WAIT_L(0); PG8_BAR; PG8_MMA(1, 0, At, B0); PG8_MMA(1, 1, At, B1); PG8_BAR; PG8_SCHED;
            } else {
            PG8_LDB(B0, 0, 0); PG8_SCHED; PG8_LDA(At, 0, 0); PG8_STAGE(PG8_SA(1, 1), a1 + hstep, voffA);
            PG8_WAIT_L(8); PG8_BAR; PG8_WAIT_L(0); PG8_MMA(0, 0, At, B0); PG8_BAR; PG8_SCHED;
            PG8_LDB(B1, 0, 1); PG8_STAGE(PG8_SB(0, 0), b2, voffB);
            PG8_BAR; PG8_WAIT_L(0); PG8_MMA(0, 1, At, B1); PG8_BAR;
            PG8_LDA(At, 0, 1); PG8_STAGE(PG8_SA(0, 0), a2, voffA);
            PG8_BAR; PG8_WAIT_L(0); PG8_MMA(1, 0, At, B0); PG8_BAR; PG8_SCHED;
            PG8_STAGE(PG8_SB(0, 1), b2 + hstep, voffB);
            PG8_WAIT_V(6); PG8_BAR; PG8_MMA(1, 1, At, B1); PG8_BAR;
            PG8_LDB(B0, 1, 0); PG8_SCHED; PG8_LDA(At, 1, 0); PG8_STAGE(PG8_SA(0, 1), a2 + hstep, voffA);
            PG8_WAIT_L(8); PG8_BAR; PG8_WAIT_L(0); PG8_MMA(0, 0, At, B0); PG8_BAR; PG8_SCHED;
            PG8_LDB(B1, 1, 1); PG8_STAGE(PG8_SB(1, 0), b3, voffB);
            PG8_BAR; PG8_WAIT_L(0); PG8_MMA(0, 1, At, B1); PG8_BAR;
            PG8_LDA(At, 1, 1); PG8_STAGE(PG8_SA(1, 0), a3, voffA);
            PG8_BAR; PG8_WAIT_L(0); PG8_MMA(1, 0, At, B0); PG8_BAR; PG8_SCHED;
            PG8_STAGE(PG8_SB(1, 1), b3 + hstep, voffB);
            PG8_WAIT_V(6); PG8_BAR; PG8_MMA(1, 1, At, B1); PG8_BAR;
            }
        }
        if constexpr (ALIGN_EPI) { if (wr == 0) PG8_BAR; }
        E(acc, cur, wr, wc, fr, fq);
        if (!has_next) break;
#pragma unroll
        for (int a = 0; a < 2; ++a)
#pragma unroll
            for (int b = 0; b < 2; ++b)
#pragma unroll
                for (int m = 0; m < 4; ++m)
#pragma unroll
                    for (int n = 0; n < 2; ++n) acc[a][b][m][n] = (f32x4){0.f, 0.f, 0.f, 0.f};
        if constexpr (GATHER) { _Pragma("unroll") for (int h_ = 0; h_ < 2; ++h_) _Pragma("unroll") for (int i_ = 0; i_ < 2; ++i_) vAc[h_][i_] = vAn[h_][i_];
            Unit nn; if (S.next(ui + 2, nn)) PG8_ROWS(vAn, nn.pm); }
        cur = nxt; cA = nA; cB = nB; ++ui;
        if constexpr (ALIGN_EPI) { if (wr == 1) PG8_BAR; }
    }
    PG8_WAIT_V(0);
    if constexpr (!ALIGN_EPI) { if (wr == 0) PG8_BAR; }
    PG8_BAR;
#undef PG8_ROWS
#undef PG8_STAGE_A
#undef PG8_SA
#undef PG8_SB
#undef PG8_STAGE
#undef PG8_LDA
#undef PG8_LDB
#undef PG8_MMA
#undef PG8_WAIT_V
#undef PG8_WAIT_L
#undef PG8_BAR
#undef PG8_SCHED
}
}

struct Args { const float* in[23]; float* out; unsigned char* ws; int ph_lo, ph_hi; };
struct Ctx {
    LAS unsigned char* lds; int tid, lane, wave, G, bid;
    const float* const* in; float* out; unsigned char* ws;
};
__device__ __forceinline__ Ctx fresh(const Ctx& F) {
    Ctx R = F; unsigned z0 = 0u; asm volatile("" : "+s"(z0)); int ln = (int)__builtin_amdgcn_mbcnt_hi(~0u, __builtin_amdgcn_mbcnt_lo(~0u, z0)); asm volatile("" : "+v"(ln));
    int wv = F.wave; asm volatile("" : "+s"(wv)); R.wave = wv; R.lane = ln; R.tid = wv * 64 + ln;
    unsigned char* w = F.ws; asm volatile("" : "+s"(w)); R.ws = as_global(w); R.out = as_global(F.out);
    int bd = F.bid, gg = F.G; asm volatile("" : "+s"(bd)); asm volatile("" : "+s"(gg)); R.bid = bd; R.G = gg;
    return R;
}
enum { I_X = 0, I_MEM, I_LN0G, I_LN0B, I_WIN, I_CONVQKV, I_CONVMIX, I_ALOG, I_DTB, I_GDNNORM, I_WMEMKV, I_WBR, I_WO, I_LN1G, I_LN1B, I_WR, I_BR, I_WGU, I_BGU, I_WD, I_BD, I_LN2G, I_LN2B };

__device__ __forceinline__ void transpose_item(const float* src, int ld, bf16* dst, int ldk, LAS float* scr, int lane) {
#pragma unroll 8
    for (int i = 0; i < 32; ++i) { const int kk = 2 * i + (lane >> 5); scr[kk * 33 + (lane & 31)] = src[(size_t)kk * ld + (lane & 31)]; }
    LDS_WAIT();
    const int c = lane & 7;
#pragma unroll
    for (int j = 0; j < 4; ++j) { const int n = (lane >> 3) + 8 * j; const LAS float* s = scr + (8 * c) * 33 + n;
        v4u o; o.x = cvt_pk_bf16(s[0 * 33], s[1 * 33]); o.y = cvt_pk_bf16(s[2 * 33], s[3 * 33]); o.z = cvt_pk_bf16(s[4 * 33], s[5 * 33]); o.w = cvt_pk_bf16(s[6 * 33], s[7 * 33]);
        *(v4u*)(dst + (size_t)n * ldk + 8 * c) = o; }
    LDS_WAIT();
}
__device__ __forceinline__ void ln_apply(f32x4 (&v)[4], const float* g, const float* b, int lane) {
    float s = 0.f;
#pragma unroll
    for (int j = 0; j < 4; ++j) s += (v[j][0] + v[j][1]) + (v[j][2] + v[j][3]);
    const float mean = wave_sum(s) * (1.f / D); float s2 = 0.f;
#pragma unroll
    for (int j = 0; j < 4; ++j) { v[j] = v[j] - mean; s2 += (v[j][0] * v[j][0] + v[j][1] * v[j][1]) + (v[j][2] * v[j][2] + v[j][3] * v[j][3]); }
    const float rstd = 1.f / sqrtf(wave_sum(s2) * (1.f / D) + LN_EPS);
#pragma unroll
    for (int j = 0; j < 4; ++j) { const f32x4 gg = *(const f32x4*)(g + 4 * lane + 256 * j), bb = *(const f32x4*)(b + 4 * lane + 256 * j); v[j] = v[j] * rstd * gg + bb; }
}
__device__ __forceinline__ void load_row_bf16(const bf16* p, f32x4 (&v)[4], int lane) {
#pragma unroll
    for (int j = 0; j < 4; ++j) { const v2u w = *(const v2u*)(p + 4 * lane + 256 * j); v[j] = (f32x4){bf_lo(w.x), bf_hi(w.x), bf_lo(w.y), bf_hi(w.y)}; }
}
__device__ __forceinline__ void store_row_f32(float* p, const f32x4 (&v)[4], int lane) {
#pragma unroll
    for (int j = 0; j < 4; ++j) *(f32x4*)(p + 4 * lane + 256 * j) = v[j];
}
__device__ __forceinline__ void store_row_bf16(bf16* p, const f32x4 (&v)[4], int lane) {
#pragma unroll
    for (int j = 0; j < 4; ++j) { v2u w; w.x = cvt_pk_bf16(v[j][0], v[j][1]); w.y = cvt_pk_bf16(v[j][2], v[j][3]); *(v2u*)(p + 4 * lane + 256 * j) = w; }
}
__device__ __forceinline__ void small_proj(const f32x4 (&v)[4], const LAS float* ws_s, float* ab_row, int lane) {
    float keep = 0.f;
#pragma unroll
    for (int c = 0; c < 8; ++c) { float p = 0.f;
#pragma unroll
        for (int j = 0; j < 4; ++j) { const f32x4 w = *(const LAS f32x4*)(ws_s + c * 1024 + 4 * lane + 256 * j); p += (v[j][0] * w[0] + v[j][1] * w[1]) + (v[j][2] * w[2] + v[j][3] * w[3]); }
        p = wave_sum(p); keep = (lane == c) ? p : keep; }
    if (lane < 8) ab_row[lane] = keep;
}
__device__ __forceinline__ void load_small_w(Ctx& F, int l, LAS float* ws_s) {
    const float* w = as_global(F.in[I_WIN]) + (size_t)l * D * NPROJ_SRC + 1536;
    for (int i = F.tid; i < 8 * 1024; i += 512) { const int k = i >> 3, c = i & 7; ws_s[c * 1024 + k] = w[(size_t)k * NPROJ_SRC + c]; }
}

__device__ __forceinline__ void phase_prologue(Ctx& F) {
    LAS float* scr = (LAS float*)(F.lds + F.wave * 8448);
    LAS float* ws_s = (LAS float*)(F.lds + 69632);
    const int gw = F.bid * 8 + F.wave, NGW = F.G * 8;
    bf16* WinT = (bf16*)(F.ws + WS_WIN); bf16* WbrT = (bf16*)(F.ws + WS_WBR); bf16* WoT = (bf16*)(F.ws + WS_WO); bf16* WkvT = (bf16*)(F.ws + WS_WKV);
    bf16* WguT = (bf16*)(F.ws + WS_WGU); bf16* WdT = (bf16*)(F.ws + WS_WD);
    constexpr int N_IN = 2 * 3584, N_BR = 6 * 256, N_O = 2 * 512, N_KV = 2 * 512, N_GU = 64 * 1024, N_D = 64 * 512;
    constexpr int NITEMS = N_IN + N_BR + N_O + N_KV + N_GU + N_D;
    for (int it = gw; it < NITEMS; it += NGW) {
        int r = it;
        if (r < N_IN) { const int l = r / 3584, q = r % 3584, kb = q / 224, nb = q % 224, k0 = 64 * kb, n0 = 32 * nb, ns = n0 + (n0 >= 1536 ? 8 : 0);
            transpose_item(as_global(F.in[I_WIN]) + (size_t)l * D * NPROJ_SRC + (size_t)k0 * NPROJ_SRC + ns, NPROJ_SRC, WinT + (size_t)l * NPROJ * D + (size_t)n0 * D + k0, D, scr, F.lane); continue; }
        r -= N_IN;
        if (r < N_BR) { const int m = r / 256, q = r % 256, kb = q / 32, nb = q % 32, k0 = 64 * kb, n0 = 32 * nb;
            transpose_item(as_global(F.in[I_WBR]) + (size_t)m * 512 * D + (size_t)k0 * D + n0, D, WbrT + (size_t)m * D * 512 + (size_t)n0 * 512 + k0, 512, scr, F.lane); continue; }
        r -= N_BR;
        if (r < N_O) { const int l = r / 512, q = r % 512, kb = q / 32, nb = q % 32, k0 = 64 * kb, n0 = 32 * nb;
            transpose_item(as_global(F.in[I_WO]) + (size_t)l * D * D + (size_t)k0 * D + n0, D, WoT + (size_t)l * D * D + (size_t)n0 * D + k0, D, scr, F.lane); continue; }
        r -= N_O;
        if (r < N_KV) { const int l = r / 512, q = r % 512, kb = q / 32, nb = q % 32, k0 = 64 * kb, n0 = 32 * nb;
            transpose_item(as_global(F.in[I_WMEMKV]) + (size_t)l * D * D + (size_t)k0 * D + n0, D, WkvT + (size_t)l * D * D + (size_t)n0 * D + k0, D, scr, F.lane); continue; }
        r -= N_KV;
        if (r < N_GU) { const int m = r / 1024, q = r % 1024, blk = q >> 3, j8 = q & 7, nb = (blk % 16) * 4 + (j8 >> 1), kb = (blk / 16) * 2 + (j8 & 1), k0 = 64 * kb, n0 = 32 * nb, jj = n0 / 256, r0 = n0 % 256;
            const int ns = (r0 < 128) ? (128 * jj + r0) : (1024 + 128 * jj + r0 - 128);
            transpose_item(as_global(F.in[I_WGU]) + (size_t)m * D * 2048 + (size_t)k0 * 2048 + ns, 2048, WguT + (size_t)m * 2048 * D + (size_t)n0 * D + k0, D, scr, F.lane); continue; }
        r -= N_GU;
        { const int m = r / 512, q = r % 512, blk = q >> 3, j8 = q & 7, nb = (blk % 8) * 4 + (j8 >> 1), kb = (blk / 8) * 2 + (j8 & 1), k0 = 64 * kb, n0 = 32 * nb;
            transpose_item(as_global(F.in[I_WD]) + (size_t)m * D * D + (size_t)k0 * D + n0, D, WdT + (size_t)m * D * D + (size_t)n0 * D + k0, D, scr, F.lane); }
    }
    { const f32x4* src = (const f32x4*)as_global(F.in[I_MEM]); v2u* dst = (v2u*)(F.ws + WS_MEMB);
      for (int i = F.bid * 512 + F.tid; i < NB * NMEM * D / 4; i += F.G * 512) { const f32x4 x = src[i]; v2u w; w.x = cvt_pk_bf16(x[0], x[1]); w.y = cvt_pk_bf16(x[2], x[3]); dst[i] = w; } }
    load_small_w(F, 0, ws_s);
    __syncthreads();
    bf16* hb = (bf16*)(F.ws + WS_HB); float* ab = (float*)(F.ws + WS_AB);
    for (int m = gw; m < NTOK; m += NGW) {
        f32x4 v[4]; const float* xr = as_global(F.in[I_X]) + (size_t)m * D;
#pragma unroll
        for (int j = 0; j < 4; ++j) v[j] = *(const f32x4*)(xr + 4 * F.lane + 256 * j);
        ln_apply(v, as_global(F.in[I_LN0G]), as_global(F.in[I_LN0B]), F.lane);
        store_row_bf16(hb + (size_t)m * D, v, F.lane);
        small_proj(v, ws_s, ab + (size_t)m * 8, F.lane);
    }
}

__device__ __forceinline__ void unpack8(const v4u x, float (&o)[8]) { o[0] = bf_lo(x.x); o[1] = bf_hi(x.x); o[2] = bf_lo(x.y); o[3] = bf_hi(x.y); o[4] = bf_lo(x.z); o[5] = bf_hi(x.z); o[6] = bf_lo(x.w); o[7] = bf_hi(x.w); }
__device__ __forceinline__ void conv4_silu(const v4u x0, const v4u x1, const v4u x2, const v4u x3, const LAS float* w  , float (&o)[8]) {
    float a[8], b[8], c[8], d[8]; unpack8(x0, a); unpack8(x1, b); unpack8(x2, c); unpack8(x3, d);
    const f32x4 w0l = *(const LAS f32x4*)(w), w0h = *(const LAS f32x4*)(w + 4), w1l = *(const LAS f32x4*)(w + 1536), w1h = *(const LAS f32x4*)(w + 1540);
    const f32x4 w2l = *(const LAS f32x4*)(w + 3072), w2h = *(const LAS f32x4*)(w + 3076), w3l = *(const LAS f32x4*)(w + 4608), w3h = *(const LAS f32x4*)(w + 4612);
#pragma unroll
    for (int i = 0; i < 8; ++i) { const float w0 = i < 4 ? w0l[i & 3] : w0h[i & 3], w1 = i < 4 ? w1l[i & 3] : w1h[i & 3], w2 = i < 4 ? w2l[i & 3] : w2h[i & 3], w3 = i < 4 ? w3l[i & 3] : w3h[i & 3];
        const float s = (w0 * a[i] + w1 * b[i]) + (w2 * c[i] + w3 * d[i]); o[i] = siluf_(s); }
}
__device__ __forceinline__ void phase_prep(Ctx& F, int l) {
    const bf16* proj = (const bf16*)(F.ws + WS_R1);
    LAS float* cw = (LAS float*)F.lds;
    LAS float* mw = (LAS float*)(F.lds + 4 * 1536 * 4);
    for (int i = F.tid; i < 4 * 1536; i += 512) cw[i] = as_global(F.in[I_CONVQKV])[(size_t)l * 4 * 1536 + i];
    for (int i = F.tid; i < 3 * 512; i += 512) mw[i] = as_global(F.in[I_CONVMIX])[(size_t)l * 3 * 512 + i];
    __syncthreads();
    const int lane = F.lane, c8 = lane * 8, hh = lane >> 4;
    bf16* qnb = (bf16*)(F.ws + WS_QN); bf16* knb = (bf16*)(F.ws + WS_KN); bf16* vvb = (bf16*)(F.ws + WS_VV); float* gs = (float*)(F.ws + WS_GS);
    const float* ab = (const float*)(F.ws + WS_AB); bf16* yb = (bf16*)(F.ws + WS_YB);
    const float Ah = __expf(as_global(F.in[I_ALOG])[l * 4 + hh]), dtb = as_global(F.in[I_DTB])[l * 4 + hh];
    const int gw = F.bid * 8 + F.wave, NGW = F.G * 8;
    for (int t0 = gw * 16; t0 < NTOK; t0 += NGW * 16) {
        const bool first = (t0 % T) == 0;
        const v4u z4 = {0u, 0u, 0u, 0u};
        v4u q0, q1, q2, k0, k1, k2, v0, v1, v2; float p0[8], p1[8];
        if (first) { q0 = q1 = q2 = k0 = k1 = k2 = v0 = v1 = v2 = z4;
#pragma unroll
            for (int i = 0; i < 8; ++i) { p0[i] = 0.f; p1[i] = 0.f; } }
        else {
            const bf16* r3 = proj + (size_t)(t0 - 3) * NPROJ + c8; const bf16* r2 = r3 + NPROJ; const bf16* r1 = r2 + NPROJ;
            q0 = *(const v4u*)(r3 + C_Q); q1 = *(const v4u*)(r2 + C_Q); q2 = *(const v4u*)(r1 + C_Q);
            k0 = *(const v4u*)(r3 + C_K); k1 = *(const v4u*)(r2 + C_K); k2 = *(const v4u*)(r1 + C_K);
            v0 = *(const v4u*)(r3 + C_V); v1 = *(const v4u*)(r2 + C_V); v2 = *(const v4u*)(r1 + C_V);
            float a[8], b[8]; unpack8(*(const v4u*)(r2 + C_XC), a); unpack8(*(const v4u*)(r2 + C_GC), b);
#pragma unroll
            for (int i = 0; i < 8; ++i) p0[i] = a[i] * b[i];
            unpack8(*(const v4u*)(r1 + C_XC), a); unpack8(*(const v4u*)(r1 + C_GC), b);
#pragma unroll
            for (int i = 0; i < 8; ++i) p1[i] = a[i] * b[i];
        }
        v4u nq, nk, nv, nxc, ngc, ngb; float na = 0.f, nbt = 0.f;
        { const bf16* rn = proj + (size_t)t0 * NPROJ + c8; nq = *(const v4u*)(rn + C_Q); nk = *(const v4u*)(rn + C_K); nv = *(const v4u*)(rn + C_V); nxc = *(const v4u*)(rn + C_XC); ngc = *(const v4u*)(rn + C_GC); ngb = *(const v4u*)(rn + C_GB);
          if ((lane & 15) == 0) { na = ab[(size_t)t0 * 8 + hh]; nbt = ab[(size_t)t0 * 8 + 4 + hh]; } }
        for (int i16 = 0; i16 < 16; ++i16) {
            const int tok = t0 + i16;
            const v4u q3 = nq, k3 = nk, v3 = nv, xc3 = nxc, gc3 = ngc, gb3 = ngb; const float a_in = na, bt_in = nbt;
            if (i16 < 15) { const bf16* rn = proj + (size_t)(tok + 1) * NPROJ + c8; nq = *(const v4u*)(rn + C_Q); nk = *(const v4u*)(rn + C_K); nv = *(const v4u*)(rn + C_V); nxc = *(const v4u*)(rn + C_XC); ngc = *(const v4u*)(rn + C_GC); ngb = *(const v4u*)(rn + C_GB);
                if ((lane & 15) == 0) { na = ab[(size_t)(tok + 1) * 8 + hh]; nbt = ab[(size_t)(tok + 1) * 8 + 4 + hh]; } }
            float qo[8], ko[8], vo[8];
            conv4_silu(q0, q1, q2, q3, cw + C_Q + c8, qo); conv4_silu(k0, k1, k2, k3, cw + C_K + c8, ko); conv4_silu(v0, v1, v2, v3, cw + C_V + c8, vo);
            q0 = q1; q1 = q2; q2 = q3; k0 = k1; k1 = k2; k2 = k3; v0 = v1; v1 = v2; v2 = v3;
            float sq = 0.f, sk = 0.f;
#pragma unroll
            for (int i = 0; i < 8; ++i) { sq += qo[i] * qo[i]; sk += ko[i] * ko[i]; }
            sq = row16_sum(sq); sk = row16_sum(sk);
            const float rq = (1.f / sqrtf(sq + RMS_EPS)) * 0.08838834764831845f, rk = 1.f / sqrtf(sk + RMS_EPS);
#pragma unroll
            for (int i = 0; i < 8; ++i) { qo[i] *= rq; ko[i] *= rk; }
            { v4u w; w.x = cvt_pk_bf16(qo[0], qo[1]); w.y = cvt_pk_bf16(qo[2], qo[3]); w.z = cvt_pk_bf16(qo[4], qo[5]); w.w = cvt_pk_bf16(qo[6], qo[7]); *(v4u*)(qnb + (size_t)tok * 512 + c8) = w; }
            { v4u w; w.x = cvt_pk_bf16(ko[0], ko[1]); w.y = cvt_pk_bf16(ko[2], ko[3]); w.z = cvt_pk_bf16(ko[4], ko[5]); w.w = cvt_pk_bf16(ko[6], ko[7]); *(v4u*)(knb + (size_t)tok * 512 + c8) = w; }
            { v4u w; w.x = cvt_pk_bf16(vo[0], vo[1]); w.y = cvt_pk_bf16(vo[2], vo[3]); w.z = cvt_pk_bf16(vo[4], vo[5]); w.w = cvt_pk_bf16(vo[6], vo[7]); *(v4u*)(vvb + (size_t)tok * 512 + c8) = w; }
            if ((lane & 15) == 0) {
                const float a = a_in + dtb, bt = bt_in;
                const float sp = a > 20.f ? a : log1pf(expf(a));
                const float g = -Ah * sp;
                *(f32x4*)(gs + ((size_t)tok * 4 + hh) * 4) = (f32x4){g, 1.f / (1.f + expf(-bt)), 0.f, 0.f};
            }
            float xa[8], ga[8], gbv[8], p2[8]; unpack8(xc3, xa); unpack8(gc3, ga); unpack8(gb3, gbv);
            const f32x4 m0l = *(const LAS f32x4*)(mw + c8), m0h = *(const LAS f32x4*)(mw + c8 + 4), m1l = *(const LAS f32x4*)(mw + 512 + c8), m1h = *(const LAS f32x4*)(mw + 512 + c8 + 4);
            const f32x4 m2l = *(const LAS f32x4*)(mw + 1024 + c8), m2h = *(const LAS f32x4*)(mw + 1024 + c8 + 4);
            float yo[8];
#pragma unroll
            for (int i = 0; i < 8; ++i) { p2[i] = xa[i] * ga[i];
                const float w0 = i < 4 ? m0l[i & 3] : m0h[i & 3], w1 = i < 4 ? m1l[i & 3] : m1h[i & 3], w2 = i < 4 ? m2l[i & 3] : m2h[i & 3];
                yo[i] = gbv[i] * ((w0 * p0[i] + w1 * p1[i]) + w2 * p2[i]); p0[i] = p1[i]; p1[i] = p2[i]; }
            v4u w; w.x = cvt_pk_bf16(yo[0], yo[1]); w.y = cvt_pk_bf16(yo[2], yo[3]); w.z = cvt_pk_bf16(yo[4], yo[5]); w.w = cvt_pk_bf16(yo[6], yo[7]);
            *(v4u*)(yb + (size_t)tok * 512 + c8) = w;
        }
    }
}

#define MFMA16(a, b, c) __builtin_amdgcn_mfma_f32_16x16x32_bf16(a, b, c, 0, 0, 0)
__device__ __forceinline__ bf16x8 pack8(const f32x4 a, const f32x4 b) { v4u w; w.x = cvt_pk_nat(a[0], a[1]); w.y = cvt_pk_nat(a[2], a[3]); w.z = cvt_pk_nat(b[0], b[1]); w.w = cvt_pk_nat(b[2], b[3]); return __builtin_bit_cast(bf16x8, w); }
__device__ __forceinline__ v2u pack4(const f32x4 a) { v2u w; w.x = cvt_pk_nat(a[0], a[1]); w.y = cvt_pk_nat(a[2], a[3]); return w; }
constexpr int GA_PITCH = 72, GA_WAVE_BYTES = 19456;
constexpr int NCHUNK = NB * 4 * (T / 64);

__device__ __forceinline__ void gdn_kend_products(const LAS bf16* XA, const LAS bf16* XB, const LAS float* sE, const v4u* UPK, const v4u* WPK, int ci, int lane, v2u* BC, v4u* ATF) {
    const int fr = lane & 15, fq = lane >> 4;
    bf16x8 ke[8][2];
#pragma unroll
    for (int mt = 0; mt < 8; ++mt)
#pragma unroll
        for (int s = 0; s < 2; ++s) { const LAS bf16* p = (mt < 4 ? XA : XB) + (16 * (mt & 3) + fr) * GA_PITCH + 32 * s + 4 * fq;
            const v2u lo = *(const LAS v2u*)p, hi = *(const LAS v2u*)(p + 16); const f32x4 e0 = *(const LAS f32x4*)(sE + 32 * s + 4 * fq), e1 = *(const LAS f32x4*)(sE + 32 * s + 16 + 4 * fq);
            ke[mt][s] = pack8((f32x4){bf_lo(lo.x) * e0[0], bf_hi(lo.x) * e0[1], bf_lo(lo.y) * e0[2], bf_hi(lo.y) * e0[3]}, (f32x4){bf_lo(hi.x) * e1[0], bf_hi(hi.x) * e1[1], bf_lo(hi.y) * e1[2], bf_hi(hi.y) * e1[3]}); }
#pragma unroll 4
    for (int ne = 0; ne < 8; ++ne) {
        const bf16x8 u0 = __builtin_bit_cast(bf16x8, (UPK + ((size_t)ci * 16 + 2 * ne) * 64)[(unsigned)lane]), u1 = __builtin_bit_cast(bf16x8, (UPK + ((size_t)ci * 16 + 2 * ne + 1) * 64)[(unsigned)lane]);
#pragma unroll
        for (int mt = 0; mt < 8; ++mt) { f32x4 acc = (f32x4){0.f, 0.f, 0.f, 0.f}; acc = MFMA16(ke[mt][0], u0, acc); acc = MFMA16(ke[mt][1], u1, acc);
            (BC + ((size_t)(ci * 8 + ne) * 8 + mt) * 64)[(unsigned)lane] = pack4(acc); } }
#pragma unroll 2
    for (int sp = 0; sp < 4; ++sp) {
        const bf16x8 w00 = __builtin_bit_cast(bf16x8, (WPK + ((size_t)ci * 16 + 4 * sp) * 64)[(unsigned)lane]), w01 = __builtin_bit_cast(bf16x8, (WPK + ((size_t)ci * 16 + 4 * sp + 1) * 64)[(unsigned)lane]);
        const bf16x8 w10 = __builtin_bit_cast(bf16x8, (WPK + ((size_t)ci * 16 + 4 * sp + 2) * 64)[(unsigned)lane]), w11 = __builtin_bit_cast(bf16x8, (WPK + ((size_t)ci * 16 + 4 * sp + 3) * 64)[(unsigned)lane]);
#pragma unroll
        for (int mt = 0; mt < 8; ++mt) { f32x4 d0 = (f32x4){0.f, 0.f, 0.f, 0.f}, d1 = (f32x4){0.f, 0.f, 0.f, 0.f};
            d0 = MFMA16(w00, ke[mt][0], d0); d0 = MFMA16(w01, ke[mt][1], d0); d1 = MFMA16(w10, ke[mt][0], d1); d1 = MFMA16(w11, ke[mt][1], d1);
            (ATF + ((size_t)(ci * 8 + mt) * 4 + sp) * 64)[(unsigned)lane] = __builtin_bit_cast(v4u, pack8(-d0, -d1)); } }
}
__device__ __forceinline__ void xb_store_pair(LAS bf16* XB, int r0, unsigned w, int lane) {
    const unsigned send = (lane & 1) ? (w & 0xffffu) : (w >> 16);
    const unsigned recv = (unsigned)__builtin_amdgcn_update_dpp(0, (int)send, 0xB1, 0xF, 0xF, true);
    const unsigned outw = (lane & 1) ? (recv | (w & 0xffff0000u)) : ((w & 0xffffu) | (recv << 16));
    *(LAS unsigned*)(XB + (r0 + (lane & 1)) * GA_PITCH + (lane & ~1)) = outw;
}
__device__ __forceinline__ void gdn_fill_kT(const bf16* KN, LAS bf16* XB, int tok0, int h, int half, int lane) {
    const bf16* kbase = KN + (size_t)tok0 * 512 + h * 128 + half * 64; const unsigned lo = (unsigned)lane * 512u;
    asm volatile("s_waitcnt lgkmcnt(0)" ::: "memory");
#pragma unroll
    for (int c = 0; c < 8; ++c) { const v4u x = *(const v4u*)((kbase + 8 * c) + lo);
        xb_store_pair(XB, 8 * c, x.x, lane); xb_store_pair(XB, 8 * c + 2, x.y, lane); xb_store_pair(XB, 8 * c + 4, x.z, lane); xb_store_pair(XB, 8 * c + 6, x.w, lane); }
    asm volatile("s_waitcnt lgkmcnt(0)" ::: "memory");
}
__device__ __forceinline__ void phase_gdn_a(Ctx& F) {
    const int lane = F.lane, fr = lane & 15, fq = lane >> 4;
    LAS unsigned char* wl = F.lds + F.wave * GA_WAVE_BYTES;
    LAS bf16* Ts = (LAS bf16*)wl; LAS bf16* XB = (LAS bf16*)(wl + 9216);
    LAS float* gcv = (LAS float*)(wl + 18432); LAS float* sKp = gcv + 64; LAS float* sE = gcv + 128; LAS float* bev = gcv + 192;
    const bf16* KN = (const bf16*)(F.ws + WS_KN); const bf16* QN = (const bf16*)(F.ws + WS_QN); const bf16* VV = (const bf16*)(F.ws + WS_VV); const float* gs = (const float*)(F.ws + WS_GS);
    v2u* BC = (v2u*)(F.ws + WS_BC); v4u* ATF = (v4u*)(F.ws + WS_ATF); v4u* QTF = (v4u*)(F.ws + WS_QTF); v2u* OL = (v2u*)(F.ws + WS_OL); float* CD = (float*)(F.ws + WS_CD);
    v4u* UPK = (v4u*)(F.ws + WS_UPK); v4u* WPK = (v4u*)(F.ws + WS_WPK);
    { const int b = F.bid >> 7, h = F.wave & 3, n = 2 * (F.bid & 127) + (F.wave >> 2);
        const int bh = b * 4 + h, ci = bh * 256 + n, tok0 = b * T + n * 64;
        const f32x2 gb = *(const f32x2*)((gs + ((size_t)tok0 * 4 + h) * 4) + (unsigned)lane * 16u);
        float gc = gb.x; const float be = gb.y;
#pragma unroll
        for (int off = 1; off < 64; off <<= 1) { const float t = bperm(gc, (lane - off) & 63); gc += (lane >= off) ? t : 0.f; }
        const float gl = rdlane(gc, 63);
        gcv[lane] = gc; sKp[lane] = be * __expf(gc); sE[lane] = __expf(gl - gc); bev[lane] = be;
        if (lane == 0) CD[ci] = __expf(gl);
        asm volatile("s_waitcnt lgkmcnt(0)" ::: "memory");
        {
            bf16x8 kf[4][4];
#pragma unroll
            for (int t = 0; t < 4; ++t)
#pragma unroll
                for (int s = 0; s < 4; ++s) kf[t][s] = *(const bf16x8*)((KN + (size_t)(tok0 + 16 * t) * 512 + h * 128 + 32 * s) + ((unsigned)fr * 512u + 8u * (unsigned)fq));
            float gcj[4];
#pragma unroll
            for (int t = 0; t < 4; ++t) gcj[t] = gcv[16 * t + fr];
            LAS float* Nc = (LAS float*)wl;
#pragma unroll
            for (int t = 0; t < 4; ++t) { const f32x4 gci = *(const LAS f32x4*)(gcv + 16 * t + 4 * fq), bei = *(const LAS f32x4*)(bev + 16 * t + 4 * fq);
#pragma unroll
                for (int u = 0; u <= t; ++u) {
                    f32x4 acc = (f32x4){0.f, 0.f, 0.f, 0.f};
#pragma unroll
                    for (int s = 0; s < 4; ++s) acc = MFMA16(kf[t][s], kf[u][s], acc);
                    f32x4 nv;
#pragma unroll
                    for (int r = 0; r < 4; ++r) { const int i = 16 * t + 4 * fq + r, j = 16 * u + fr; const float v = bei[r] * acc[r] * __expf(fminf(gci[r] - gcj[u], 0.f)); nv[r] = (i > j) ? v : 0.f; }
                    *(LAS f32x4*)(Nc + (16 * u + fr) * 64 + 16 * t + 4 * fq) = nv;
                } }
        }
        asm volatile("s_waitcnt lgkmcnt(0)" ::: "memory");
        {
            float x[64];
#pragma unroll
            for (int c = 63; c >= 0; --c) { float a = (lane == c) ? 1.f : 0.f, a1 = 0.f, a2 = 0.f, a3 = 0.f;
#pragma unroll
                for (int k4 = ((c + 1) & ~3); k4 < 64; k4 += 4) { const f32x4 nv = *(const LAS f32x4*)((const LAS float*)wl + c * 64 + k4);
                    if (k4 + 0 > c) a -= x[k4 + 0] * nv[0]; if (k4 + 1 > c) a1 -= x[k4 + 1] * nv[1]; if (k4 + 2 > c) a2 -= x[k4 + 2] * nv[2]; if (k4 + 3 > c) a3 -= x[k4 + 3] * nv[3]; }
                a = (a + a1) + (a2 + a3);
                asm volatile("" : "+v"(a) :: "memory");
                x[c] = a; }
#pragma unroll
            for (int q8 = 0; q8 < 8; ++q8) { v4u w; w.x = cvt_pk_nat(x[8 * q8], x[8 * q8 + 1]); w.y = cvt_pk_nat(x[8 * q8 + 2], x[8 * q8 + 3]); w.z = cvt_pk_nat(x[8 * q8 + 4], x[8 * q8 + 5]); w.w = cvt_pk_nat(x[8 * q8 + 6], x[8 * q8 + 7]);
                *(LAS v4u*)(Ts + lane * GA_PITCH + 8 * q8) = w; }
        }
        asm volatile("s_waitcnt lgkmcnt(0)" ::: "memory");
        {
            bf16x8 tsf[4][2];
#pragma unroll
            for (int t = 0; t < 4; ++t)
#pragma unroll
                for (int s = 0; s < 2; ++s) tsf[t][s] = *(const LAS bf16x8*)(Ts + (16 * t + fr) * GA_PITCH + 32 * s + 8 * fq);
#pragma unroll 1
            for (int half = 0; half < 2; ++half) {
                const bf16* vbase = VV + (size_t)tok0 * 512 + h * 128 + half * 64; const unsigned vlo = (unsigned)lane * 512u;
#pragma unroll
                for (int c = 0; c < 8; ++c) { float f[8]; unpack8(*(const v4u*)((vbase + 8 * c) + vlo), f);
#pragma unroll
                    for (int i2 = 0; i2 < 4; ++i2) xb_store_pair(XB, 8 * c + 2 * i2, cvt_pk_nat(f[2 * i2] * be, f[2 * i2 + 1] * be), lane); }
                asm volatile("s_waitcnt lgkmcnt(0)" ::: "memory");
#pragma unroll
                for (int nl = 0; nl < 4; ++nl) { const bf16x8 b0 = *(const LAS bf16x8*)(XB + (16 * nl + fr) * GA_PITCH + 8 * fq), b1 = *(const LAS bf16x8*)(XB + (16 * nl + fr) * GA_PITCH + 32 + 8 * fq);
                    f32x4 ut[4];
#pragma unroll
                    for (int t = 0; t < 4; ++t) { f32x4 acc = (f32x4){0.f, 0.f, 0.f, 0.f}; acc = MFMA16(tsf[t][0], b0, acc); if (t >= 2) acc = MFMA16(tsf[t][1], b1, acc); ut[t] = acc; }
                    (UPK + ((size_t)ci * 16 + 2 * (half * 4 + nl)) * 64)[(unsigned)lane] = __builtin_bit_cast(v4u, pack8(ut[0], ut[1]));
                    (UPK + ((size_t)ci * 16 + 2 * (half * 4 + nl) + 1) * 64)[(unsigned)lane] = __builtin_bit_cast(v4u, pack8(ut[2], ut[3])); }
                asm volatile("s_waitcnt lgkmcnt(0)" ::: "memory");
            }
#pragma unroll 1
            for (int half = 0; half < 2; ++half) {
                gdn_fill_kT(KN, XB, tok0, h, half, lane);
#pragma unroll
                for (int nl = 0; nl < 4; ++nl) { bf16x8 kp[2];
#pragma unroll
                    for (int s = 0; s < 2; ++s) { const v4u raw = *(const LAS v4u*)(XB + (16 * nl + fr) * GA_PITCH + 32 * s + 8 * fq); const f32x4 c0 = *(const LAS f32x4*)(sKp + 32 * s + 8 * fq), c1 = *(const LAS f32x4*)(sKp + 32 * s + 8 * fq + 4);
                        kp[s] = pack8((f32x4){bf_lo(raw.x) * c0[0], bf_hi(raw.x) * c0[1], bf_lo(raw.y) * c0[2], bf_hi(raw.y) * c0[3]}, (f32x4){bf_lo(raw.z) * c1[0], bf_hi(raw.z) * c1[1], bf_lo(raw.w) * c1[2], bf_hi(raw.w) * c1[3]}); }
                    f32x4 wt[4];
#pragma unroll
                    for (int t = 0; t < 4; ++t) { f32x4 acc = (f32x4){0.f, 0.f, 0.f, 0.f}; acc = MFMA16(tsf[t][0], kp[0], acc); if (t >= 2) acc = MFMA16(tsf[t][1], kp[1], acc); wt[t] = acc; }
                    (WPK + ((size_t)ci * 16 + 2 * (half * 4 + nl)) * 64)[(unsigned)lane] = __builtin_bit_cast(v4u, pack8(wt[0], wt[1]));
                    (WPK + ((size_t)ci * 16 + 2 * (half * 4 + nl) + 1) * 64)[(unsigned)lane] = __builtin_bit_cast(v4u, pack8(wt[2], wt[3])); }
                asm volatile("s_waitcnt lgkmcnt(0)" ::: "memory");
            }
        }
        asm volatile("s_waitcnt vmcnt(0)" ::: "memory");
        gdn_fill_kT(KN, Ts, tok0, h, 0, lane);
        gdn_kend_products(Ts, XB, sE, UPK, WPK, ci, lane, BC, ATF);
        asm volatile("s_waitcnt lgkmcnt(0)" ::: "memory");
        bf16x8 qkpk[4][2];
        {
            bf16x8 kf[4][4];
#pragma unroll
            for (int t = 0; t < 4; ++t)
#pragma unroll
                for (int s = 0; s < 4; ++s) kf[t][s] = *(const bf16x8*)((KN + (size_t)(tok0 + 16 * t) * 512 + h * 128 + 32 * s) + ((unsigned)fr * 512u + 8u * (unsigned)fq));
#pragma unroll
            for (int t = 0; t < 4; ++t) { bf16x8 qf[4]; const float gct = gcv[16 * t + fr];
#pragma unroll
                for (int s = 0; s < 4; ++s) qf[s] = *(const bf16x8*)((QN + (size_t)(tok0 + 16 * t) * 512 + h * 128 + 32 * s) + ((unsigned)fr * 512u + 8u * (unsigned)fq));
                f32x4 tl[4];
#pragma unroll
                for (int u = 0; u < 4; ++u) { tl[u] = (f32x4){0.f, 0.f, 0.f, 0.f}; if (u > t) continue;
                    const f32x4 gcu = *(const LAS f32x4*)(gcv + 16 * u + 4 * fq);
                    f32x4 acc = (f32x4){0.f, 0.f, 0.f, 0.f};
#pragma unroll
                    for (int s = 0; s < 4; ++s) acc = MFMA16(kf[u][s], qf[s], acc);
#pragma unroll
                    for (int r = 0; r < 4; ++r) { const int i = 16 * t + fr, j = 16 * u + 4 * fq + r; const float v = acc[r] * __expf(fminf(gct - gcu[r], 0.f)); tl[u][r] = (i >= j) ? v : 0.f; } }
                qkpk[t][0] = pack8(tl[0], tl[1]); qkpk[t][1] = pack8(tl[2], tl[3]); }
        }
        asm volatile("s_waitcnt lgkmcnt(0)" ::: "memory");
#pragma unroll 2
        for (int sp = 0; sp < 4; ++sp) {
            const bf16x8 w00 = __builtin_bit_cast(bf16x8, (WPK + ((size_t)ci * 16 + 4 * sp) * 64)[(unsigned)lane]), w01 = __builtin_bit_cast(bf16x8, (WPK + ((size_t)ci * 16 + 4 * sp + 1) * 64)[(unsigned)lane]);
            const bf16x8 w10 = __builtin_bit_cast(bf16x8, (WPK + ((size_t)ci * 16 + 4 * sp + 2) * 64)[(unsigned)lane]), w11 = __builtin_bit_cast(bf16x8, (WPK + ((size_t)ci * 16 + 4 * sp + 3) * 64)[(unsigned)lane]);
#pragma unroll
            for (int t = 0; t < 4; ++t) { const float egi = __expf(gcv[16 * t + fr]); f32x4 dd[2];
#pragma unroll
                for (int hh = 0; hh < 2; ++hh) { f32x4 acc = (f32x4){0.f, 0.f, 0.f, 0.f}; acc = MFMA16(hh ? w10 : w00, qkpk[t][0], acc); if (t >= 2) acc = MFMA16(hh ? w11 : w01, qkpk[t][1], acc);
                    const v2u q4 = *(const v2u*)((QN + (size_t)(tok0 + 16 * t) * 512 + h * 128) + ((unsigned)fr * 512u + 4u * (unsigned)fq + 16u * (unsigned)(2 * sp + hh)));
                    dd[hh] = (f32x4){bf_lo(q4.x) * egi - acc[0], bf_hi(q4.x) * egi - acc[1], bf_lo(q4.y) * egi - acc[2], bf_hi(q4.y) * egi - acc[3]}; }
                (QTF + ((size_t)(ci * 4 + t) * 4 + sp) * 64)[(unsigned)lane] = __builtin_bit_cast(v4u, pack8(dd[0], dd[1])); } }
#pragma unroll 4
        for (int et = 0; et < 8; ++et) {
            const bf16x8 u0 = __builtin_bit_cast(bf16x8, (UPK + ((size_t)ci * 16 + 2 * et) * 64)[(unsigned)lane]), u1 = __builtin_bit_cast(bf16x8, (UPK + ((size_t)ci * 16 + 2 * et + 1) * 64)[(unsigned)lane]);
#pragma unroll
            for (int t = 0; t < 4; ++t) { f32x4 acc = (f32x4){0.f, 0.f, 0.f, 0.f}; acc = MFMA16(u0, qkpk[t][0], acc); if (t >= 2) acc = MFMA16(u1, qkpk[t][1], acc);
                (OL + ((size_t)(ci * 8 + et) * 4 + t) * 64)[(unsigned)lane] = pack4(acc); } }
    }
}
__device__ __forceinline__ void phase_gdn_b(Ctx& F) {
    const int bh = F.bid >> 2, sl = F.bid & 3, w = F.wave, lane = F.lane, fr = lane & 15, fq = lane >> 4;
    const v4u* ATF = (const v4u*)(F.ws + WS_ATF); const v2u* BC = (const v2u*)(F.ws + WS_BC); const float* CD = (const float*)(F.ws + WS_CD); bf16* ST = (bf16*)(F.ws + WS_ST);
    LAS unsigned char* xb = F.lds;
    const int cbase = bh * 256;
    f32x4 S[2]; S[0] = (f32x4){0.f, 0.f, 0.f, 0.f}; S[1] = (f32x4){0.f, 0.f, 0.f, 0.f};
    constexpr int RD = 6;
    v4u afr[RD][4]; v2u bcr[RD][2]; float cdr[RD];
#define GB_LOAD(k, n_) do { const int cc_ = (n_) < 256 ? (n_) : 255; const size_t ci_ = (size_t)(cbase + cc_); \
        _Pragma("unroll") for (int s_ = 0; s_ < 4; ++s_) afr[k][s_] = (ATF + ((ci_ * 8 + w) * 4 + s_) * 64)[(unsigned)lane]; \
        _Pragma("unroll") for (int n2_ = 0; n2_ < 2; ++n2_) bcr[k][n2_] = (BC + ((ci_ * 8 + 2 * sl + n2_) * 8 + w) * 64)[(unsigned)lane]; \
        cdr[k] = CD[ci_]; } while (0)
#pragma unroll
    for (int k = 0; k < RD; ++k) GB_LOAD(k, k);
    for (int n0 = 0; n0 < 256; n0 += RD) {
#pragma unroll
        for (int k = 0; k < RD; ++k) { const int n = n0 + k, par = k & 1; const size_t ci = (size_t)(cbase + n);
            if (n >= 256) break;
#pragma unroll
            for (int nt = 0; nt < 2; ++nt) { const v2u p = pack4(S[nt]);
                *(LAS v2u*)(xb + par * 8192 + ((nt * 4 + (w >> 1)) * 64 + lane) * 16 + (w & 1) * 8) = p;
                ((v2u*)ST + ((ci * 8 + w) * 8 + 2 * sl + nt) * 64)[(unsigned)lane] = p; }
            asm volatile("s_waitcnt lgkmcnt(0)" ::: "memory"); __builtin_amdgcn_s_barrier(); asm volatile("" ::: "memory");
            bf16x8 sf[2][4];
#pragma unroll
            for (int nt = 0; nt < 2; ++nt)
#pragma unroll
                for (int s = 0; s < 4; ++s) sf[nt][s] = *(const LAS bf16x8*)(xb + par * 8192 + ((nt * 4 + s) * 64 + lane) * 16);
#pragma unroll
            for (int nt = 0; nt < 2; ++nt) { const v2u bw = bcr[k][nt]; f32x4 acc = S[nt] * cdr[k] + (f32x4){bf_lo(bw.x), bf_hi(bw.x), bf_lo(bw.y), bf_hi(bw.y)};
                f32x4 acc2 = (f32x4){0.f, 0.f, 0.f, 0.f};
                acc = MFMA16(__builtin_bit_cast(bf16x8, afr[k][0]), sf[nt][0], acc); acc2 = MFMA16(__builtin_bit_cast(bf16x8, afr[k][1]), sf[nt][1], acc2);
                acc = MFMA16(__builtin_bit_cast(bf16x8, afr[k][2]), sf[nt][2], acc); acc2 = MFMA16(__builtin_bit_cast(bf16x8, afr[k][3]), sf[nt][3], acc2);
                S[nt] = acc + acc2; }
            GB_LOAD(k, n + RD);
        }
    }
#undef GB_LOAD
}
__device__ __forceinline__ void phase_gdn_c(Ctx& F, int l) {
    const int lane = F.lane, fr = lane & 15, fq = lane >> 4;
    const v4u* QTF = (const v4u*)(F.ws + WS_QTF); const v2u* OL = (const v2u*)(F.ws + WS_OL); const bf16* ST = (const bf16*)(F.ws + WS_ST);
    const bf16* proj = (const bf16*)(F.ws + WS_R1); bf16* ya = (bf16*)(F.ws + WS_YA); const float* gnp = as_global(F.in[I_GDNNORM]) + (size_t)l * 128;
    { const int ci = F.bid * 8 + F.wave;
        const int bh = ci >> 8, n = ci & 255, b = bh >> 2, h = bh & 3, tok0 = b * T + n * 64;
        bf16x8 qt[4][4];
#pragma unroll
        for (int t = 0; t < 4; ++t)
#pragma unroll
            for (int s = 0; s < 4; ++s) qt[t][s] = __builtin_bit_cast(bf16x8, (QTF + ((size_t)(ci * 4 + t) * 4 + s) * 64)[(unsigned)lane]);
        f32x4 o[8][4];
#pragma unroll
        for (int et = 0; et < 8; ++et) {
#pragma unroll
            for (int t = 0; t < 4; ++t) { const v2u ow = (OL + ((size_t)(ci * 8 + et) * 4 + t) * 64)[(unsigned)lane]; o[et][t] = (f32x4){bf_lo(ow.x), bf_hi(ow.x), bf_lo(ow.y), bf_hi(ow.y)}; }
#pragma unroll
            for (int s = 0; s < 4; ++s) { const v2u lo = ((const v2u*)ST + (((size_t)ci * 8 + 2 * s) * 8 + et) * 64)[(unsigned)lane], hi = ((const v2u*)ST + (((size_t)ci * 8 + 2 * s + 1) * 8 + et) * 64)[(unsigned)lane];
                v4u aw; aw.x = lo.x; aw.y = lo.y; aw.z = hi.x; aw.w = hi.y; const bf16x8 a = __builtin_bit_cast(bf16x8, aw);
#pragma unroll
                for (int t = 0; t < 4; ++t) o[et][t] = MFMA16(a, qt[t][s], o[et][t]); }
        }
        LAS bf16* slab = (LAS bf16*)(F.lds + F.wave * (64 * 136 * 2));
#pragma unroll
        for (int t = 0; t < 4; ++t) { float ss = 0.f;
#pragma unroll
            for (int et = 0; et < 8; ++et) ss += (o[et][t][0] * o[et][t][0] + o[et][t][1] * o[et][t][1]) + (o[et][t][2] * o[et][t][2] + o[et][t][3] * o[et][t][3]);
            ss += bperm(ss, lane ^ 16); ss += bperm(ss, lane ^ 32);
            const float sc = 1.f / sqrtf(ss * (1.f / 128.f) + RMS_EPS);
#pragma unroll
            for (int et = 0; et < 8; ++et) *(LAS v2u*)(slab + (16 * t + fr) * 136 + 16 * et + 4 * fq) = pack4(o[et][t] * sc); }
        asm volatile("s_waitcnt lgkmcnt(0)" ::: "memory");
        { const int rr = lane >> 4, cc = (lane & 15) * 8;
          const f32x4 g0 = *(const f32x4*)(gnp + cc), g1 = *(const f32x4*)(gnp + cc + 4);
#pragma unroll 2
          for (int p = 0; p < 16; ++p) { const int i = 4 * p + rr;
              const v4u ov = *(const LAS v4u*)(slab + i * 136 + cc);
              const v4u zv = *(const v4u*)((proj + (size_t)tok0 * NPROJ + C_Z + h * 128) + ((unsigned)i * (unsigned)NPROJ + (unsigned)cc));
              float of[8], zf[8]; unpack8(ov, of); unpack8(zv, zf);
              v4u w; w.x = cvt_pk_nat(of[0] * g0[0] * siluf_(zf[0]), of[1] * g0[1] * siluf_(zf[1])); w.y = cvt_pk_nat(of[2] * g0[2] * siluf_(zf[2]), of[3] * g0[3] * siluf_(zf[3]));
              w.z = cvt_pk_nat(of[4] * g1[0] * siluf_(zf[4]), of[5] * g1[1] * siluf_(zf[5])); w.w = cvt_pk_nat(of[6] * g1[2] * siluf_(zf[6]), of[7] * g1[3] * siluf_(zf[7]));
              *(v4u*)((ya + (size_t)tok0 * 512 + h * 128) + ((unsigned)i * 512u + (unsigned)cc)) = w; } }
    }
}
constexpr int XK_PITCH = 136, XV_PITCH = 264;
__device__ __forceinline__ void phase_xattn(Ctx& F, int first, int stride) {
    const bf16* proj = (const bf16*)(F.ws + WS_R1); const bf16* kvb = (const bf16*)(F.ws + WS_KVB); const bf16* vtb = (const bf16*)(F.ws + WS_KVB + 512 * 1024); bf16* ym = (bf16*)(F.ws + WS_YM);
    LAS bf16* Ks = (LAS bf16*)F.lds; LAS bf16* VTs = (LAS bf16*)(F.lds + 256 * XK_PITCH * 2);
    const int NU = NB * 4 * (T / 512);
    for (int unit = first; unit < NU; unit += stride) {
        const int qt = unit % (T / 512), bh = unit / (T / 512), b = bh >> 2, head = bh & 3;
        int lane = F.lane; asm volatile("" : "+v"(lane));
        const int fr = lane & 15, fq = lane >> 4, tid_l = F.wave * 64 + lane;
        __syncthreads();
        for (int it = 0; it < 8; ++it) { const int idx = it * 512 + tid_l, key = idx >> 4, ch = idx & 15;
            const v4u kx = *(const v4u*)((kvb + (size_t)(b * NMEM) * 512 + head * 128) + ((unsigned)key * 512u + (unsigned)ch * 8u)); *(LAS v4u*)(Ks + key * XK_PITCH + ch * 8) = kx;
            const int e = idx >> 5, kc = idx & 31;
            const v4u vx = *(const v4u*)((vtb + (size_t)((b * 4 + head) * 128) * 256) + ((unsigned)e * 256u + (unsigned)kc * 8u)); *(LAS v4u*)(VTs + e * XV_PITCH + kc * 8) = vx; }
        __syncthreads();
#pragma unroll 1
        for (int qi = 0; qi < 2; ++qi) {
            const int tok0 = b * T + qt * 512 + F.wave * 64 + qi * 32;
            bf16x8 qf[2][4];
#pragma unroll
            for (int g = 0; g < 2; ++g)
#pragma unroll
                for (int s = 0; s < 4; ++s) qf[g][s] = *(const bf16x8*)((proj + (size_t)(tok0 + g * 16) * NPROJ + C_QM + head * 128 + 32 * s) + ((unsigned)fr * (unsigned)NPROJ + 8u * (unsigned)fq));
            f32x4 sc[2][16];
#pragma unroll
            for (int kt = 0; kt < 16; ++kt) {
                sc[0][kt] = (f32x4){0.f, 0.f, 0.f, 0.f}; sc[1][kt] = (f32x4){0.f, 0.f, 0.f, 0.f};
#pragma unroll
                for (int s = 0; s < 4; ++s) { const bf16x8 kf = *(const LAS bf16x8*)(Ks + (kt * 16 + fr) * XK_PITCH + 32 * s + 8 * fq);
                    sc[0][kt] = __builtin_amdgcn_mfma_f32_16x16x32_bf16(kf, qf[0][s], sc[0][kt], 0, 0, 0);
                    sc[1][kt] = __builtin_amdgcn_mfma_f32_16x16x32_bf16(kf, qf[1][s], sc[1][kt], 0, 0, 0); }
            }
            bf16x8 pf[2][8]; float inv[2];
#pragma unroll
            for (int g = 0; g < 2; ++g) {
                float mx = -3.0e38f;
#pragma unroll
                for (int kt = 0; kt < 16; ++kt) mx = fmaxf(mx, fmaxf(fmaxf(sc[g][kt][0], sc[g][kt][1]), fmaxf(sc[g][kt][2], sc[g][kt][3])));
                mx = fmaxf(mx, bperm(mx, lane ^ 16)); mx = fmaxf(mx, bperm(mx, lane ^ 32));
                float sum = 0.f;
#pragma unroll
                for (int kt = 0; kt < 16; ++kt)
#pragma unroll
                    for (int r = 0; r < 4; ++r) { const float p = __expf((sc[g][kt][r] - mx) * 0.08838834764831845f); sc[g][kt][r] = p; sum += p; }
                sum += bperm(sum, lane ^ 16); sum += bperm(sum, lane ^ 32);
                inv[g] = 1.f / sum;
#pragma unroll
                for (int ks = 0; ks < 8; ++ks) { v4u w; w.x = cvt_pk_bf16_n(sc[g][2 * ks][0], sc[g][2 * ks][1]); w.y = cvt_pk_bf16_n(sc[g][2 * ks][2], sc[g][2 * ks][3]);
                    w.z = cvt_pk_bf16_n(sc[g][2 * ks + 1][0], sc[g][2 * ks + 1][1]); w.w = cvt_pk_bf16_n(sc[g][2 * ks + 1][2], sc[g][2 * ks + 1][3]); pf[g][ks] = __builtin_bit_cast(bf16x8, w); }
            }
#pragma unroll
            for (int et = 0; et < 8; ++et) {
                f32x4 o0 = (f32x4){0.f, 0.f, 0.f, 0.f}, o1 = (f32x4){0.f, 0.f, 0.f, 0.f};
#pragma unroll
                for (int ks = 0; ks < 8; ++ks) { const LAS bf16* vp = VTs + (et * 16 + fr) * XV_PITCH + 32 * ks + 4 * fq;
                    const v2u lo = *(const LAS v2u*)vp, hi = *(const LAS v2u*)(vp + 16); v4u w; w.x = lo.x; w.y = lo.y; w.z = hi.x; w.w = hi.y; const bf16x8 vf = __builtin_bit_cast(bf16x8, w);
                    o0 = __builtin_amdgcn_mfma_f32_16x16x32_bf16(vf, pf[0][ks], o0, 0, 0, 0);
                    o1 = __builtin_amdgcn_mfma_f32_16x16x32_bf16(vf, pf[1][ks], o1, 0, 0, 0); }
                o0 = o0 * inv[0]; o1 = o1 * inv[1];
                v2u w0, w1; w0.x = cvt_pk_bf16_n(o0[0], o0[1]); w0.y = cvt_pk_bf16_n(o0[2], o0[3]); w1.x = cvt_pk_bf16_n(o1[0], o1[1]); w1.y = cvt_pk_bf16_n(o1[2], o1[3]);
                *(v2u*)((ym + (size_t)tok0 * 512 + head * 128 + et * 16) + ((unsigned)fr * 512u + 4u * (unsigned)fq)) = w0;
                *(v2u*)((ym + (size_t)(tok0 + 16) * 512 + head * 128 + et * 16) + ((unsigned)fr * 512u + 4u * (unsigned)fq)) = w1;
            }
        }
    }
}

constexpr int TPW = NTOK / 256;
constexpr int WR_PITCH = 1028;
__device__ __forceinline__ int dpp_i(int s, int ctrl_sel) {
    if (ctrl_sel == 0) return __builtin_amdgcn_update_dpp(0, s, 0xB1, 0xF, 0xF, true);
    if (ctrl_sel == 1) return __builtin_amdgcn_update_dpp(0, s, 0x4E, 0xF, 0xF, true);
    if (ctrl_sel == 2) return __builtin_amdgcn_update_dpp(0, s, 0x141, 0xF, 0xF, true);
    return __builtin_amdgcn_update_dpp(0, s, 0x140, 0xF, 0xF, true);
}
__device__ __forceinline__ void phase_ln1_router(Ctx& F, int l) {
    LAS float* wr_s = (LAS float*)F.lds;
    LAS int* hist = (LAS int*)(F.lds + 32 * WR_PITCH * 4);
    const float* wrp = as_global(F.in[I_WR]) + (size_t)l * D * NE;
    { const int e = F.tid & 31, kg = F.tid >> 5;
      for (int k = kg * 64; k < kg * 64 + 64; k += 4) { f32x4 w; w[0] = wrp[(size_t)(k + 0) * NE + e]; w[1] = wrp[(size_t)(k + 1) * NE + e]; w[2] = wrp[(size_t)(k + 2) * NE + e]; w[3] = wrp[(size_t)(k + 3) * NE + e];
          *(LAS f32x4*)(wr_s + e * WR_PITCH + k) = w; } }
    if (F.tid < 32) hist[F.tid] = 0;
    __syncthreads();
    const bf16* tb = (const bf16*)(F.ws + WS_HF); bf16* hb = (bf16*)(F.ws + WS_HB);
    int* tok_e = (int*)(F.ws + WS_TOKE); float* tok_w = (float*)(F.ws + WS_TOKW);
    const float* brp = as_global(F.in[I_BR]) + (size_t)l * NE;
    const int lane = F.lane, fr = lane & 15, q = lane >> 4;
    const int tok_base = F.bid * TPW + F.wave * 16;
    const size_t rowoff = (size_t)(tok_base + fr) * D + 8 * q;
    float s = 0.f, s2 = 0.f;
#pragma unroll 8
    for (int c = 0; c < 32; ++c) { float x[8]; unpack8(*(const v4u*)(tb + rowoff + 32 * c), x);
#pragma unroll
        for (int i = 0; i < 8; ++i) { s += x[i]; s2 += x[i] * x[i]; } }
    s += bperm(s, lane ^ 16); s += bperm(s, lane ^ 32); s2 += bperm(s2, lane ^ 16); s2 += bperm(s2, lane ^ 32);
    const float mean = s * (1.f / D);
    const float rstd = 1.f / sqrtf(fmaxf(s2 * (1.f / D) - mean * mean, 0.f) + LN_EPS);
    const float* gp = as_global(F.in[I_LN1G]) + (size_t)l * D + 8 * q; const float* bp = as_global(F.in[I_LN1B]) + (size_t)l * D + 8 * q;
    const LAS float* w0p = wr_s + fr * WR_PITCH + 8 * q; const LAS float* w1p = wr_s + (16 + fr) * WR_PITCH + 8 * q;
    f32x4 acc0 = (f32x4){0.f, 0.f, 0.f, 0.f}, acc1 = (f32x4){0.f, 0.f, 0.f, 0.f};
#pragma unroll 2
    for (int c = 0; c < 32; ++c) {
        float x[8]; unpack8(*(const v4u*)(tb + rowoff + 32 * c), x);
        const f32x4 g0 = *(const f32x4*)(gp + 32 * c), g1 = *(const f32x4*)(gp + 32 * c + 4), b0 = *(const f32x4*)(bp + 32 * c), b1 = *(const f32x4*)(bp + 32 * c + 4);
        float h[8];
#pragma unroll
        for (int i = 0; i < 4; ++i) { h[i] = (x[i] - mean) * rstd * g0[i] + b0[i]; h[4 + i] = (x[4 + i] - mean) * rstd * g1[i] + b1[i]; }
        const f32x4 wa0 = *(const LAS f32x4*)(w0p + 32 * c), wa1 = *(const LAS f32x4*)(w0p + 32 * c + 4), wb0 = *(const LAS f32x4*)(w1p + 32 * c), wb1 = *(const LAS f32x4*)(w1p + 32 * c + 4);
#pragma unroll
        for (int i = 0; i < 4; ++i) { acc0 = __builtin_amdgcn_mfma_f32_16x16x4f32(h[i], wa0[i], acc0, 0, 0, 0); acc1 = __builtin_amdgcn_mfma_f32_16x16x4f32(h[i], wb0[i], acc1, 0, 0, 0); }
#pragma unroll
        for (int i = 0; i < 4; ++i) { acc0 = __builtin_amdgcn_mfma_f32_16x16x4f32(h[4 + i], wa1[i], acc0, 0, 0, 0); acc1 = __builtin_amdgcn_mfma_f32_16x16x4f32(h[4 + i], wb1[i], acc1, 0, 0, 0); }
        v4u w; w.x = cvt_pk_nat(h[0], h[1]); w.y = cvt_pk_nat(h[2], h[3]); w.z = cvt_pk_nat(h[4], h[5]); w.w = cvt_pk_nat(h[6], h[7]);
        *(v4u*)(hb + rowoff + 32 * c) = w;
        asm volatile("" ::: "memory");
    }
    const float be0 = brp[fr], be1 = brp[16 + fr];
#pragma unroll
    for (int r = 0; r < 4; ++r) {
        float v0 = acc0[r] + be0, v1 = acc1[r] + be1; float val[4]; int idx[4];
#pragma unroll
        for (int kk = 0; kk < 4; ++kk) {
            const bool use1 = v1 > v0; float bv = use1 ? v1 : v0; int bi = use1 ? 16 + fr : fr;
#pragma unroll
            for (int st = 0; st < 4; ++st) { const float ov = dpp_f(bv, st); const int oi = dpp_i(bi, st); const bool take = (ov > bv) || (ov == bv && oi < bi); bv = take ? ov : bv; bi = take ? oi : bi; }
            val[kk] = bv; idx[kk] = bi;
            v0 = (bi == fr) ? -3.0e38f : v0; v1 = (bi == 16 + fr) ? -3.0e38f : v1;
        }
        const float e1 = __expf(val[1] - val[0]), e2 = __expf(val[2] - val[0]), e3 = __expf(val[3] - val[0]); const float inv = 1.f / (1.f + e1 + e2 + e3);
        if (fr == 0) { const size_t t4 = (size_t)(tok_base + 4 * q + r) * 4;
            *(int4*)(tok_e + t4) = make_int4(idx[0], idx[1], idx[2], idx[3]); *(f32x4*)(tok_w + t4) = (f32x4){inv, e1 * inv, e2 * inv, e3 * inv};
            atomicAdd((int*)&hist[idx[0]], 1); atomicAdd((int*)&hist[idx[1]], 1); atomicAdd((int*)&hist[idx[2]], 1); atomicAdd((int*)&hist[idx[3]], 1); }
    }
    __syncthreads();
    if (F.tid < 32) ((int*)(F.ws + WS_CNT))[F.bid * 32 + F.tid] = hist[F.tid];
}

__device__ __forceinline__ void phase_assign(Ctx& F) {
    LAS int* part_tot = (LAS int*)F.lds;
    LAS int* part_bef = part_tot + 512;
    LAS int* tot_s = part_bef + 512; LAS int* bef_s = tot_s + 32; LAS int* pstart_s = bef_s + 32;
    LAS int* cntw = pstart_s + 32;
    const int* cnt = (const int*)(F.ws + WS_CNT); int* meta = (int*)(F.ws + WS_META);
    const int* tok_e = (const int*)(F.ws + WS_TOKE); const float* tok_w = (const float*)(F.ws + WS_TOKW);
    int* tok_slot = (int*)(F.ws + WS_TOKS); float* slot_w = (float*)(F.ws + WS_SLOTW);
    const int lane = F.lane;
    const int n = F.tid, my_e = tok_e[(size_t)F.bid * TPW * 4 + n]; const float my_w = tok_w[(size_t)F.bid * TPW * 4 + n];
    int my_rank = 0, my_cnt = 0;
    const unsigned long long lt = (1ull << lane) - 1ull;
#pragma unroll
    for (int e = 0; e < 32; ++e) { const unsigned long long m = __ballot(my_e == e); my_rank = (my_e == e) ? __popcll(m & lt) : my_rank; my_cnt = (lane == e) ? __popcll(m) : my_cnt; }
    if (lane < 32) cntw[F.wave * 32 + lane] = my_cnt;
    { const int e = F.tid & 31, part = F.tid >> 5; const int per = (F.G + 15) / 16; int c[16];
#pragma unroll
      for (int j = 0; j < 16; ++j) { const int w = part * per + j; c[j] = (j < per && w < F.G) ? cnt[w * 32 + e] : 0; }
      int tot = 0, bef = 0;
#pragma unroll
      for (int j = 0; j < 16; ++j) { tot += c[j]; bef += (part * per + j < F.bid) ? c[j] : 0; }
      part_tot[part * 32 + e] = tot; part_bef[part * 32 + e] = bef; }
    __syncthreads();
    if (F.tid < 32) { int tot = 0, bef = 0;
#pragma unroll
        for (int p = 0; p < 16; ++p) { tot += part_tot[p * 32 + F.tid]; bef += part_bef[p * 32 + F.tid]; }
        tot_s[F.tid] = tot;
        const int pc = ((tot + 255) >> 8) << 8; int incl = pc;
#pragma unroll
        for (int off = 1; off < 32; off <<= 1) { const int t = __builtin_amdgcn_ds_bpermute(((lane - off) & 63) << 2, incl); incl += (lane >= off) ? t : 0; }
        const int ps = incl - pc; pstart_s[F.tid] = ps; bef_s[F.tid] = ps + bef;
        if (F.bid == 0) { for (int tt = ps >> 8; tt < (ps + pc) >> 8; ++tt) meta[64 + tt] = F.tid; if (F.tid == 31) meta[0] = (ps + pc) >> 8; } }
    __syncthreads();
    int pre = 0;
    for (int w = 0; w < F.wave; ++w) pre += cntw[w * 32 + my_e];
    const int slot = bef_s[my_e] + pre + my_rank;
    { const int tok = F.bid * TPW + (n >> 2); tok_slot[(size_t)tok * 4 + (n & 3)] = slot; slot_w[slot] = my_w; ((int*)(F.ws + WS_SLOTT))[slot] = tok; }
    if (F.bid == 0 && F.tid < 32) { const int tot = tot_s[F.tid], ps = pstart_s[F.tid], pe = ps + (((tot + 255) >> 8) << 8); int* st = (int*)(F.ws + WS_SLOTT);
        for (int s2 = ps + tot; s2 < pe; ++s2) st[s2] = 0; }
}

__device__ __forceinline__ void phase_combine_ln2(Ctx& F, int l) {
    LAS float* ws_s = (LAS float*)F.lds;
    if (l + 1 < DEPTH) { load_small_w(F, l + 1, ws_s); }
    __syncthreads();
    bf16* hb = (bf16*)(F.ws + WS_HB); float* ab = (float*)(F.ws + WS_AB);
    const bf16* Y = (const bf16*)(F.ws + WS_XS); const int* tok_slot = (const int*)(F.ws + WS_TOKS);
    const int lane = F.lane, gw = F.bid * 8 + F.wave, NGW = F.G * 8;
    for (int tok = gw; tok < NTOK; tok += NGW) {
        f32x4 v[4]; load_row_bf16(hb + (size_t)tok * D, v, lane);
#pragma unroll
        for (int j = 0; j < 4; ++j) v[j] = v[j] * ALPHA;
#pragma unroll
        for (int kk = 0; kk < 4; ++kk) { const int slot = tok_slot[(size_t)tok * 4 + kk]; const bf16* yr = Y + (size_t)slot * D;
#pragma unroll
            for (int j = 0; j < 4; ++j) { const v2u w = *(const v2u*)(yr + 4 * lane + 256 * j); v[j][0] += bf_lo(w.x); v[j][1] += bf_hi(w.x); v[j][2] += bf_lo(w.y); v[j][3] += bf_hi(w.y); } }
        ln_apply(v, as_global(F.in[I_LN2G]) + (size_t)l * D, as_global(F.in[I_LN2B]) + (size_t)l * D, lane);
        if (l + 1 < DEPTH) { store_row_bf16(hb + (size_t)tok * D, v, lane); small_proj(v, ws_s, ab + (size_t)tok * 8, lane); }
        else store_row_f32(F.out + (size_t)tok * D, v, lane);
    }
}


#define PHASE_FN __device__ __forceinline__
PHASE_FN void g_inproj(LAS unsigned char* lds, unsigned char* ws, int l, int G, int bid, int wave) { asm volatile("" : "+s"(ws)); ws = as_global(ws); asm volatile("" : "+s"(G)); asm volatile("" : "+s"(bid)); asm volatile("" : "+s"(l));
    pg8::SchedDense S{(const char*)(ws + WS_HB), (const char*)(ws + WS_WIN) + (size_t)l * NPROJ * D * 2, NTOK / 256, NPROJ / 256, G, bid, (size_t)256 * D * 2};
    pg8::EpiStoreBf16 E{(bf16*)(ws + WS_R1), NPROJ};
    pg8::gemm_phase<pg8::EpiStoreBf16, pg8::SchedDense, true, true>(lds, D, S, E, wave);
}
PHASE_FN void g_kvproj(LAS unsigned char* lds, unsigned char* ws, int l, int G, int bid, int wave) { asm volatile("" : "+s"(ws)); ws = as_global(ws); asm volatile("" : "+s"(G)); asm volatile("" : "+s"(bid)); asm volatile("" : "+s"(l));
    pg8::SchedDense S{(const char*)(ws + WS_MEMB), (const char*)(ws + WS_WKV) + (size_t)l * D * D * 2, NB * NMEM / 256, D / 256, G, bid, (size_t)256 * D * 2};
    pg8::EpiKV E{(bf16*)(ws + WS_KVB), (bf16*)(ws + WS_KVB + 512 * 1024)};
    pg8::gemm_phase<pg8::EpiKV, pg8::SchedDense, true, true>(lds, D, S, E, wave);
}
PHASE_FN void g_branch1(LAS unsigned char* lds, unsigned char* ws, int l, int G, int bid, int wave) { asm volatile("" : "+s"(ws)); ws = as_global(ws); asm volatile("" : "+s"(G)); asm volatile("" : "+s"(bid)); asm volatile("" : "+s"(l));
    pg8::SchedBranch S{(const char*)(ws + WS_YA), (const char*)(ws + WS_YB), (const char*)(ws + WS_YM), (const char*)(ws + WS_WBR) + (size_t)l * 3 * D * 512 * 2, (size_t)D * 512 * 2,
                       NTOK / 256, D / 256, G - 32, bid - 32, 1, 1, 1, (size_t)256 * 512 * 2};
    pg8::EpiBranch E{(const bf16*)(ws + WS_R1), (bf16*)(ws + WS_MB), 1};
    pg8::gemm_phase<pg8::EpiBranch, pg8::SchedBranch, true, true>(lds, 512, S, E, wave);
}
PHASE_FN void g_branch(LAS unsigned char* lds, unsigned char* ws, int l, int G, int bid, int wave) { asm volatile("" : "+s"(ws)); ws = as_global(ws); asm volatile("" : "+s"(G)); asm volatile("" : "+s"(bid)); asm volatile("" : "+s"(l));
    pg8::SchedBranch S{(const char*)(ws + WS_YA), (const char*)(ws + WS_YB), (const char*)(ws + WS_YM), (const char*)(ws + WS_WBR) + (size_t)l * 3 * D * 512 * 2, (size_t)D * 512 * 2,
                       NTOK / 256, D / 256, G, bid, 2, 0, 2, (size_t)256 * 512 * 2};
    pg8::EpiBranch E{(const bf16*)(ws + WS_R1), (bf16*)(ws + WS_MB), 1};
    pg8::gemm_phase<pg8::EpiBranch, pg8::SchedBranch, true, true>(lds, 512, S, E, wave);
}
PHASE_FN void g_outproj(LAS unsigned char* lds, unsigned char* ws, int l, int G, int bid, int wave) { asm volatile("" : "+s"(ws)); ws = as_global(ws); asm volatile("" : "+s"(G)); asm volatile("" : "+s"(bid)); asm volatile("" : "+s"(l));
    pg8::SchedDense S{(const char*)(ws + WS_MB), (const char*)(ws + WS_WO) + (size_t)l * D * D * 2, NTOK / 256, D / 256, G, bid, (size_t)256 * D * 2};
    pg8::EpiOut E{(const bf16*)(ws + WS_HB), (bf16*)(ws + WS_HF)};
    pg8::gemm_phase<pg8::EpiOut, pg8::SchedDense, true, true>(lds, D, S, E, wave);
}
PHASE_FN void g_gateup(LAS unsigned char* lds, unsigned char* ws, const float* bgu, int l, int G, int bid, int wave) { asm volatile("" : "+s"(ws)); ws = as_global(ws); asm volatile("" : "+s"(G)); asm volatile("" : "+s"(bid)); asm volatile("" : "+s"(l)); bgu = as_global(bgu);
    const int* meta = (const int*)(ws + WS_META); const int n_tiles = __builtin_amdgcn_readfirstlane(meta[0]);
    pg8::SchedGrouped S{(const char*)(ws + WS_HB), (const char*)(ws + WS_WGU) + (size_t)l * NE * 2048 * D * 2, (size_t)2048 * D * 2, meta + 64, n_tiles, 8, G, bid, (size_t)256 * D * 2, (const int*)(ws + WS_SLOTT)};
    pg8::EpiSwiglu E{(bf16*)(ws + WS_HBUF), bgu + (size_t)l * NE * 2048};
    pg8::gemm_phase<pg8::EpiSwiglu, pg8::SchedGrouped, true, true, true>(lds, D, S, E, wave);
}
PHASE_FN void g_down(LAS unsigned char* lds, unsigned char* ws, const float* bd, int l, int G, int bid, int wave) { asm volatile("" : "+s"(ws)); ws = as_global(ws); asm volatile("" : "+s"(G)); asm volatile("" : "+s"(bid)); asm volatile("" : "+s"(l)); bd = as_global(bd);
    const int* meta = (const int*)(ws + WS_META); const int n_tiles = __builtin_amdgcn_readfirstlane(meta[0]);
    pg8::SchedGrouped S{(const char*)(ws + WS_HBUF), (const char*)(ws + WS_WD) + (size_t)l * NE * D * D * 2, (size_t)D * D * 2, meta + 64, n_tiles, 4, G, bid, (size_t)256 * D * 2, nullptr};
    pg8::EpiDown E{(bf16*)(ws + WS_XS), bd + (size_t)l * NE * D, (const float*)(ws + WS_SLOTW)};
    pg8::gemm_phase<pg8::EpiDown, pg8::SchedGrouped, true, true>(lds, D, S, E, wave);
}

constexpr int PH_PER_LAYER = 12, NPHASE = 1 + DEPTH * PH_PER_LAYER;
__global__ void __launch_bounds__(512, 2) fwd_kernel(Args args) {
    extern __shared__ __attribute__((aligned(16))) unsigned char lds_raw[];
    Ctx F;
    F.lds = (LAS unsigned char*)lds_raw; F.tid = 0; F.lane = 0; F.wave = __builtin_amdgcn_readfirstlane((int)threadIdx.x >> 6); F.G = gridDim.x; F.bid = blockIdx.x;
    F.in = args.in; F.out = args.out; F.ws = args.ws;
    volatile LAS unsigned* MISC = (volatile LAS unsigned*)(F.lds + MISC_OFF);
    if (threadIdx.x < 64) MISC[threadIdx.x] = 0u;
    __syncthreads();
    const int lo = args.ph_lo, hi = args.ph_hi;
#define REP_BRANCH g_branch
#ifndef REP_PH
#define REP_PH -1
#define REP_N 0
#endif
#define NREP(k) (((k) == REP_PH) ? 1 + REP_N : 1)
#if MK_MULTI
#define GRID_BAR() do { } while (0)
#else
    XcdBarrier bar = xcd_barrier_post((unsigned*)(F.ws + WS_CTL) + CW_BAR, MISC + 8);
#define GRID_BAR() xcd_barrier(bar)
#endif
#define IN(k) (lo <= (k) && (k) < hi)
#define SEAM(k) do { if (IN(k) && IN((k) + 1)) GRID_BAR(); } while (0)

    if (IN(0)) { for (int rep_ = 0; rep_ < ((REP_PH == 100) ? 1 + REP_N : 1); ++rep_) { if (rep_) GRID_BAR(); { Ctx P = fresh(F); phase_prologue(P); } } } SEAM(0);

#define LAYER_PHASES(l) do { const int p0 = 1 + (l) * PH_PER_LAYER; \
        if (IN(p0 + 0)) { for (int rep_ = 0; rep_ < NREP(0); ++rep_) { if (rep_) GRID_BAR(); g_inproj(F.lds, F.ws, l, F.G, F.bid, F.wave); } } SEAM(p0 + 0); \
        if (IN(p0 + 1)) { for (int rep_ = 0; rep_ < NREP(1); ++rep_) { if (rep_) GRID_BAR(); g_kvproj(F.lds, F.ws, l, F.G, F.bid, F.wave); __syncthreads(); { Ctx P = fresh(F); phase_prep(P, l); } asm volatile("s_waitcnt vmcnt(0)" ::: "memory"); __syncthreads(); { Ctx P = fresh(F); phase_gdn_a(P); } } }   \
        SEAM(p0 + 2); \
        if (IN(p0 + 3)) { for (int rep_ = 0; rep_ < NREP(3); ++rep_) { if (rep_) GRID_BAR(); __syncthreads(); { Ctx P = fresh(F); if (P.bid < 32) phase_gdn_b(P); else { phase_xattn(P, P.bid - 32, P.G - 32); __syncthreads(); g_branch1(F.lds, F.ws, l, F.G, F.bid, F.wave); } } } } SEAM(p0 + 3); \
        if (IN(p0 + 4)) { for (int rep_ = 0; rep_ < NREP(4); ++rep_) { if (rep_) GRID_BAR(); __syncthreads(); { Ctx P = fresh(F); phase_gdn_c(P, l); } } } SEAM(p0 + 4); \
        if (IN(p0 + 5)) { for (int rep_ = 0; rep_ < NREP(5); ++rep_) { if (rep_) GRID_BAR(); __syncthreads(); if (rep_ == 0) g_branch(F.lds, F.ws, l, F.G, F.bid, F.wave); else REP_BRANCH(F.lds, F.ws, l, F.G, F.bid, F.wave); } } SEAM(p0 + 5); \
        if (IN(p0 + 6)) { for (int rep_ = 0; rep_ < NREP(6); ++rep_) { if (rep_) GRID_BAR(); g_outproj(F.lds, F.ws, l, F.G, F.bid, F.wave); } } SEAM(p0 + 6); \
        if (IN(p0 + 7)) { for (int rep_ = 0; rep_ < NREP(7); ++rep_) { if (rep_) GRID_BAR(); __syncthreads(); { Ctx P = fresh(F); phase_ln1_router(P, l); } } } SEAM(p0 + 7); \
        if (IN(p0 + 8)) { for (int rep_ = 0; rep_ < NREP(8); ++rep_) { if (rep_) GRID_BAR(); __syncthreads(); { Ctx P = fresh(F); phase_assign(P); } } } SEAM(p0 + 8); \
        if (IN(p0 + 9)) { for (int rep_ = 0; rep_ < NREP(9); ++rep_) { if (rep_) GRID_BAR(); __syncthreads(); g_gateup(F.lds, F.ws, as_global(F.in[I_BGU]), l, F.G, F.bid, F.wave); } } SEAM(p0 + 9); \
        if (IN(p0 + 10)) { for (int rep_ = 0; rep_ < NREP(10); ++rep_) { if (rep_) GRID_BAR(); g_down(F.lds, F.ws, as_global(F.in[I_BD]), l, F.G, F.bid, F.wave); } } SEAM(p0 + 10); \
        if (IN(p0 + 11)) { for (int rep_ = 0; rep_ < NREP(11); ++rep_) { if (rep_) GRID_BAR(); __syncthreads(); { Ctx P = fresh(F); phase_combine_ln2(P, l); } } } SEAM(p0 + 11); \
    } while (0)
    LAYER_PHASES(0);
    LAYER_PHASES(1);
#undef LAYER_PHASES
#undef IN
#undef SEAM
#undef GRID_BAR
}

extern "C" void kernel_launch(void* const* d_in, const int* in_sizes, int n_in, void* d_out, int out_size, void* d_ws, size_t ws_size, hipStream_t stream) {
    static int grid = 0;
    if (grid == 0) {
        if (n_in != 23 || out_size != NTOK * D || ws_size < WS_END) { fprintf(stderr, "kernel_launch: unexpected problem (n_in %d, out %d, ws %zu < %zu)\n", n_in, out_size, ws_size, (size_t)WS_END); grid = -1; return; }
        if (hipFuncSetAttribute((const void*)fwd_kernel, hipFuncAttributeMaxDynamicSharedMemorySize, LDS_BYTES) != hipSuccess) { fprintf(stderr, "kernel_launch: hipFuncSetAttribute failed\n"); grid = -1; return; }
        int per_cu = 0;
        if (hipOccupancyMaxActiveBlocksPerMultiprocessor(&per_cu, (const void*)fwd_kernel, 512, LDS_BYTES) != hipSuccess || per_cu < 1) fprintf(stderr, "kernel_launch: occupancy query reports %d\n", per_cu);
        (void)hipGetLastError();
        grid = 256;
    }
    if (grid < 0) return;
    (void)hipMemsetAsync((char*)d_ws + WS_CTL, 0, CTL_ZERO_BYTES, stream);
    Args a{};
    for (int i = 0; i < 23; ++i) a.in[i] = (const float*)d_in[i];
    a.out = (float*)d_out; a.ws = (unsigned char*)d_ws;
#if MK_MULTI
    for (int p = 0; p < NPHASE; ++p) { a.ph_lo = p; a.ph_hi = p + 1; hipLaunchKernelGGL(fwd_kernel, dim3(grid), dim3(512), LDS_BYTES, stream, a); }
#else
    a.ph_lo = 0; a.ph_hi = NPHASE;
    hipLaunchKernelGGL(fwd_kernel, dim3(grid), dim3(512), LDS_BYTES, stream, a);
#endif
}
```

```cpp
#include <hip/hip_runtime.h>
#include <cstdio>
#include <cstdint>

#ifndef MK_MULTI
#define MK_MULTI 0
#endif

#define LAS __attribute__((address_space(3)))
typedef unsigned short bf16;
typedef unsigned v4u __attribute__((ext_vector_type(4)));
typedef unsigned v2u __attribute__((ext_vector_type(2)));
typedef float f32x4 __attribute__((ext_vector_type(4)));
typedef float f32x2 __attribute__((ext_vector_type(2)));
typedef short bf16x8 __attribute__((ext_vector_type(8)));

constexpr int NB = 2, T = 16384, NTOK = NB * T, D = 1024, DEPTH = 2;
constexpr int NPROJ = 7168;
constexpr int NPROJ_SRC = 7176;
constexpr int C_Q = 0, C_K = 512, C_V = 1024, C_Z = 1536, C_XC = 2048, C_GB = 2560, C_GC = 3072, C_QM = 3584, C_GL = 4096;
constexpr int NMEM = 256, NE = 32, TOPK = 4, DFF = 1024;
constexpr int NSLOT_MAX = 544 * 256;
constexpr float ALPHA = 1.41421356237309515f;
constexpr float LN_EPS = 1e-5f, RMS_EPS = 1e-6f;

constexpr size_t MiB = 1u << 20;
constexpr size_t WS_CTL = 0, CTL_ZERO_BYTES = 1 * MiB;
constexpr size_t WS_WIN = 1 * MiB;
constexpr size_t WS_WBR = WS_WIN + 28 * MiB;
constexpr size_t WS_WO = WS_WBR + 6 * MiB;
constexpr size_t WS_WKV = WS_WO + 4 * MiB;
constexpr size_t WS_WGU = WS_WKV + 4 * MiB;
constexpr size_t WS_WD = WS_WGU + 256 * MiB;
constexpr size_t WS_MEMB = WS_WD + 128 * MiB;
constexpr size_t WS_KVB = WS_MEMB + 1 * MiB;
constexpr size_t WS_HF = WS_KVB + 1 * MiB;
constexpr size_t WS_HB = WS_HF + 128 * MiB;
constexpr size_t WS_AB = WS_HB + 64 * MiB;
constexpr size_t WS_R1 = WS_AB + 1 * MiB;
constexpr size_t WS_XS = WS_R1, WS_HBUF = WS_R1 + 272 * MiB;
constexpr size_t WS_KN = WS_R1 + 544 * MiB;
constexpr size_t WS_QN = WS_KN + 32 * MiB;
constexpr size_t WS_VV = WS_QN + 32 * MiB;
constexpr size_t WS_GS = WS_VV + 32 * MiB;
constexpr size_t WS_ATF = WS_GS + 2 * MiB;
constexpr size_t WS_BC = WS_ATF + 64 * MiB;
constexpr size_t WS_QTF = WS_BC + 64 * MiB;
constexpr size_t WS_OL = WS_QTF + 32 * MiB;
constexpr size_t WS_ST = WS_OL + 64 * MiB;
constexpr size_t WS_CD = WS_ST + 64 * MiB;
constexpr size_t WS_UPK = WS_CD + 1 * MiB;
constexpr size_t WS_WPK = WS_UPK + 32 * MiB;
constexpr size_t WS_YA = WS_WPK + 32 * MiB;
constexpr size_t WS_YB = WS_YA + 32 * MiB, WS_YM = WS_YB + 32 * MiB;
constexpr size_t WS_MF = WS_YM + 32 * MiB;
constexpr size_t WS_MB = WS_MF + 128 * MiB;
constexpr size_t WS_TOKE = WS_MB + 64 * MiB;
constexpr size_t WS_TOKW = WS_TOKE + MiB / 2;
constexpr size_t WS_TOKS = WS_TOKW + MiB / 2;
constexpr size_t WS_SLOTW = WS_TOKS + MiB / 2;
constexpr size_t WS_CNT = WS_SLOTW + 1 * MiB;
constexpr size_t WS_META = WS_CNT + MiB / 4;
constexpr size_t WS_SLOTT = WS_META + MiB / 4;
constexpr size_t WS_END = WS_SLOTT + 1 * MiB;
static_assert(WS_END <= (size_t)2048 * MiB, "workspace map exceeds 2 GiB");
constexpr int CW_BAR = 4096;

constexpr int LDS_BYTES = 159744;
constexpr int MISC_OFF = LDS_BYTES - 256;

#define GAS __attribute__((address_space(1)))
template <class Tp> __device__ __forceinline__ Tp* as_global(Tp* p) { GAS Tp* g = (GAS Tp*)p; asm("" : "+s"(g)); return (Tp*)g; }
#define LDS_WAIT() asm volatile("s_waitcnt lgkmcnt(0)" ::: "memory")
#define VM_WAIT() asm volatile("s_waitcnt vmcnt(0)" ::: "memory")
__device__ __forceinline__ unsigned cvt_pk_bf16(float lo, float hi) { unsigned r; asm volatile("v_cvt_pk_bf16_f32 %0, %1, %2" : "=v"(r) : "v"(lo), "v"(hi)); return r; }
__device__ __forceinline__ unsigned cvt_pk_bf16_n(float lo, float hi) { unsigned r; asm volatile("v_cvt_pk_bf16_f32 %0, %1, %2\n\ts_nop 1" : "=v"(r) : "v"(lo), "v"(hi)); return r; }
typedef __bf16 bf16x2_t __attribute__((ext_vector_type(2)));
__device__ __forceinline__ unsigned cvt_pk_nat(float lo, float hi) { bf16x2_t v; v[0] = (__bf16)lo; v[1] = (__bf16)hi; return __builtin_bit_cast(unsigned, v); }
__device__ __forceinline__ float bf_lo(unsigned w) { return __uint_as_float(w << 16); }
__device__ __forceinline__ float bf_hi(unsigned w) { return __uint_as_float(w & 0xffff0000u); }
__device__ __forceinline__ float fast_rcp(float x) { return __builtin_amdgcn_rcpf(x); }
__device__ __forceinline__ float sigmoidf_(float x) { return fast_rcp(1.0f + __expf(-x)); }
__device__ __forceinline__ float siluf_(float x) { return x * sigmoidf_(x); }
__device__ __forceinline__ float dpp_f(float v, int ctrl_sel) {
    const int s = __builtin_bit_cast(int, v); int r;
    if (ctrl_sel == 0) r = __builtin_amdgcn_update_dpp(0, s, 0xB1, 0xF, 0xF, true);
    else if (ctrl_sel == 1) r = __builtin_amdgcn_update_dpp(0, s, 0x4E, 0xF, 0xF, true);
    else if (ctrl_sel == 2) r = __builtin_amdgcn_update_dpp(0, s, 0x141, 0xF, 0xF, true);
    else r = __builtin_amdgcn_update_dpp(0, s, 0x140, 0xF, 0xF, true);
    return __builtin_bit_cast(float, r);
}
__device__ __forceinline__ float row16_sum(float v) {
    v += dpp_f(v, 0); v += dpp_f(v, 1); v += dpp_f(v, 2); v += dpp_f(v, 3); return v;
}
__device__ __forceinline__ float rdlane(float v, int l) { return __builtin_bit_cast(float, __builtin_amdgcn_readlane(__builtin_bit_cast(int, v), l)); }
__device__ __forceinline__ float wave_sum(float v) { v = row16_sum(v); return (rdlane(v, 0) + rdlane(v, 16)) + (rdlane(v, 32) + rdlane(v, 48)); }
__device__ __forceinline__ float bperm(float v, int src_lane) { return __builtin_bit_cast(float, __builtin_amdgcn_ds_bpermute(src_lane << 2, __builtin_bit_cast(int, v))); }

#define XB_TMO      128
#define XB_XCNT(j)  (256  + 64 * (j))
#define XB_XSUB(j)  (1280 + 64 * (j))
#define XB_XGEN(j)  (2304 + 64 * (j))
#define XB_TOP      3328
#define XB_TOPGEN   3392
#define XCD_BAR_WORDS 3456
#define XB_SPIN_CAP (1u << 18)
__device__ __forceinline__ unsigned xb_ld(unsigned* p)              { return __hip_atomic_load(p, __ATOMIC_RELAXED, __HIP_MEMORY_SCOPE_AGENT); }
__device__ __forceinline__ unsigned xb_add(unsigned* p, unsigned v) { return __hip_atomic_fetch_add(p, v, __ATOMIC_RELAXED, __HIP_MEMORY_SCOPE_AGENT); }
__device__ __forceinline__ unsigned xb_xcc_id() { return (unsigned)__builtin_amdgcn_s_getreg((3 << 11) | 20) & 0xFu; }
#define XB_SPIN(cond, bar) do { unsigned _sp = 0; while (cond) { __builtin_amdgcn_s_sleep(1); \
    if ((++_sp & 255u) == 0u) { if (xb_ld(&(bar)[XB_TMO])) break; if (_sp > XB_SPIN_CAP) { atomicAdd(&(bar)[XB_TMO], 1u); break; } } } } while (0)
struct XcdBarrier { unsigned* bar; unsigned x; volatile LAS unsigned* st; };
__device__ __forceinline__ XcdBarrier xcd_barrier_post(unsigned* bar, volatile LAS unsigned* st) {
    XcdBarrier b; b.bar = bar; b.x = xb_xcc_id(); b.st = st;
    if (threadIdx.x == 0) (void)xb_add(&bar[XB_XCNT(b.x)], 1u);
    return b;
}
__device__ __forceinline__ void xcd_barrier_complete(unsigned* bar, unsigned x, unsigned& nloc, unsigned& nx) {
    const unsigned G = gridDim.x * gridDim.y * gridDim.z;
    unsigned sum, cnt, mine, sp = 0u;
    for (;;) {
        sum = 0u; cnt = 0u; mine = 0u;
#pragma unroll
        for (unsigned j = 0; j < 16; ++j) { const unsigned c = xb_ld(&bar[XB_XCNT(j)]); sum += c; cnt += (c > 0u) ? 1u : 0u; mine = (j == x) ? c : mine; }
        if (sum == G) break;
        __builtin_amdgcn_s_sleep(1);
        if ((++sp & 255u) == 0u) { if (xb_ld(&bar[XB_TMO])) break; if (sp > XB_SPIN_CAP) { atomicAdd(&bar[XB_TMO], 1u); break; } }
    }
    nloc = mine > 0u ? mine : 1u; nx = cnt > 0u ? cnt : 1u;
}
__device__ __forceinline__ void xcd_barrier(const XcdBarrier& b) {
    asm volatile("s_waitcnt vmcnt(0)" ::: "memory");
    __syncthreads();
    if (threadIdx.x == 0) {
        unsigned* bar = b.bar;
        __builtin_amdgcn_s_waitcnt(0);
        unsigned nloc = b.st[0], nx = b.st[1];
        if (nloc == 0u) { xcd_barrier_complete(bar, b.x, nloc, nx); b.st[0] = nloc; b.st[1] = nx; }
        const unsigned old = xb_add(&bar[XB_XSUB(b.x)], 1u);
        const unsigned gen = old / nloc;
        if (old + 1u == (gen + 1u) * nloc) {
            __builtin_amdgcn_fence(__ATOMIC_RELEASE, "agent");
            asm volatile("s_waitcnt vmcnt(0)" ::: "memory");
            const unsigned og = xb_add(&bar[XB_TOP], 1u);
            const unsigned tg = og / nx;
            if (og + 1u == (tg + 1u) * nx) xb_add(&bar[XB_TOPGEN], 1u);
            else XB_SPIN(xb_ld(&bar[XB_TOPGEN]) == tg, bar);
            __builtin_amdgcn_fence(__ATOMIC_ACQUIRE, "agent");
            xb_add(&bar[XB_XGEN(b.x)], 1u);
            asm volatile("s_waitcnt vmcnt(0)" ::: "memory");
        } else {
            XB_SPIN(xb_ld(&bar[XB_XGEN(b.x)]) == gen, bar);
            __builtin_amdgcn_fence(__ATOMIC_ACQUIRE, "agent");
            asm volatile("s_waitcnt vmcnt(0)" ::: "memory");
        }
    }
    __syncthreads();
}

namespace pg8 {
constexpr int BM = 256, BK = 64, HALF = 128, HTB = HALF * BK * 2, STAGE_BYTES = 8 * HTB, NXCD = 8, WGM = 8;
__host__ __device__ __forceinline__ int lds_byte(int r, int c) { const int st = (r >> 4) * 2 + (c >> 5), rr = r & 15, cc = c & 31, ob = rr * 64 + cc * 2; return st * 1024 + (ob ^ (((ob >> 9) & 1) << 5)); }
__host__ __device__ __forceinline__ void stage_rc(int b, int& R, int& C) { const int st = b / 1024, sb = b % 1024, swz = sb ^ (((sb >> 9) & 1) << 5); R = (st >> 1) * 16 + swz / 64; C = (st & 1) * 32 + (swz % 64) / 2; }
__host__ __device__ __forceinline__ int perm32(int rho) { const int n = rho >> 4, i = rho & 15; return 8 * (i >> 2) + 4 * n + (i & 3); }

struct Unit { int pm, pn, e; const char* a; const char* b; };

__device__ __forceinline__ void tile_map(int L, int nM, int nN, int& pm, int& pn) {
    const int nwg = nM * nN; int wgid = L;
    { const int q = nwg / NXCD, r = nwg % NXCD, xcd = wgid % NXCD, off = wgid / NXCD; wgid = (xcd < r ? xcd * (q + 1) : r * (q + 1) + (xcd - r) * q) + off; }
    const int nig = WGM * nN, gid = wgid / nig, fm = gid * WGM, gsz = (nM - fm) < WGM ? (nM - fm) : WGM;
    pm = fm + ((wgid % nig) % gsz); pn = (wgid % nig) / gsz;
}
struct SchedDense {
    const char* A; const char* B; int nM, nN, G, c; size_t tstep;
    __device__ __forceinline__ bool next(int i, Unit& u) const {
        const long L = (long)i * G + c; if (L >= (long)nM * nN) return false;
        tile_map((int)L, nM, nN, u.pm, u.pn); u.e = 0; u.a = A + (size_t)u.pm * tstep; u.b = B + (size_t)u.pn * tstep; return true; }
    __device__ __forceinline__ int row_of(int, int) const { return 0; }
};
struct SchedBranch {
    const char* A0; const char* A1; const char* A2; const char* B; size_t bstride; int nM, nN, G, c, nb, b0, b1; size_t tstep;
    __device__ __forceinline__ bool next(int i, Unit& u) const {
        const int nwg = nM * nN, j = i % nb; const long Lr = (long)(i / nb) * G + c; if (Lr >= nwg) return false;
        const int br = (j == 0) ? b0 : b1;
        tile_map((int)Lr, nM, nN, u.pm, u.pn); u.e = br; u.a = (br == 0 ? A0 : (br == 1 ? A1 : A2)) + (size_t)u.pm * tstep; u.b = B + (size_t)br * bstride + (size_t)u.pn * tstep; return true; }
    __device__ __forceinline__ int row_of(int, int) const { return 0; }
};
struct SchedGrouped {
    const char* A; const char* B; size_t estride; const int* tile_e; int nM, nN, G, c; size_t tstep; const int* rows;
    __device__ __forceinline__ bool next(int i, Unit& u) const {
        const long L = (long)i * G + c; if (L >= (long)nM * nN) return false;
        tile_map((int)L, nM, nN, u.pm, u.pn); u.e = __builtin_amdgcn_readfirstlane(tile_e[u.pm]); u.a = rows ? A : A + (size_t)u.pm * tstep; u.b = B + (size_t)u.e * estride + (size_t)u.pn * tstep; return true; }
    __device__ __forceinline__ int row_of(int pm, int r) const { return rows[pm * BM + r]; }
};
struct EpiStoreBf16 {
    static constexpr bool PERM = true;
    bf16* O; int ldc;
    __device__ __forceinline__ void operator()(const f32x4 (&acc)[2][2][4][2], const Unit& u, int wr, int wc, int fr, int fq) const {
        const int row0 = u.pm * BM + wr * 64 + fr, col0 = u.pn * BM + wc * 32 + 8 * fq;
#pragma unroll
        for (int ai = 0; ai < 2; ++ai)
#pragma unroll
            for (int m = 0; m < 4; ++m) { bf16* rowp = O + (size_t)(row0 + ai * HALF + m * 16) * ldc + col0;
#pragma unroll
                for (int bj = 0; bj < 2; ++bj) { const f32x4 v0 = acc[ai][bj][m][0], v1 = acc[ai][bj][m][1];
                    v4u w; w.x = cvt_pk_bf16(v0[0], v0[1]); w.y = cvt_pk_bf16(v0[2], v0[3]); w.z = cvt_pk_bf16(v1[0], v1[1]); w.w = cvt_pk_bf16(v1[2], v1[3]);
                    *(v4u*)(rowp + bj * HALF) = w; } }
    }
};
struct EpiKV {
    static constexpr bool PERM = true;
    bf16* K; bf16* VT;
    __device__ __forceinline__ void operator()(const f32x4 (&acc)[2][2][4][2], const Unit& u, int wr, int wc, int fr, int fq) const {
        const int row0 = wr * 64 + fr, colt = u.pn * BM + wc * 32 + 8 * fq;
#pragma unroll
        for (int ai = 0; ai < 2; ++ai)
#pragma unroll
            for (int m = 0; m < 4; ++m) { const int key = row0 + ai * HALF + m * 16;
#pragma unroll
                for (int bj = 0; bj < 2; ++bj) { const f32x4 v0 = acc[ai][bj][m][0], v1 = acc[ai][bj][m][1]; const int col = colt + bj * HALF;
                    v4u w; w.x = cvt_pk_bf16(v0[0], v0[1]); w.y = cvt_pk_bf16(v0[2], v0[3]); w.z = cvt_pk_bf16(v1[0], v1[1]); w.w = cvt_pk_bf16(v1[2], v1[3]);
                    if (u.pn < 2) *(v4u*)(K + (size_t)(u.pm * BM + key) * 512 + col) = w;
                    else { bf16* d = VT + ((size_t)u.pm * 512 + (col - 512)) * 256 + key;
                        d[0] = (bf16)(w.x & 0xffff); d[256] = (bf16)(w.x >> 16); d[512] = (bf16)(w.y & 0xffff); d[768] = (bf16)(w.y >> 16);
                        d[1024] = (bf16)(w.z & 0xffff); d[1280] = (bf16)(w.z >> 16); d[1536] = (bf16)(w.w & 0xffff); d[1792] = (bf16)(w.w >> 16); } } }
    }
};
struct EpiBranch {
    static constexpr bool PERM = true;
    const bf16* proj; bf16* mb; int store_br;
    __device__ __forceinline__ void operator()(const f32x4 (&acc)[2][2][4][2], const Unit& u, int wr, int wc, int fr, int fq) const {
        const int row0 = u.pm * BM + wr * 64 + fr, col0 = u.pn * BM + wc * 32 + 8 * fq; const int br = u.e; const bool accum = (br != store_br);
        const bf16* gp = proj + (size_t)row0 * NPROJ + C_GL + br * D + col0; bf16* mp = mb + (size_t)row0 * D + col0;
#pragma unroll
        for (int ai = 0; ai < 2; ++ai) {
            v4u gw[4][2], ow[4][2];
#pragma unroll
            for (int m = 0; m < 4; ++m)
#pragma unroll
                for (int bj = 0; bj < 2; ++bj) { const size_t ro = (size_t)(ai * HALF + m * 16); const int co = bj * HALF;
                    gw[m][bj] = *(const v4u*)(gp + ro * NPROJ + co); ow[m][bj] = accum ? *(const v4u*)(mp + ro * D + co) : (v4u){0u, 0u, 0u, 0u}; }
#pragma unroll
            for (int m = 0; m < 4; ++m)
#pragma unroll
                for (int bj = 0; bj < 2; ++bj) { const size_t ro = (size_t)(ai * HALF + m * 16); const int co = bj * HALF; const v4u g4 = gw[m][bj], o = ow[m][bj];
                    const f32x4 a0 = acc[ai][bj][m][0], a1 = acc[ai][bj][m][1];
                    v4u w;
                    w.x = cvt_pk_bf16(sigmoidf_(bf_lo(g4.x)) * a0[0] + bf_lo(o.x), sigmoidf_(bf_hi(g4.x)) * a0[1] + bf_hi(o.x));
                    w.y = cvt_pk_bf16(sigmoidf_(bf_lo(g4.y)) * a0[2] + bf_lo(o.y), sigmoidf_(bf_hi(g4.y)) * a0[3] + bf_hi(o.y));
                    w.z = cvt_pk_bf16(sigmoidf_(bf_lo(g4.z)) * a1[0] + bf_lo(o.z), sigmoidf_(bf_hi(g4.z)) * a1[1] + bf_hi(o.z));
                    w.w = cvt_pk_bf16(sigmoidf_(bf_lo(g4.w)) * a1[2] + bf_lo(o.w), sigmoidf_(bf_hi(g4.w)) * a1[3] + bf_hi(o.w));
                    *(v4u*)(mp + ro * D + co) = w; }
        }
    }
};
struct EpiOut {
    static constexpr bool PERM = true;
    const bf16* hb; bf16* tb;
    __device__ __forceinline__ void operator()(const f32x4 (&acc)[2][2][4][2], const Unit& u, int wr, int wc, int fr, int fq) const {
        const int row0 = u.pm * BM + wr * 64 + fr, col0 = u.pn * BM + wc * 32 + 8 * fq;
        const bf16* hp = hb + (size_t)row0 * D + col0; bf16* tp = tb + (size_t)row0 * D + col0;
#pragma unroll
        for (int ai = 0; ai < 2; ++ai) {
            v4u hw[4][2];
#pragma unroll
            for (int m = 0; m < 4; ++m)
#pragma unroll
                for (int bj = 0; bj < 2; ++bj) hw[m][bj] = *(const v4u*)(hp + (size_t)(ai * HALF + m * 16) * D + bj * HALF);
#pragma unroll
            for (int m = 0; m < 4; ++m)
#pragma unroll
                for (int bj = 0; bj < 2; ++bj) { const v4u h = hw[m][bj]; const f32x4 a0 = acc[ai][bj][m][0], a1 = acc[ai][bj][m][1];
                    v4u w; w.x = cvt_pk_bf16(bf_lo(h.x) * ALPHA + a0[0], bf_hi(h.x) * ALPHA + a0[1]); w.y = cvt_pk_bf16(bf_lo(h.y) * ALPHA + a0[2], bf_hi(h.y) * ALPHA + a0[3]);
                    w.z = cvt_pk_bf16(bf_lo(h.z) * ALPHA + a1[0], bf_hi(h.z) * ALPHA + a1[1]); w.w = cvt_pk_bf16(bf_lo(h.w) * ALPHA + a1[2], bf_hi(h.w) * ALPHA + a1[3]);
                    *(v4u*)(tp + (size_t)(ai * HALF + m * 16) * D + bj * HALF) = w; }
        }
    }
};
struct EpiSwiglu {
    static constexpr bool PERM = true;
    bf16* H; const float* bgu;
    __device__ __forceinline__ void operator()(const f32x4 (&acc)[2][2][4][2], const Unit& u, int wr, int wc, int fr, int fq) const {
        const int row0 = u.pm * BM + wr * 64 + fr, cc0 = u.pn * HALF + wc * 32 + 8 * fq;
        const float* bg = bgu + (size_t)u.e * 2048 + cc0;
        f32x4 bgv[2], buv[2];
#pragma unroll
        for (int n = 0; n < 2; ++n) { bgv[n] = *(const f32x4*)(bg + 4 * n); buv[n] = *(const f32x4*)(bg + 1024 + 4 * n); }
#pragma unroll
        for (int ai = 0; ai < 2; ++ai)
#pragma unroll
            for (int m = 0; m < 4; ++m) { float h[8];
#pragma unroll
                for (int n = 0; n < 2; ++n)
#pragma unroll
                    for (int j = 0; j < 4; ++j) { float g = acc[ai][0][m][n][j] + bgv[n][j], up = acc[ai][1][m][n][j] + buv[n][j];
                        g = fminf(g, 7.0f); up = fminf(fmaxf(up, -7.0f), 7.0f);
                        h[n * 4 + j] = (up + 1.0f) * (g * sigmoidf_(g * 1.702f)); }
                v4u w; w.x = cvt_pk_bf16(h[0], h[1]); w.y = cvt_pk_bf16(h[2], h[3]); w.z = cvt_pk_bf16(h[4], h[5]); w.w = cvt_pk_bf16(h[6], h[7]);
                *(v4u*)(H + (size_t)(row0 + ai * HALF + m * 16) * DFF + cc0) = w; }
    }
};
struct EpiDown {
    static constexpr bool PERM = true;
    bf16* Y; const float* bd; const float* slot_w;
    __device__ __forceinline__ void operator()(const f32x4 (&acc)[2][2][4][2], const Unit& u, int wr, int wc, int fr, int fq) const {
        const int row0 = u.pm * BM + wr * 64 + fr, col0 = u.pn * BM + wc * 32 + 8 * fq;
        const float* bp = bd + (size_t)u.e * D + col0;
        f32x4 bv[2][2];
#pragma unroll
        for (int bj = 0; bj < 2; ++bj)
#pragma unroll
            for (int n = 0; n < 2; ++n) bv[bj][n] = *(const f32x4*)(bp + bj * HALF + 4 * n);
#pragma unroll
        for (int ai = 0; ai < 2; ++ai)
#pragma unroll
            for (int m = 0; m < 4; ++m) { const int row = row0 + ai * HALF + m * 16; const float sw = slot_w[row]; bf16* rowp = Y + (size_t)row * D + col0;
#pragma unroll
                for (int bj = 0; bj < 2; ++bj) { const f32x4 v0 = (acc[ai][bj][m][0] + bv[bj][0]) * sw, v1 = (acc[ai][bj][m][1] + bv[bj][1]) * sw;
                    v4u w; w.x = cvt_pk_bf16(v0[0], v0[1]); w.y = cvt_pk_bf16(v0[2], v0[3]); w.z = cvt_pk_bf16(v1[0], v1[1]); w.w = cvt_pk_bf16(v1[2], v1[3]);
                    *(v4u*)(rowp + bj * HALF) = w; } }
    }
};

template <class Epi, class Sched, bool ALIGN_EPI, bool SP2, bool GATHER = false>
__device__ __forceinline__ void gemm_phase(LAS unsigned char* lds, const int K, const Sched& S, const Epi& E, int wave_id) {
    unsigned z0_ = 0u; asm volatile("" : "+s"(z0_)); int ln_ = (int)__builtin_amdgcn_mbcnt_hi(~0u, __builtin_amdgcn_mbcnt_lo(~0u, z0_)); asm volatile("" : "+v"(ln_)); asm volatile("" : "+s"(wave_id));
    const int wid = wave_id, lane = ln_, tid = wid * 64 + lane, wr = wid >> 2, wc = wid & 3, fr = lane & 15, fq = lane >> 4;
    const int nt = K / BK;
    static_assert(!GATHER || SP2, "row gather is written for the two-super-phase loop");
    unsigned voffA[2], voffB[2], gC[2]; int gR[2];
    unsigned vAc[2][2], vAn[2][2];
#define PG8_ROWS(dst, pm_) do { _Pragma("unroll") for (int h_ = 0; h_ < 2; ++h_) _Pragma("unroll") for (int i_ = 0; i_ < 2; ++i_) dst[h_][i_] = (unsigned)S.row_of(pm_, h_ * HALF + gR[i_]) * (unsigned)(K * 2) + gC[i_]; } while (0)
#define PG8_STAGE_A(bufoff, gbase, h, OFF) do { if constexpr (GATHER) { PG8_STAGE(bufoff, gbase, OFF[h]); } else { PG8_STAGE(bufoff, (gbase) + (h) * hstep, voffA); } } while (0)
#pragma unroll
    for (int i = 0; i < 2; ++i) { int R, C; stage_rc(tid * 16 + i * 8192, R, C); const int Rb = Epi::PERM ? ((R & ~31) + perm32(R & 31)) : R;
        voffA[i] = (unsigned)(R * K + C) * 2u; voffB[i] = (unsigned)(Rb * K + C) * 2u; gR[i] = R; gC[i] = (unsigned)C * 2u; }
    const size_t kstep = (size_t)(BK * 2);
    const size_t hstep = (size_t)HALF * K * 2;
    const unsigned ldsw = (unsigned)wid * 1024u;
    const int aoff = lds_byte(wr * 64 + fr, fq * 8), boff = lds_byte(wc * 32 + fr, fq * 8);
#define PG8_SA(b, h) (((b) * 2 + (h)) * HTB)
#define PG8_SB(b, h) ((4 + (b) * 2 + (h)) * HTB)
#define PG8_STAGE(bufoff, gbase, voff) do { _Pragma("unroll") for (int _i = 0; _i < 2; ++_i) \
        __builtin_amdgcn_global_load_lds((const unsigned*)((const char*)(gbase) + (voff)[_i]), (LAS unsigned*)(lds + (bufoff) + ldsw + _i * 8192), 16, 0, 0); } while (0)
#define PG8_LDA(dst, b, h) do { _Pragma("unroll") for (int m = 0; m < 4; ++m) _Pragma("unroll") for (int k = 0; k < 2; ++k) dst[m][k] = *(const LAS bf16x8*)(lds + PG8_SA(b, h) + aoff + m * 2048 + k * 1024); } while (0)
#define PG8_LDB(dst, b, h) do { _Pragma("unroll") for (int n = 0; n < 2; ++n) _Pragma("unroll") for (int k = 0; k < 2; ++k) dst[n][k] = *(const LAS bf16x8*)(lds + PG8_SB(b, h) + boff + n * 2048 + k * 1024); } while (0)
#define PG8_MMA(ai, bj, At, Bt) do { __builtin_amdgcn_s_setprio(1); _Pragma("unroll") for (int m = 0; m < 4; ++m) _Pragma("unroll") for (int n = 0; n < 2; ++n) _Pragma("unroll") for (int k = 0; k < 2; ++k) \
        acc[ai][bj][m][n] = __builtin_amdgcn_mfma_f32_16x16x32_bf16(Bt[n][k], At[m][k], acc[ai][bj][m][n], 0, 0, 0); __builtin_amdgcn_s_setprio(0); } while (0)
#define PG8_WAIT_V(n) asm volatile("s_waitcnt vmcnt(" #n ")" ::: "memory")
#define PG8_WAIT_L(n) asm volatile("s_waitcnt lgkmcnt(" #n ")" ::: "memory")
#define PG8_BAR __builtin_amdgcn_s_barrier()
#define PG8_SCHED __builtin_amdgcn_sched_barrier(0)
    Unit cur, nxt; int ui = 0;
    if (!S.next(0, cur)) return;
    f32x4 acc[2][2][4][2];
#pragma unroll
    for (int a = 0; a < 2; ++a)
#pragma unroll
        for (int b = 0; b < 2; ++b)
#pragma unroll
            for (int m = 0; m < 4; ++m)
#pragma unroll
                for (int n = 0; n < 2; ++n) acc[a][b][m][n] = (f32x4){0.f, 0.f, 0.f, 0.f};
    bf16x8 At[4][2], B0[2][2], B1[2][2];
    const char* cA = cur.a; const char* cB = cur.b;
    if constexpr (SP2) {
        if constexpr (GATHER) { PG8_ROWS(vAc, cur.pm); asm volatile("s_waitcnt vmcnt(0)" ::: "memory"); }
        PG8_STAGE(PG8_SB(0, 0), cB, voffB); PG8_STAGE(PG8_SB(0, 1), cB + hstep, voffB); PG8_STAGE_A(PG8_SA(0, 0), cA, 0, vAc); PG8_STAGE_A(PG8_SA(0, 1), cA, 1, vAc);
        if (wr == 1) PG8_BAR;
        PG8_WAIT_V(2); PG8_BAR;
        PG8_STAGE(PG8_SB(1, 0), cB + kstep, voffB); PG8_STAGE_A(PG8_SA(1, 0), cA + kstep, 0, vAc); PG8_STAGE(PG8_SB(1, 1), cB + hstep + kstep, voffB);
        PG8_WAIT_V(6); PG8_BAR;
    } else {
        PG8_STAGE(PG8_SB(0, 0), cB, voffB); PG8_STAGE(PG8_SA(0, 0), cA, voffA); PG8_STAGE(PG8_SB(0, 1), cB + hstep, voffB); PG8_STAGE(PG8_SA(0, 1), cA + hstep, voffA);
        if (wr == 1) PG8_BAR;
        PG8_WAIT_V(4); PG8_BAR;
        PG8_STAGE(PG8_SB(1, 0), cB + kstep, voffB); PG8_STAGE(PG8_SA(1, 0), cA + kstep, voffA); PG8_STAGE(PG8_SB(1, 1), cB + hstep + kstep, voffB);
        PG8_WAIT_V(6); PG8_BAR;
    }
    for (;;) {
        const bool has_next = S.next(ui + 1, nxt);
        const char* nA = has_next ? nxt.a : cA; const char* nB = has_next ? nxt.b : cB;
        if constexpr (GATHER) { if (ui == 0) { if (has_next) PG8_ROWS(vAn, nxt.pm); else { _Pragma("unroll") for (int h_ = 0; h_ < 2; ++h_) _Pragma("unroll") for (int i_ = 0; i_ < 2; ++i_) vAn[h_][i_] = vAc[h_][i_]; } } }
        for (int t = 0; t < nt; t += 2) {
            const bool last = (t == nt - 2);
            const char* a1 = cA + (size_t)(t + 1) * kstep;
            const char* a2 = last ? nA : cA + (size_t)(t + 2) * kstep; const char* b2 = last ? nB : cB + (size_t)(t + 2) * kstep;
            const char* a3 = a2 + kstep; const char* b3 = b2 + kstep;
            if constexpr (SP2) {
            unsigned o2[2][2];
            if constexpr (GATHER) { _Pragma("unroll") for (int h_ = 0; h_ < 2; ++h_) _Pragma("unroll") for (int i_ = 0; i_ < 2; ++i_) o2[h_][i_] = last ? vAn[h_][i_] : vAc[h_][i_]; }
            PG8_LDB(B0, 0, 0); PG8_LDB(B1, 0, 1); PG8_SCHED; PG8_LDA(At, 0, 0); PG8_STAGE_A(PG8_SA(1, 1), a1, 1, vAc);
            PG8_WAIT_V(8); PG8_WAIT_L(0); PG8_BAR; PG8_MMA(0, 0, At, B0); PG8_MMA(0, 1, At, B1); PG8_BAR; PG8_SCHED;
            PG8_LDA(At, 0, 1); PG8_STAGE(PG8_SB(0, 0), b2, voffB); PG8_STAGE(PG8_SB(0, 1), b2 + hstep, voffB); PG8_STAGE_A(PG8_SA(0, 0), a2, 0, o2);
            PG8_WAIT_V(8); PG8_WAIT_L(0); PG8_BAR; PG8_MMA(1, 0, At, B0); PG8_MMA(1, 1, At, B1); PG8_BAR; PG8_SCHED;
            PG8_LDB(B0, 1, 0); PG8_LDB(B1, 1, 1); PG8_SCHED; PG8_LDA(At, 1, 0); PG8_STAGE_A(PG8_SA(0, 1), a2, 1, o2);
            PG8_WAIT_V(8); PG8_WAIT_L(0); PG8_BAR; PG8_MMA(0, 0, At, B0); PG8_MMA(0, 1, At, B1); PG8_BAR; PG8_SCHED;
            PG8_LDA(At, 1, 1); PG8_STAGE(PG8_SB(1, 0), b3, voffB); PG8_STAGE(PG8_SB(1, 1), b3 + hstep, voffB); PG8_STAGE_A(PG8_SA(1, 0), a3, 0, o2);
            PG8_WAIT_V(8); PG8_WAIT_L(0); PG8_BAR; PG8_MMA(1, 0, At, B0); PG8_MMA(1, 1, At, B1); PG8_BAR; PG8_SCHED;
            } else {
            PG8_LDB(B0, 0, 0); PG8_SCHED; PG8_LDA(At, 0, 0); PG8_STAGE(PG8_SA(1, 1), a1 + hstep, voffA);
            PG8_WAIT_L(8); PG8_BAR; PG8_WAIT_L(0); PG8_MMA(0, 0, At, B0); PG8_BAR; PG8_SCHED;
            PG8_LDB(B1, 0, 1); PG8_STAGE(PG8_SB(0, 0), b2, voffB);
            PG8_BAR; PG8_WAIT_L(0); PG8_MMA(0, 1, At, B1); PG8_BAR;
            PG8_LDA(At, 0, 1); PG8_STAGE(PG8_SA(0, 0), a2, voffA);
            PG8_BAR; PG8_WAIT_L(0); PG8_MMA(1, 0, At, B0); PG8_BAR; PG8_SCHED;
            PG8_STAGE(PG8_SB(0, 1), b2 + hstep, voffB);
            PG8_WAIT_V(6); PG8_BAR; PG8_MMA(1, 1, At, B1); PG8_BAR;
            PG8_LDB(B0, 1, 0); PG8_SCHED; PG8_LDA(At, 1, 0); PG8_STAGE(PG8_SA(0, 1), a2 + hstep, voffA);
            PG8_WAIT_L(8); PG8_BAR; PG8_WAIT_L(0); PG8_MMA(0, 0, At, B0); PG8_BAR; PG8_SCHED;
            PG8_LDB(B1, 1, 1); PG8_STAGE(PG8_SB(1, 0), b3, voffB);
            PG8_BAR; PG8_WAIT_L(0); PG8_MMA(0, 1, At, B1); PG8_BAR;
            PG8_LDA(At, 1, 1); PG8_STAGE(PG8_SA(1, 0), a3, voffA);
            PG8_BAR; PG8_WAIT_L(0); PG8_MMA(1, 0, At, B0); PG8_BAR; PG8_SCHED;
            PG8_STAGE(PG8_SB(1, 1), b3 + hstep, voffB);
            PG8_WAIT_V(6); PG8_BAR; PG8_MMA(1, 1, At, B1); PG8_BAR;
            }
        }
        if constexpr (ALIGN_EPI) { if (wr == 0) PG8_BAR; }
        E(acc, cur, wr, wc, fr, fq);
        if (!has_next) break;
#pragma unroll
        for (int a = 0; a < 2; ++a)
#pragma unroll
            for (int b = 0; b < 2; ++b)
#pragma unroll
                for (int m = 0; m < 4; ++m)
#pragma unroll
                    for (int n = 0; n < 2; ++n) acc[a][b][m][n] = (f32x4){0.f, 0.f, 0.f, 0.f};
        if constexpr (GATHER) { _Pragma("unroll") for (int h_ = 0; h_ < 2; ++h_) _Pragma("unroll") for (int i_ = 0; i_ < 2; ++i_) vAc[h_][i_] = vAn[h_][i_];
            Unit nn; if (S.next(ui + 2, nn)) PG8_ROWS(vAn, nn.pm); }
        cur = nxt; cA = nA; cB = nB; ++ui;
        if constexpr (ALIGN_EPI) { if (wr == 1) PG8_BAR; }
    }
    PG8_WAIT_V(0);
    if constexpr (!ALIGN_EPI) { if (wr == 0) PG8_BAR; }
    PG8_BAR;
#undef PG8_ROWS
#undef PG8_STAGE_A
#undef PG8_SA
#undef PG8_SB
#undef PG8_STAGE
#undef PG8_LDA
#undef PG8_LDB
#undef PG8_MMA
#undef PG8_WAIT_V
#undef PG8_WAIT_L
#undef PG8_BAR
#undef PG8_SCHED
}
}

struct Args { const float* in[23]; float* out; unsigned char* ws; int ph_lo, ph_hi; };
struct Ctx {
    LAS unsigned char* lds; int tid, lane, wave, G, bid;
    const float* const* in; float* out; unsigned char* ws;
};
__device__ __forceinline__ Ctx fresh(const Ctx& F) {
    Ctx R = F; unsigned z0 = 0u; asm volatile("" : "+s"(z0)); int ln = (int)__builtin_amdgcn_mbcnt_hi(~0u, __builtin_amdgcn_mbcnt_lo(~0u, z0)); asm volatile("" : "+v"(ln));
    int wv = F.wave; asm volatile("" : "+s"(wv)); R.wave = wv; R.lane = ln; R.tid = wv * 64 + ln;
    unsigned char* w = F.ws; asm volatile("" : "+s"(w)); R.ws = as_global(w); R.out = as_global(F.out);
    int bd = F.bid, gg = F.G; asm volatile("" : "+s"(bd)); asm volatile("" : "+s"(gg)); R.bid = bd; R.G = gg;
    return R;
}
enum { I_X = 0, I_MEM, I_LN0G, I_LN0B, I_WIN, I_CONVQKV, I_CONVMIX, I_ALOG, I_DTB, I_GDNNORM, I_WMEMKV, I_WBR, I_WO, I_LN1G, I_LN1B, I_WR, I_BR, I_WGU, I_BGU, I_WD, I_BD, I_LN2G, I_LN2B };

__device__ __forceinline__ void transpose_item(const float* src, int ld, bf16* dst, int ldk, LAS float* scr, int lane) {
#pragma unroll 8
    for (int i = 0; i < 32; ++i) { const int kk = 2 * i + (lane >> 5); scr[kk * 33 + (lane & 31)] = src[(size_t)kk * ld + (lane & 31)]; }
    LDS_WAIT();
    const int c = lane & 7;
#pragma unroll
    for (int j = 0; j < 4; ++j) { const int n = (lane >> 3) + 8 * j; const LAS float* s = scr + (8 * c) * 33 + n;
        v4u o; o.x = cvt_pk_bf16(s[0 * 33], s[1 * 33]); o.y = cvt_pk_bf16(s[2 * 33], s[3 * 33]); o.z = cvt_pk_bf16(s[4 * 33], s[5 * 33]); o.w = cvt_pk_bf16(s[6 * 33], s[7 * 33]);
        *(v4u*)(dst + (size_t)n * ldk + 8 * c) = o; }
    LDS_WAIT();
}
__device__ __forceinline__ void ln_apply(f32x4 (&v)[4], const float* g, const float* b, int lane) {
    float s = 0.f;
#pragma unroll
    for (int j = 0; j < 4; ++j) s += (v[j][0] + v[j][1]) + (v[j][2] + v[j][3]);
    const float mean = wave_sum(s) * (1.f / D); float s2 = 0.f;
#pragma unroll
    for (int j = 0; j < 4; ++j) { v[j] = v[j] - mean; s2 += (v[j][0] * v[j][0] + v[j][1] * v[j][1]) + (v[j][2] * v[j][2] + v[j][3] * v[j][3]); }
    const float rstd = 1.f / sqrtf(wave_sum(s2) * (1.f / D) + LN_EPS);
#pragma unroll
    for (int j = 0; j < 4; ++j) { const f32x4 gg = *(const f32x4*)(g + 4 * lane + 256 * j), bb = *(const f32x4*)(b + 4 * lane + 256 * j); v[j] = v[j] * rstd * gg + bb; }
}
__device__ __forceinline__ void load_row_bf16(const bf16* p, f32x4 (&v)[4], int lane) {
#pragma unroll
    for (int j = 0; j < 4; ++j) { const v2u w = *(const v2u*)(p + 4 * lane + 256 * j); v[j] = (f32x4){bf_lo(w.x), bf_hi(w.x), bf_lo(w.y), bf_hi(w.y)}; }
}
__device__ __forceinline__ void store_row_f32(float* p, const f32x4 (&v)[4], int lane) {
#pragma unroll
    for (int j = 0; j < 4; ++j) *(f32x4*)(p + 4 * lane + 256 * j) = v[j];
}
__device__ __forceinline__ void store_row_bf16(bf16* p, const f32x4 (&v)[4], int lane) {
#pragma unroll
    for (int j = 0; j < 4; ++j) { v2u w; w.x = cvt_pk_bf16(v[j][0], v[j][1]); w.y = cvt_pk_bf16(v[j][2], v[j][3]); *(v2u*)(p + 4 * lane + 256 * j) = w; }
}
__device__ __forceinline__ void small_proj(const f32x4 (&v)[4], const LAS float* ws_s, float* ab_row, int lane) {
    float keep = 0.f;
#pragma unroll
    for (int c = 0; c < 8; ++c) { float p = 0.f;
#pragma unroll
        for (int j = 0; j < 4; ++j) { const f32x4 w = *(const LAS f32x4*)(ws_s + c * 1024 + 4 * lane + 256 * j); p += (v[j][0] * w[0] + v[j][1] * w[1]) + (v[j][2] * w[2] + v[j][3] * w[3]); }
        p = wave_sum(p); keep = (lane == c) ? p : keep; }
    if (lane < 8) ab_row[lane] = keep;
}
__device__ __forceinline__ void load_small_w(Ctx& F, int l, LAS float* ws_s) {
    const float* w = as_global(F.in[I_WIN]) + (size_t)l * D * NPROJ_SRC + 1536;
    for (int i = F.tid; i < 8 * 1024; i += 512) { const int k = i >> 3, c = i & 7; ws_s[c * 1024 + k] = w[(size_t)k * NPROJ_SRC + c]; }
}

constexpr int N_IN = 2 * 3584, N_BR = 6 * 256, N_O = 2 * 512, N_KV = 2 * 512, N_GU = 64 * 1024, N_D = 64 * 512;
constexpr int NITEMS = N_IN + N_BR + N_O + N_KV + N_GU + N_D;
#ifndef NDEF_PER_WAVE
#define NDEF_PER_WAVE 0
#endif
constexpr int NDEF = (256 - 32) * 8 * NDEF_PER_WAVE;
static_assert(NDEF <= N_GU + N_D, "deferred items must be MoE weights");
__device__ __forceinline__ void convert_items(Ctx& F, int first, int step, int begin, int end) {
    LAS float* scr = (LAS float*)(F.lds + F.wave * 8448);
    bf16* WinT = (bf16*)(F.ws + WS_WIN); bf16* WbrT = (bf16*)(F.ws + WS_WBR); bf16* WoT = (bf16*)(F.ws + WS_WO); bf16* WkvT = (bf16*)(F.ws + WS_WKV);
    bf16* WguT = (bf16*)(F.ws + WS_WGU); bf16* WdT = (bf16*)(F.ws + WS_WD);
    for (int it = begin + first; it < end; it += step) {
        int r = it;
        if (r < N_IN) { const int l = r / 3584, q = r % 3584, kb = q / 224, nb = q % 224, k0 = 64 * kb, n0 = 32 * nb, ns = n0 + (n0 >= 1536 ? 8 : 0);
            transpose_item(as_global(F.in[I_WIN]) + (size_t)l * D * NPROJ_SRC + (size_t)k0 * NPROJ_SRC + ns, NPROJ_SRC, WinT + (size_t)l * NPROJ * D + (size_t)n0 * D + k0, D, scr, F.lane); continue; }
        r -= N_IN;
        if (r < N_BR) { const int m = r / 256, q = r % 256, kb = q / 32, nb = q % 32, k0 = 64 * kb, n0 = 32 * nb;
            transpose_item(as_global(F.in[I_WBR]) + (size_t)m * 512 * D + (size_t)k0 * D + n0, D, WbrT + (size_t)m * D * 512 + (size_t)n0 * 512 + k0, 512, scr, F.lane); continue; }
        r -= N_BR;
        if (r < N_O) { const int l = r / 512, q = r % 512, kb = q / 32, nb = q % 32, k0 = 64 * kb, n0 = 32 * nb;
            transpose_item(as_global(F.in[I_WO]) + (size_t)l * D * D + (size_t)k0 * D + n0, D, WoT + (size_t)l * D * D + (size_t)n0 * D + k0, D, scr, F.lane); continue; }
        r -= N_O;
        if (r < N_KV) { const int l = r / 512, q = r % 512, kb = q / 32, nb = q % 32, k0 = 64 * kb, n0 = 32 * nb;
            transpose_item(as_global(F.in[I_WMEMKV]) + (size_t)l * D * D + (size_t)k0 * D + n0, D, WkvT + (size_t)l * D * D + (size_t)n0 * D + k0, D, scr, F.lane); continue; }
        r -= N_KV;
        if (r < N_GU) { const int m = r / 1024, q = r % 1024, kb = q / 64, nb = q % 64, k0 = 64 * kb, n0 = 32 * nb, jj = n0 / 256, r0 = n0 % 256;
            const int ns = (r0 < 128) ? (128 * jj + r0) : (1024 + 128 * jj + r0 - 128);
            transpose_item(as_global(F.in[I_WGU]) + (size_t)m * D * 2048 + (size_t)k0 * 2048 + ns, 2048, WguT + (size_t)m * 2048 * D + (size_t)n0 * D + k0, D, scr, F.lane); continue; }
        r -= N_GU;
        { const int m = r / 512, q = r % 512, kb = q / 32, nb = q % 32, k0 = 64 * kb, n0 = 32 * nb;
            transpose_item(as_global(F.in[I_WD]) + (size_t)m * D * D + (size_t)k0 * D + n0, D, WdT + (size_t)m * D * D + (size_t)n0 * D + k0, D, scr, F.lane); }
    }
}
__device__ __forceinline__ void convert_deferred(Ctx& F, int first, int step) {
    LAS float* scr = (LAS float*)(F.lds + F.wave * 8448);
    bf16* WguT = (bf16*)(F.ws + WS_WGU); bf16* WdT = (bf16*)(F.ws + WS_WD);
    for (int it = NITEMS - NDEF + first; it < NITEMS; it += step) {
        int r = it - (N_IN + N_BR + N_O + N_KV);
        if (r < N_GU) { const int m = r / 1024, q = r % 1024, kb = q / 64, nb = q % 64, k0 = 64 * kb, n0 = 32 * nb, jj = n0 / 256, r0 = n0 % 256;
            const int ns = (r0 < 128) ? (128 * jj + r0) : (1024 + 128 * jj + r0 - 128);
            transpose_item(as_global(F.in[I_WGU]) + (size_t)m * D * 2048 + (size_t)k0 * 2048 + ns, 2048, WguT + (size_t)m * 2048 * D + (size_t)n0 * D + k0, D, scr, F.lane); continue; }
        r -= N_GU;
        { const int m = r / 512, q = r % 512, kb = q / 32, nb = q % 32, k0 = 64 * kb, n0 = 32 * nb;
            transpose_item(as_global(F.in[I_WD]) + (size_t)m * D * D + (size_t)k0 * D + n0, D, WdT + (size_t)m * D * D + (size_t)n0 * D + k0, D, scr, F.lane); }
    }
}

__device__ __forceinline__ void phase_prologue(Ctx& F) {
    LAS float* ws_s = (LAS float*)(F.lds + 69632);
    const int gw = F.bid * 8 + F.wave, NGW = F.G * 8;
    convert_items(F, gw, NGW, 0, NITEMS - NDEF);
    { const f32x4* src = (const f32x4*)as_global(F.in[I_MEM]); v2u* dst = (v2u*)(F.ws + WS_MEMB);
      for (int i = F.bid * 512 + F.tid; i < NB * NMEM * D / 4; i += F.G * 512) { const f32x4 x = src[i]; v2u w; w.x = cvt_pk_bf16(x[0], x[1]); w.y = cvt_pk_bf16(x[2], x[3]); dst[i] = w; } }
    load_small_w(F, 0, ws_s);
    __syncthreads();
    bf16* hb = (bf16*)(F.ws + WS_HB); float* ab = (float*)(F.ws + WS_AB);
    for (int m = gw; m < NTOK; m += NGW) {
        f32x4 v[4]; const float* xr = as_global(F.in[I_X]) + (size_t)m * D;
#pragma unroll
        for (int j = 0; j < 4; ++j) v[j] = *(const f32x4*)(xr + 4 * F.lane + 256 * j);
        ln_apply(v, as_global(F.in[I_LN0G]), as_global(F.in[I_LN0B]), F.lane);
        store_row_bf16(hb + (size_t)m * D, v, F.lane);
        small_proj(v, ws_s, ab + (size_t)m * 8, F.lane);
    }
}

__device__ __forceinline__ void unpack8(const v4u x, float (&o)[8]) { o[0] = bf_lo(x.x); o[1] = bf_hi(x.x); o[2] = bf_lo(x.y); o[3] = bf_hi(x.y); o[4] = bf_lo(x.z); o[5] = bf_hi(x.z); o[6] = bf_lo(x.w); o[7] = bf_hi(x.w); }
__device__ __forceinline__ void conv4_silu(const v4u x0, const v4u x1, const v4u x2, const v4u x3, const LAS float* w  , float (&o)[8]) {
    float a[8], b[8], c[8], d[8]; unpack8(x0, a); unpack8(x1, b); unpack8(x2, c); unpack8(x3, d);
    const f32x4 w0l = *(const LAS f32x4*)(w), w0h = *(const LAS f32x4*)(w + 4), w1l = *(const LAS f32x4*)(w + 1536), w1h = *(const LAS f32x4*)(w + 1540);
    const f32x4 w2l = *(const LAS f32x4*)(w + 3072), w2h = *(const LAS f32x4*)(w + 3076), w3l = *(const LAS f32x4*)(w + 4608), w3h = *(const LAS f32x4*)(w + 4612);
#pragma unroll
    for (int i = 0; i < 8; ++i) { const float w0 = i < 4 ? w0l[i & 3] : w0h[i & 3], w1 = i < 4 ? w1l[i & 3] : w1h[i & 3], w2 = i < 4 ? w2l[i & 3] : w2h[i & 3], w3 = i < 4 ? w3l[i & 3] : w3h[i & 3];
        const float s = (w0 * a[i] + w1 * b[i]) + (w2 * c[i] + w3 * d[i]); o[i] = siluf_(s); }
}
__device__ __forceinline__ void phase_prep(Ctx& F, int l) {
    const bf16* proj = (const bf16*)(F.ws + WS_R1);
    LAS float* cw = (LAS float*)F.lds;
    LAS float* mw = (LAS float*)(F.lds + 4 * 1536 * 4);
    for (int i = F.tid; i < 4 * 1536; i += 512) cw[i] = as_global(F.in[I_CONVQKV])[(size_t)l * 4 * 1536 + i];
    for (int i = F.tid; i < 3 * 512; i += 512) mw[i] = as_global(F.in[I_CONVMIX])[(size_t)l * 3 * 512 + i];
    __syncthreads();
    const int lane = F.lane, c8 = lane * 8, hh = lane >> 4;
    bf16* qnb = (bf16*)(F.ws + WS_QN); bf16* knb = (bf16*)(F.ws + WS_KN); bf16* vvb = (bf16*)(F.ws + WS_VV); float* gs = (float*)(F.ws + WS_GS);
    const float* ab = (const float*)(F.ws + WS_AB); bf16* yb = (bf16*)(F.ws + WS_YB);
    const float Ah = __expf(as_global(F.in[I_ALOG])[l * 4 + hh]), dtb = as_global(F.in[I_DTB])[l * 4 + hh];
    const int gw = F.bid * 8 + F.wave, NGW = F.G * 8;
    for (int t0 = gw * 16; t0 < NTOK; t0 += NGW * 16) {
        const bool first = (t0 % T) == 0;
        const v4u z4 = {0u, 0u, 0u, 0u};
        v4u q0, q1, q2, k0, k1, k2, v0, v1, v2; float p0[8], p1[8];
        if (first) { q0 = q1 = q2 = k0 = k1 = k2 = v0 = v1 = v2 = z4;
#pragma unroll
            for (int i = 0; i < 8; ++i) { p0[i] = 0.f; p1[i] = 0.f; } }
        else {
            const bf16* r3 = proj + (size_t)(t0 - 3) * NPROJ + c8; const bf16* r2 = r3 + NPROJ; const bf16* r1 = r2 + NPROJ;
            q0 = *(const v4u*)(r3 + C_Q); q1 = *(const v4u*)(r2 + C_Q); q2 = *(const v4u*)(r1 + C_Q);
            k0 = *(const v4u*)(r3 + C_K); k1 = *(const v4u*)(r2 + C_K); k2 = *(const v4u*)(r1 + C_K);
            v0 = *(const v4u*)(r3 + C_V); v1 = *(const v4u*)(r2 + C_V); v2 = *(const v4u*)(r1 + C_V);
            float a[8], b[8]; unpack8(*(const v4u*)(r2 + C_XC), a); unpack8(*(const v4u*)(r2 + C_GC), b);
#pragma unroll
            for (int i = 0; i < 8; ++i) p0[i] = a[i] * b[i];
            unpack8(*(const v4u*)(r1 + C_XC), a); unpack8(*(const v4u*)(r1 + C_GC), b);
#pragma unroll
            for (int i = 0; i < 8; ++i) p1[i] = a[i] * b[i];
        }
        v4u nq, nk, nv, nxc, ngc, ngb; float na = 0.f, nbt = 0.f;
        { const bf16* rn = proj + (size_t)t0 * NPROJ + c8; nq = *(const v4u*)(rn + C_Q); nk = *(const v4u*)(rn + C_K); nv = *(const v4u*)(rn + C_V); nxc = *(const v4u*)(rn + C_XC); ngc = *(const v4u*)(rn + C_GC); ngb = *(const v4u*)(rn + C_GB);
          if ((lane & 15) == 0) { na = ab[(size_t)t0 * 8 + hh]; nbt = ab[(size_t)t0 * 8 + 4 + hh]; } }
        for (int i16 = 0; i16 < 16; ++i16) {
            const int tok = t0 + i16;
            const v4u q3 = nq, k3 = nk, v3 = nv, xc3 = nxc, gc3 = ngc, gb3 = ngb; const float a_in = na, bt_in = nbt;
            if (i16 < 15) { const bf16* rn = proj + (size_t)(tok + 1) * NPROJ + c8; nq = *(const v4u*)(rn + C_Q); nk = *(const v4u*)(rn + C_K); nv = *(const v4u*)(rn + C_V); nxc = *(const v4u*)(rn + C_XC); ngc = *(const v4u*)(rn + C_GC); ngb = *(const v4u*)(rn + C_GB);
                if ((lane & 15) == 0) { na = ab[(size_t)(tok + 1) * 8 + hh]; nbt = ab[(size_t)(tok + 1) * 8 + 4 + hh]; } }
            float qo[8], ko[8], vo[8];
            conv4_silu(q0, q1, q2, q3, cw + C_Q + c8, qo); conv4_silu(k0, k1, k2, k3, cw + C_K + c8, ko); conv4_silu(v0, v1, v2, v3, cw + C_V + c8, vo);
            q0 = q1; q1 = q2; q2 = q3; k0 = k1; k1 = k2; k2 = k3; v0 = v1; v1 = v2; v2 = v3;
            float sq = 0.f, sk = 0.f;
#pragma unroll
            for (int i = 0; i < 8; ++i) { sq += qo[i] * qo[i]; sk += ko[i] * ko[i]; }
            sq = row16_sum(sq); sk = row16_sum(sk);
            const float rq = (1.f / sqrtf(sq + RMS_EPS)) * 0.08838834764831845f, rk = 1.f / sqrtf(sk + RMS_EPS);
#pragma unroll
            for (int i = 0; i < 8; ++i) { qo[i] *= rq; ko[i] *= rk; }
            { v4u w; w.x = cvt_pk_bf16(qo[0], qo[1]); w.y = cvt_pk_bf16(qo[2], qo[3]); w.z = cvt_pk_bf16(qo[4], qo[5]); w.w = cvt_pk_bf16(qo[6], qo[7]); *(v4u*)(qnb + (size_t)tok * 512 + c8) = w; }
            { v4u w; w.x = cvt_pk_bf16(ko[0], ko[1]); w.y = cvt_pk_bf16(ko[2], ko[3]); w.z = cvt_pk_bf16(ko[4], ko[5]); w.w = cvt_pk_bf16(ko[6], ko[7]); *(v4u*)(knb + (size_t)tok * 512 + c8) = w; }
            { v4u w; w.x = cvt_pk_bf16(vo[0], vo[1]); w.y = cvt_pk_bf16(vo[2], vo[3]); w.z = cvt_pk_bf16(vo[4], vo[5]); w.w = cvt_pk_bf16(vo[6], vo[7]); *(v4u*)(vvb + (size_t)tok * 512 + c8) = w; }
            if ((lane & 15) == 0) {
                const float a = a_in + dtb, bt = bt_in;
                const float sp = a > 20.f ? a : log1pf(expf(a));
                const float g = -Ah * sp;
                *(f32x4*)(gs + ((size_t)tok * 4 + hh) * 4) = (f32x4){g, 1.f / (1.f + expf(-bt)), 0.f, 0.f};
            }
            float xa[8], ga[8], gbv[8], p2[8]; unpack8(xc3, xa); unpack8(gc3, ga); unpack8(gb3, gbv);
            const f32x4 m0l = *(const LAS f32x4*)(mw + c8), m0h = *(const LAS f32x4*)(mw + c8 + 4), m1l = *(const LAS f32x4*)(mw + 512 + c8), m1h = *(const LAS f32x4*)(mw + 512 + c8 + 4);
            const f32x4 m2l = *(const LAS f32x4*)(mw + 1024 + c8), m2h = *(const LAS f32x4*)(mw + 1024 + c8 + 4);
            float yo[8];
#pragma unroll
            for (int i = 0; i < 8; ++i) { p2[i] = xa[i] * ga[i];
                const float w0 = i < 4 ? m0l[i & 3] : m0h[i & 3], w1 = i < 4 ? m1l[i & 3] : m1h[i & 3], w2 = i < 4 ? m2l[i & 3] : m2h[i & 3];
                yo[i] = gbv[i] * ((w0 * p0[i] + w1 * p1[i]) + w2 * p2[i]); p0[i] = p1[i]; p1[i] = p2[i]; }
            v4u w; w.x = cvt_pk_bf16(yo[0], yo[1]); w.y = cvt_pk_bf16(yo[2], yo[3]); w.z = cvt_pk_bf16(yo[4], yo[5]); w.w = cvt_pk_bf16(yo[6], yo[7]);
            *(v4u*)(yb + (size_t)tok * 512 + c8) = w;
        }
    }
}

#define MFMA16(a, b, c) __builtin_amdgcn_mfma_f32_16x16x32_bf16(a, b, c, 0, 0, 0)
__device__ __forceinline__ bf16x8 pack8(const f32x4 a, const f32x4 b) { v4u w; w.x = cvt_pk_nat(a[0], a[1]); w.y = cvt_pk_nat(a[2], a[3]); w.z = cvt_pk_nat(b[0], b[1]); w.w = cvt_pk_nat(b[2], b[3]); return __builtin_bit_cast(bf16x8, w); }
__device__ __forceinline__ v2u pack4(const f32x4 a) { v2u w; w.x = cvt_pk_nat(a[0], a[1]); w.y = cvt_pk_nat(a[2], a[3]); return w; }
constexpr int GA_PITCH = 72, GA_WAVE_BYTES = 19456;
constexpr int NCHUNK = NB * 4 * (T / 64);

__device__ __forceinline__ void gdn_kend_products(const LAS bf16* XA, const LAS bf16* XB, const LAS float* sE, const v4u* UPK, const v4u* WPK, int ci, int lane, v2u* BC, v4u* ATF) {
    const int fr = lane & 15, fq = lane >> 4;
    bf16x8 ke[8][2];
#pragma unroll
    for (int mt = 0; mt < 8; ++mt)
#pragma unroll
        for (int s = 0; s < 2; ++s) { const LAS bf16* p = (mt < 4 ? XA : XB) + (16 * (mt & 3) + fr) * GA_PITCH + 32 * s + 4 * fq;
            const v2u lo = *(const LAS v2u*)p, hi = *(const LAS v2u*)(p + 16); const f32x4 e0 = *(const LAS f32x4*)(sE + 32 * s + 4 * fq), e1 = *(const LAS f32x4*)(sE + 32 * s + 16 + 4 * fq);
            ke[mt][s] = pack8((f32x4){bf_lo(lo.x) * e0[0], bf_hi(lo.x) * e0[1], bf_lo(lo.y) * e0[2], bf_hi(lo.y) * e0[3]}, (f32x4){bf_lo(hi.x) * e1[0], bf_hi(hi.x) * e1[1], bf_lo(hi.y) * e1[2], bf_hi(hi.y) * e1[3]}); }
#pragma unroll 4
    for (int ne = 0; ne < 8; ++ne) {
        const bf16x8 u0 = __builtin_bit_cast(bf16x8, (UPK + ((size_t)ci * 16 + 2 * ne) * 64)[(unsigned)lane]), u1 = __builtin_bit_cast(bf16x8, (UPK + ((size_t)ci * 16 + 2 * ne + 1) * 64)[(unsigned)lane]);
#pragma unroll
        for (int mt = 0; mt < 8; ++mt) { f32x4 acc = (f32x4){0.f, 0.f, 0.f, 0.f}; acc = MFMA16(ke[mt][0], u0, acc); acc = MFMA16(ke[mt][1], u1, acc);
            (BC + ((size_t)(ci * 8 + ne) * 8 + mt) * 64)[(unsigned)lane] = pack4(acc); } }
#pragma unroll 2
    for (int sp = 0; sp < 4; ++sp) {
        const bf16x8 w00 = __builtin_bit_cast(bf16x8, (WPK + ((size_t)ci * 16 + 4 * sp) * 64)[(unsigned)lane]), w01 = __builtin_bit_cast(bf16x8, (WPK + ((size_t)ci * 16 + 4 * sp + 1) * 64)[(unsigned)lane]);
        const bf16x8 w10 = __builtin_bit_cast(bf16x8, (WPK + ((size_t)ci * 16 + 4 * sp + 2) * 64)[(unsigned)lane]), w11 = __builtin_bit_cast(bf16x8, (WPK + ((size_t)ci * 16 + 4 * sp + 3) * 64)[(unsigned)lane]);
#pragma unroll
        for (int mt = 0; mt < 8; ++mt) { f32x4 d0 = (f32x4){0.f, 0.f, 0.f, 0.f}, d1 = (f32x4){0.f, 0.f, 0.f, 0.f};
            d0 = MFMA16(w00, ke[mt][0], d0); d0 = MFMA16(w01, ke[mt][1], d0); d1 = MFMA16(w10, ke[mt][0], d1); d1 = MFMA16(w11, ke[mt][1], d1);
            (ATF + ((size_t)(ci * 8 + mt) * 4 + sp) * 64)[(unsigned)lane] = __builtin_bit_cast(v4u, pack8(-d0, -d1)); } }
}
__device__ __forceinline__ void xb_store_pair(LAS bf16* XB, int r0, unsigned w, int lane) {
    const unsigned send = (lane & 1) ? (w & 0xffffu) : (w >> 16);
    const unsigned recv = (unsigned)__builtin_amdgcn_update_dpp(0, (int)send, 0xB1, 0xF, 0xF, true);
    const unsigned outw = (lane & 1) ? (recv | (w & 0xffff0000u)) : ((w & 0xffffu) | (recv << 16));
    *(LAS unsigned*)(XB + (r0 + (lane & 1)) * GA_PITCH + (lane & ~1)) = outw;
}
__device__ __forceinline__ void gdn_fill_kT(const bf16* KN, LAS bf16* XB, int tok0, int h, int half, int lane) {
    const bf16* kbase = KN + (size_t)tok0 * 512 + h * 128 + half * 64; const unsigned lo = (unsigned)lane * 512u;
    asm volatile("s_waitcnt lgkmcnt(0)" ::: "memory");
#pragma unroll
    for (int c = 0; c < 8; ++c) { const v4u x = *(const v4u*)((kbase + 8 * c) + lo);
        xb_store_pair(XB, 8 * c, x.x, lane); xb_store_pair(XB, 8 * c + 2, x.y, lane); xb_store_pair(XB, 8 * c + 4, x.z, lane); xb_store_pair(XB, 8 * c + 6, x.w, lane); }
    asm volatile("s_waitcnt lgkmcnt(0)" ::: "memory");
}
__device__ __forceinline__ void phase_gdn_a(Ctx& F) {
    const int lane = F.lane, fr = lane & 15, fq = lane >> 4;
    LAS unsigned char* wl = F.lds + F.wave * GA_WAVE_BYTES;
    LAS bf16* Ts = (LAS bf16*)wl; LAS bf16* XB = (LAS bf16*)(wl + 9216);
    LAS float* gcv = (LAS float*)(wl + 18432); LAS float* sKp = gcv + 64; LAS float* sE = gcv + 128; LAS float* bev = gcv + 192;
    const bf16* KN = (const bf16*)(F.ws + WS_KN); const bf16* QN = (const bf16*)(F.ws + WS_QN); const bf16* VV = (const bf16*)(F.ws + WS_VV); const float* gs = (const float*)(F.ws + WS_GS);
    v2u* BC = (v2u*)(F.ws + WS_BC); v4u* ATF = (v4u*)(F.ws + WS_ATF); v4u* QTF = (v4u*)(F.ws + WS_QTF); v2u* OL = (v2u*)(F.ws + WS_OL); float* CD = (float*)(F.ws + WS_CD);
    v4u* UPK = (v4u*)(F.ws + WS_UPK); v4u* WPK = (v4u*)(F.ws + WS_WPK);
    { const int b = F.bid >> 7, h = F.wave & 3, n = 2 * (F.bid & 127) + (F.wave >> 2);
        const int bh = b * 4 + h, ci = bh * 256 + n, tok0 = b * T + n * 64;
        const f32x2 gb = *(const f32x2*)((gs + ((size_t)tok0 * 4 + h) * 4) + (unsigned)lane * 16u);
        float gc = gb.x; const float be = gb.y;
#pragma unroll
        for (int off = 1; off < 64; off <<= 1) { const float t = bperm(gc, (lane - off) & 63); gc += (lane >= off) ? t : 0.f; }
        const float gl = rdlane(gc, 63);
        gcv[lane] = gc; sKp[lane] = be * __expf(gc); sE[lane] = __expf(gl - gc); bev[lane] = be;
        if (lane == 0) CD[ci] = __expf(gl);
        asm volatile("s_waitcnt lgkmcnt(0)" ::: "memory");
        {
            bf16x8 kf[4][4];
#pragma unroll
            for (int t = 0; t < 4; ++t)
#pragma unroll
                for (int s = 0; s < 4; ++s) kf[t][s] = *(const bf16x8*)((KN + (size_t)(tok0 + 16 * t) * 512 + h * 128 + 32 * s) + ((unsigned)fr * 512u + 8u * (unsigned)fq));
            float gcj[4];
#pragma unroll
            for (int t = 0; t < 4; ++t) gcj[t] = gcv[16 * t + fr];
            LAS float* Nc = (LAS float*)wl;
#pragma unroll
            for (int t = 0; t < 4; ++t) { const f32x4 gci = *(const LAS f32x4*)(gcv + 16 * t + 4 * fq), bei = *(const LAS f32x4*)(bev + 16 * t + 4 * fq);
#pragma unroll
                for (int u = 0; u <= t; ++u) {
                    f32x4 acc = (f32x4){0.f, 0.f, 0.f, 0.f};
#pragma unroll
                    for (int s = 0; s < 4; ++s) acc = MFMA16(kf[t][s], kf[u][s], acc);
                    f32x4 nv;
#pragma unroll
                    for (int r = 0; r < 4; ++r) { const int i = 16 * t + 4 * fq + r, j = 16 * u + fr; const float v = bei[r] * acc[r] * __expf(fminf(gci[r] - gcj[u], 0.f)); nv[r] = (i > j) ? v : 0.f; }
                    *(LAS f32x4*)(Nc + (16 * u + fr) * 64 + 16 * t + 4 * fq) = nv;
                } }
        }
        asm volatile("s_waitcnt lgkmcnt(0)" ::: "memory");
        {
            float x[64];
#pragma unroll
            for (int c = 63; c >= 0; --c) { float a = (lane == c) ? 1.f : 0.f, a1 = 0.f, a2 = 0.f, a3 = 0.f;
#pragma unroll
                for (int k4 = ((c + 1) & ~3); k4 < 64; k4 += 4) { const f32x4 nv = *(const LAS f32x4*)((const LAS float*)wl + c * 64 + k4);
                    if (k4 + 0 > c) a -= x[k4 + 0] * nv[0]; if (k4 + 1 > c) a1 -= x[k4 + 1] * nv[1]; if (k4 + 2 > c) a2 -= x[k4 + 2] * nv[2]; if (k4 + 3 > c) a3 -= x[k4 + 3] * nv[3]; }
                a = (a + a1) + (a2 + a3);
                asm volatile("" : "+v"(a) :: "memory");
                x[c] = a; }
#pragma unroll
            for (int q8 = 0; q8 < 8; ++q8) { v4u w; w.x = cvt_pk_nat(x[8 * q8], x[8 * q8 + 1]); w.y = cvt_pk_nat(x[8 * q8 + 2], x[8 * q8 + 3]); w.z = cvt_pk_nat(x[8 * q8 + 4], x[8 * q8 + 5]); w.w = cvt_pk_nat(x[8 * q8 + 6], x[8 * q8 + 7]);
                *(LAS v4u*)(Ts + lane * GA_PITCH + 8 * q8) = w; }
        }
        asm volatile("s_waitcnt lgkmcnt(0)" ::: "memory");
        {
            bf16x8 tsf[4][2];
#pragma unroll
            for (int t = 0; t < 4; ++t)
#pragma unroll
                for (int s = 0; s < 2; ++s) tsf[t][s] = *(const LAS bf16x8*)(Ts + (16 * t + fr) * GA_PITCH + 32 * s + 8 * fq);
#pragma unroll 1
            for (int half = 0; half < 2; ++half) {
                const bf16* vbase = VV + (size_t)tok0 * 512 + h * 128 + half * 64; const unsigned vlo = (unsigned)lane * 512u;
#pragma unroll
                for (int c = 0; c < 8; ++c) { float f[8]; unpack8(*(const v4u*)((vbase + 8 * c) + vlo), f);
#pragma unroll
                    for (int i2 = 0; i2 < 4; ++i2) xb_store_pair(XB, 8 * c + 2 * i2, cvt_pk_nat(f[2 * i2] * be, f[2 * i2 + 1] * be), lane); }
                asm volatile("s_waitcnt lgkmcnt(0)" ::: "memory");
#pragma unroll
                for (int nl = 0; nl < 4; ++nl) { const bf16x8 b0 = *(const LAS bf16x8*)(XB + (16 * nl + fr) * GA_PITCH + 8 * fq), b1 = *(const LAS bf16x8*)(XB + (16 * nl + fr) * GA_PITCH + 32 + 8 * fq);
                    f32x4 ut[4];
#pragma unroll
                    for (int t = 0; t < 4; ++t) { f32x4 acc = (f32x4){0.f, 0.f, 0.f, 0.f}; acc = MFMA16(tsf[t][0], b0, acc); if (t >= 2) acc = MFMA16(tsf[t][1], b1, acc); ut[t] = acc; }
                    (UPK + ((size_t)ci * 16 + 2 * (half * 4 + nl)) * 64)[(unsigned)lane] = __builtin_bit_cast(v4u, pack8(ut[0], ut[1]));
                    (UPK + ((size_t)ci * 16 + 2 * (half * 4 + nl) + 1) * 64)[(unsigned)lane] = __builtin_bit_cast(v4u, pack8(ut[2], ut[3])); }
                asm volatile("s_waitcnt lgkmcnt(0)" ::: "memory");
            }
#pragma unroll 1
            for (int half = 0; half < 2; ++half) {
                gdn_fill_kT(KN, XB, tok0, h, half, lane);
#pragma unroll
                for (int nl = 0; nl < 4; ++nl) { bf16x8 kp[2];
#pragma unroll
                    for (int s = 0; s < 2; ++s) { const v4u raw = *(const LAS v4u*)(XB + (16 * nl + fr) * GA_PITCH + 32 * s + 8 * fq); const f32x4 c0 = *(const LAS f32x4*)(sKp + 32 * s + 8 * fq), c1 = *(const LAS f32x4*)(sKp + 32 * s + 8 * fq + 4);
                        kp[s] = pack8((f32x4){bf_lo(raw.x) * c0[0], bf_hi(raw.x) * c0[1], bf_lo(raw.y) * c0[2], bf_hi(raw.y) * c0[3]}, (f32x4){bf_lo(raw.z) * c1[0], bf_hi(raw.z) * c1[1], bf_lo(raw.w) * c1[2], bf_hi(raw.w) * c1[3]}); }
                    f32x4 wt[4];
#pragma unroll
                    for (int t = 0; t < 4; ++t) { f32x4 acc = (f32x4){0.f, 0.f, 0.f, 0.f}; acc = MFMA16(tsf[t][0], kp[0], acc); if (t >= 2) acc = MFMA16(tsf[t][1], kp[1], acc); wt[t] = acc; }
                    (WPK + ((size_t)ci * 16 + 2 * (half * 4 + nl)) * 64)[(unsigned)lane] = __builtin_bit_cast(v4u, pack8(wt[0], wt[1]));
                    (WPK + ((size_t)ci * 16 + 2 * (half * 4 + nl) + 1) * 64)[(unsigned)lane] = __builtin_bit_cast(v4u, pack8(wt[2], wt[3])); }
                asm volatile("s_waitcnt lgkmcnt(0)" ::: "memory");
            }
        }
        asm volatile("s_waitcnt vmcnt(0)" ::: "memory");
        gdn_fill_kT(KN, Ts, tok0, h, 0, lane);
        gdn_kend_products(Ts, XB, sE, UPK, WPK, ci, lane, BC, ATF);
        asm volatile("s_waitcnt lgkmcnt(0)" ::: "memory");
        bf16x8 qkpk[4][2];
        {
            bf16x8 kf[4][4];
#pragma unroll
            for (int t = 0; t < 4; ++t)
#pragma unroll
                for (int s = 0; s < 4; ++s) kf[t][s] = *(const bf16x8*)((KN + (size_t)(tok0 + 16 * t) * 512 + h * 128 + 32 * s) + ((unsigned)fr * 512u + 8u * (unsigned)fq));
#pragma unroll
            for (int t = 0; t < 4; ++t) { bf16x8 qf[4]; const float gct = gcv[16 * t + fr];
#pragma unroll
                for (int s = 0; s < 4; ++s) qf[s] = *(const bf16x8*)((QN + (size_t)(tok0 + 16 * t) * 512 + h * 128 + 32 * s) + ((unsigned)fr * 512u + 8u * (unsigned)fq));
                f32x4 tl[4];
#pragma unroll
                for (int u = 0; u < 4; ++u) { tl[u] = (f32x4){0.f, 0.f, 0.f, 0.f}; if (u > t) continue;
                    const f32x4 gcu = *(const LAS f32x4*)(gcv + 16 * u + 4 * fq);
                    f32x4 acc = (f32x4){0.f, 0.f, 0.f, 0.f};
#pragma unroll
                    for (int s = 0; s < 4; ++s) acc = MFMA16(kf[u][s], qf[s], acc);
#pragma unroll
                    for (int r = 0; r < 4; ++r) { const int i = 16 * t + fr, j = 16 * u + 4 * fq + r; const float v = acc[r] * __expf(fminf(gct - gcu[r], 0.f)); tl[u][r] = (i >= j) ? v : 0.f; } }
                qkpk[t][0] = pack8(tl[0], tl[1]); qkpk[t][1] = pack8(tl[2], tl[3]); }
        }
        asm volatile("s_waitcnt lgkmcnt(0)" ::: "memory");
#pragma unroll 2
        for (int sp = 0; sp < 4; ++sp) {
            const bf16x8 w00 = __builtin_bit_cast(bf16x8, (WPK + ((size_t)ci * 16 + 4 * sp) * 64)[(unsigned)lane]), w01 = __builtin_bit_cast(bf16x8, (WPK + ((size_t)ci * 16 + 4 * sp + 1) * 64)[(unsigned)lane]);
            const bf16x8 w10 = __builtin_bit_cast(bf16x8, (WPK + ((size_t)ci * 16 + 4 * sp + 2) * 64)[(unsigned)lane]), w11 = __builtin_bit_cast(bf16x8, (WPK + ((size_t)ci * 16 + 4 * sp + 3) * 64)[(unsigned)lane]);
#pragma unroll
            for (int t = 0; t < 4; ++t) { const float egi = __expf(gcv[16 * t + fr]); f32x4 dd[2];
#pragma unroll
                for (int hh = 0; hh < 2; ++hh) { f32x4 acc = (f32x4){0.f, 0.f, 0.f, 0.f}; acc = MFMA16(hh ? w10 : w00, qkpk[t][0], acc); if (t >= 2) acc = MFMA16(hh ? w11 : w01, qkpk[t][1], acc);
                    const v2u q4 = *(const v2u*)((QN + (size_t)(tok0 + 16 * t) * 512 + h * 128) + ((unsigned)fr * 512u + 4u * (unsigned)fq + 16u * (unsigned)(2 * sp + hh)));
                    dd[hh] = (f32x4){bf_lo(q4.x) * egi - acc[0], bf_hi(q4.x) * egi - acc[1], bf_lo(q4.y) * egi - acc[2], bf_hi(q4.y) * egi - acc[3]}; }
                (QTF + ((size_t)(ci * 4 + t) * 4 + sp) * 64)[(unsigned)lane] = __builtin_bit_cast(v4u, pack8(dd[0], dd[1])); } }
#pragma unroll 4
        for (int et = 0; et < 8; ++et) {
            const bf16x8 u0 = __builtin_bit_cast(bf16x8, (UPK + ((size_t)ci * 16 + 2 * et) * 64)[(unsigned)lane]), u1 = __builtin_bit_cast(bf16x8, (UPK + ((size_t)ci * 16 + 2 * et + 1) * 64)[(unsigned)lane]);
#pragma unroll
            for (int t = 0; t < 4; ++t) { f32x4 acc = (f32x4){0.f, 0.f, 0.f, 0.f}; acc = MFMA16(u0, qkpk[t][0], acc); if (t >= 2) acc = MFMA16(u1, qkpk[t][1], acc);
                (OL + ((size_t)(ci * 8 + et) * 4 + t) * 64)[(unsigned)lane] = pack4(acc); } }
    }
}
#ifndef B_OLDMAP
#define BH_OF(bid) ((bid) & 7)
#define SL_OF(bid) ((bid) >> 3)
#else
#define BH_OF(bid) ((bid) >> 2)
#define SL_OF(bid) ((bid) & 3)
#endif
__device__ __forceinline__ void phase_gdn_b(Ctx& F, int bvar) {
    const int bh = BH_OF(F.bid), sl = SL_OF(F.bid), w = F.wave, lane = F.lane, fr = lane & 15, fq = lane >> 4;
    const v4u* ATF = (const v4u*)(F.ws + WS_ATF); const v2u* BC = (const v2u*)(F.ws + WS_BC); const float* CD = (const float*)(F.ws + WS_CD); bf16* ST = (bf16*)(F.ws + WS_ST);
    LAS unsigned char* xb = F.lds;
    const int cbase = bh * 256;
    f32x4 S[2]; S[0] = (f32x4){0.f, 0.f, 0.f, 0.f}; S[1] = (f32x4){0.f, 0.f, 0.f, 0.f};
    constexpr int RD = 6;
    v4u afr[RD][4]; v2u bcr[RD][2]; float cdr[RD];
#define GB_LOAD(k, n_) do { const int cc_ = (n_) < 256 ? (n_) : 255; const size_t ci_ = (size_t)(cbase + cc_); \
        _Pragma("unroll") for (int s_ = 0; s_ < 4; ++s_) afr[k][s_] = (ATF + ((ci_ * 8 + w) * 4 + s_) * 64)[(unsigned)lane]; \
        _Pragma("unroll") for (int n2_ = 0; n2_ < 2; ++n2_) bcr[k][n2_] = (BC + ((ci_ * 8 + 2 * sl + n2_) * 8 + w) * 64)[(unsigned)lane]; \
        cdr[k] = CD[ci_]; } while (0)
#pragma unroll
    for (int k = 0; k < RD; ++k) GB_LOAD(k, k);
    _Pragma("unroll") for (int k = 0; k < RD; ++k) asm volatile("" :: "v"(afr[k][0]), "v"(afr[k][1]), "v"(afr[k][2]), "v"(afr[k][3]), "v"(bcr[k][0]), "v"(bcr[k][1]), "v"(cdr[k]));
#define GB_STEP(k, n_, LOADNEXT) do { const int n = (n_), par = (k) & 1; const size_t ci = (size_t)(cbase + n); \
            _Pragma("unroll") for (int nt = 0; nt < 2; ++nt) { const v2u p = pack4(S[nt]); \
                *(LAS v2u*)(xb + par * 8192 + ((nt * 4 + (w >> 1)) * 64 + lane) * 16 + (w & 1) * 8) = p; \
                if (!(bvar & 1)) ((v2u*)ST + ((ci * 8 + w) * 8 + 2 * sl + nt) * 64)[(unsigned)lane] = p; }     \
            asm volatile("s_waitcnt lgkmcnt(0)" ::: "memory"); __builtin_amdgcn_s_barrier(); asm volatile("" ::: "memory"); \
            bf16x8 sf[2][4]; \
            _Pragma("unroll") for (int nt = 0; nt < 2; ++nt) \
                _Pragma("unroll") for (int s = 0; s < 4; ++s) sf[nt][s] = *(const LAS bf16x8*)(xb + par * 8192 + ((nt * 4 + s) * 64 + lane) * 16); \
              \
            asm volatile("" : "+v"(cdr[k]));     \
            const float cdk = __builtin_bit_cast(float, __builtin_amdgcn_readfirstlane(__builtin_bit_cast(int, cdr[k]))); \
            _Pragma("unroll") for (int nt = 0; nt < 2; ++nt) { const v2u bw = bcr[k][nt]; f32x4 acc = S[nt] * cdk + (f32x4){bf_lo(bw.x), bf_hi(bw.x), bf_lo(bw.y), bf_hi(bw.y)}; \
                f32x4 acc2 = (f32x4){0.f, 0.f, 0.f, 0.f};                      \
                acc = MFMA16(__builtin_bit_cast(bf16x8, afr[k][0]), sf[nt][0], acc); acc2 = MFMA16(__builtin_bit_cast(bf16x8, afr[k][1]), sf[nt][1], acc2); \
                acc = MFMA16(__builtin_bit_cast(bf16x8, afr[k][2]), sf[nt][2], acc); acc2 = MFMA16(__builtin_bit_cast(bf16x8, afr[k][3]), sf[nt][3], acc2); \
                S[nt] = acc + acc2; } \
            if (LOADNEXT && !(bvar & 2)) GB_LOAD(k, n + RD); } while (0)
    for (int n0 = 0; n0 + RD <= 256; n0 += RD) {
#pragma unroll
        for (int k = 0; k < RD; ++k) GB_STEP(k, n0 + k, true);
    }
#pragma unroll
    for (int k = 0; k < 256 % RD; ++k) GB_STEP(k, 256 / RD * RD + k, false);
#undef GB_STEP
#undef GB_LOAD
}
__device__ __forceinline__ void phase_gdn_c(Ctx& F, int l) {
    const int lane = F.lane, fr = lane & 15, fq = lane >> 4;
    const v4u* QTF = (const v4u*)(F.ws + WS_QTF); const v2u* OL = (const v2u*)(F.ws + WS_OL); const bf16* ST = (const bf16*)(F.ws + WS_ST);
    const bf16* proj = (const bf16*)(F.ws + WS_R1); bf16* ya = (bf16*)(F.ws + WS_YA); const float* gnp = as_global(F.in[I_GDNNORM]) + (size_t)l * 128;
    { const int ci = F.bid * 8 + F.wave;
        const int bh = ci >> 8, n = ci & 255, b = bh >> 2, h = bh & 3, tok0 = b * T + n * 64;
        bf16x8 qt[4][4];
#pragma unroll
        for (int t = 0; t < 4; ++t)
#pragma unroll
            for (int s = 0; s < 4; ++s) qt[t][s] = __builtin_bit_cast(bf16x8, (QTF + ((size_t)(ci * 4 + t) * 4 + s) * 64)[(unsigned)lane]);
        f32x4 o[8][4];
#pragma unroll
        for (int et = 0; et < 8; ++et) {
#pragma unroll
            for (int t = 0; t < 4; ++t) { const v2u ow = (OL + ((size_t)(ci * 8 + et) * 4 + t) * 64)[(unsigned)lane]; o[et][t] = (f32x4){bf_lo(ow.x), bf_hi(ow.x), bf_lo(ow.y), bf_hi(ow.y)}; }
#pragma unroll
            for (int s = 0; s < 4; ++s) { const v2u lo = ((const v2u*)ST + (((size_t)ci * 8 + 2 * s) * 8 + et) * 64)[(unsigned)lane], hi = ((const v2u*)ST + (((size_t)ci * 8 + 2 * s + 1) * 8 + et) * 64)[(unsigned)lane];
                v4u aw; aw.x = lo.x; aw.y = lo.y; aw.z = hi.x; aw.w = hi.y; const bf16x8 a = __builtin_bit_cast(bf16x8, aw);
#pragma unroll
                for (int t = 0; t < 4; ++t) o[et][t] = MFMA16(a, qt[t][s], o[et][t]); }
        }
        LAS bf16* slab = (LAS bf16*)(F.lds + F.wave * (64 * 136 * 2));
#pragma unroll
        for (int t = 0; t < 4; ++t) { float ss = 0.f;
#pragma unroll
            for (int et = 0; et < 8; ++et) ss += (o[et][t][0] * o[et][t][0] + o[et][t][1] * o[et][t][1]) + (o[et][t][2] * o[et][t][2] + o[et][t][3] * o[et][t][3]);
            ss += bperm(ss, lane ^ 16); ss += bperm(ss, lane ^ 32);
            const float sc = 1.f / sqrtf(ss * (1.f / 128.f) + RMS_EPS);
#pragma unroll
            for (int et = 0; et < 8; ++et) *(LAS v2u*)(slab + (16 * t + fr) * 136 + 16 * et + 4 * fq) = pack4(o[et][t] * sc); }
        asm volatile("s_waitcnt lgkmcnt(0)" ::: "memory");
        { const int rr = lane >> 4, cc = (lane & 15) * 8;
          const f32x4 g0 = *(const f32x4*)(gnp + cc), g1 = *(const f32x4*)(gnp + cc + 4);
#pragma unroll 2
          for (int p = 0; p < 16; ++p) { const int i = 4 * p + rr;
              const v4u ov = *(const LAS v4u*)(slab + i * 136 + cc);
              const v4u zv = *(const v4u*)((proj + (size_t)tok0 * NPROJ + C_Z + h * 128) + ((unsigned)i * (unsigned)NPROJ + (unsigned)cc));
              float of[8], zf[8]; unpack8(ov, of); unpack8(zv, zf);
              v4u w; w.x = cvt_pk_nat(of[0] * g0[0] * siluf_(zf[0]), of[1] * g0[1] * siluf_(zf[1])); w.y = cvt_pk_nat(of[2] * g0[2] * siluf_(zf[2]), of[3] * g0[3] * siluf_(zf[3]));
              w.z = cvt_pk_nat(of[4] * g1[0] * siluf_(zf[4]), of[5] * g1[1] * siluf_(zf[5])); w.w = cvt_pk_nat(of[6] * g1[2] * siluf_(zf[6]), of[7] * g1[3] * siluf_(zf[7]));
              *(v4u*)((ya + (size_t)tok0 * 512 + h * 128) + ((unsigned)i * 512u + (unsigned)cc)) = w; } }
    }
}
constexpr int XK_PITCH = 136, XV_PITCH = 264;
__device__ __forceinline__ void phase_xattn(Ctx& F, int first, int stride) {
    const bf16* proj = (const bf16*)(F.ws + WS_R1); const bf16* kvb = (const bf16*)(F.ws + WS_KVB); const bf16* vtb = (const bf16*)(F.ws + WS_KVB + 512 * 1024); bf16* ym = (bf16*)(F.ws + WS_YM);
    LAS bf16* Ks = (LAS bf16*)F.lds; LAS bf16* VTs = (LAS bf16*)(F.lds + 256 * XK_PITCH * 2);
    const int NU = NB * 4 * (T / 512);
    for (int unit = first; unit < NU; unit += stride) {
        const int qt = unit % (T / 512), bh = unit / (T / 512), b = bh >> 2, head = bh & 3;
        int lane = F.lane; asm volatile("" : "+v"(lane));
        const int fr = lane & 15, fq = lane >> 4, tid_l = F.wave * 64 + lane;
        __syncthreads();
        for (int it = 0; it < 8; ++it) { const int idx = it * 512 + tid_l, key = idx >> 4, ch = idx & 15;
            const v4u kx = *(const v4u*)((kvb + (size_t)(b * NMEM) * 512 + head * 128) + ((unsigned)key * 512u + (unsigned)ch * 8u)); *(LAS v4u*)(Ks + key * XK_PITCH + ch * 8) = kx;
            const int e = idx >> 5, kc = idx & 31;
            const v4u vx = *(const v4u*)((vtb + (size_t)((b * 4 + head) * 128) * 256) + ((unsigned)e * 256u + (unsigned)kc * 8u)); *(LAS v4u*)(VTs + e * XV_PITCH + kc * 8) = vx; }
        __syncthreads();
#pragma unroll 1
        for (int qi = 0; qi < 2; ++qi) {
            const int tok0 = b * T + qt * 512 + F.wave * 64 + qi * 32;
            bf16x8 qf[2][4];
#pragma unroll
            for (int g = 0; g < 2; ++g)
#pragma unroll
                for (int s = 0; s < 4; ++s) qf[g][s] = *(const bf16x8*)((proj + (size_t)(tok0 + g * 16) * NPROJ + C_QM + head * 128 + 32 * s) + ((unsigned)fr * (unsigned)NPROJ + 8u * (unsigned)fq));
            f32x4 sc[2][16];
#pragma unroll
            for (int kt = 0; kt < 16; ++kt) {
                sc[0][kt] = (f32x4){0.f, 0.f, 0.f, 0.f}; sc[1][kt] = (f32x4){0.f, 0.f, 0.f, 0.f};
#pragma unroll
                for (int s = 0; s < 4; ++s) { const bf16x8 kf = *(const LAS bf16x8*)(Ks + (kt * 16 + fr) * XK_PITCH + 32 * s + 8 * fq);
                    sc[0][kt] = __builtin_amdgcn_mfma_f32_16x16x32_bf16(kf, qf[0][s], sc[0][kt], 0, 0, 0);
                    sc[1][kt] = __builtin_amdgcn_mfma_f32_16x16x32_bf16(kf, qf[1][s], sc[1][kt], 0, 0, 0); }
            }
            bf16x8 pf[2][8]; float inv[2];
#pragma unroll
            for (int g = 0; g < 2; ++g) {
                float mx = -3.0e38f;
#pragma unroll
                for (int kt = 0; kt < 16; ++kt) mx = fmaxf(mx, fmaxf(fmaxf(sc[g][kt][0], sc[g][kt][1]), fmaxf(sc[g][kt][2], sc[g][kt][3])));
                mx = fmaxf(mx, bperm(mx, lane ^ 16)); mx = fmaxf(mx, bperm(mx, lane ^ 32));
                float sum = 0.f;
#pragma unroll
                for (int kt = 0; kt < 16; ++kt)
#pragma unroll
                    for (int r = 0; r < 4; ++r) { const float p = __expf((sc[g][kt][r] - mx) * 0.08838834764831845f); sc[g][kt][r] = p; sum += p; }
                sum += bperm(sum, lane ^ 16); sum += bperm(sum, lane ^ 32);
                inv[g] = 1.f / sum;
#pragma unroll
                for (int ks = 0; ks < 8; ++ks) { v4u w; w.x = cvt_pk_bf16_n(sc[g][2 * ks][0], sc[g][2 * ks][1]); w.y = cvt_pk_bf16_n(sc[g][2 * ks][2], sc[g][2 * ks][3]);
                    w.z = cvt_pk_bf16_n(sc[g][2 * ks + 1][0], sc[g][2 * ks + 1][1]); w.w = cvt_pk_bf16_n(sc[g][2 * ks + 1][2], sc[g][2 * ks + 1][3]); pf[g][ks] = __builtin_bit_cast(bf16x8, w); }
            }
#pragma unroll
            for (int et = 0; et < 8; ++et) {
                f32x4 o0 = (f32x4){0.f, 0.f, 0.f, 0.f}, o1 = (f32x4){0.f, 0.f, 0.f, 0.f};
#pragma unroll
                for (int ks = 0; ks < 8; ++ks) { const LAS bf16* vp = VTs + (et * 16 + fr) * XV_PITCH + 32 * ks + 4 * fq;
                    const v2u lo = *(const LAS v2u*)vp, hi = *(const LAS v2u*)(vp + 16); v4u w; w.x = lo.x; w.y = lo.y; w.z = hi.x; w.w = hi.y; const bf16x8 vf = __builtin_bit_cast(bf16x8, w);
                    o0 = __builtin_amdgcn_mfma_f32_16x16x32_bf16(vf, pf[0][ks], o0, 0, 0, 0);
                    o1 = __builtin_amdgcn_mfma_f32_16x16x32_bf16(vf, pf[1][ks], o1, 0, 0, 0); }
                o0 = o0 * inv[0]; o1 = o1 * inv[1];
                v2u w0, w1; w0.x = cvt_pk_bf16_n(o0[0], o0[1]); w0.y = cvt_pk_bf16_n(o0[2], o0[3]); w1.x = cvt_pk_bf16_n(o1[0], o1[1]); w1.y = cvt_pk_bf16_n(o1[2], o1[3]);
                *(v2u*)((ym + (size_t)tok0 * 512 + head * 128 + et * 16) + ((unsigned)fr * 512u + 4u * (unsigned)fq)) = w0;
                *(v2u*)((ym + (size_t)(tok0 + 16) * 512 + head * 128 + et * 16) + ((unsigned)fr * 512u + 4u * (unsigned)fq)) = w1;
            }
        }
    }
}

constexpr int TPW = NTOK / 256;
constexpr int WR_PITCH = 1028;
__device__ __forceinline__ int dpp_i(int s, int ctrl_sel) {
    if (ctrl_sel == 0) return __builtin_amdgcn_update_dpp(0, s, 0xB1, 0xF, 0xF, true);
    if (ctrl_sel == 1) return __builtin_amdgcn_update_dpp(0, s, 0x4E, 0xF, 0xF, true);
    if (ctrl_sel == 2) return __builtin_amdgcn_update_dpp(0, s, 0x141, 0xF, 0xF, true);
    return __builtin_amdgcn_update_dpp(0, s, 0x140, 0xF, 0xF, true);
}
__device__ __forceinline__ void phase_ln1_router(Ctx& F, int l) {
    LAS float* wr_s = (LAS float*)F.lds;
    LAS int* hist = (LAS int*)(F.lds + 32 * WR_PITCH * 4);
    const float* wrp = as_global(F.in[I_WR]) + (size_t)l * D * NE;
    { const int e = F.tid & 31, kg = F.tid >> 5;
      for (int k = kg * 64; k < kg * 64 + 64; k += 4) { f32x4 w; w[0] = wrp[(size_t)(k + 0) * NE + e]; w[1] = wrp[(size_t)(k + 1) * NE + e]; w[2] = wrp[(size_t)(k + 2) * NE + e]; w[3] = wrp[(size_t)(k + 3) * NE + e];
          *(LAS f32x4*)(wr_s + e * WR_PITCH + k) = w; } }
    if (F.tid < 32) hist[F.tid] = 0;
    __syncthreads();
    const bf16* tb = (const bf16*)(F.ws + WS_HF); bf16* hb = (bf16*)(F.ws + WS_HB);
    int* tok_e = (int*)(F.ws + WS_TOKE); float* tok_w = (float*)(F.ws + WS_TOKW);
    const float* brp = as_global(F.in[I_BR]) + (size_t)l * NE;
    const int lane = F.lane, fr = lane & 15, q = lane >> 4;
    const int tok_base = F.bid * TPW + F.wave * 16;
    const size_t rowoff = (size_t)(tok_base + fr) * D + 8 * q;
    float s = 0.f, s2 = 0.f;
#pragma unroll 8
    for (int c = 0; c < 32; ++c) { float x[8]; unpack8(*(const v4u*)(tb + rowoff + 32 * c), x);
#pragma unroll
        for (int i = 0; i < 8; ++i) { s += x[i]; s2 += x[i] * x[i]; } }
    s += bperm(s, lane ^ 16); s += bperm(s, lane ^ 32); s2 += bperm(s2, lane ^ 16); s2 += bperm(s2, lane ^ 32);
    const float mean = s * (1.f / D);
    const float rstd = 1.f / sqrtf(fmaxf(s2 * (1.f / D) - mean * mean, 0.f) + LN_EPS);
    const float* gp = as_global(F.in[I_LN1G]) + (size_t)l * D + 8 * q; const float* bp = as_global(F.in[I_LN1B]) + (size_t)l * D + 8 * q;
    const LAS float* w0p = wr_s + fr * WR_PITCH + 8 * q; const LAS float* w1p = wr_s + (16 + fr) * WR_PITCH + 8 * q;
    f32x4 acc0 = (f32x4){0.f, 0.f, 0.f, 0.f}, acc1 = (f32x4){0.f, 0.f, 0.f, 0.f};
#pragma unroll 2
    for (int c = 0; c < 32; ++c) {
        float x[8]; unpack8(*(const v4u*)(tb + rowoff + 32 * c), x);
        const f32x4 g0 = *(const f32x4*)(gp + 32 * c), g1 = *(const f32x4*)(gp + 32 * c + 4), b0 = *(const f32x4*)(bp + 32 * c), b1 = *(const f32x4*)(bp + 32 * c + 4);
        float h[8];
#pragma unroll
        for (int i = 0; i < 4; ++i) { h[i] = (x[i] - mean) * rstd * g0[i] + b0[i]; h[4 + i] = (x[4 + i] - mean) * rstd * g1[i] + b1[i]; }
        const f32x4 wa0 = *(const LAS f32x4*)(w0p + 32 * c), wa1 = *(const LAS f32x4*)(w0p + 32 * c + 4), wb0 = *(const LAS f32x4*)(w1p + 32 * c), wb1 = *(const LAS f32x4*)(w1p + 32 * c + 4);
#pragma unroll
        for (int i = 0; i < 4; ++i) { acc0 = __builtin_amdgcn_mfma_f32_16x16x4f32(h[i], wa0[i], acc0, 0, 0, 0); acc1 = __builtin_amdgcn_mfma_f32_16x16x4f32(h[i], wb0[i], acc1, 0, 0, 0); }
#pragma unroll
        for (int i = 0; i < 4; ++i) { acc0 = __builtin_amdgcn_mfma_f32_16x16x4f32(h[4 + i], wa1[i], acc0, 0, 0, 0); acc1 = __builtin_amdgcn_mfma_f32_16x16x4f32(h[4 + i], wb1[i], acc1, 0, 0, 0); }
        v4u w; w.x = cvt_pk_nat(h[0], h[1]); w.y = cvt_pk_nat(h[2], h[3]); w.z = cvt_pk_nat(h[4], h[5]); w.w = cvt_pk_nat(h[6], h[7]);
        *(v4u*)(hb + rowoff + 32 * c) = w;
        asm volatile("" ::: "memory");
    }
    const float be0 = brp[fr], be1 = brp[16 + fr];
#pragma unroll
    for (int r = 0; r < 4; ++r) {
        float v0 = acc0[r] + be0, v1 = acc1[r] + be1; float val[4]; int idx[4];
#pragma unroll
        for (int kk = 0; kk < 4; ++kk) {
            const bool use1 = v1 > v0; float bv = use1 ? v1 : v0; int bi = use1 ? 16 + fr : fr;
#pragma unroll
            for (int st = 0; st < 4; ++st) { const float ov = dpp_f(bv, st); const int oi = dpp_i(bi, st); const bool take = (ov > bv) || (ov == bv && oi < bi); bv = take ? ov : bv; bi = take ? oi : bi; }
            val[kk] = bv; idx[kk] = bi;
            v0 = (bi == fr) ? -3.0e38f : v0; v1 = (bi == 16 + fr) ? -3.0e38f : v1;
        }
        const float e1 = __expf(val[1] - val[0]), e2 = __expf(val[2] - val[0]), e3 = __expf(val[3] - val[0]); const float inv = 1.f / (1.f + e1 + e2 + e3);
        if (fr == 0) { const size_t t4 = (size_t)(tok_base + 4 * q + r) * 4;
            *(int4*)(tok_e + t4) = make_int4(idx[0], idx[1], idx[2], idx[3]); *(f32x4*)(tok_w + t4) = (f32x4){inv, e1 * inv, e2 * inv, e3 * inv};
            atomicAdd((int*)&hist[idx[0]], 1); atomicAdd((int*)&hist[idx[1]], 1); atomicAdd((int*)&hist[idx[2]], 1); atomicAdd((int*)&hist[idx[3]], 1); }
    }
    __syncthreads();
    if (F.tid < 32) ((int*)(F.ws + WS_CNT))[F.bid * 32 + F.tid] = hist[F.tid];
}

__device__ __forceinline__ void phase_assign(Ctx& F) {
    LAS int* part_tot = (LAS int*)F.lds;
    LAS int* part_bef = part_tot + 512;
    LAS int* tot_s = part_bef + 512; LAS int* bef_s = tot_s + 32; LAS int* pstart_s = bef_s + 32;
    LAS int* cntw = pstart_s + 32;
    const int* cnt = (const int*)(F.ws + WS_CNT); int* meta = (int*)(F.ws + WS_META);
    const int* tok_e = (const int*)(F.ws + WS_TOKE); const float* tok_w = (const float*)(F.ws + WS_TOKW);
    int* tok_slot = (int*)(F.ws + WS_TOKS); float* slot_w = (float*)(F.ws + WS_SLOTW);
    const int lane = F.lane;
    const int n = F.tid, my_e = tok_e[(size_t)F.bid * TPW * 4 + n]; const float my_w = tok_w[(size_t)F.bid * TPW * 4 + n];
    int my_rank = 0, my_cnt = 0;
    const unsigned long long lt = (1ull << lane) - 1ull;
#pragma unroll
    for (int e = 0; e < 32; ++e) { const unsigned long long m = __ballot(my_e == e); my_rank = (my_e == e) ? __popcll(m & lt) : my_rank; my_cnt = (lane == e) ? __popcll(m) : my_cnt; }
    if (lane < 32) cntw[F.wave * 32 + lane] = my_cnt;
    { const int e = F.tid & 31, part = F.tid >> 5; const int per = (F.G + 15) / 16; int c[16];
#pragma unroll
      for (int j = 0; j < 16; ++j) { const int w = part * per + j; c[j] = (j < per && w < F.G) ? cnt[w * 32 + e] : 0; }
      int tot = 0, bef = 0;
#pragma unroll
      for (int j = 0; j < 16; ++j) { tot += c[j]; bef += (part * per + j < F.bid) ? c[j] : 0; }
      part_tot[part * 32 + e] = tot; part_bef[part * 32 + e] = bef; }
    __syncthreads();
    if (F.tid < 32) { int tot = 0, bef = 0;
#pragma unroll
        for (int p = 0; p < 16; ++p) { tot += part_tot[p * 32 + F.tid]; bef += part_bef[p * 32 + F.tid]; }
        tot_s[F.tid] = tot;
        const int pc = ((tot + 255) >> 8) << 8; int incl = pc;
#pragma unroll
        for (int off = 1; off < 32; off <<= 1) { const int t = __builtin_amdgcn_ds_bpermute(((lane - off) & 63) << 2, incl); incl += (lane >= off) ? t : 0; }
        const int ps = incl - pc; pstart_s[F.tid] = ps; bef_s[F.tid] = ps + bef;
        if (F.bid == 0) { for (int tt = ps >> 8; tt < (ps + pc) >> 8; ++tt) meta[64 + tt] = F.tid; if (F.tid == 31) meta[0] = (ps + pc) >> 8; } }
    __syncthreads();
    int pre = 0;
    for (int w = 0; w < F.wave; ++w) pre += cntw[w * 32 + my_e];
    const int slot = bef_s[my_e] + pre + my_rank;
    { const int tok = F.bid * TPW + (n >> 2); tok_slot[(size_t)tok * 4 + (n & 3)] = slot; slot_w[slot] = my_w; ((int*)(F.ws + WS_SLOTT))[slot] = tok; }
    if (F.bid == 0 && F.tid < 32) { const int tot = tot_s[F.tid], ps = pstart_s[F.tid], pe = ps + (((tot + 255) >> 8) << 8); int* st = (int*)(F.ws + WS_SLOTT);
        for (int s2 = ps + tot; s2 < pe; ++s2) st[s2] = 0; }
}

__device__ __forceinline__ void phase_combine_ln2(Ctx& F, int l) {
    LAS float* ws_s = (LAS float*)F.lds;
    if (l + 1 < DEPTH) { load_small_w(F, l + 1, ws_s); }
    __syncthreads();
    bf16* hb = (bf16*)(F.ws + WS_HB); float* ab = (float*)(F.ws + WS_AB);
    const bf16* Y = (const bf16*)(F.ws + WS_XS); const int* tok_slot = (const int*)(F.ws + WS_TOKS);
    const int lane = F.lane, gw = F.bid * 8 + F.wave, NGW = F.G * 8;
    for (int tok = gw; tok < NTOK; tok += NGW) {
        f32x4 v[4]; load_row_bf16(hb + (size_t)tok * D, v, lane);
#pragma unroll
        for (int j = 0; j < 4; ++j) v[j] = v[j] * ALPHA;
#pragma unroll
        for (int kk = 0; kk < 4; ++kk) { const int slot = tok_slot[(size_t)tok * 4 + kk]; const bf16* yr = Y + (size_t)slot * D;
#pragma unroll
            for (int j = 0; j < 4; ++j) { const v2u w = *(const v2u*)(yr + 4 * lane + 256 * j); v[j][0] += bf_lo(w.x); v[j][1] += bf_hi(w.x); v[j][2] += bf_lo(w.y); v[j][3] += bf_hi(w.y); } }
        ln_apply(v, as_global(F.in[I_LN2G]) + (size_t)l * D, as_global(F.in[I_LN2B]) + (size_t)l * D, lane);
        if (l + 1 < DEPTH) { store_row_bf16(hb + (size_t)tok * D, v, lane); small_proj(v, ws_s, ab + (size_t)tok * 8, lane); }
        else store_row_f32(F.out + (size_t)tok * D, v, lane);
    }
}


#define PHASE_FN __device__ __forceinline__
PHASE_FN void g_inproj(LAS unsigned char* lds, unsigned char* ws, int l, int G, int bid, int wave) { asm volatile("" : "+s"(ws)); ws = as_global(ws); asm volatile("" : "+s"(G)); asm volatile("" : "+s"(bid)); asm volatile("" : "+s"(l));
    pg8::SchedDense S{(const char*)(ws + WS_HB), (const char*)(ws + WS_WIN) + (size_t)l * NPROJ * D * 2, NTOK / 256, NPROJ / 256, G, bid, (size_t)256 * D * 2};
    pg8::EpiStoreBf16 E{(bf16*)(ws + WS_R1), NPROJ};
    pg8::gemm_phase<pg8::EpiStoreBf16, pg8::SchedDense, true, true>(lds, D, S, E, wave);
}
PHASE_FN void g_kvproj(LAS unsigned char* lds, unsigned char* ws, int l, int G, int bid, int wave) { asm volatile("" : "+s"(ws)); ws = as_global(ws); asm volatile("" : "+s"(G)); asm volatile("" : "+s"(bid)); asm volatile("" : "+s"(l));
    pg8::SchedDense S{(const char*)(ws + WS_MEMB), (const char*)(ws + WS_WKV) + (size_t)l * D * D * 2, NB * NMEM / 256, D / 256, G, bid, (size_t)256 * D * 2};
    pg8::EpiKV E{(bf16*)(ws + WS_KVB), (bf16*)(ws + WS_KVB + 512 * 1024)};
    pg8::gemm_phase<pg8::EpiKV, pg8::SchedDense, true, true>(lds, D, S, E, wave);
}
#ifndef SIDE_OLD
#define SIDE_G(bid, G) ((bid - 32 < 64) ? (1 << 20) : (G - 32 - 64))
#else
#define SIDE_G(bid, G) (G - 32)
#endif
PHASE_FN void g_branch1(LAS unsigned char* lds, unsigned char* ws, int l, int G, int bid, int wave) { asm volatile("" : "+s"(ws)); ws = as_global(ws); asm volatile("" : "+s"(G)); asm volatile("" : "+s"(bid)); asm volatile("" : "+s"(l));
    pg8::SchedBranch S{(const char*)(ws + WS_YA), (const char*)(ws + WS_YB), (const char*)(ws + WS_YM), (const char*)(ws + WS_WBR) + (size_t)l * 3 * D * 512 * 2, (size_t)D * 512 * 2,
                       NTOK / 256, D / 256, SIDE_G(bid, G), bid - 32, 1, 1, 1, (size_t)256 * 512 * 2};
    pg8::EpiBranch E{(const bf16*)(ws + WS_R1), (bf16*)(ws + WS_MB), 1};
    pg8::gemm_phase<pg8::EpiBranch, pg8::SchedBranch, true, true>(lds, 512, S, E, wave);
}
PHASE_FN void g_branch(LAS unsigned char* lds, unsigned char* ws, int l, int G, int bid, int wave) { asm volatile("" : "+s"(ws)); ws = as_global(ws); asm volatile("" : "+s"(G)); asm volatile("" : "+s"(bid)); asm volatile("" : "+s"(l));
    pg8::SchedBranch S{(const char*)(ws + WS_YA), (const char*)(ws + WS_YB), (const char*)(ws + WS_YM), (const char*)(ws + WS_WBR) + (size_t)l * 3 * D * 512 * 2, (size_t)D * 512 * 2,
                       NTOK / 256, D / 256, G, bid, 2, 0, 2, (size_t)256 * 512 * 2};
    pg8::EpiBranch E{(const bf16*)(ws + WS_R1), (bf16*)(ws + WS_MB), 1};
    pg8::gemm_phase<pg8::EpiBranch, pg8::SchedBranch, true, true>(lds, 512, S, E, wave);
}
PHASE_FN void g_outproj(LAS unsigned char* lds, unsigned char* ws, int l, int G, int bid, int wave) { asm volatile("" : "+s"(ws)); ws = as_global(ws); asm volatile("" : "+s"(G)); asm volatile("" : "+s"(bid)); asm volatile("" : "+s"(l));
    pg8::SchedDense S{(const char*)(ws + WS_MB), (const char*)(ws + WS_WO) + (size_t)l * D * D * 2, NTOK / 256, D / 256, G, bid, (size_t)256 * D * 2};
    pg8::EpiOut E{(const bf16*)(ws + WS_HB), (bf16*)(ws + WS_HF)};
    pg8::gemm_phase<pg8::EpiOut, pg8::SchedDense, true, true>(lds, D, S, E, wave);
}
PHASE_FN void g_gateup(LAS unsigned char* lds, unsigned char* ws, const float* bgu, int l, int G, int bid, int wave) { asm volatile("" : "+s"(ws)); ws = as_global(ws); asm volatile("" : "+s"(G)); asm volatile("" : "+s"(bid)); asm volatile("" : "+s"(l)); bgu = as_global(bgu);
    const int* meta = (const int*)(ws + WS_META); const int n_tiles = __builtin_amdgcn_readfirstlane(meta[0]);
    pg8::SchedGrouped S{(const char*)(ws + WS_HB), (const char*)(ws + WS_WGU) + (size_t)l * NE * 2048 * D * 2, (size_t)2048 * D * 2, meta + 64, n_tiles, 8, G, bid, (size_t)256 * D * 2, (const int*)(ws + WS_SLOTT)};
    pg8::EpiSwiglu E{(bf16*)(ws + WS_HBUF), bgu + (size_t)l * NE * 2048};
    pg8::gemm_phase<pg8::EpiSwiglu, pg8::SchedGrouped, true, true, true>(lds, D, S, E, wave);
}
PHASE_FN void g_down(LAS unsigned char* lds, unsigned char* ws, const float* bd, int l, int G, int bid, int wave) { asm volatile("" : "+s"(ws)); ws = as_global(ws); asm volatile("" : "+s"(G)); asm volatile("" : "+s"(bid)); asm volatile("" : "+s"(l)); bd = as_global(bd);
    const int* meta = (const int*)(ws + WS_META); const int n_tiles = __builtin_amdgcn_readfirstlane(meta[0]);
    pg8::SchedGrouped S{(const char*)(ws + WS_HBUF), (const char*)(ws + WS_WD) + (size_t)l * NE * D * D * 2, (size_t)D * D * 2, meta + 64, n_tiles, 4, G, bid, (size_t)256 * D * 2, nullptr};
    pg8::EpiDown E{(bf16*)(ws + WS_XS), bd + (size_t)l * NE * D, (const float*)(ws + WS_SLOTW)};
    pg8::gemm_phase<pg8::EpiDown, pg8::SchedGrouped, true, true>(lds, D, S, E, wave);
}

constexpr int PH_PER_LAYER = 12, NPHASE = 1 + DEPTH * PH_PER_LAYER;
__global__ void __launch_bounds__(512, 2) fwd_kernel(Args args) {
    extern __shared__ __attribute__((aligned(16))) unsigned char lds_raw[];
    Ctx F;
    F.lds = (LAS unsigned char*)lds_raw; F.tid = 0; F.lane = 0; F.wave = __builtin_amdgcn_readfirstlane((int)threadIdx.x >> 6); F.G = gridDim.x; F.bid = blockIdx.x;
    F.in = args.in; F.out = args.out; F.ws = args.ws;
    volatile LAS unsigned* MISC = (volatile LAS unsigned*)(F.lds + MISC_OFF);
    if (threadIdx.x < 64) MISC[threadIdx.x] = 0u;
    __syncthreads();
    const int lo = args.ph_lo, hi = args.ph_hi;
#define REP_BRANCH g_branch
#ifdef AMP_BID
#define AMP_BEGIN() const unsigned long long amp_t0_ = __builtin_amdgcn_s_memrealtime()
#define AMP_END() do { if (exp_ && F.bid == AMP_BID) { __syncthreads(); const unsigned long long t1_ = __builtin_amdgcn_s_memrealtime(); while (__builtin_amdgcn_s_memrealtime() - t1_ < (unsigned long long)AMP * (t1_ - amp_t0_)) __builtin_amdgcn_s_sleep(8); } } while (0)
#else
#define AMP_BEGIN() do {} while (0)
#define AMP_END() do {} while (0)
#endif
#ifndef XA_LO
#define XA_LO 128
#endif
#ifndef BVAR
#define BVAR 0
#endif
#ifndef REP_MODE
#define REP_MODE 0
#endif
#ifndef REP_PH
#define REP_PH -1
#define REP_N 0
#endif
#define NREP(k) (((k) == REP_PH) ? 1 + REP_N : 1)
#if MK_MULTI
#define GRID_BAR() do { } while (0)
#else
    XcdBarrier bar = xcd_barrier_post((unsigned*)(F.ws + WS_CTL) + CW_BAR, MISC + 8);
#define GRID_BAR() xcd_barrier(bar)
#endif
#define IN(k) (lo <= (k) && (k) < hi)
#define SEAM(k) do { if (IN(k) && IN((k) + 1)) GRID_BAR(); } while (0)

    if (IN(0)) { for (int rep_ = 0; rep_ < ((REP_PH == 100) ? 1 + REP_N : 1); ++rep_) { if (rep_) GRID_BAR(); { Ctx P = fresh(F); phase_prologue(P); } } } SEAM(0);

#define LAYER_PHASES(l) do { const int p0 = 1 + (l) * PH_PER_LAYER; \
        if (IN(p0 + 0)) { for (int rep_ = 0; rep_ < NREP(0); ++rep_) { if (rep_) GRID_BAR(); g_inproj(F.lds, F.ws, l, F.G, F.bid, F.wave); } } SEAM(p0 + 0); \
        if (IN(p0 + 1)) { for (int rep_ = 0; rep_ < NREP(1); ++rep_) { if (rep_) GRID_BAR(); g_kvproj(F.lds, F.ws, l, F.G, F.bid, F.wave); __syncthreads(); { Ctx P = fresh(F); phase_prep(P, l); } asm volatile("s_waitcnt vmcnt(0)" ::: "memory"); __syncthreads(); { Ctx P = fresh(F); phase_gdn_a(P); } } }   \
        SEAM(p0 + 2); \
        if (IN(p0 + 3)) { for (int rep_ = 0; rep_ < NREP(3); ++rep_) { if (rep_) GRID_BAR(); __syncthreads(); { Ctx P = fresh(F); const bool exp_ = rep_ + 1 < NREP(3); const int mode_ = exp_ ? REP_MODE : 0; AMP_BEGIN(); if (P.bid < 32) { if (mode_ != 2) phase_gdn_b(P, exp_ ? BVAR : 0); } else if (mode_ != 1) { if (mode_ == 5) { if (P.bid >= XA_LO && P.bid < XA_LO + 64) phase_xattn(P, P.bid - XA_LO, 1 << 20); } else if (mode_ != 4) phase_xattn(P, P.bid - 32, P.G - 32); __syncthreads(); if (mode_ != 3 && mode_ != 5) g_branch1(F.lds, F.ws, l, F.G, F.bid, F.wave); if (l == 0 && !exp_ && NDEF > 0) { __syncthreads(); Ctx Q = fresh(F); convert_deferred(Q, (Q.bid - 32) * 8 + Q.wave, (Q.G - 32) * 8); } } AMP_END(); } } } SEAM(p0 + 3); \
        if (IN(p0 + 4)) { for (int rep_ = 0; rep_ < NREP(4); ++rep_) { if (rep_) GRID_BAR(); __syncthreads(); { Ctx P = fresh(F); phase_gdn_c(P, l); } } } SEAM(p0 + 4); \
        if (IN(p0 + 5)) { for (int rep_ = 0; rep_ < NREP(5); ++rep_) { if (rep_) GRID_BAR(); __syncthreads(); if (rep_ == 0) g_branch(F.lds, F.ws, l, F.G, F.bid, F.wave); else REP_BRANCH(F.lds, F.ws, l, F.G, F.bid, F.wave); } } SEAM(p0 + 5); \
        if (IN(p0 + 6)) { for (int rep_ = 0; rep_ < NREP(6); ++rep_) { if (rep_) GRID_BAR(); g_outproj(F.lds, F.ws, l, F.G, F.bid, F.wave); } } SEAM(p0 + 6); \
        if (IN(p0 + 7)) { for (int rep_ = 0; rep_ < NREP(7); ++rep_) { if (rep_) GRID_BAR(); __syncthreads(); { Ctx P = fresh(F); phase_ln1_router(P, l); } } } SEAM(p0 + 7); \
        if (IN(p0 + 8)) { for (int rep_ = 0; rep_ < NREP(8); ++rep_) { if (rep_) GRID_BAR(); __syncthreads(); { Ctx P = fresh(F); phase_assign(P); } } } SEAM(p0 + 8); \
        if (IN(p0 + 9)) { for (int rep_ = 0; rep_ < NREP(9); ++rep_) { if (rep_) GRID_BAR(); __syncthreads(); g_gateup(F.lds, F.ws, as_global(F.in[I_BGU]), l, F.G, F.bid, F.wave); } } SEAM(p0 + 9); \
        if (IN(p0 + 10)) { for (int rep_ = 0; rep_ < NREP(10); ++rep_) { if (rep_) GRID_BAR(); g_down(F.lds, F.ws, as_global(F.in[I_BD]), l, F.G, F.bid, F.wave); } } SEAM(p0 + 10); \
        if (IN(p0 + 11)) { for (int rep_ = 0; rep_ < NREP(11); ++rep_) { if (rep_) GRID_BAR(); __syncthreads(); { Ctx P = fresh(F); phase_combine_ln2(P, l); } } } SEAM(p0 + 11); \
    } while (0)
    LAYER_PHASES(0);
    LAYER_PHASES(1);
#undef LAYER_PHASES
#undef IN
#undef SEAM
#undef GRID_BAR
}

extern "C" void kernel_launch(void* const* d_in, const int* in_sizes, int n_in, void* d_out, int out_size, void* d_ws, size_t ws_size, hipStream_t stream) {
    static int grid = 0;
    if (grid == 0) {
        if (n_in != 23 || out_size != NTOK * D || ws_size < WS_END) { fprintf(stderr, "kernel_launch: unexpected problem (n_in %d, out %d, ws %zu < %zu)\n", n_in, out_size, ws_size, (size_t)WS_END); grid = -1; return; }
        if (hipFuncSetAttribute((const void*)fwd_kernel, hipFuncAttributeMaxDynamicSharedMemorySize, LDS_BYTES) != hipSuccess) { fprintf(stderr, "kernel_launch: hipFuncSetAttribute failed\n"); grid = -1; return; }
        int per_cu = 0;
        if (hipOccupancyMaxActiveBlocksPerMultiprocessor(&per_cu, (const void*)fwd_kernel, 512, LDS_BYTES) != hipSuccess || per_cu < 1) fprintf(stderr, "kernel_launch: occupancy query reports %d\n", per_cu);
        (void)hipGetLastError();
        grid = 256;
    }
    if (grid < 0) return;
    (void)hipMemsetAsync((char*)d_ws + WS_CTL, 0, CTL_ZERO_BYTES, stream);
    Args a{};
    for (int i = 0; i < 23; ++i) a.in[i] = (const float*)d_in[i];
    a.out = (float*)d_out; a.ws = (unsigned char*)d_ws;
#if MK_MULTI
    for (int p = 0; p < NPHASE; ++p) { a.ph_lo = p; a.ph_hi = p + 1; hipLaunchKernelGGL(fwd_kernel, dim3(grid), dim3(512), LDS_BYTES, stream, a); }
#else
    a.ph_lo = 0; a.ph_hi = NPHASE;
    hipLaunchKernelGGL(fwd_kernel, dim3(grid), dim3(512), LDS_BYTES, stream, a);
#endif
}
```

```cpp
#define NHELP 3
#define HLEAD 10
#include <hip/hip_runtime.h>
#include <cstdio>
#include <cstdint>

#ifndef MK_MULTI
#define MK_MULTI 0
#endif

#define LAS __attribute__((address_space(3)))
typedef unsigned short bf16;
typedef unsigned v4u __attribute__((ext_vector_type(4)));
typedef unsigned v2u __attribute__((ext_vector_type(2)));
typedef float f32x4 __attribute__((ext_vector_type(4)));
typedef float f32x2 __attribute__((ext_vector_type(2)));
typedef short bf16x8 __attribute__((ext_vector_type(8)));

constexpr int NB = 2, T = 16384, NTOK = NB * T, D = 1024, DEPTH = 2;
constexpr int NPROJ = 7168;
constexpr int NPROJ_SRC = 7176;
constexpr int C_Q = 0, C_K = 512, C_V = 1024, C_Z = 1536, C_XC = 2048, C_GB = 2560, C_GC = 3072, C_QM = 3584, C_GL = 4096;
constexpr int NMEM = 256, NE = 32, TOPK = 4, DFF = 1024;
constexpr int NSLOT_MAX = 544 * 256;
constexpr float ALPHA = 1.41421356237309515f;
constexpr float LN_EPS = 1e-5f, RMS_EPS = 1e-6f;

constexpr size_t MiB = 1u << 20;
constexpr size_t WS_CTL = 0, CTL_ZERO_BYTES = 1 * MiB;
constexpr size_t WS_WIN = 1 * MiB;
constexpr size_t WS_WBR = WS_WIN + 28 * MiB;
constexpr size_t WS_WO = WS_WBR + 6 * MiB;
constexpr size_t WS_WKV = WS_WO + 4 * MiB;
constexpr size_t WS_WGU = WS_WKV + 4 * MiB;
constexpr size_t WS_WD = WS_WGU + 256 * MiB;
constexpr size_t WS_MEMB = WS_WD + 128 * MiB;
constexpr size_t WS_KVB = WS_MEMB + 1 * MiB;
constexpr size_t WS_HF = WS_KVB + 1 * MiB;
constexpr size_t WS_HB = WS_HF + 128 * MiB;
constexpr size_t WS_AB = WS_HB + 64 * MiB;
constexpr size_t WS_R1 = WS_AB + 1 * MiB;
constexpr size_t WS_XS = WS_R1, WS_HBUF = WS_R1 + 272 * MiB;
constexpr size_t WS_KN = WS_R1 + 544 * MiB;
constexpr size_t WS_QN = WS_KN + 32 * MiB;
constexpr size_t WS_VV = WS_QN + 32 * MiB;
constexpr size_t WS_GS = WS_VV + 32 * MiB;
constexpr size_t WS_ATF = WS_GS + 2 * MiB;
constexpr size_t WS_BC = WS_ATF + 64 * MiB;
constexpr size_t WS_QTF = WS_BC + 64 * MiB;
constexpr size_t WS_OL = WS_QTF + 32 * MiB;
constexpr size_t WS_ST = WS_OL + 64 * MiB;
constexpr size_t WS_CD = WS_ST + 64 * MiB;
constexpr size_t WS_UPK = WS_CD + 1 * MiB;
constexpr size_t WS_WPK = WS_UPK + 32 * MiB;
constexpr size_t WS_YA = WS_WPK + 32 * MiB;
constexpr size_t WS_YB = WS_YA + 32 * MiB, WS_YM = WS_YB + 32 * MiB;
constexpr size_t WS_MF = WS_YM + 32 * MiB;
constexpr size_t WS_MB = WS_MF + 128 * MiB;
constexpr size_t WS_TOKE = WS_MB + 64 * MiB;
constexpr size_t WS_TOKW = WS_TOKE + MiB / 2;
constexpr size_t WS_TOKS = WS_TOKW + MiB / 2;
constexpr size_t WS_SLOTW = WS_TOKS + MiB / 2;
constexpr size_t WS_CNT = WS_SLOTW + 1 * MiB;
constexpr size_t WS_META = WS_CNT + MiB / 4;
constexpr size_t WS_SLOTT = WS_META + MiB / 4;
constexpr size_t WS_END = WS_SLOTT + 1 * MiB;
static_assert(WS_END <= (size_t)2048 * MiB, "workspace map exceeds 2 GiB");
constexpr int CW_PROG = 16384;
constexpr int CW_BAR = 4096;

constexpr int LDS_BYTES = 159744;
constexpr int MISC_OFF = LDS_BYTES - 256;

#define GAS __attribute__((address_space(1)))
template <class Tp> __device__ __forceinline__ Tp* as_global(Tp* p) { GAS Tp* g = (GAS Tp*)p; asm("" : "+s"(g)); return (Tp*)g; }
#define LDS_WAIT() asm volatile("s_waitcnt lgkmcnt(0)" ::: "memory")
#define VM_WAIT() asm volatile("s_waitcnt vmcnt(0)" ::: "memory")
__device__ __forceinline__ unsigned cvt_pk_bf16(float lo, float hi) { unsigned r; asm volatile("v_cvt_pk_bf16_f32 %0, %1, %2" : "=v"(r) : "v"(lo), "v"(hi)); return r; }
__device__ __forceinline__ unsigned cvt_pk_bf16_n(float lo, float hi) { unsigned r; asm volatile("v_cvt_pk_bf16_f32 %0, %1, %2\n\ts_nop 1" : "=v"(r) : "v"(lo), "v"(hi)); return r; }
typedef __bf16 bf16x2_t __attribute__((ext_vector_type(2)));
__device__ __forceinline__ unsigned cvt_pk_nat(float lo, float hi) { bf16x2_t v; v[0] = (__bf16)lo; v[1] = (__bf16)hi; return __builtin_bit_cast(unsigned, v); }
__device__ __forceinline__ float bf_lo(unsigned w) { return __uint_as_float(w << 16); }
__device__ __forceinline__ float bf_hi(unsigned w) { return __uint_as_float(w & 0xffff0000u); }
__device__ __forceinline__ float fast_rcp(float x) { return __builtin_amdgcn_rcpf(x); }
__device__ __forceinline__ float sigmoidf_(float x) { return fast_rcp(1.0f + __expf(-x)); }
__device__ __forceinline__ float siluf_(float x) { return x * sigmoidf_(x); }
__device__ __forceinline__ float dpp_f(float v, int ctrl_sel) {
    const int s = __builtin_bit_cast(int, v); int r;
    if (ctrl_sel == 0) r = __builtin_amdgcn_update_dpp(0, s, 0xB1, 0xF, 0xF, true);
    else if (ctrl_sel == 1) r = __builtin_amdgcn_update_dpp(0, s, 0x4E, 0xF, 0xF, true);
    else if (ctrl_sel == 2) r = __builtin_amdgcn_update_dpp(0, s, 0x141, 0xF, 0xF, true);
    else r = __builtin_amdgcn_update_dpp(0, s, 0x140, 0xF, 0xF, true);
    return __builtin_bit_cast(float, r);
}
__device__ __forceinline__ float row16_sum(float v) {
    v += dpp_f(v, 0); v += dpp_f(v, 1); v += dpp_f(v, 2); v += dpp_f(v, 3); return v;
}
__device__ __forceinline__ float rdlane(float v, int l) { return __builtin_bit_cast(float, __builtin_amdgcn_readlane(__builtin_bit_cast(int, v), l)); }
__device__ __forceinline__ float wave_sum(float v) { v = row16_sum(v); return (rdlane(v, 0) + rdlane(v, 16)) + (rdlane(v, 32) + rdlane(v, 48)); }
__device__ __forceinline__ float bperm(float v, int src_lane) { return __builtin_bit_cast(float, __builtin_amdgcn_ds_bpermute(src_lane << 2, __builtin_bit_cast(int, v))); }

#define XB_TMO      128
#define XB_XCNT(j)  (256  + 64 * (j))
#define XB_XSUB(j)  (1280 + 64 * (j))
#define XB_XGEN(j)  (2304 + 64 * (j))
#define XB_TOP      3328
#define XB_TOPGEN   3392
#define XCD_BAR_WORDS 3456
#define XB_SPIN_CAP (1u << 18)
__device__ __forceinline__ unsigned xb_ld(unsigned* p)              { return __hip_atomic_load(p, __ATOMIC_RELAXED, __HIP_MEMORY_SCOPE_AGENT); }
__device__ __forceinline__ unsigned xb_add(unsigned* p, unsigned v) { return __hip_atomic_fetch_add(p, v, __ATOMIC_RELAXED, __HIP_MEMORY_SCOPE_AGENT); }
__device__ __forceinline__ unsigned xb_xcc_id() { return (unsigned)__builtin_amdgcn_s_getreg((3 << 11) | 20) & 0xFu; }
#define XB_SPIN(cond, bar) do { unsigned _sp = 0; while (cond) { __builtin_amdgcn_s_sleep(1); \
    if ((++_sp & 255u) == 0u) { if (xb_ld(&(bar)[XB_TMO])) break; if (_sp > XB_SPIN_CAP) { atomicAdd(&(bar)[XB_TMO], 1u); break; } } } } while (0)
struct XcdBarrier { unsigned* bar; unsigned x; volatile LAS unsigned* st; };
__device__ __forceinline__ XcdBarrier xcd_barrier_post(unsigned* bar, volatile LAS unsigned* st) {
    XcdBarrier b; b.bar = bar; b.x = xb_xcc_id(); b.st = st;
    if (threadIdx.x == 0) (void)xb_add(&bar[XB_XCNT(b.x)], 1u);
    return b;
}
__device__ __forceinline__ void xcd_barrier_complete(unsigned* bar, unsigned x, unsigned& nloc, unsigned& nx) {
    const unsigned G = gridDim.x * gridDim.y * gridDim.z;
    unsigned sum, cnt, mine, sp = 0u;
    for (;;) {
        sum = 0u; cnt = 0u; mine = 0u;
#pragma unroll
        for (unsigned j = 0; j < 16; ++j) { const unsigned c = xb_ld(&bar[XB_XCNT(j)]); sum += c; cnt += (c > 0u) ? 1u : 0u; mine = (j == x) ? c : mine; }
        if (sum == G) break;
        __builtin_amdgcn_s_sleep(1);
        if ((++sp & 255u) == 0u) { if (xb_ld(&bar[XB_TMO])) break; if (sp > XB_SPIN_CAP) { atomicAdd(&bar[XB_TMO], 1u); break; } }
    }
    nloc = mine > 0u ? mine : 1u; nx = cnt > 0u ? cnt : 1u;
}
__device__ __forceinline__ void xcd_barrier(const XcdBarrier& b) {
    asm volatile("s_waitcnt vmcnt(0)" ::: "memory");
    __syncthreads();
    if (threadIdx.x == 0) {
        unsigned* bar = b.bar;
        __builtin_amdgcn_s_waitcnt(0);
        unsigned nloc = b.st[0], nx = b.st[1];
        if (nloc == 0u) { xcd_barrier_complete(bar, b.x, nloc, nx); b.st[0] = nloc; b.st[1] = nx; }
        const unsigned old = xb_add(&bar[XB_XSUB(b.x)], 1u);
        const unsigned gen = old / nloc;
        if (old + 1u == (gen + 1u) * nloc) {
            __builtin_amdgcn_fence(__ATOMIC_RELEASE, "agent");
            asm volatile("s_waitcnt vmcnt(0)" ::: "memory");
            const unsigned og = xb_add(&bar[XB_TOP], 1u);
            const unsigned tg = og / nx;
            if (og + 1u == (tg + 1u) * nx) xb_add(&bar[XB_TOPGEN], 1u);
            else XB_SPIN(xb_ld(&bar[XB_TOPGEN]) == tg, bar);
            __builtin_amdgcn_fence(__ATOMIC_ACQUIRE, "agent");
            xb_add(&bar[XB_XGEN(b.x)], 1u);
            asm volatile("s_waitcnt vmcnt(0)" ::: "memory");
        } else {
            XB_SPIN(xb_ld(&bar[XB_XGEN(b.x)]) == gen, bar);
            __builtin_amdgcn_fence(__ATOMIC_ACQUIRE, "agent");
            asm volatile("s_waitcnt vmcnt(0)" ::: "memory");
        }
    }
    __syncthreads();
}

namespace pg8 {
constexpr int BM = 256, BK = 64, HALF = 128, HTB = HALF * BK * 2, STAGE_BYTES = 8 * HTB, NXCD = 8, WGM = 8;
__host__ __device__ __forceinline__ int lds_byte(int r, int c) { const int st = (r >> 4) * 2 + (c >> 5), rr = r & 15, cc = c & 31, ob = rr * 64 + cc * 2; return st * 1024 + (ob ^ (((ob >> 9) & 1) << 5)); }
__host__ __device__ __forceinline__ void stage_rc(int b, int& R, int& C) { const int st = b / 1024, sb = b % 1024, swz = sb ^ (((sb >> 9) & 1) << 5); R = (st >> 1) * 16 + swz / 64; C = (st & 1) * 32 + (swz % 64) / 2; }
__host__ __device__ __forceinline__ int perm32(int rho) { const int n = rho >> 4, i = rho & 15; return 8 * (i >> 2) + 4 * n + (i & 3); }

struct Unit { int pm, pn, e; const char* a; const char* b; };

__device__ __forceinline__ void tile_map(int L, int nM, int nN, int& pm, int& pn) {
    const int nwg = nM * nN; int wgid = L;
    { const int q = nwg / NXCD, r = nwg % NXCD, xcd = wgid % NXCD, off = wgid / NXCD; wgid = (xcd < r ? xcd * (q + 1) : r * (q + 1) + (xcd - r) * q) + off; }
    const int nig = WGM * nN, gid = wgid / nig, fm = gid * WGM, gsz = (nM - fm) < WGM ? (nM - fm) : WGM;
    pm = fm + ((wgid % nig) % gsz); pn = (wgid % nig) / gsz;
}
struct SchedDense {
    const char* A; const char* B; int nM, nN, G, c; size_t tstep;
    __device__ __forceinline__ bool next(int i, Unit& u) const {
        const long L = (long)i * G + c; if (L >= (long)nM * nN) return false;
        tile_map((int)L, nM, nN, u.pm, u.pn); u.e = 0; u.a = A + (size_t)u.pm * tstep; u.b = B + (size_t)u.pn * tstep; return true; }
    __device__ __forceinline__ int row_of(int, int) const { return 0; }
};
struct SchedBranch {
    const char* A0; const char* A1; const char* A2; const char* B; size_t bstride; int nM, nN, G, c, nb, b0, b1; size_t tstep; int nmax = 1 << 30;
    __device__ __forceinline__ bool next(int i, Unit& u) const {
        const int nwg = nM * nN, j = i % nb; const long Lr = (long)(i / nb) * G + c; if (Lr >= nwg || i / nb >= nmax) return false;
        const int br = (j == 0) ? b0 : b1;
        tile_map((int)Lr, nM, nN, u.pm, u.pn); u.e = br; u.a = (br == 0 ? A0 : (br == 1 ? A1 : A2)) + (size_t)u.pm * tstep; u.b = B + (size_t)br * bstride + (size_t)u.pn * tstep; return true; }
    __device__ __forceinline__ int row_of(int, int) const { return 0; }
};
struct SchedGrouped {
    const char* A; const char* B; size_t estride; const int* tile_e; int nM, nN, G, c; size_t tstep; const int* rows;
    __device__ __forceinline__ bool next(int i, Unit& u) const {
        const long L = (long)i * G + c; if (L >= (long)nM * nN) return false;
        tile_map((int)L, nM, nN, u.pm, u.pn); u.e = __builtin_amdgcn_readfirstlane(tile_e[u.pm]); u.a = rows ? A : A + (size_t)u.pm * tstep; u.b = B + (size_t)u.e * estride + (size_t)u.pn * tstep; return true; }
    __device__ __forceinline__ int row_of(int pm, int r) const { return rows[pm * BM + r]; }
};
struct EpiStoreBf16 {
    static constexpr bool PERM = true;
    bf16* O; int ldc;
    __device__ __forceinline__ void operator()(const f32x4 (&acc)[2][2][4][2], const Unit& u, int wr, int wc, int fr, int fq) const {
        const int row0 = u.pm * BM + wr * 64 + fr, col0 = u.pn * BM + wc * 32 + 8 * fq;
#pragma unroll
        for (int ai = 0; ai < 2; ++ai)
#pragma unroll
            for (int m = 0; m < 4; ++m) { bf16* rowp = O + (size_t)(row0 + ai * HALF + m * 16) * ldc + col0;
#pragma unroll
                for (int bj = 0; bj < 2; ++bj) { const f32x4 v0 = acc[ai][bj][m][0], v1 = acc[ai][bj][m][1];
                    v4u w; w.x = cvt_pk_bf16(v0[0], v0[1]); w.y = cvt_pk_bf16(v0[2], v0[3]); w.z = cvt_pk_bf16(v1[0], v1[1]); w.w = cvt_pk_bf16(v1[2], v1[3]);
                    *(v4u*)(rowp + bj * HALF) = w; } }
    }
};
struct EpiKV {
    static constexpr bool PERM = true;
    bf16* K; bf16* VT;
    __device__ __forceinline__ void operator()(const f32x4 (&acc)[2][2][4][2], const Unit& u, int wr, int wc, int fr, int fq) const {
        const int row0 = wr * 64 + fr, colt = u.pn * BM + wc * 32 + 8 * fq;
#pragma unroll
        for (int ai = 0; ai < 2; ++ai)
#pragma unroll
            for (int m = 0; m < 4; ++m) { const int key = row0 + ai * HALF + m * 16;
#pragma unroll
                for (int bj = 0; bj < 2; ++bj) { const f32x4 v0 = acc[ai][bj][m][0], v1 = acc[ai][bj][m][1]; const int col = colt + bj * HALF;
                    v4u w; w.x = cvt_pk_bf16(v0[0], v0[1]); w.y = cvt_pk_bf16(v0[2], v0[3]); w.z = cvt_pk_bf16(v1[0], v1[1]); w.w = cvt_pk_bf16(v1[2], v1[3]);
                    if (u.pn < 2) *(v4u*)(K + (size_t)(u.pm * BM + key) * 512 + col) = w;
                    else { bf16* d = VT + ((size_t)u.pm * 512 + (col - 512)) * 256 + key;
                        d[0] = (bf16)(w.x & 0xffff); d[256] = (bf16)(w.x >> 16); d[512] = (bf16)(w.y & 0xffff); d[768] = (bf16)(w.y >> 16);
                        d[1024] = (bf16)(w.z & 0xffff); d[1280] = (bf16)(w.z >> 16); d[1536] = (bf16)(w.w & 0xffff); d[1792] = (bf16)(w.w >> 16); } } }
    }
};
struct EpiBranch {
    static constexpr bool PERM = true;
    const bf16* proj; bf16* mb; int store_br;
    __device__ __forceinline__ void operator()(const f32x4 (&acc)[2][2][4][2], const Unit& u, int wr, int wc, int fr, int fq) const {
        const int row0 = u.pm * BM + wr * 64 + fr, col0 = u.pn * BM + wc * 32 + 8 * fq; const int br = u.e; const bool accum = (br != store_br);
        const bf16* gp = proj + (size_t)row0 * NPROJ + C_GL + br * D + col0; bf16* mp = mb + (size_t)row0 * D + col0;
#pragma unroll
        for (int ai = 0; ai < 2; ++ai) {
            v4u gw[4][2], ow[4][2];
#pragma unroll
            for (int m = 0; m < 4; ++m)
#pragma unroll
                for (int bj = 0; bj < 2; ++bj) { const size_t ro = (size_t)(ai * HALF + m * 16); const int co = bj * HALF;
                    gw[m][bj] = *(const v4u*)(gp + ro * NPROJ + co); ow[m][bj] = accum ? *(const v4u*)(mp + ro * D + co) : (v4u){0u, 0u, 0u, 0u}; }
#pragma unroll
            for (int m = 0; m < 4; ++m)
#pragma unroll
                for (int bj = 0; bj < 2; ++bj) { const size_t ro = (size_t)(ai * HALF + m * 16); const int co = bj * HALF; const v4u g4 = gw[m][bj], o = ow[m][bj];
                    const f32x4 a0 = acc[ai][bj][m][0], a1 = acc[ai][bj][m][1];
                    v4u w;
                    w.x = cvt_pk_bf16(sigmoidf_(bf_lo(g4.x)) * a0[0] + bf_lo(o.x), sigmoidf_(bf_hi(g4.x)) * a0[1] + bf_hi(o.x));
                    w.y = cvt_pk_bf16(sigmoidf_(bf_lo(g4.y)) * a0[2] + bf_lo(o.y), sigmoidf_(bf_hi(g4.y)) * a0[3] + bf_hi(o.y));
                    w.z = cvt_pk_bf16(sigmoidf_(bf_lo(g4.z)) * a1[0] + bf_lo(o.z), sigmoidf_(bf_hi(g4.z)) * a1[1] + bf_hi(o.z));
                    w.w = cvt_pk_bf16(sigmoidf_(bf_lo(g4.w)) * a1[2] + bf_lo(o.w), sigmoidf_(bf_hi(g4.w)) * a1[3] + bf_hi(o.w));
                    *(v4u*)(mp + ro * D + co) = w; }
        }
    }
};
struct EpiOut {
    static constexpr bool PERM = true;
    const bf16* hb; bf16* tb;
    __device__ __forceinline__ void operator()(const f32x4 (&acc)[2][2][4][2], const Unit& u, int wr, int wc, int fr, int fq) const {
        const int row0 = u.pm * BM + wr * 64 + fr, col0 = u.pn * BM + wc * 32 + 8 * fq;
        const bf16* hp = hb + (size_t)row0 * D + col0; bf16* tp = tb + (size_t)row0 * D + col0;
#pragma unroll
        for (int ai = 0; ai < 2; ++ai) {
            v4u hw[4][2];
#pragma unroll
            for (int m = 0; m < 4; ++m)
#pragma unroll
                for (int bj = 0; bj < 2; ++bj) hw[m][bj] = *(const v4u*)(hp + (size_t)(ai * HALF + m * 16) * D + bj * HALF);
#pragma unroll
            for (int m = 0; m < 4; ++m)
#pragma unroll
                for (int bj = 0; bj < 2; ++bj) { const v4u h = hw[m][bj]; const f32x4 a0 = acc[ai][bj][m][0], a1 = acc[ai][bj][m][1];
                    v4u w; w.x = cvt_pk_bf16(bf_lo(h.x) * ALPHA + a0[0], bf_hi(h.x) * ALPHA + a0[1]); w.y = cvt_pk_bf16(bf_lo(h.y) * ALPHA + a0[2], bf_hi(h.y) * ALPHA + a0[3]);
                    w.z = cvt_pk_bf16(bf_lo(h.z) * ALPHA + a1[0], bf_hi(h.z) * ALPHA + a1[1]); w.w = cvt_pk_bf16(bf_lo(h.w) * ALPHA + a1[2], bf_hi(h.w) * ALPHA + a1[3]);
                    *(v4u*)(tp + (size_t)(ai * HALF + m * 16) * D + bj * HALF) = w; }
        }
    }
};
struct EpiSwiglu {
    static constexpr bool PERM = true;
    bf16* H; const float* bgu;
    __device__ __forceinline__ void operator()(const f32x4 (&acc)[2][2][4][2], const Unit& u, int wr, int wc, int fr, int fq) const {
        const int row0 = u.pm * BM + wr * 64 + fr, cc0 = u.pn * HALF + wc * 32 + 8 * fq;
        const float* bg = bgu + (size_t)u.e * 2048 + cc0;
        f32x4 bgv[2], buv[2];
#pragma unroll
        for (int n = 0; n < 2; ++n) { bgv[n] = *(const f32x4*)(bg + 4 * n); buv[n] = *(const f32x4*)(bg + 1024 + 4 * n); }
#pragma unroll
        for (int ai = 0; ai < 2; ++ai)
#pragma unroll
            for (int m = 0; m < 4; ++m) { float h[8];
#pragma unroll
                for (int n = 0; n < 2; ++n)
#pragma unroll
                    for (int j = 0; j < 4; ++j) { float g = acc[ai][0][m][n][j] + bgv[n][j], up = acc[ai][1][m][n][j] + buv[n][j];
                        g = fminf(g, 7.0f); up = fminf(fmaxf(up, -7.0f), 7.0f);
                        h[n * 4 + j] = (up + 1.0f) * (g * sigmoidf_(g * 1.702f)); }
                v4u w; w.x = cvt_pk_bf16(h[0], h[1]); w.y = cvt_pk_bf16(h[2], h[3]); w.z = cvt_pk_bf16(h[4], h[5]); w.w = cvt_pk_bf16(h[6], h[7]);
                *(v4u*)(H + (size_t)(row0 + ai * HALF + m * 16) * DFF + cc0) = w; }
    }
};
struct EpiDown {
    static constexpr bool PERM = true;
    bf16* Y; const float* bd; const float* slot_w;
    __device__ __forceinline__ void operator()(const f32x4 (&acc)[2][2][4][2], const Unit& u, int wr, int wc, int fr, int fq) const {
        const int row0 = u.pm * BM + wr * 64 + fr, col0 = u.pn * BM + wc * 32 + 8 * fq;
        const float* bp = bd + (size_t)u.e * D + col0;
        f32x4 bv[2][2];
#pragma unroll
        for (int bj = 0; bj < 2; ++bj)
#pragma unroll
            for (int n = 0; n < 2; ++n) bv[bj][n] = *(const f32x4*)(bp + bj * HALF + 4 * n);
#pragma unroll
        for (int ai = 0; ai < 2; ++ai)
#pragma unroll
            for (int m = 0; m < 4; ++m) { const int row = row0 + ai * HALF + m * 16; const float sw = slot_w[row]; bf16* rowp = Y + (size_t)row * D + col0;
#pragma unroll
                for (int bj = 0; bj < 2; ++bj) { const f32x4 v0 = (acc[ai][bj][m][0] + bv[bj][0]) * sw, v1 = (acc[ai][bj][m][1] + bv[bj][1]) * sw;
                    v4u w; w.x = cvt_pk_bf16(v0[0], v0[1]); w.y = cvt_pk_bf16(v0[2], v0[3]); w.z = cvt_pk_bf16(v1[0], v1[1]); w.w = cvt_pk_bf16(v1[2], v1[3]);
                    *(v4u*)(rowp + bj * HALF) = w; } }
    }
};

template <class Epi, class Sched, bool ALIGN_EPI, bool SP2, bool GATHER = false>
__device__ __forceinline__ void gemm_phase(LAS unsigned char* lds, const int K, const Sched& S, const Epi& E, int wave_id) {
    unsigned z0_ = 0u; asm volatile("" : "+s"(z0_)); int ln_ = (int)__builtin_amdgcn_mbcnt_hi(~0u, __builtin_amdgcn_mbcnt_lo(~0u, z0_)); asm volatile("" : "+v"(ln_)); asm volatile("" : "+s"(wave_id));
    const int wid = wave_id, lane = ln_, tid = wid * 64 + lane, wr = wid >> 2, wc = wid & 3, fr = lane & 15, fq = lane >> 4;
    const int nt = K / BK;
    static_assert(!GATHER || SP2, "row gather is written for the two-super-phase loop");
    unsigned voffA[2], voffB[2], gC[2]; int gR[2];
    unsigned vAc[2][2], vAn[2][2];
#define PG8_ROWS(dst, pm_) do { _Pragma("unroll") for (int h_ = 0; h_ < 2; ++h_) _Pragma("unroll") for (int i_ = 0; i_ < 2; ++i_) dst[h_][i_] = (unsigned)S.row_of(pm_, h_ * HALF + gR[i_]) * (unsigned)(K * 2) + gC[i_]; } while (0)
#define PG8_STAGE_A(bufoff, gbase, h, OFF) do { if constexpr (GATHER) { PG8_STAGE(bufoff, gbase, OFF[h]); } else { PG8_STAGE(bufoff, (gbase) + (h) * hstep, voffA); } } while (0)
#pragma unroll
    for (int i = 0; i < 2; ++i) { int R, C; stage_rc(tid * 16 + i * 8192, R, C); const int Rb = Epi::PERM ? ((R & ~31) + perm32(R & 31)) : R;
        voffA[i] = (unsigned)(R * K + C) * 2u; voffB[i] = (unsigned)(Rb * K + C) * 2u; gR[i] = R; gC[i] = (unsigned)C * 2u; }
    const size_t kstep = (size_t)(BK * 2);
    const size_t hstep = (size_t)HALF * K * 2;
    const unsigned ldsw = (unsigned)wid * 1024u;
    const int aoff = lds_byte(wr * 64 + fr, fq * 8), boff = lds_byte(wc * 32 + fr, fq * 8);
#define PG8_SA(b, h) (((b) * 2 + (h)) * HTB)
#define PG8_SB(b, h) ((4 + (b) * 2 + (h)) * HTB)
#define PG8_STAGE(bufoff, gbase, voff) do { _Pragma("unroll") for (int _i = 0; _i < 2; ++_i) \
        __builtin_amdgcn_global_load_lds((const unsigned*)((const char*)(gbase) + (voff)[_i]), (LAS unsigned*)(lds + (bufoff) + ldsw + _i * 8192), 16, 0, 0); } while (0)
#define PG8_LDA(dst, b, h) do { _Pragma("unroll") for (int m = 0; m < 4; ++m) _Pragma("unroll") for (int k = 0; k < 2; ++k) dst[m][k] = *(const LAS bf16x8*)(lds + PG8_SA(b, h) + aoff + m * 2048 + k * 1024); } while (0)
#define PG8_LDB(dst, b, h) do { _Pragma("unroll") for (int n = 0; n < 2; ++n) _Pragma("unroll") for (int k = 0; k < 2; ++k) dst[n][k] = *(const LAS bf16x8*)(lds + PG8_SB(b, h) + boff + n * 2048 + k * 1024); } while (0)
#define PG8_MMA(ai, bj, At, Bt) do { __builtin_amdgcn_s_setprio(1); _Pragma("unroll") for (int m = 0; m < 4; ++m) _Pragma("unroll") for (int n = 0; n < 2; ++n) _Pragma("unroll") for (int k = 0; k < 2; ++k) \
        acc[ai][bj][m][n] = __builtin_amdgcn_mfma_f32_16x16x32_bf16(Bt[n][k], At[m][k], acc[ai][bj][m][n], 0, 0, 0); __builtin_amdgcn_s_setprio(0); } while (0)
#define PG8_WAIT_V(n) asm volatile("s_waitcnt vmcnt(" #n ")" ::: "memory")
#define PG8_WAIT_L(n) asm volatile("s_waitcnt lgkmcnt(" #n ")" ::: "memory")
#define PG8_BAR __builtin_amdgcn_s_barrier()
#define PG8_SCHED __builtin_amdgcn_sched_barrier(0)
    Unit cur, nxt; int ui = 0;
    if (!S.next(0, cur)) return;
    f32x4 acc[2][2][4][2];
#pragma unroll
    for (int a = 0; a < 2; ++a)
#pragma unroll
        for (int b = 0; b < 2; ++b)
#pragma unroll
            for (int m = 0; m < 4; ++m)
#pragma unroll
                for (int n = 0; n < 2; ++n) acc[a][b][m][n] = (f32x4){0.f, 0.f, 0.f, 0.f};
    bf16x8 At[4][2], B0[2][2], B1[2][2];
    const char* cA = cur.a; const char* cB = cur.b;
    if constexpr (SP2) {
        if constexpr (GATHER) { PG8_ROWS(vAc, cur.pm); asm volatile("s_waitcnt vmcnt(0)" ::: "memory"); }
        PG8_STAGE(PG8_SB(0, 0), cB, voffB); PG8_STAGE(PG8_SB(0, 1), cB + hstep, voffB); PG8_STAGE_A(PG8_SA(0, 0), cA, 0, vAc); PG8_STAGE_A(PG8_SA(0, 1), cA, 1, vAc);
        if (wr == 1) PG8_BAR;
        PG8_WAIT_V(2); PG8_BAR;
        PG8_STAGE(PG8_SB(1, 0), cB + kstep, voffB); PG8_STAGE_A(PG8_SA(1, 0), cA + kstep, 0, vAc); PG8_STAGE(PG8_SB(1, 1), cB + hstep + kstep, voffB);
        PG8_WAIT_V(6); PG8_BAR;
    } else {
        PG8_STAGE(PG8_SB(0, 0), cB, voffB); PG8_STAGE(PG8_SA(0, 0), cA, voffA); PG8_STAGE(PG8_SB(0, 1), cB + hstep, voffB); PG8_STAGE(PG8_SA(0, 1), cA + hstep, voffA);
        if (wr == 1) PG8_BAR;
        PG8_WAIT_V(4); PG8_BAR;
        PG8_STAGE(PG8_SB(1, 0), cB + kstep, voffB); PG8_STAGE(PG8_SA(1, 0), cA + kstep, voffA); PG8_STAGE(PG8_SB(1, 1), cB + hstep + kstep, voffB);
        PG8_WAIT_V(6); PG8_BAR;
    }
    for (;;) {
        const bool has_next = S.next(ui + 1, nxt);
        const char* nA = has_next ? nxt.a : cA; const char* nB = has_next ? nxt.b : cB;
        if constexpr (GATHER) { if (ui == 0) { if (has_next) PG8_ROWS(vAn, nxt.pm); else { _Pragma("unroll") for (int h_ = 0; h_ < 2; ++h_) _Pragma("unroll") for (int i_ = 0; i_ < 2; ++i_) vAn[h_][i_] = vAc[h_][i_]; } } }
        for (int t = 0; t < nt; t += 2) {
            const bool last = (t == nt - 2);
            const char* a1 = cA + (size_t)(t + 1) * kstep;
            const char* a2 = last ? nA : cA + (size_t)(t + 2) * kstep; const char* b2 = last ? nB : cB + (size_t)(t + 2) * kstep;
            const char* a3 = a2 + kstep; const char* b3 = b2 + kstep;
            if constexpr (SP2) {
            unsigned o2[2][2];
            if constexpr (GATHER) { _Pragma("unroll") for (int h_ = 0; h_ < 2; ++h_) _Pragma("unroll") for (int i_ = 0; i_ < 2; ++i_) o2[h_][i_] = last ? vAn[h_][i_] : vAc[h_][i_]; }
            PG8_LDB(B0, 0, 0); PG8_LDB(B1, 0, 1); PG8_SCHED; PG8_LDA(At, 0, 0); PG8_STAGE_A(PG8_SA(1, 1), a1, 1, vAc);
            PG8_WAIT_V(8); PG8_WAIT_L(0); PG8_BAR; PG8_MMA(0, 0, At, B0); PG8_MMA(0, 1, At, B1); PG8_BAR; PG8_SCHED;
            PG8_LDA(At, 0, 1); PG8_STAGE(PG8_SB(0, 0), b2, voffB); PG8_STAGE(PG8_SB(0, 1), b2 + hstep, voffB); PG8_STAGE_A(PG8_SA(0, 0), a2, 0, o2);
            PG8_WAIT_V(8); PG8_WAIT_L(0); PG8_BAR; PG8_MMA(1, 0, At, B0); PG8_MMA(1, 1, At, B1); PG8_BAR; PG8_SCHED;
            PG8_LDB(B0, 1, 0); PG8_LDB(B1, 1, 1); PG8_SCHED; PG8_LDA(At, 1, 0); PG8_STAGE_A(PG8_SA(0, 1), a2, 1, o2);
            PG8_WAIT_V(8); PG8_WAIT_L(0); PG8_BAR; PG8_MMA(0, 0, At, B0); PG8_MMA(0, 1, At, B1); PG8_BAR; PG8_SCHED;
            PG8_LDA(At, 1, 1); PG8_STAGE(PG8_SB(1, 0), b3, voffB); PG8_STAGE(PG8_SB(1, 1), b3 + hstep, voffB); PG8_STAGE_A(PG8_SA(1, 0), a3, 0, o2);
            PG8_WAIT_V(8); PG8_WAIT_L(0); PG8_BAR; PG8_MMA(1, 0, At, B0); PG8_MMA(1, 1, At, B1); PG8_BAR; PG8_SCHED;
            } else {
            PG8_LDB(B0, 0, 0); PG8_SCHED; PG8_LDA(At, 0, 0); PG8_STAGE(PG8_SA(1, 1), a1 + hstep, voffA);
            PG8_WAIT_L(8); PG8_BAR; PG8_WAIT_L(0); PG8_MMA(0, 0, At, B0); PG8_BAR; PG8_SCHED;
            PG8_LDB(B1, 0, 1); PG8_STAGE(PG8_SB(0, 0), b2, voffB);
            PG8_BAR; PG8_WAIT_L(0); PG8_MMA(0, 1, At, B1); PG8_BAR;
            PG8_LDA(At, 0, 1); PG8_STAGE(PG8_SA(0, 0), a2, voffA);
            PG8_BAR; PG8_WAIT_L(0); PG8_MMA(1, 0, At, B0); PG8_BAR; PG8_SCHED;
            PG8_STAGE(PG8_SB(0, 1), b2 + hstep, voffB);
            PG8_WAIT_V(6); PG8_BAR; PG8_MMA(1, 1, At, B1); PG8_BAR;
            PG8_LDB(B0, 1, 0); PG8_SCHED; PG8_LDA(At, 1, 0); PG8_STAGE(PG8_SA(0, 1), a2 + hstep, voffA);
            PG8_WAIT_L(8); PG8_BAR; PG8_WAIT_L(0); PG8_MMA(0, 0, At, B0); PG8_BAR; PG8_SCHED;
            PG8_LDB(B1, 1, 1); PG8_STAGE(PG8_SB(1, 0), b3, voffB);
            PG8_BAR; PG8_WAIT_L(0); PG8_MMA(0, 1, At, B1); PG8_BAR;
            PG8_LDA(At, 1, 1); PG8_STAGE(PG8_SA(1, 0), a3, voffA);
            PG8_BAR; PG8_WAIT_L(0); PG8_MMA(1, 0, At, B0); PG8_BAR; PG8_SCHED;
            PG8_STAGE(PG8_SB(1, 1), b3 + hstep, voffB);
            PG8_WAIT_V(6); PG8_BAR; PG8_MMA(1, 1, At, B1); PG8_BAR;
            }
        }
        if constexpr (ALIGN_EPI) { if (wr == 0) PG8_BAR; }
        E(acc, cur, wr, wc, fr, fq);
        if (!has_next) break;
#pragma unroll
        for (int a = 0; a < 2; ++a)
#pragma unroll
            for (int b = 0; b < 2; ++b)
#pragma unroll
                for (int m = 0; m < 4; ++m)
#pragma unroll
                    for (int n = 0; n < 2; ++n) acc[a][b][m][n] = (f32x4){0.f, 0.f, 0.f, 0.f};
        if constexpr (GATHER) { _Pragma("unroll") for (int h_ = 0; h_ < 2; ++h_) _Pragma("unroll") for (int i_ = 0; i_ < 2; ++i_) vAc[h_][i_] = vAn[h_][i_];
            Unit nn; if (S.next(ui + 2, nn)) PG8_ROWS(vAn, nn.pm); }
        cur = nxt; cA = nA; cB = nB; ++ui;
        if constexpr (ALIGN_EPI) { if (wr == 1) PG8_BAR; }
    }
    PG8_WAIT_V(0);
    if constexpr (!ALIGN_EPI) { if (wr == 0) PG8_BAR; }
    PG8_BAR;
#undef PG8_ROWS
#undef PG8_STAGE_A
#undef PG8_SA
#undef PG8_SB
#undef PG8_STAGE
#undef PG8_LDA
#undef PG8_LDB
#undef PG8_MMA
#undef PG8_WAIT_V
#undef PG8_WAIT_L
#undef PG8_BAR
#undef PG8_SCHED
}
}

struct Args { const float* in[23]; float* out; unsigned char* ws; int ph_lo, ph_hi; };
struct Ctx {
    LAS unsigned char* lds; int tid, lane, wave, G, bid;
    const float* const* in; float* out; unsigned char* ws;
};
__device__ __forceinline__ Ctx fresh(const Ctx& F) {
    Ctx R = F; unsigned z0 = 0u; asm volatile("" : "+s"(z0)); int ln = (int)__builtin_amdgcn_mbcnt_hi(~0u, __builtin_amdgcn_mbcnt_lo(~0u, z0)); asm volatile("" : "+v"(ln));
    int wv = F.wave; asm volatile("" : "+s"(wv)); R.wave = wv; R.lane = ln; R.tid = wv * 64 + ln;
    unsigned char* w = F.ws; asm volatile("" : "+s"(w)); R.ws = as_global(w); R.out = as_global(F.out);
    int bd = F.bid, gg = F.G; asm volatile("" : "+s"(bd)); asm volatile("" : "+s"(gg)); R.bid = bd; R.G = gg;
    return R;
}
enum { I_X = 0, I_MEM, I_LN0G, I_LN0B, I_WIN, I_CONVQKV, I_CONVMIX, I_ALOG, I_DTB, I_GDNNORM, I_WMEMKV, I_WBR, I_WO, I_LN1G, I_LN1B, I_WR, I_BR, I_WGU, I_BGU, I_WD, I_BD, I_LN2G, I_LN2B };

__device__ __forceinline__ void transpose_item(const float* src, int ld, bf16* dst, int ldk, LAS float* scr, int lane) {
#pragma unroll 8
    for (int i = 0; i < 32; ++i) { const int kk = 2 * i + (lane >> 5); scr[kk * 33 + (lane & 31)] = src[(size_t)kk * ld + (lane & 31)]; }
    LDS_WAIT();
    const int c = lane & 7;
#pragma unroll
    for (int j = 0; j < 4; ++j) { const int n = (lane >> 3) + 8 * j; const LAS float* s = scr + (8 * c) * 33 + n;
        v4u o; o.x = cvt_pk_bf16(s[0 * 33], s[1 * 33]); o.y = cvt_pk_bf16(s[2 * 33], s[3 * 33]); o.z = cvt_pk_bf16(s[4 * 33], s[5 * 33]); o.w = cvt_pk_bf16(s[6 * 33], s[7 * 33]);
        *(v4u*)(dst + (size_t)n * ldk + 8 * c) = o; }
    LDS_WAIT();
}
__device__ __forceinline__ void ln_apply(f32x4 (&v)[4], const float* g, const float* b, int lane) {
    float s = 0.f;
#pragma unroll
    for (int j = 0; j < 4; ++j) s += (v[j][0] + v[j][1]) + (v[j][2] + v[j][3]);
    const float mean = wave_sum(s) * (1.f / D); float s2 = 0.f;
#pragma unroll
    for (int j = 0; j < 4; ++j) { v[j] = v[j] - mean; s2 += (v[j][0] * v[j][0] + v[j][1] * v[j][1]) + (v[j][2] * v[j][2] + v[j][3] * v[j][3]); }
    const float rstd = 1.f / sqrtf(wave_sum(s2) * (1.f / D) + LN_EPS);
#pragma unroll
    for (int j = 0; j < 4; ++j) { const f32x4 gg = *(const f32x4*)(g + 4 * lane + 256 * j), bb = *(const f32x4*)(b + 4 * lane + 256 * j); v[j] = v[j] * rstd * gg + bb; }
}
__device__ __forceinline__ void load_row_bf16(const bf16* p, f32x4 (&v)[4], int lane) {
#pragma unroll
    for (int j = 0; j < 4; ++j) { const v2u w = *(const v2u*)(p + 4 * lane + 256 * j); v[j] = (f32x4){bf_lo(w.x), bf_hi(w.x), bf_lo(w.y), bf_hi(w.y)}; }
}
__device__ __forceinline__ void store_row_f32(float* p, const f32x4 (&v)[4], int lane) {
#pragma unroll
    for (int j = 0; j < 4; ++j) *(f32x4*)(p + 4 * lane + 256 * j) = v[j];
}
__device__ __forceinline__ void store_row_bf16(bf16* p, const f32x4 (&v)[4], int lane) {
#pragma unroll
    for (int j = 0; j < 4; ++j) { v2u w; w.x = cvt_pk_bf16(v[j][0], v[j][1]); w.y = cvt_pk_bf16(v[j][2], v[j][3]); *(v2u*)(p + 4 * lane + 256 * j) = w; }
}
__device__ __forceinline__ void small_proj(const f32x4 (&v)[4], const LAS float* ws_s, float* ab_row, int lane) {
    float keep = 0.f;
#pragma unroll
    for (int c = 0; c < 8; ++c) { float p = 0.f;
#pragma unroll
        for (int j = 0; j < 4; ++j) { const f32x4 w = *(const LAS f32x4*)(ws_s + c * 1024 + 4 * lane + 256 * j); p += (v[j][0] * w[0] + v[j][1] * w[1]) + (v[j][2] * w[2] + v[j][3] * w[3]); }
        p = wave_sum(p); keep = (lane == c) ? p : keep; }
    if (lane < 8) ab_row[lane] = keep;
}
__device__ __forceinline__ void load_small_w(Ctx& F, int l, LAS float* ws_s) {
    const float* w = as_global(F.in[I_WIN]) + (size_t)l * D * NPROJ_SRC + 1536;
    for (int i = F.tid; i < 8 * 1024; i += 512) { const int k = i >> 3, c = i & 7; ws_s[c * 1024 + k] = w[(size_t)k * NPROJ_SRC + c]; }
}

constexpr int N_IN = 2 * 3584, N_BR = 6 * 256, N_O = 2 * 512, N_KV = 2 * 512, N_GU = 64 * 1024, N_D = 64 * 512;
constexpr int NITEMS = N_IN + N_BR + N_O + N_KV + N_GU + N_D;
#ifndef NDEF_PER_WAVE
#define NDEF_PER_WAVE 0
#endif
constexpr int NDEF = (256 - 32) * 8 * NDEF_PER_WAVE;
static_assert(NDEF <= N_GU + N_D, "deferred items must be MoE weights");
__device__ __forceinline__ void convert_items(Ctx& F, int first, int step, int begin, int end) {
    LAS float* scr = (LAS float*)(F.lds + F.wave * 8448);
    bf16* WinT = (bf16*)(F.ws + WS_WIN); bf16* WbrT = (bf16*)(F.ws + WS_WBR); bf16* WoT = (bf16*)(F.ws + WS_WO); bf16* WkvT = (bf16*)(F.ws + WS_WKV);
    bf16* WguT = (bf16*)(F.ws + WS_WGU); bf16* WdT = (bf16*)(F.ws + WS_WD);
    for (int it = begin + first; it < end; it += step) {
        int r = it;
        if (r < N_IN) { const int l = r / 3584, q = r % 3584, kb = q / 224, nb = q % 224, k0 = 64 * kb, n0 = 32 * nb, ns = n0 + (n0 >= 1536 ? 8 : 0);
            transpose_item(as_global(F.in[I_WIN]) + (size_t)l * D * NPROJ_SRC + (size_t)k0 * NPROJ_SRC + ns, NPROJ_SRC, WinT + (size_t)l * NPROJ * D + (size_t)n0 * D + k0, D, scr, F.lane); continue; }
        r -= N_IN;
        if (r < N_BR) { const int m = r / 256, q = r % 256, kb = q / 32, nb = q % 32, k0 = 64 * kb, n0 = 32 * nb;
            transpose_item(as_global(F.in[I_WBR]) + (size_t)m * 512 * D + (size_t)k0 * D + n0, D, WbrT + (size_t)m * D * 512 + (size_t)n0 * 512 + k0, 512, scr, F.lane); continue; }
        r -= N_BR;
        if (r < N_O) { const int l = r / 512, q = r % 512, kb = q / 32, nb = q % 32, k0 = 64 * kb, n0 = 32 * nb;
            transpose_item(as_global(F.in[I_WO]) + (size_t)l * D * D + (size_t)k0 * D + n0, D, WoT + (size_t)l * D * D + (size_t)n0 * D + k0, D, scr, F.lane); continue; }
        r -= N_O;
        if (r < N_KV) { const int l = r / 512, q = r % 512, kb = q / 32, nb = q % 32, k0 = 64 * kb, n0 = 32 * nb;
            transpose_item(as_global(F.in[I_WMEMKV]) + (size_t)l * D * D + (size_t)k0 * D + n0, D, WkvT + (size_t)l * D * D + (size_t)n0 * D + k0, D, scr, F.lane); continue; }
        r -= N_KV;
        if (r < N_GU) { const int m = r / 1024, q = r % 1024, kb = q / 64, nb = q % 64, k0 = 64 * kb, n0 = 32 * nb, jj = n0 / 256, r0 = n0 % 256;
            const int ns = (r0 < 128) ? (128 * jj + r0) : (1024 + 128 * jj + r0 - 128);
            transpose_item(as_global(F.in[I_WGU]) + (size_t)m * D * 2048 + (size_t)k0 * 2048 + ns, 2048, WguT + (size_t)m * 2048 * D + (size_t)n0 * D + k0, D, scr, F.lane); continue; }
        r -= N_GU;
        { const int m = r / 512, q = r % 512, kb = q / 32, nb = q % 32, k0 = 64 * kb, n0 = 32 * nb;
            transpose_item(as_global(F.in[I_WD]) + (size_t)m * D * D + (size_t)k0 * D + n0, D, WdT + (size_t)m * D * D + (size_t)n0 * D + k0, D, scr, F.lane); }
    }
}
__device__ __forceinline__ void convert_deferred(Ctx& F, int first, int step) {
    LAS float* scr = (LAS float*)(F.lds + F.wave * 8448);
    bf16* WguT = (bf16*)(F.ws + WS_WGU); bf16* WdT = (bf16*)(F.ws + WS_WD);
    for (int it = NITEMS - NDEF + first; it < NITEMS; it += step) {
        int r = it - (N_IN + N_BR + N_O + N_KV);
        if (r < N_GU) { const int m = r / 1024, q = r % 1024, kb = q / 64, nb = q % 64, k0 = 64 * kb, n0 = 32 * nb, jj = n0 / 256, r0 = n0 % 256;
            const int ns = (r0 < 128) ? (128 * jj + r0) : (1024 + 128 * jj + r0 - 128);
            transpose_item(as_global(F.in[I_WGU]) + (size_t)m * D * 2048 + (size_t)k0 * 2048 + ns, 2048, WguT + (size_t)m * 2048 * D + (size_t)n0 * D + k0, D, scr, F.lane); continue; }
        r -= N_GU;
        { const int m = r / 512, q = r % 512, kb = q / 32, nb = q % 32, k0 = 64 * kb, n0 = 32 * nb;
            transpose_item(as_global(F.in[I_WD]) + (size_t)m * D * D + (size_t)k0 * D + n0, D, WdT + (size_t)m * D * D + (size_t)n0 * D + k0, D, scr, F.lane); }
    }
}

__device__ __forceinline__ void phase_prologue(Ctx& F) {
    LAS float* ws_s = (LAS float*)(F.lds + 69632);
    const int gw = F.bid * 8 + F.wave, NGW = F.G * 8;
    convert_items(F, gw, NGW, 0, NITEMS - NDEF);
    { const f32x4* src = (const f32x4*)as_global(F.in[I_MEM]); v2u* dst = (v2u*)(F.ws + WS_MEMB);
      for (int i = F.bid * 512 + F.tid; i < NB * NMEM * D / 4; i += F.G * 512) { const f32x4 x = src[i]; v2u w; w.x = cvt_pk_bf16(x[0], x[1]); w.y = cvt_pk_bf16(x[2], x[3]); dst[i] = w; } }
    load_small_w(F, 0, ws_s);
    __syncthreads();
    bf16* hb = (bf16*)(F.ws + WS_HB); float* ab = (float*)(F.ws + WS_AB);
    for (int m = gw; m < NTOK; m += NGW) {
        f32x4 v[4]; const float* xr = as_global(F.in[I_X]) + (size_t)m * D;
#pragma unroll
        for (int j = 0; j < 4; ++j) v[j] = *(const f32x4*)(xr + 4 * F.lane + 256 * j);
        ln_apply(v, as_global(F.in[I_LN0G]), as_global(F.in[I_LN0B]), F.lane);
        store_row_bf16(hb + (size_t)m * D, v, F.lane);
        small_proj(v, ws_s, ab + (size_t)m * 8, F.lane);
    }
}

__device__ __forceinline__ void unpack8(const v4u x, float (&o)[8]) { o[0] = bf_lo(x.x); o[1] = bf_hi(x.x); o[2] = bf_lo(x.y); o[3] = bf_hi(x.y); o[4] = bf_lo(x.z); o[5] = bf_hi(x.z); o[6] = bf_lo(x.w); o[7] = bf_hi(x.w); }
__device__ __forceinline__ void conv4_silu(const v4u x0, const v4u x1, const v4u x2, const v4u x3, const LAS float* w  , float (&o)[8]) {
    float a[8], b[8], c[8], d[8]; unpack8(x0, a); unpack8(x1, b); unpack8(x2, c); unpack8(x3, d);
    const f32x4 w0l = *(const LAS f32x4*)(w), w0h = *(const LAS f32x4*)(w + 4), w1l = *(const LAS f32x4*)(w + 1536), w1h = *(const LAS f32x4*)(w + 1540);
    const f32x4 w2l = *(const LAS f32x4*)(w + 3072), w2h = *(const LAS f32x4*)(w + 3076), w3l = *(const LAS f32x4*)(w + 4608), w3h = *(const LAS f32x4*)(w + 4612);
#pragma unroll
    for (int i = 0; i < 8; ++i) { const float w0 = i < 4 ? w0l[i & 3] : w0h[i & 3], w1 = i < 4 ? w1l[i & 3] : w1h[i & 3], w2 = i < 4 ? w2l[i & 3] : w2h[i & 3], w3 = i < 4 ? w3l[i & 3] : w3h[i & 3];
        const float s = (w0 * a[i] + w1 * b[i]) + (w2 * c[i] + w3 * d[i]); o[i] = siluf_(s); }
}
__device__ __forceinline__ void phase_prep(Ctx& F, int l) {
    const bf16* proj = (const bf16*)(F.ws + WS_R1);
    LAS float* cw = (LAS float*)F.lds;
    LAS float* mw = (LAS float*)(F.lds + 4 * 1536 * 4);
    for (int i = F.tid; i < 4 * 1536; i += 512) cw[i] = as_global(F.in[I_CONVQKV])[(size_t)l * 4 * 1536 + i];
    for (int i = F.tid; i < 3 * 512; i += 512) mw[i] = as_global(F.in[I_CONVMIX])[(size_t)l * 3 * 512 + i];
    __syncthreads();
    const int lane = F.lane, c8 = lane * 8, hh = lane >> 4;
    bf16* qnb = (bf16*)(F.ws + WS_QN); bf16* knb = (bf16*)(F.ws + WS_KN); bf16* vvb = (bf16*)(F.ws + WS_VV); float* gs = (float*)(F.ws + WS_GS);
    const float* ab = (const float*)(F.ws + WS_AB); bf16* yb = (bf16*)(F.ws + WS_YB);
    const float Ah = __expf(as_global(F.in[I_ALOG])[l * 4 + hh]), dtb = as_global(F.in[I_DTB])[l * 4 + hh];
    const int gw = F.bid * 8 + F.wave, NGW = F.G * 8;
    for (int t0 = gw * 16; t0 < NTOK; t0 += NGW * 16) {
        const bool first = (t0 % T) == 0;
        const v4u z4 = {0u, 0u, 0u, 0u};
        v4u q0, q1, q2, k0, k1, k2, v0, v1, v2; float p0[8], p1[8];
        if (first) { q0 = q1 = q2 = k0 = k1 = k2 = v0 = v1 = v2 = z4;
#pragma unroll
            for (int i = 0; i < 8; ++i) { p0[i] = 0.f; p1[i] = 0.f; } }
        else {
            const bf16* r3 = proj + (size_t)(t0 - 3) * NPROJ + c8; const bf16* r2 = r3 + NPROJ; const bf16* r1 = r2 + NPROJ;
            q0 = *(const v4u*)(r3 + C_Q); q1 = *(const v4u*)(r2 + C_Q); q2 = *(const v4u*)(r1 + C_Q);
            k0 = *(const v4u*)(r3 + C_K); k1 = *(const v4u*)(r2 + C_K); k2 = *(const v4u*)(r1 + C_K);
            v0 = *(const v4u*)(r3 + C_V); v1 = *(const v4u*)(r2 + C_V); v2 = *(const v4u*)(r1 + C_V);
            float a[8], b[8]; unpack8(*(const v4u*)(r2 + C_XC), a); unpack8(*(const v4u*)(r2 + C_GC), b);
#pragma unroll
            for (int i = 0; i < 8; ++i) p0[i] = a[i] * b[i];
            unpack8(*(const v4u*)(r1 + C_XC), a); unpack8(*(const v4u*)(r1 + C_GC), b);
#pragma unroll
            for (int i = 0; i < 8; ++i) p1[i] = a[i] * b[i];
        }
        v4u nq, nk, nv, nxc, ngc, ngb; float na = 0.f, nbt = 0.f;
        { const bf16* rn = proj + (size_t)t0 * NPROJ + c8; nq = *(const v4u*)(rn + C_Q); nk = *(const v4u*)(rn + C_K); nv = *(const v4u*)(rn + C_V); nxc = *(const v4u*)(rn + C_XC); ngc = *(const v4u*)(rn + C_GC); ngb = *(const v4u*)(rn + C_GB);
          if ((lane & 15) == 0) { na = ab[(size_t)t0 * 8 + hh]; nbt = ab[(size_t)t0 * 8 + 4 + hh]; } }
        for (int i16 = 0; i16 < 16; ++i16) {
            const int tok = t0 + i16;
            const v4u q3 = nq, k3 = nk, v3 = nv, xc3 = nxc, gc3 = ngc, gb3 = ngb; const float a_in = na, bt_in = nbt;
            if (i16 < 15) { const bf16* rn = proj + (size_t)(tok + 1) * NPROJ + c8; nq = *(const v4u*)(rn + C_Q); nk = *(const v4u*)(rn + C_K); nv = *(const v4u*)(rn + C_V); nxc = *(const v4u*)(rn + C_XC); ngc = *(const v4u*)(rn + C_GC); ngb = *(const v4u*)(rn + C_GB);
                if ((lane & 15) == 0) { na = ab[(size_t)(tok + 1) * 8 + hh]; nbt = ab[(size_t)(tok + 1) * 8 + 4 + hh]; } }
            float qo[8], ko[8], vo[8];
            conv4_silu(q0, q1, q2, q3, cw + C_Q + c8, qo); conv4_silu(k0, k1, k2, k3, cw + C_K + c8, ko); conv4_silu(v0, v1, v2, v3, cw + C_V + c8, vo);
            q0 = q1; q1 = q2; q2 = q3; k0 = k1; k1 = k2; k2 = k3; v0 = v1; v1 = v2; v2 = v3;
            float sq = 0.f, sk = 0.f;
#pragma unroll
            for (int i = 0; i < 8; ++i) { sq += qo[i] * qo[i]; sk += ko[i] * ko[i]; }
            sq = row16_sum(sq); sk = row16_sum(sk);
            const float rq = (1.f / sqrtf(sq + RMS_EPS)) * 0.08838834764831845f, rk = 1.f / sqrtf(sk + RMS_EPS);
#pragma unroll
            for (int i = 0; i < 8; ++i) { qo[i] *= rq; ko[i] *= rk; }
            { v4u w; w.x = cvt_pk_bf16(qo[0], qo[1]); w.y = cvt_pk_bf16(qo[2], qo[3]); w.z = cvt_pk_bf16(qo[4], qo[5]); w.w = cvt_pk_bf16(qo[6], qo[7]); *(v4u*)(qnb + (size_t)tok * 512 + c8) = w; }
            { v4u w; w.x = cvt_pk_bf16(ko[0], ko[1]); w.y = cvt_pk_bf16(ko[2], ko[3]); w.z = cvt_pk_bf16(ko[4], ko[5]); w.w = cvt_pk_bf16(ko[6], ko[7]); *(v4u*)(knb + (size_t)tok * 512 + c8) = w; }
            { v4u w; w.x = cvt_pk_bf16(vo[0], vo[1]); w.y = cvt_pk_bf16(vo[2], vo[3]); w.z = cvt_pk_bf16(vo[4], vo[5]); w.w = cvt_pk_bf16(vo[6], vo[7]); *(v4u*)(vvb + (size_t)tok * 512 + c8) = w; }
            if ((lane & 15) == 0) {
                const float a = a_in + dtb, bt = bt_in;
                const float sp = a > 20.f ? a : log1pf(expf(a));
                const float g = -Ah * sp;
                *(f32x4*)(gs + ((size_t)tok * 4 + hh) * 4) = (f32x4){g, 1.f / (1.f + expf(-bt)), 0.f, 0.f};
            }
            float xa[8], ga[8], gbv[8], p2[8]; unpack8(xc3, xa); unpack8(gc3, ga); unpack8(gb3, gbv);
            const f32x4 m0l = *(const LAS f32x4*)(mw + c8), m0h = *(const LAS f32x4*)(mw + c8 + 4), m1l = *(const LAS f32x4*)(mw + 512 + c8), m1h = *(const LAS f32x4*)(mw + 512 + c8 + 4);
            const f32x4 m2l = *(const LAS f32x4*)(mw + 1024 + c8), m2h = *(const LAS f32x4*)(mw + 1024 + c8 + 4);
            float yo[8];
#pragma unroll
            for (int i = 0; i < 8; ++i) { p2[i] = xa[i] * ga[i];
                const float w0 = i < 4 ? m0l[i & 3] : m0h[i & 3], w1 = i < 4 ? m1l[i & 3] : m1h[i & 3], w2 = i < 4 ? m2l[i & 3] : m2h[i & 3];
                yo[i] = gbv[i] * ((w0 * p0[i] + w1 * p1[i]) + w2 * p2[i]); p0[i] = p1[i]; p1[i] = p2[i]; }
            v4u w; w.x = cvt_pk_bf16(yo[0], yo[1]); w.y = cvt_pk_bf16(yo[2], yo[3]); w.z = cvt_pk_bf16(yo[4], yo[5]); w.w = cvt_pk_bf16(yo[6], yo[7]);
            *(v4u*)(yb + (size_t)tok * 512 + c8) = w;
        }
    }
}

#define MFMA16(a, b, c) __builtin_amdgcn_mfma_f32_16x16x32_bf16(a, b, c, 0, 0, 0)
__device__ __forceinline__ bf16x8 pack8(const f32x4 a, const f32x4 b) { v4u w; w.x = cvt_pk_nat(a[0], a[1]); w.y = cvt_pk_nat(a[2], a[3]); w.z = cvt_pk_nat(b[0], b[1]); w.w = cvt_pk_nat(b[2], b[3]); return __builtin_bit_cast(bf16x8, w); }
__device__ __forceinline__ v2u pack4(const f32x4 a) { v2u w; w.x = cvt_pk_nat(a[0], a[1]); w.y = cvt_pk_nat(a[2], a[3]); return w; }
constexpr int GA_PITCH = 72, GA_WAVE_BYTES = 19456;
constexpr int NCHUNK = NB * 4 * (T / 64);

__device__ __forceinline__ void gdn_kend_products(const LAS bf16* XA, const LAS bf16* XB, const LAS float* sE, const v4u* UPK, const v4u* WPK, int ci, int lane, v2u* BC, v4u* ATF) {
    const int fr = lane & 15, fq = lane >> 4;
    bf16x8 ke[8][2];
#pragma unroll
    for (int mt = 0; mt < 8; ++mt)
#pragma unroll
        for (int s = 0; s < 2; ++s) { const LAS bf16* p = (mt < 4 ? XA : XB) + (16 * (mt & 3) + fr) * GA_PITCH + 32 * s + 4 * fq;
            const v2u lo = *(const LAS v2u*)p, hi = *(const LAS v2u*)(p + 16); const f32x4 e0 = *(const LAS f32x4*)(sE + 32 * s + 4 * fq), e1 = *(const LAS f32x4*)(sE + 32 * s + 16 + 4 * fq);
            ke[mt][s] = pack8((f32x4){bf_lo(lo.x) * e0[0], bf_hi(lo.x) * e0[1], bf_lo(lo.y) * e0[2], bf_hi(lo.y) * e0[3]}, (f32x4){bf_lo(hi.x) * e1[0], bf_hi(hi.x) * e1[1], bf_lo(hi.y) * e1[2], bf_hi(hi.y) * e1[3]}); }
#pragma unroll 4
    for (int ne = 0; ne < 8; ++ne) {
        const bf16x8 u0 = __builtin_bit_cast(bf16x8, (UPK + ((size_t)ci * 16 + 2 * ne) * 64)[(unsigned)lane]), u1 = __builtin_bit_cast(bf16x8, (UPK + ((size_t)ci * 16 + 2 * ne + 1) * 64)[(unsigned)lane]);
#pragma unroll
        for (int mt = 0; mt < 8; ++mt) { f32x4 acc = (f32x4){0.f, 0.f, 0.f, 0.f}; acc = MFMA16(ke[mt][0], u0, acc); acc = MFMA16(ke[mt][1], u1, acc);
            (BC + ((size_t)(ci * 8 + ne) * 8 + mt) * 64)[(unsigned)lane] = pack4(acc); } }
#pragma unroll 2
    for (int sp = 0; sp < 4; ++sp) {
        const bf16x8 w00 = __builtin_bit_cast(bf16x8, (WPK + ((size_t)ci * 16 + 4 * sp) * 64)[(unsigned)lane]), w01 = __builtin_bit_cast(bf16x8, (WPK + ((size_t)ci * 16 + 4 * sp + 1) * 64)[(unsigned)lane]);
        const bf16x8 w10 = __builtin_bit_cast(bf16x8, (WPK + ((size_t)ci * 16 + 4 * sp + 2) * 64)[(unsigned)lane]), w11 = __builtin_bit_cast(bf16x8, (WPK + ((size_t)ci * 16 + 4 * sp + 3) * 64)[(unsigned)lane]);
#pragma unroll
        for (int mt = 0; mt < 8; ++mt) { f32x4 d0 = (f32x4){0.f, 0.f, 0.f, 0.f}, d1 = (f32x4){0.f, 0.f, 0.f, 0.f};
            d0 = MFMA16(w00, ke[mt][0], d0); d0 = MFMA16(w01, ke[mt][1], d0); d1 = MFMA16(w10, ke[mt][0], d1); d1 = MFMA16(w11, ke[mt][1], d1);
            (ATF + ((size_t)(ci * 8 + mt) * 4 + sp) * 64)[(unsigned)lane] = __builtin_bit_cast(v4u, pack8(-d0, -d1)); } }
}
__device__ __forceinline__ void xb_store_pair(LAS bf16* XB, int r0, unsigned w, int lane) {
    const unsigned send = (lane & 1) ? (w & 0xffffu) : (w >> 16);
    const unsigned recv = (unsigned)__builtin_amdgcn_update_dpp(0, (int)send, 0xB1, 0xF, 0xF, true);
    const unsigned outw = (lane & 1) ? (recv | (w & 0xffff0000u)) : ((w & 0xffffu) | (recv << 16));
    *(LAS unsigned*)(XB + (r0 + (lane & 1)) * GA_PITCH + (lane & ~1)) = outw;
}
__device__ __forceinline__ void gdn_fill_kT(const bf16* KN, LAS bf16* XB, int tok0, int h, int half, int lane) {
    const bf16* kbase = KN + (size_t)tok0 * 512 + h * 128 + half * 64; const unsigned lo = (unsigned)lane * 512u;
    asm volatile("s_waitcnt lgkmcnt(0)" ::: "memory");
#pragma unroll
    for (int c = 0; c < 8; ++c) { const v4u x = *(const v4u*)((kbase + 8 * c) + lo);
        xb_store_pair(XB, 8 * c, x.x, lane); xb_store_pair(XB, 8 * c + 2, x.y, lane); xb_store_pair(XB, 8 * c + 4, x.z, lane); xb_store_pair(XB, 8 * c + 6, x.w, lane); }
    asm volatile("s_waitcnt lgkmcnt(0)" ::: "memory");
}
__device__ __forceinline__ void phase_gdn_a(Ctx& F) {
    const int lane = F.lane, fr = lane & 15, fq = lane >> 4;
    LAS unsigned char* wl = F.lds + F.wave * GA_WAVE_BYTES;
    LAS bf16* Ts = (LAS bf16*)wl; LAS bf16* XB = (LAS bf16*)(wl + 9216);
    LAS float* gcv = (LAS float*)(wl + 18432); LAS float* sKp = gcv + 64; LAS float* sE = gcv + 128; LAS float* bev = gcv + 192;
    const bf16* KN = (const bf16*)(F.ws + WS_KN); const bf16* QN = (const bf16*)(F.ws + WS_QN); const bf16* VV = (const bf16*)(F.ws + WS_VV); const float* gs = (const float*)(F.ws + WS_GS);
    v2u* BC = (v2u*)(F.ws + WS_BC); v4u* ATF = (v4u*)(F.ws + WS_ATF); v4u* QTF = (v4u*)(F.ws + WS_QTF); v2u* OL = (v2u*)(F.ws + WS_OL); float* CD = (float*)(F.ws + WS_CD);
    v4u* UPK = (v4u*)(F.ws + WS_UPK); v4u* WPK = (v4u*)(F.ws + WS_WPK);
    { const int b = F.bid >> 7, h = F.wave & 3, n = 2 * (F.bid & 127) + (F.wave >> 2);
        const int bh = b * 4 + h, ci = bh * 256 + n, tok0 = b * T + n * 64;
        const f32x2 gb = *(const f32x2*)((gs + ((size_t)tok0 * 4 + h) * 4) + (unsigned)lane * 16u);
        float gc = gb.x; const float be = gb.y;
#pragma unroll
        for (int off = 1; off < 64; off <<= 1) { const float t = bperm(gc, (lane - off) & 63); gc += (lane >= off) ? t : 0.f; }
        const float gl = rdlane(gc, 63);
        gcv[lane] = gc; sKp[lane] = be * __expf(gc); sE[lane] = __expf(gl - gc); bev[lane] = be;
        if (lane == 0) CD[ci] = __expf(gl);
        asm volatile("s_waitcnt lgkmcnt(0)" ::: "memory");
        {
            bf16x8 kf[4][4];
#pragma unroll
            for (int t = 0; t < 4; ++t)
#pragma unroll
                for (int s = 0; s < 4; ++s) kf[t][s] = *(const bf16x8*)((KN + (size_t)(tok0 + 16 * t) * 512 + h * 128 + 32 * s) + ((unsigned)fr * 512u + 8u * (unsigned)fq));
            float gcj[4];
#pragma unroll
            for (int t = 0; t < 4; ++t) gcj[t] = gcv[16 * t + fr];
            LAS float* Nc = (LAS float*)wl;
#pragma unroll
            for (int t = 0; t < 4; ++t) { const f32x4 gci = *(const LAS f32x4*)(gcv + 16 * t + 4 * fq), bei = *(const LAS f32x4*)(bev + 16 * t + 4 * fq);
#pragma unroll
                for (int u = 0; u <= t; ++u) {
                    f32x4 acc = (f32x4){0.f, 0.f, 0.f, 0.f};
#pragma unroll
                    for (int s = 0; s < 4; ++s) acc = MFMA16(kf[t][s], kf[u][s], acc);
                    f32x4 nv;
#pragma unroll
                    for (int r = 0; r < 4; ++r) { const int i = 16 * t + 4 * fq + r, j = 16 * u + fr; const float v = bei[r] * acc[r] * __expf(fminf(gci[r] - gcj[u], 0.f)); nv[r] = (i > j) ? v : 0.f; }
                    *(LAS f32x4*)(Nc + (16 * u + fr) * 64 + 16 * t + 4 * fq) = nv;
                } }
        }
        asm volatile("s_waitcnt lgkmcnt(0)" ::: "memory");
        {
            float x[64];
#pragma unroll
            for (int c = 63; c >= 0; --c) { float a = (lane == c) ? 1.f : 0.f, a1 = 0.f, a2 = 0.f, a3 = 0.f;
#pragma unroll
                for (int k4 = ((c + 1) & ~3); k4 < 64; k4 += 4) { const f32x4 nv = *(const LAS f32x4*)((const LAS float*)wl + c * 64 + k4);
                    if (k4 + 0 > c) a -= x[k4 + 0] * nv[0]; if (k4 + 1 > c) a1 -= x[k4 + 1] * nv[1]; if (k4 + 2 > c) a2 -= x[k4 + 2] * nv[2]; if (k4 + 3 > c) a3 -= x[k4 + 3] * nv[3]; }
                a = (a + a1) + (a2 + a3);
                asm volatile("" : "+v"(a) :: "memory");
                x[c] = a; }
#pragma unroll
            for (int q8 = 0; q8 < 8; ++q8) { v4u w; w.x = cvt_pk_nat(x[8 * q8], x[8 * q8 + 1]); w.y = cvt_pk_nat(x[8 * q8 + 2], x[8 * q8 + 3]); w.z = cvt_pk_nat(x[8 * q8 + 4], x[8 * q8 + 5]); w.w = cvt_pk_nat(x[8 * q8 + 6], x[8 * q8 + 7]);
                *(LAS v4u*)(Ts + lane * GA_PITCH + 8 * q8) = w; }
        }
        asm volatile("s_waitcnt lgkmcnt(0)" ::: "memory");
        {
            bf16x8 tsf[4][2];
#pragma unroll
            for (int t = 0; t < 4; ++t)
#pragma unroll
                for (int s = 0; s < 2; ++s) tsf[t][s] = *(const LAS bf16x8*)(Ts + (16 * t + fr) * GA_PITCH + 32 * s + 8 * fq);
#pragma unroll 1
            for (int half = 0; half < 2; ++half) {
                const bf16* vbase = VV + (size_t)tok0 * 512 + h * 128 + half * 64; const unsigned vlo = (unsigned)lane * 512u;
#pragma unroll
                for (int c = 0; c < 8; ++c) { float f[8]; unpack8(*(const v4u*)((vbase + 8 * c) + vlo), f);
#pragma unroll
                    for (int i2 = 0; i2 < 4; ++i2) xb_store_pair(XB, 8 * c + 2 * i2, cvt_pk_nat(f[2 * i2] * be, f[2 * i2 + 1] * be), lane); }
                asm volatile("s_waitcnt lgkmcnt(0)" ::: "memory");
#pragma unroll
                for (int nl = 0; nl < 4; ++nl) { const bf16x8 b0 = *(const LAS bf16x8*)(XB + (16 * nl + fr) * GA_PITCH + 8 * fq), b1 = *(const LAS bf16x8*)(XB + (16 * nl + fr) * GA_PITCH + 32 + 8 * fq);
                    f32x4 ut[4];
#pragma unroll
                    for (int t = 0; t < 4; ++t) { f32x4 acc = (f32x4){0.f, 0.f, 0.f, 0.f}; acc = MFMA16(tsf[t][0], b0, acc); if (t >= 2) acc = MFMA16(tsf[t][1], b1, acc); ut[t] = acc; }
                    (UPK + ((size_t)ci * 16 + 2 * (half * 4 + nl)) * 64)[(unsigned)lane] = __builtin_bit_cast(v4u, pack8(ut[0], ut[1]));
                    (UPK + ((size_t)ci * 16 + 2 * (half * 4 + nl) + 1) * 64)[(unsigned)lane] = __builtin_bit_cast(v4u, pack8(ut[2], ut[3])); }
                asm volatile("s_waitcnt lgkmcnt(0)" ::: "memory");
            }
#pragma unroll 1
            for (int half = 0; half < 2; ++half) {
                gdn_fill_kT(KN, XB, tok0, h, half, lane);
#pragma unroll
                for (int nl = 0; nl < 4; ++nl) { bf16x8 kp[2];
#pragma unroll
                    for (int s = 0; s < 2; ++s) { const v4u raw = *(const LAS v4u*)(XB + (16 * nl + fr) * GA_PITCH + 32 * s + 8 * fq); const f32x4 c0 = *(const LAS f32x4*)(sKp + 32 * s + 8 * fq), c1 = *(const LAS f32x4*)(sKp + 32 * s + 8 * fq + 4);
                        kp[s] = pack8((f32x4){bf_lo(raw.x) * c0[0], bf_hi(raw.x) * c0[1], bf_lo(raw.y) * c0[2], bf_hi(raw.y) * c0[3]}, (f32x4){bf_lo(raw.z) * c1[0], bf_hi(raw.z) * c1[1], bf_lo(raw.w) * c1[2], bf_hi(raw.w) * c1[3]}); }
                    f32x4 wt[4];
#pragma unroll
                    for (int t = 0; t < 4; ++t) { f32x4 acc = (f32x4){0.f, 0.f, 0.f, 0.f}; acc = MFMA16(tsf[t][0], kp[0], acc); if (t >= 2) acc = MFMA16(tsf[t][1], kp[1], acc); wt[t] = acc; }
                    (WPK + ((size_t)ci * 16 + 2 * (half * 4 + nl)) * 64)[(unsigned)lane] = __builtin_bit_cast(v4u, pack8(wt[0], wt[1]));
                    (WPK + ((size_t)ci * 16 + 2 * (half * 4 + nl) + 1) * 64)[(unsigned)lane] = __builtin_bit_cast(v4u, pack8(wt[2], wt[3])); }
                asm volatile("s_waitcnt lgkmcnt(0)" ::: "memory");
            }
        }
        asm volatile("s_waitcnt vmcnt(0)" ::: "memory");
        gdn_fill_kT(KN, Ts, tok0, h, 0, lane);
        gdn_kend_products(Ts, XB, sE, UPK, WPK, ci, lane, BC, ATF);
        asm volatile("s_waitcnt lgkmcnt(0)" ::: "memory");
        bf16x8 qkpk[4][2];
        {
            bf16x8 kf[4][4];
#pragma unroll
            for (int t = 0; t < 4; ++t)
#pragma unroll
                for (int s = 0; s < 4; ++s) kf[t][s] = *(const bf16x8*)((KN + (size_t)(tok0 + 16 * t) * 512 + h * 128 + 32 * s) + ((unsigned)fr * 512u + 8u * (unsigned)fq));
#pragma unroll
            for (int t = 0; t < 4; ++t) { bf16x8 qf[4]; const float gct = gcv[16 * t + fr];
#pragma unroll
                for (int s = 0; s < 4; ++s) qf[s] = *(const bf16x8*)((QN + (size_t)(tok0 + 16 * t) * 512 + h * 128 + 32 * s) + ((unsigned)fr * 512u + 8u * (unsigned)fq));
                f32x4 tl[4];
#pragma unroll
                for (int u = 0; u < 4; ++u) { tl[u] = (f32x4){0.f, 0.f, 0.f, 0.f}; if (u > t) continue;
                    const f32x4 gcu = *(const LAS f32x4*)(gcv + 16 * u + 4 * fq);
                    f32x4 acc = (f32x4){0.f, 0.f, 0.f, 0.f};
#pragma unroll
                    for (int s = 0; s < 4; ++s) acc = MFMA16(kf[u][s], qf[s], acc);
#pragma unroll
                    for (int r = 0; r < 4; ++r) { const int i = 16 * t + fr, j = 16 * u + 4 * fq + r; const float v = acc[r] * __expf(fminf(gct - gcu[r], 0.f)); tl[u][r] = (i >= j) ? v : 0.f; } }
                qkpk[t][0] = pack8(tl[0], tl[1]); qkpk[t][1] = pack8(tl[2], tl[3]); }
        }
        asm volatile("s_waitcnt lgkmcnt(0)" ::: "memory");
#pragma unroll 2
        for (int sp = 0; sp < 4; ++sp) {
            const bf16x8 w00 = __builtin_bit_cast(bf16x8, (WPK + ((size_t)ci * 16 + 4 * sp) * 64)[(unsigned)lane]), w01 = __builtin_bit_cast(bf16x8, (WPK + ((size_t)ci * 16 + 4 * sp + 1) * 64)[(unsigned)lane]);
            const bf16x8 w10 = __builtin_bit_cast(bf16x8, (WPK + ((size_t)ci * 16 + 4 * sp + 2) * 64)[(unsigned)lane]), w11 = __builtin_bit_cast(bf16x8, (WPK + ((size_t)ci * 16 + 4 * sp + 3) * 64)[(unsigned)lane]);
#pragma unroll
            for (int t = 0; t < 4; ++t) { const float egi = __expf(gcv[16 * t + fr]); f32x4 dd[2];
#pragma unroll
                for (int hh = 0; hh < 2; ++hh) { f32x4 acc = (f32x4){0.f, 0.f, 0.f, 0.f}; acc = MFMA16(hh ? w10 : w00, qkpk[t][0], acc); if (t >= 2) acc = MFMA16(hh ? w11 : w01, qkpk[t][1], acc);
                    const v2u q4 = *(const v2u*)((QN + (size_t)(tok0 + 16 * t) * 512 + h * 128) + ((unsigned)fr * 512u + 4u * (unsigned)fq + 16u * (unsigned)(2 * sp + hh)));
                    dd[hh] = (f32x4){bf_lo(q4.x) * egi - acc[0], bf_hi(q4.x) * egi - acc[1], bf_lo(q4.y) * egi - acc[2], bf_hi(q4.y) * egi - acc[3]}; }
                (QTF + ((size_t)(ci * 4 + t) * 4 + sp) * 64)[(unsigned)lane] = __builtin_bit_cast(v4u, pack8(dd[0], dd[1])); } }
#pragma unroll 4
        for (int et = 0; et < 8; ++et) {
            const bf16x8 u0 = __builtin_bit_cast(bf16x8, (UPK + ((size_t)ci * 16 + 2 * et) * 64)[(unsigned)lane]), u1 = __builtin_bit_cast(bf16x8, (UPK + ((size_t)ci * 16 + 2 * et + 1) * 64)[(unsigned)lane]);
#pragma unroll
            for (int t = 0; t < 4; ++t) { f32x4 acc = (f32x4){0.f, 0.f, 0.f, 0.f}; acc = MFMA16(u0, qkpk[t][0], acc); if (t >= 2) acc = MFMA16(u1, qkpk[t][1], acc);
                (OL + ((size_t)(ci * 8 + et) * 4 + t) * 64)[(unsigned)lane] = pack4(acc); } }
    }
}
#ifndef NHELP
#define NHELP 3
#endif
#ifndef HLEAD
#define HLEAD 20
#endif
__device__ __forceinline__ void phase_gdn_b_helper(Ctx& F, int epoch, int bh, int h) {
    const v4u* at = (const v4u*)(F.ws + WS_ATF) + (size_t)bh * 256 * 2048 + F.tid;
    const v4u* bc = (const v4u*)(F.ws + WS_BC) + (size_t)bh * 256 * 2048 + F.tid;
    unsigned* prog = (unsigned*)(F.ws + WS_CTL) + CW_PROG + bh * 64; const unsigned pbase = (unsigned)epoch * 1024u + 1u;
    v4u acc = (v4u){0u, 0u, 0u, 0u}; v4u d0[8], d1[8];
#pragma unroll
    for (int j = 0; j < 8; ++j) { d0[j] = (v4u){0u, 0u, 0u, 0u}; d1[j] = (v4u){0u, 0u, 0u, 0u}; }
#define HP_WAIT(n_) do { if ((n_) >= HLEAD) { const unsigned want_ = pbase + (unsigned)((n_) - HLEAD); unsigned spins_ = 0; \
        while ((unsigned)__builtin_amdgcn_readfirstlane((int)__hip_atomic_load(prog, __ATOMIC_RELAXED, __HIP_MEMORY_SCOPE_AGENT)) < want_ && ++spins_ < (1u << 18)) __builtin_amdgcn_s_sleep(1); } } while (0)
#define HP_LOAD(d, n_) do { const v4u* a_ = at + (size_t)(n_) * 2048; const v4u* b_ = bc + (size_t)(n_) * 2048; \
        _Pragma("unroll") for (int j = 0; j < 4; ++j) { d[j] = a_[512 * j]; d[4 + j] = b_[512 * j]; } } while (0)
#define HP_USE(d) do { _Pragma("unroll") for (int j = 0; j < 8; ++j) { acc.x ^= d[j].x; acc.y ^= d[j].y; acc.z ^= d[j].z; acc.w ^= d[j].w; } } while (0)
    for (int n = h; n < 256; n += 2 * NHELP) {
        HP_WAIT(n); HP_USE(d0); HP_LOAD(d0, n);
        if (n + NHELP < 256) { HP_WAIT(n + NHELP); HP_USE(d1); HP_LOAD(d1, n + NHELP); }
    }
    HP_USE(d0); HP_USE(d1);
    asm volatile("" :: "v"(acc.x), "v"(acc.y), "v"(acc.z), "v"(acc.w));
#undef HP_WAIT
#undef HP_LOAD
#undef HP_USE
}
#ifndef B_OLDMAP
#define BH_OF(bid) ((bid) & 7)
#define SL_OF(bid) ((bid) >> 3)
#else
#define BH_OF(bid) ((bid) >> 2)
#define SL_OF(bid) ((bid) & 3)
#endif
__device__ __forceinline__ void phase_gdn_b(Ctx& F, int epoch, int bvar) {
    const int bh = BH_OF(F.bid), sl = SL_OF(F.bid), w = F.wave, lane = F.lane, fr = lane & 15, fq = lane >> 4;
    const v4u* ATF = (const v4u*)(F.ws + WS_ATF); const v2u* BC = (const v2u*)(F.ws + WS_BC); const float* CD = (const float*)(F.ws + WS_CD); bf16* ST = (bf16*)(F.ws + WS_ST);
    LAS unsigned char* xb = F.lds;
    const int cbase = bh * 256;
    unsigned* prog = (unsigned*)(F.ws + WS_CTL) + CW_PROG + bh * 64; const unsigned pbase = (unsigned)epoch * 1024u + 1u; const bool pub = (sl == 0) && (w == 0) && (lane == 0);
    f32x4 S[2]; S[0] = (f32x4){0.f, 0.f, 0.f, 0.f}; S[1] = (f32x4){0.f, 0.f, 0.f, 0.f};
    constexpr int RD = 6;
    v4u afr[RD][4]; v2u bcr[RD][2]; float cdr[RD];
#define GB_LOAD(k, n_) do { const int cc_ = (n_) < 256 ? (n_) : 255; const size_t ci_ = (size_t)(cbase + cc_); \
        _Pragma("unroll") for (int s_ = 0; s_ < 4; ++s_) afr[k][s_] = (ATF + ((ci_ * 8 + w) * 4 + s_) * 64)[(unsigned)lane]; \
        _Pragma("unroll") for (int n2_ = 0; n2_ < 2; ++n2_) bcr[k][n2_] = (BC + ((ci_ * 8 + 2 * sl + n2_) * 8 + w) * 64)[(unsigned)lane]; \
        cdr[k] = CD[ci_]; } while (0)
#pragma unroll
    for (int k = 0; k < RD; ++k) GB_LOAD(k, k);
    _Pragma("unroll") for (int k = 0; k < RD; ++k) asm volatile("" :: "v"(afr[k][0]), "v"(afr[k][1]), "v"(afr[k][2]), "v"(afr[k][3]), "v"(bcr[k][0]), "v"(bcr[k][1]), "v"(cdr[k]));
#define GB_STEP(k, n_, LOADNEXT) do { const int n = (n_), par = (k) & 1; const size_t ci = (size_t)(cbase + n); \
            if (NHELP > 0 && pub) __hip_atomic_store(prog, pbase + (unsigned)n, __ATOMIC_RELAXED, __HIP_MEMORY_SCOPE_AGENT);     \
            _Pragma("unroll") for (int nt = 0; nt < 2; ++nt) { const v2u p = pack4(S[nt]); \
                *(LAS v2u*)(xb + par * 8192 + ((nt * 4 + (w >> 1)) * 64 + lane) * 16 + (w & 1) * 8) = p; \
                if (!(bvar & 1)) ((v2u*)ST + ((ci * 8 + w) * 8 + 2 * sl + nt) * 64)[(unsigned)lane] = p; }     \
            asm volatile("s_waitcnt lgkmcnt(0)" ::: "memory"); __builtin_amdgcn_s_barrier(); asm volatile("" ::: "memory"); \
            bf16x8 sf[2][4]; \
            _Pragma("unroll") for (int nt = 0; nt < 2; ++nt) \
                _Pragma("unroll") for (int s = 0; s < 4; ++s) sf[nt][s] = *(const LAS bf16x8*)(xb + par * 8192 + ((nt * 4 + s) * 64 + lane) * 16); \
              \
            asm volatile("" : "+v"(cdr[k]));     \
            const float cdk = __builtin_bit_cast(float, __builtin_amdgcn_readfirstlane(__builtin_bit_cast(int, cdr[k]))); \
            _Pragma("unroll") for (int nt = 0; nt < 2; ++nt) { const v2u bw = bcr[k][nt]; f32x4 acc = S[nt] * cdk + (f32x4){bf_lo(bw.x), bf_hi(bw.x), bf_lo(bw.y), bf_hi(bw.y)}; \
                f32x4 acc2 = (f32x4){0.f, 0.f, 0.f, 0.f};                      \
                acc = MFMA16(__builtin_bit_cast(bf16x8, afr[k][0]), sf[nt][0], acc); acc2 = MFMA16(__builtin_bit_cast(bf16x8, afr[k][1]), sf[nt][1], acc2); \
                acc = MFMA16(__builtin_bit_cast(bf16x8, afr[k][2]), sf[nt][2], acc); acc2 = MFMA16(__builtin_bit_cast(bf16x8, afr[k][3]), sf[nt][3], acc2); \
                S[nt] = acc + acc2; } \
            if (LOADNEXT && !(bvar & 2)) GB_LOAD(k, n + RD); } while (0)
    for (int n0 = 0; n0 + RD <= 256; n0 += RD) {
#pragma unroll
        for (int k = 0; k < RD; ++k) GB_STEP(k, n0 + k, true);
    }
#pragma unroll
    for (int k = 0; k < 256 % RD; ++k) GB_STEP(k, 256 / RD * RD + k, false);
#undef GB_STEP
#undef GB_LOAD
}
__device__ __forceinline__ void phase_gdn_c(Ctx& F, int l) {
    const int lane = F.lane, fr = lane & 15, fq = lane >> 4;
    const v4u* QTF = (const v4u*)(F.ws + WS_QTF); const v2u* OL = (const v2u*)(F.ws + WS_OL); const bf16* ST = (const bf16*)(F.ws + WS_ST);
    const bf16* proj = (const bf16*)(F.ws + WS_R1); bf16* ya = (bf16*)(F.ws + WS_YA); const float* gnp = as_global(F.in[I_GDNNORM]) + (size_t)l * 128;
    { const int ci = F.bid * 8 + F.wave;
        const int bh = ci >> 8, n = ci & 255, b = bh >> 2, h = bh & 3, tok0 = b * T + n * 64;
        bf16x8 qt[4][4];
#pragma unroll
        for (int t = 0; t < 4; ++t)
#pragma unroll
            for (int s = 0; s < 4; ++s) qt[t][s] = __builtin_bit_cast(bf16x8, (QTF + ((size_t)(ci * 4 + t) * 4 + s) * 64)[(unsigned)lane]);
        f32x4 o[8][4];
#pragma unroll
        for (int et = 0; et < 8; ++et) {
#pragma unroll
            for (int t = 0; t < 4; ++t) { const v2u ow = (OL + ((size_t)(ci * 8 + et) * 4 + t) * 64)[(unsigned)lane]; o[et][t] = (f32x4){bf_lo(ow.x), bf_hi(ow.x), bf_lo(ow.y), bf_hi(ow.y)}; }
#pragma unroll
            for (int s = 0; s < 4; ++s) { const v2u lo = ((const v2u*)ST + (((size_t)ci * 8 + 2 * s) * 8 + et) * 64)[(unsigned)lane], hi = ((const v2u*)ST + (((size_t)ci * 8 + 2 * s + 1) * 8 + et) * 64)[(unsigned)lane];
                v4u aw; aw.x = lo.x; aw.y = lo.y; aw.z = hi.x; aw.w = hi.y; const bf16x8 a = __builtin_bit_cast(bf16x8, aw);
#pragma unroll
                for (int t = 0; t < 4; ++t) o[et][t] = MFMA16(a, qt[t][s], o[et][t]); }
        }
        LAS bf16* slab = (LAS bf16*)(F.lds + F.wave * (64 * 136 * 2));
#pragma unroll
        for (int t = 0; t < 4; ++t) { float ss = 0.f;
#pragma unroll
            for (int et = 0; et < 8; ++et) ss += (o[et][t][0] * o[et][t][0] + o[et][t][1] * o[et][t][1]) + (o[et][t][2] * o[et][t][2] + o[et][t][3] * o[et][t][3]);
            ss += bperm(ss, lane ^ 16); ss += bperm(ss, lane ^ 32);
            const float sc = 1.f / sqrtf(ss * (1.f / 128.f) + RMS_EPS);
#pragma unroll
            for (int et = 0; et < 8; ++et) *(LAS v2u*)(slab + (16 * t + fr) * 136 + 16 * et + 4 * fq) = pack4(o[et][t] * sc); }
        asm volatile("s_waitcnt lgkmcnt(0)" ::: "memory");
        { const int rr = lane >> 4, cc = (lane & 15) * 8;
          const f32x4 g0 = *(const f32x4*)(gnp + cc), g1 = *(const f32x4*)(gnp + cc + 4);
#pragma unroll 2
          for (int p = 0; p < 16; ++p) { const int i = 4 * p + rr;
              const v4u ov = *(const LAS v4u*)(slab + i * 136 + cc);
              const v4u zv = *(const v4u*)((proj + (size_t)tok0 * NPROJ + C_Z + h * 128) + ((unsigned)i * (unsigned)NPROJ + (unsigned)cc));
              float of[8], zf[8]; unpack8(ov, of); unpack8(zv, zf);
              v4u w; w.x = cvt_pk_nat(of[0] * g0[0] * siluf_(zf[0]), of[1] * g0[1] * siluf_(zf[1])); w.y = cvt_pk_nat(of[2] * g0[2] * siluf_(zf[2]), of[3] * g0[3] * siluf_(zf[3]));
              w.z = cvt_pk_nat(of[4] * g1[0] * siluf_(zf[4]), of[5] * g1[1] * siluf_(zf[5])); w.w = cvt_pk_nat(of[6] * g1[2] * siluf_(zf[6]), of[7] * g1[3] * siluf_(zf[7]));
              *(v4u*)((ya + (size_t)tok0 * 512 + h * 128) + ((unsigned)i * 512u + (unsigned)cc)) = w; } }
    }
}
constexpr int XK_PITCH = 136, XV_PITCH = 264;
__device__ __forceinline__ void phase_xattn(Ctx& F, int first, int stride) {
    const bf16* proj = (const bf16*)(F.ws + WS_R1); const bf16* kvb = (const bf16*)(F.ws + WS_KVB); const bf16* vtb = (const bf16*)(F.ws + WS_KVB + 512 * 1024); bf16* ym = (bf16*)(F.ws + WS_YM);
    LAS bf16* Ks = (LAS bf16*)F.lds; LAS bf16* VTs = (LAS bf16*)(F.lds + 256 * XK_PITCH * 2);
    const int NU = NB * 4 * (T / 512);
    for (int unit = first; unit < NU; unit += stride) {
        const int qt = unit % (T / 512), bh = unit / (T / 512), b = bh >> 2, head = bh & 3;
        int lane = F.lane; asm volatile("" : "+v"(lane));
        const int fr = lane & 15, fq = lane >> 4, tid_l = F.wave * 64 + lane;
        __syncthreads();
        for (int it = 0; it < 8; ++it) { const int idx = it * 512 + tid_l, key = idx >> 4, ch = idx & 15;
            const v4u kx = *(const v4u*)((kvb + (size_t)(b * NMEM) * 512 + head * 128) + ((unsigned)key * 512u + (unsigned)ch * 8u)); *(LAS v4u*)(Ks + key * XK_PITCH + ch * 8) = kx;
            const int e = idx >> 5, kc = idx & 31;
            const v4u vx = *(const v4u*)((vtb + (size_t)((b * 4 + head) * 128) * 256) + ((unsigned)e * 256u + (unsigned)kc * 8u)); *(LAS v4u*)(VTs + e * XV_PITCH + kc * 8) = vx; }
        __syncthreads();
#pragma unroll 1
        for (int qi = 0; qi < 2; ++qi) {
            const int tok0 = b * T + qt * 512 + F.wave * 64 + qi * 32;
            bf16x8 qf[2][4];
#pragma unroll
            for (int g = 0; g < 2; ++g)
#pragma unroll
                for (int s = 0; s < 4; ++s) qf[g][s] = *(const bf16x8*)((proj + (size_t)(tok0 + g * 16) * NPROJ + C_QM + head * 128 + 32 * s) + ((unsigned)fr * (unsigned)NPROJ + 8u * (unsigned)fq));
            f32x4 sc[2][16];
#pragma unroll
            for (int kt = 0; kt < 16; ++kt) {
                sc[0][kt] = (f32x4){0.f, 0.f, 0.f, 0.f}; sc[1][kt] = (f32x4){0.f, 0.f, 0.f, 0.f};
#pragma unroll
                for (int s = 0; s < 4; ++s) { const bf16x8 kf = *(const LAS bf16x8*)(Ks + (kt * 16 + fr) * XK_PITCH + 32 * s + 8 * fq);
                    sc[0][kt] = __builtin_amdgcn_mfma_f32_16x16x32_bf16(kf, qf[0][s], sc[0][kt], 0, 0, 0);
                    sc[1][kt] = __builtin_amdgcn_mfma_f32_16x16x32_bf16(kf, qf[1][s], sc[1][kt], 0, 0, 0); }
            }
            bf16x8 pf[2][8]; float inv[2];
#pragma unroll
            for (int g = 0; g < 2; ++g) {
                float mx = -3.0e38f;
#pragma unroll
                for (int kt = 0; kt < 16; ++kt) mx = fmaxf(mx, fmaxf(fmaxf(sc[g][kt][0], sc[g][kt][1]), fmaxf(sc[g][kt][2], sc[g][kt][3])));
                mx = fmaxf(mx, bperm(mx, lane ^ 16)); mx = fmaxf(mx, bperm(mx, lane ^ 32));
                float sum = 0.f;
#pragma unroll
                for (int kt = 0; kt < 16; ++kt)
#pragma unroll
                    for (int r = 0; r < 4; ++r) { const float p = __expf((sc[g][kt][r] - mx) * 0.08838834764831845f); sc[g][kt][r] = p; sum += p; }
                sum += bperm(sum, lane ^ 16); sum += bperm(sum, lane ^ 32);
                inv[g] = 1.f / sum;
#pragma unroll
                for (int ks = 0; ks < 8; ++ks) { v4u w; w.x = cvt_pk_bf16_n(sc[g][2 * ks][0], sc[g][2 * ks][1]); w.y = cvt_pk_bf16_n(sc[g][2 * ks][2], sc[g][2 * ks][3]);
                    w.z = cvt_pk_bf16_n(sc[g][2 * ks + 1][0], sc[g][2 * ks + 1][1]); w.w = cvt_pk_bf16_n(sc[g][2 * ks + 1][2], sc[g][2 * ks + 1][3]); pf[g][ks] = __builtin_bit_cast(bf16x8, w); }
            }
#pragma unroll
            for (int et = 0; et < 8; ++et) {
                f32x4 o0 = (f32x4){0.f, 0.f, 0.f, 0.f}, o1 = (f32x4){0.f, 0.f, 0.f, 0.f};
#pragma unroll
                for (int ks = 0; ks < 8; ++ks) { const LAS bf16* vp = VTs + (et * 16 + fr) * XV_PITCH + 32 * ks + 4 * fq;
                    const v2u lo = *(const LAS v2u*)vp, hi = *(const LAS v2u*)(vp + 16); v4u w; w.x = lo.x; w.y = lo.y; w.z = hi.x; w.w = hi.y; const bf16x8 vf = __builtin_bit_cast(bf16x8, w);
                    o0 = __builtin_amdgcn_mfma_f32_16x16x32_bf16(vf, pf[0][ks], o0, 0, 0, 0);
                    o1 = __builtin_amdgcn_mfma_f32_16x16x32_bf16(vf, pf[1][ks], o1, 0, 0, 0); }
                o0 = o0 * inv[0]; o1 = o1 * inv[1];
                v2u w0, w1; w0.x = cvt_pk_bf16_n(o0[0], o0[1]); w0.y = cvt_pk_bf16_n(o0[2], o0[3]); w1.x = cvt_pk_bf16_n(o1[0], o1[1]); w1.y = cvt_pk_bf16_n(o1[2], o1[3]);
                *(v2u*)((ym + (size_t)tok0 * 512 + head * 128 + et * 16) + ((unsigned)fr * 512u + 4u * (unsigned)fq)) = w0;
                *(v2u*)((ym + (size_t)(tok0 + 16) * 512 + head * 128 + et * 16) + ((unsigned)fr * 512u + 4u * (unsigned)fq)) = w1;
            }
        }
    }
}

constexpr int TPW = NTOK / 256;
constexpr int WR_PITCH = 1028;
__device__ __forceinline__ int dpp_i(int s, int ctrl_sel) {
    if (ctrl_sel == 0) return __builtin_amdgcn_update_dpp(0, s, 0xB1, 0xF, 0xF, true);
    if (ctrl_sel == 1) return __builtin_amdgcn_update_dpp(0, s, 0x4E, 0xF, 0xF, true);
    if (ctrl_sel == 2) return __builtin_amdgcn_update_dpp(0, s, 0x141, 0xF, 0xF, true);
    return __builtin_amdgcn_update_dpp(0, s, 0x140, 0xF, 0xF, true);
}
__device__ __forceinline__ void phase_ln1_router(Ctx& F, int l) {
    LAS float* wr_s = (LAS float*)F.lds;
    LAS int* hist = (LAS int*)(F.lds + 32 * WR_PITCH * 4);
    const float* wrp = as_global(F.in[I_WR]) + (size_t)l * D * NE;
    { const int e = F.tid & 31, kg = F.tid >> 5;
      for (int k = kg * 64; k < kg * 64 + 64; k += 4) { f32x4 w; w[0] = wrp[(size_t)(k + 0) * NE + e]; w[1] = wrp[(size_t)(k + 1) * NE + e]; w[2] = wrp[(size_t)(k + 2) * NE + e]; w[3] = wrp[(size_t)(k + 3) * NE + e];
          *(LAS f32x4*)(wr_s + e * WR_PITCH + k) = w; } }
    if (F.tid < 32) hist[F.tid] = 0;
    __syncthreads();
    const bf16* tb = (const bf16*)(F.ws + WS_HF); bf16* hb = (bf16*)(F.ws + WS_HB);
    int* tok_e = (int*)(F.ws + WS_TOKE); float* tok_w = (float*)(F.ws + WS_TOKW);
    const float* brp = as_global(F.in[I_BR]) + (size_t)l * NE;
    const int lane = F.lane, fr = lane & 15, q = lane >> 4;
    const int tok_base = F.bid * TPW + F.wave * 16;
    const size_t rowoff = (size_t)(tok_base + fr) * D + 8 * q;
    float s = 0.f, s2 = 0.f;
#pragma unroll 8
    for (int c = 0; c < 32; ++c) { float x[8]; unpack8(*(const v4u*)(tb + rowoff + 32 * c), x);
#pragma unroll
        for (int i = 0; i < 8; ++i) { s += x[i]; s2 += x[i] * x[i]; } }
    s += bperm(s, lane ^ 16); s += bperm(s, lane ^ 32); s2 += bperm(s2, lane ^ 16); s2 += bperm(s2, lane ^ 32);
    const float mean = s * (1.f / D);
    const float rstd = 1.f / sqrtf(fmaxf(s2 * (1.f / D) - mean * mean, 0.f) + LN_EPS);
    const float* gp = as_global(F.in[I_LN1G]) + (size_t)l * D + 8 * q; const float* bp = as_global(F.in[I_LN1B]) + (size_t)l * D + 8 * q;
    const LAS float* w0p = wr_s + fr * WR_PITCH + 8 * q; const LAS float* w1p = wr_s + (16 + fr) * WR_PITCH + 8 * q;
    f32x4 acc0 = (f32x4){0.f, 0.f, 0.f, 0.f}, acc1 = (f32x4){0.f, 0.f, 0.f, 0.f};
#pragma unroll 2
    for (int c = 0; c < 32; ++c) {
        float x[8]; unpack8(*(const v4u*)(tb + rowoff + 32 * c), x);
        const f32x4 g0 = *(const f32x4*)(gp + 32 * c), g1 = *(const f32x4*)(gp + 32 * c + 4), b0 = *(const f32x4*)(bp + 32 * c), b1 = *(const f32x4*)(bp + 32 * c + 4);
        float h[8];
#pragma unroll
        for (int i = 0; i < 4; ++i) { h[i] = (x[i] - mean) * rstd * g0[i] + b0[i]; h[4 + i] = (x[4 + i] - mean) * rstd * g1[i] + b1[i]; }
        const f32x4 wa0 = *(const LAS f32x4*)(w0p + 32 * c), wa1 = *(const LAS f32x4*)(w0p + 32 * c + 4), wb0 = *(const LAS f32x4*)(w1p + 32 * c), wb1 = *(const LAS f32x4*)(w1p + 32 * c + 4);
#pragma unroll
        for (int i = 0; i < 4; ++i) { acc0 = __builtin_amdgcn_mfma_f32_16x16x4f32(h[i], wa0[i], acc0, 0, 0, 0); acc1 = __builtin_amdgcn_mfma_f32_16x16x4f32(h[i], wb0[i], acc1, 0, 0, 0); }
#pragma unroll
        for (int i = 0; i < 4; ++i) { acc0 = __builtin_amdgcn_mfma_f32_16x16x4f32(h[4 + i], wa1[i], acc0, 0, 0, 0); acc1 = __builtin_amdgcn_mfma_f32_16x16x4f32(h[4 + i], wb1[i], acc1, 0, 0, 0); }
        v4u w; w.x = cvt_pk_nat(h[0], h[1]); w.y = cvt_pk_nat(h[2], h[3]); w.z = cvt_pk_nat(h[4], h[5]); w.w = cvt_pk_nat(h[6], h[7]);
        *(v4u*)(hb + rowoff + 32 * c) = w;
        asm volatile("" ::: "memory");
    }
    const float be0 = brp[fr], be1 = brp[16 + fr];
#pragma unroll
    for (int r = 0; r < 4; ++r) {
        float v0 = acc0[r] + be0, v1 = acc1[r] + be1; float val[4]; int idx[4];
#pragma unroll
        for (int kk = 0; kk < 4; ++kk) {
            const bool use1 = v1 > v0; float bv = use1 ? v1 : v0; int bi = use1 ? 16 + fr : fr;
#pragma unroll
            for (int st = 0; st < 4; ++st) { const float ov = dpp_f(bv, st); const int oi = dpp_i(bi, st); const bool take = (ov > bv) || (ov == bv && oi < bi); bv = take ? ov : bv; bi = take ? oi : bi; }
            val[kk] = bv; idx[kk] = bi;
            v0 = (bi == fr) ? -3.0e38f : v0; v1 = (bi == 16 + fr) ? -3.0e38f : v1;
        }
        const float e1 = __expf(val[1] - val[0]), e2 = __expf(val[2] - val[0]), e3 = __expf(val[3] - val[0]); const float inv = 1.f / (1.f + e1 + e2 + e3);
        if (fr == 0) { const size_t t4 = (size_t)(tok_base + 4 * q + r) * 4;
            *(int4*)(tok_e + t4) = make_int4(idx[0], idx[1], idx[2], idx[3]); *(f32x4*)(tok_w + t4) = (f32x4){inv, e1 * inv, e2 * inv, e3 * inv};
            atomicAdd((int*)&hist[idx[0]], 1); atomicAdd((int*)&hist[idx[1]], 1); atomicAdd((int*)&hist[idx[2]], 1); atomicAdd((int*)&hist[idx[3]], 1); }
    }
    __syncthreads();
    if (F.tid < 32) ((int*)(F.ws + WS_CNT))[F.bid * 32 + F.tid] = hist[F.tid];
}

__device__ __forceinline__ void phase_assign(Ctx& F) {
    LAS int* part_tot = (LAS int*)F.lds;
    LAS int* part_bef = part_tot + 512;
    LAS int* tot_s = part_bef + 512; LAS int* bef_s = tot_s + 32; LAS int* pstart_s = bef_s + 32;
    LAS int* cntw = pstart_s + 32;
    const int* cnt = (const int*)(F.ws + WS_CNT); int* meta = (int*)(F.ws + WS_META);
    const int* tok_e = (const int*)(F.ws + WS_TOKE); const float* tok_w = (const float*)(F.ws + WS_TOKW);
    int* tok_slot = (int*)(F.ws + WS_TOKS); float* slot_w = (float*)(F.ws + WS_SLOTW);
    const int lane = F.lane;
    const int n = F.tid, my_e = tok_e[(size_t)F.bid * TPW * 4 + n]; const float my_w = tok_w[(size_t)F.bid * TPW * 4 + n];
    int my_rank = 0, my_cnt = 0;
    const unsigned long long lt = (1ull << lane) - 1ull;
#pragma unroll
    for (int e = 0; e < 32; ++e) { const unsigned long long m = __ballot(my_e == e); my_rank = (my_e == e) ? __popcll(m & lt) : my_rank; my_cnt = (lane == e) ? __popcll(m) : my_cnt; }
    if (lane < 32) cntw[F.wave * 32 + lane] = my_cnt;
    { const int e = F.tid & 31, part = F.tid >> 5; const int per = (F.G + 15) / 16; int c[16];
#pragma unroll
      for (int j = 0; j < 16; ++j) { const int w = part * per + j; c[j] = (j < per && w < F.G) ? cnt[w * 32 + e] : 0; }
      int tot = 0, bef = 0;
#pragma unroll
      for (int j = 0; j < 16; ++j) { tot += c[j]; bef += (part * per + j < F.bid) ? c[j] : 0; }
      part_tot[part * 32 + e] = tot; part_bef[part * 32 + e] = bef; }
    __syncthreads();
    if (F.tid < 32) { int tot = 0, bef = 0;
#pragma unroll
        for (int p = 0; p < 16; ++p) { tot += part_tot[p * 32 + F.tid]; bef += part_bef[p * 32 + F.tid]; }
        tot_s[F.tid] = tot;
        const int pc = ((tot + 255) >> 8) << 8; int incl = pc;
#pragma unroll
        for (int off = 1; off < 32; off <<= 1) { const int t = __builtin_amdgcn_ds_bpermute(((lane - off) & 63) << 2, incl); incl += (lane >= off) ? t : 0; }
        const int ps = incl - pc; pstart_s[F.tid] = ps; bef_s[F.tid] = ps + bef;
        if (F.bid == 0) { for (int tt = ps >> 8; tt < (ps + pc) >> 8; ++tt) meta[64 + tt] = F.tid; if (F.tid == 31) meta[0] = (ps + pc) >> 8; } }
    __syncthreads();
    int pre = 0;
    for (int w = 0; w < F.wave; ++w) pre += cntw[w * 32 + my_e];
    const int slot = bef_s[my_e] + pre + my_rank;
    { const int tok = F.bid * TPW + (n >> 2); tok_slot[(size_t)tok * 4 + (n & 3)] = slot; slot_w[slot] = my_w; ((int*)(F.ws + WS_SLOTT))[slot] = tok; }
    if (F.bid == 0 && F.tid < 32) { const int tot = tot_s[F.tid], ps = pstart_s[F.tid], pe = ps + (((tot + 255) >> 8) << 8); int* st = (int*)(F.ws + WS_SLOTT);
        for (int s2 = ps + tot; s2 < pe; ++s2) st[s2] = 0; }
}

__device__ __forceinline__ void phase_combine_ln2(Ctx& F, int l) {
    LAS float* ws_s = (LAS float*)F.lds;
    if (l + 1 < DEPTH) { load_small_w(F, l + 1, ws_s); }
    __syncthreads();
    bf16* hb = (bf16*)(F.ws + WS_HB); float* ab = (float*)(F.ws + WS_AB);
    const bf16* Y = (const bf16*)(F.ws + WS_XS); const int* tok_slot = (const int*)(F.ws + WS_TOKS);
    const int lane = F.lane, gw = F.bid * 8 + F.wave, NGW = F.G * 8;
    for (int tok = gw; tok < NTOK; tok += NGW) {
        f32x4 v[4]; load_row_bf16(hb + (size_t)tok * D, v, lane);
#pragma unroll
        for (int j = 0; j < 4; ++j) v[j] = v[j] * ALPHA;
#pragma unroll
        for (int kk = 0; kk < 4; ++kk) { const int slot = tok_slot[(size_t)tok * 4 + kk]; const bf16* yr = Y + (size_t)slot * D;
#pragma unroll
            for (int j = 0; j < 4; ++j) { const v2u w = *(const v2u*)(yr + 4 * lane + 256 * j); v[j][0] += bf_lo(w.x); v[j][1] += bf_hi(w.x); v[j][2] += bf_lo(w.y); v[j][3] += bf_hi(w.y); } }
        ln_apply(v, as_global(F.in[I_LN2G]) + (size_t)l * D, as_global(F.in[I_LN2B]) + (size_t)l * D, lane);
        if (l + 1 < DEPTH) { store_row_bf16(hb + (size_t)tok * D, v, lane); small_proj(v, ws_s, ab + (size_t)tok * 8, lane); }
        else store_row_f32(F.out + (size_t)tok * D, v, lane);
    }
}


#define PHASE_FN __device__ __forceinline__
PHASE_FN void g_inproj(LAS unsigned char* lds, unsigned char* ws, int l, int G, int bid, int wave) { asm volatile("" : "+s"(ws)); ws = as_global(ws); asm volatile("" : "+s"(G)); asm volatile("" : "+s"(bid)); asm volatile("" : "+s"(l));
    pg8::SchedDense S{(const char*)(ws + WS_HB), (const char*)(ws + WS_WIN) + (size_t)l * NPROJ * D * 2, NTOK / 256, NPROJ / 256, G, bid, (size_t)256 * D * 2};
    pg8::EpiStoreBf16 E{(bf16*)(ws + WS_R1), NPROJ};
    pg8::gemm_phase<pg8::EpiStoreBf16, pg8::SchedDense, true, true>(lds, D, S, E, wave);
}
PHASE_FN void g_kvproj(LAS unsigned char* lds, unsigned char* ws, int l, int G, int bid, int wave) { asm volatile("" : "+s"(ws)); ws = as_global(ws); asm volatile("" : "+s"(G)); asm volatile("" : "+s"(bid)); asm volatile("" : "+s"(l));
    pg8::SchedDense S{(const char*)(ws + WS_MEMB), (const char*)(ws + WS_WKV) + (size_t)l * D * D * 2, NB * NMEM / 256, D / 256, G, bid, (size_t)256 * D * 2};
    pg8::EpiKV E{(bf16*)(ws + WS_KVB), (bf16*)(ws + WS_KVB + 512 * 1024)};
    pg8::gemm_phase<pg8::EpiKV, pg8::SchedDense, true, true>(lds, D, S, E, wave);
}
#ifndef XT
#define XT 2
#endif
constexpr int CW_XDONE = 20480;
PHASE_FN void g_side_branch(LAS unsigned char* lds, unsigned char* ws, int l, int nside, int sidx, int wave, int br) { asm volatile("" : "+s"(ws)); ws = as_global(ws); asm volatile("" : "+s"(nside)); asm volatile("" : "+s"(sidx)); asm volatile("" : "+s"(l)); asm volatile("" : "+s"(br));
    const bool xw = sidx < 64;
    pg8::SchedBranch S{(const char*)(ws + WS_YA), (const char*)(ws + WS_YB), (const char*)(ws + WS_YM), (const char*)(ws + WS_WBR) + (size_t)l * 3 * D * 512 * 2, (size_t)D * 512 * 2,
                       NTOK / 256, D / 256, xw ? 64 : nside - 64, xw ? sidx : 64 * XT + sidx - 64, 1, br, br, (size_t)256 * 512 * 2, xw ? XT : (1 << 30)};
    pg8::EpiBranch E{(const bf16*)(ws + WS_R1), (bf16*)(ws + WS_MB), 1};
    pg8::gemm_phase<pg8::EpiBranch, pg8::SchedBranch, true, true>(lds, 512, S, E, wave);
}
__device__ __forceinline__ void xdone_publish(unsigned char* ws) {
    asm volatile("s_waitcnt vmcnt(0)" ::: "memory"); __syncthreads();
    if (threadIdx.x == 0) { __builtin_amdgcn_fence(__ATOMIC_RELEASE, "agent"); asm volatile("s_waitcnt vmcnt(0)" ::: "memory");
        __hip_atomic_fetch_add((unsigned*)(ws + WS_CTL) + CW_XDONE, 1u, __ATOMIC_RELAXED, __HIP_MEMORY_SCOPE_AGENT); }
}
__device__ __forceinline__ void xdone_wait(unsigned char* ws, unsigned want) {
    asm volatile("s_waitcnt vmcnt(0)" ::: "memory"); __syncthreads();
    if (threadIdx.x == 0) { unsigned spins = 0;
        while (__hip_atomic_load((unsigned*)(ws + WS_CTL) + CW_XDONE, __ATOMIC_RELAXED, __HIP_MEMORY_SCOPE_AGENT) < want && ++spins < (1u << 22)) __builtin_amdgcn_s_sleep(8);
        __builtin_amdgcn_fence(__ATOMIC_ACQUIRE, "agent"); asm volatile("s_waitcnt vmcnt(0)" ::: "memory"); }
    __syncthreads();
}
PHASE_FN void g_branch(LAS unsigned char* lds, unsigned char* ws, int l, int G, int bid, int wave) { asm volatile("" : "+s"(ws)); ws = as_global(ws); asm volatile("" : "+s"(G)); asm volatile("" : "+s"(bid)); asm volatile("" : "+s"(l));
    pg8::SchedBranch S{(const char*)(ws + WS_YA), (const char*)(ws + WS_YB), (const char*)(ws + WS_YM), (const char*)(ws + WS_WBR) + (size_t)l * 3 * D * 512 * 2, (size_t)D * 512 * 2,
                       NTOK / 256, D / 256, G, bid, 1, 0, 0, (size_t)256 * 512 * 2};
    pg8::EpiBranch E{(const bf16*)(ws + WS_R1), (bf16*)(ws + WS_MB), 1};
    pg8::gemm_phase<pg8::EpiBranch, pg8::SchedBranch, true, true>(lds, 512, S, E, wave);
}
PHASE_FN void g_outproj(LAS unsigned char* lds, unsigned char* ws, int l, int G, int bid, int wave) { asm volatile("" : "+s"(ws)); ws = as_global(ws); asm volatile("" : "+s"(G)); asm volatile("" : "+s"(bid)); asm volatile("" : "+s"(l));
    pg8::SchedDense S{(const char*)(ws + WS_MB), (const char*)(ws + WS_WO) + (size_t)l * D * D * 2, NTOK / 256, D / 256, G, bid, (size_t)256 * D * 2};
    pg8::EpiOut E{(const bf16*)(ws + WS_HB), (bf16*)(ws + WS_HF)};
    pg8::gemm_phase<pg8::EpiOut, pg8::SchedDense, true, true>(lds, D, S, E, wave);
}
PHASE_FN void g_gateup(LAS unsigned char* lds, unsigned char* ws, const float* bgu, int l, int G, int bid, int wave) { asm volatile("" : "+s"(ws)); ws = as_global(ws); asm volatile("" : "+s"(G)); asm volatile("" : "+s"(bid)); asm volatile("" : "+s"(l)); bgu = as_global(bgu);
    const int* meta = (const int*)(ws + WS_META); const int n_tiles = __builtin_amdgcn_readfirstlane(meta[0]);
    pg8::SchedGrouped S{(const char*)(ws + WS_HB), (const char*)(ws + WS_WGU) + (size_t)l * NE * 2048 * D * 2, (size_t)2048 * D * 2, meta + 64, n_tiles, 8, G, bid, (size_t)256 * D * 2, (const int*)(ws + WS_SLOTT)};
    pg8::EpiSwiglu E{(bf16*)(ws + WS_HBUF), bgu + (size_t)l * NE * 2048};
    pg8::gemm_phase<pg8::EpiSwiglu, pg8::SchedGrouped, true, true, true>(lds, D, S, E, wave);
}
PHASE_FN void g_down(LAS unsigned char* lds, unsigned char* ws, const float* bd, int l, int G, int bid, int wave) { asm volatile("" : "+s"(ws)); ws = as_global(ws); asm volatile("" : "+s"(G)); asm volatile("" : "+s"(bid)); asm volatile("" : "+s"(l)); bd = as_global(bd);
    const int* meta = (const int*)(ws + WS_META); const int n_tiles = __builtin_amdgcn_readfirstlane(meta[0]);
    pg8::SchedGrouped S{(const char*)(ws + WS_HBUF), (const char*)(ws + WS_WD) + (size_t)l * NE * D * D * 2, (size_t)D * D * 2, meta + 64, n_tiles, 4, G, bid, (size_t)256 * D * 2, nullptr};
    pg8::EpiDown E{(bf16*)(ws + WS_XS), bd + (size_t)l * NE * D, (const float*)(ws + WS_SLOTW)};
    pg8::gemm_phase<pg8::EpiDown, pg8::SchedGrouped, true, true>(lds, D, S, E, wave);
}

constexpr int PH_PER_LAYER = 12, NPHASE = 1 + DEPTH * PH_PER_LAYER;
__global__ void __launch_bounds__(512, 2) fwd_kernel(Args args) {
    extern __shared__ __attribute__((aligned(16))) unsigned char lds_raw[];
    Ctx F;
    F.lds = (LAS unsigned char*)lds_raw; F.tid = 0; F.lane = 0; F.wave = __builtin_amdgcn_readfirstlane((int)threadIdx.x >> 6); F.G = gridDim.x; F.bid = blockIdx.x;
    F.in = args.in; F.out = args.out; F.ws = args.ws;
    volatile LAS unsigned* MISC = (volatile LAS unsigned*)(F.lds + MISC_OFF);
    if (threadIdx.x < 64) MISC[threadIdx.x] = 0u;
    __syncthreads();
    const int lo = args.ph_lo, hi = args.ph_hi;
#define REP_BRANCH g_branch
#ifdef AMP_BID
#define AMP_BEGIN() const unsigned long long amp_t0_ = __builtin_amdgcn_s_memrealtime()
#define AMP_END() do { if (exp_ && F.bid == AMP_BID) { __syncthreads(); const unsigned long long t1_ = __builtin_amdgcn_s_memrealtime(); while (__builtin_amdgcn_s_memrealtime() - t1_ < (unsigned long long)AMP * (t1_ - amp_t0_)) __builtin_amdgcn_s_sleep(8); } } while (0)
#else
#define AMP_BEGIN() do {} while (0)
#define AMP_END() do {} while (0)
#endif
#ifndef XA_LO
#define XA_LO 128
#endif
#ifndef BVAR
#define BVAR 0
#endif
#ifndef REP_MODE
#define REP_MODE 0
#endif
#ifndef REP_PH
#define REP_PH -1
#define REP_N 0
#endif
#define NREP(k) (((k) == REP_PH) ? 1 + REP_N : 1)
#if MK_MULTI
#define GRID_BAR() do { } while (0)
#else
    XcdBarrier bar = xcd_barrier_post((unsigned*)(F.ws + WS_CTL) + CW_BAR, MISC + 8);
#define GRID_BAR() xcd_barrier(bar)
#endif
#define IN(k) (lo <= (k) && (k) < hi)
#define SEAM(k) do { if (IN(k) && IN((k) + 1)) GRID_BAR(); } while (0)

    if (IN(0)) { for (int rep_ = 0; rep_ < ((REP_PH == 100) ? 1 + REP_N : 1); ++rep_) { if (rep_) GRID_BAR(); { Ctx P = fresh(F); phase_prologue(P); } } } SEAM(0);

#define LAYER_PHASES(l) do { const int p0 = 1 + (l) * PH_PER_LAYER; \
        if (IN(p0 + 0)) { for (int rep_ = 0; rep_ < NREP(0); ++rep_) { if (rep_) GRID_BAR(); g_inproj(F.lds, F.ws, l, F.G, F.bid, F.wave); } } SEAM(p0 + 0); \
        if (IN(p0 + 1)) { for (int rep_ = 0; rep_ < NREP(1); ++rep_) { if (rep_) GRID_BAR(); g_kvproj(F.lds, F.ws, l, F.G, F.bid, F.wave); __syncthreads(); { Ctx P = fresh(F); phase_prep(P, l); } asm volatile("s_waitcnt vmcnt(0)" ::: "memory"); __syncthreads(); { Ctx P = fresh(F); phase_gdn_a(P); } } }   \
        SEAM(p0 + 2); \
        if (IN(p0 + 3)) { for (int rep_ = 0; rep_ < NREP(3); ++rep_) { if (rep_) GRID_BAR(); __syncthreads(); { Ctx P = fresh(F); const bool exp_ = rep_ + 1 < NREP(3); const int mode_ = exp_ ? REP_MODE : 0; const int epoch_ = (l) * NREP(3) + rep_; AMP_BEGIN(); if (P.bid < 32) { if (mode_ != 2) phase_gdn_b(P, epoch_, exp_ ? BVAR : 0); } else if (P.bid < 32 + 8 * NHELP) { if (mode_ != 2) phase_gdn_b_helper(P, epoch_, P.bid & 7, (P.bid - 32) >> 3); } else if (mode_ != 1) { const int sidx_ = P.bid - 32 - 8 * NHELP, nside_ = P.G - 32 - 8 * NHELP; phase_xattn(P, sidx_, nside_); if (sidx_ < 64) xdone_publish(F.ws); __syncthreads(); _Pragma("unroll 1") for (int br_ = 1; br_ <= 2; ++br_) { if (br_ == 2) xdone_wait(F.ws, 64u * (unsigned)(epoch_ + 1)); g_side_branch(F.lds, F.ws, l, nside_, sidx_, F.wave, br_); } if (l == 0 && !exp_ && NDEF > 0) { __syncthreads(); Ctx Q = fresh(F); convert_deferred(Q, sidx_ * 8 + Q.wave, nside_ * 8); } } AMP_END(); } } } SEAM(p0 + 3); \
        if (IN(p0 + 4)) { for (int rep_ = 0; rep_ < NREP(4); ++rep_) { if (rep_) GRID_BAR(); __syncthreads(); { Ctx P = fresh(F); phase_gdn_c(P, l); } } } SEAM(p0 + 4); \
        if (IN(p0 + 5)) { for (int rep_ = 0; rep_ < NREP(5); ++rep_) { if (rep_) GRID_BAR(); __syncthreads(); if (rep_ == 0) g_branch(F.lds, F.ws, l, F.G, F.bid, F.wave); else REP_BRANCH(F.lds, F.ws, l, F.G, F.bid, F.wave); } } SEAM(p0 + 5); \
        if (IN(p0 + 6)) { for (int rep_ = 0; rep_ < NREP(6); ++rep_) { if (rep_) GRID_BAR(); g_outproj(F.lds, F.ws, l, F.G, F.bid, F.wave); } } SEAM(p0 + 6); \
        if (IN(p0 + 7)) { for (int rep_ = 0; rep_ < NREP(7); ++rep_) { if (rep_) GRID_BAR(); __syncthreads(); { Ctx P = fresh(F); phase_ln1_router(P, l); } } } SEAM(p0 + 7); \
        if (IN(p0 + 8)) { for (int rep_ = 0; rep_ < NREP(8); ++rep_) { if (rep_) GRID_BAR(); __syncthreads(); { Ctx P = fresh(F); phase_assign(P); } } } SEAM(p0 + 8); \
        if (IN(p0 + 9)) { for (int rep_ = 0; rep_ < NREP(9); ++rep_) { if (rep_) GRID_BAR(); __syncthreads(); g_gateup(F.lds, F.ws, as_global(F.in[I_BGU]), l, F.G, F.bid, F.wave); } } SEAM(p0 + 9); \
        if (IN(p0 + 10)) { for (int rep_ = 0; rep_ < NREP(10); ++rep_) { if (rep_) GRID_BAR(); g_down(F.lds, F.ws, as_global(F.in[I_BD]), l, F.G, F.bid, F.wave); } } SEAM(p0 + 10); \
        if (IN(p0 + 11)) { for (int rep_ = 0; rep_ < NREP(11); ++rep_) { if (rep_) GRID_BAR(); __syncthreads(); { Ctx P = fresh(F); phase_combine_ln2(P, l); } } } SEAM(p0 + 11); \
    } while (0)
    LAYER_PHASES(0);
    LAYER_PHASES(1);
#undef LAYER_PHASES
#undef IN
#undef SEAM
#undef GRID_BAR
}

extern "C" void kernel_launch(void* const* d_in, const int* in_sizes, int n_in, void* d_out, int out_size, void* d_ws, size_t ws_size, hipStream_t stream) {
    static int grid = 0;
    if (grid == 0) {
        if (n_in != 23 || out_size != NTOK * D || ws_size < WS_END) { fprintf(stderr, "kernel_launch: unexpected problem (n_in %d, out %d, ws %zu < %zu)\n", n_in, out_size, ws_size, (size_t)WS_END); grid = -1; return; }
        if (hipFuncSetAttribute((const void*)fwd_kernel, hipFuncAttributeMaxDynamicSharedMemorySize, LDS_BYTES) != hipSuccess) { fprintf(stderr, "kernel_launch: hipFuncSetAttribute failed\n"); grid = -1; return; }
        int per_cu = 0;
        if (hipOccupancyMaxActiveBlocksPerMultiprocessor(&per_cu, (const void*)fwd_kernel, 512, LDS_BYTES) != hipSuccess || per_cu < 1) fprintf(stderr, "kernel_launch: occupancy query reports %d\n", per_cu);
        (void)hipGetLastError();
        grid = 256;
    }
    if (grid < 0) return;
    (void)hipMemsetAsync((char*)d_ws + WS_CTL, 0, CTL_ZERO_BYTES, stream);
    Args a{};
    for (int i = 0; i < 23; ++i) a.in[i] = (const float*)d_in[i];
    a.out = (float*)d_out; a.ws = (unsigned char*)d_ws;
#if MK_MULTI
    for (int p = 0; p < NPHASE; ++p) { a.ph_lo = p; a.ph_hi = p + 1; hipLaunchKernelGGL(fwd_kernel, dim3(grid), dim3(512), LDS_BYTES, stream, a); }
#else
    a.ph_lo = 0; a.ph_hi = NPHASE;
    hipLaunchKernelGGL(fwd_kernel, dim3(grid), dim3(512), LDS_BYTES, stream, a);
#endif
}
```

```cpp
#include <hip/hip_runtime.h>
#include <cstdio>
#include <cstdint>

#ifndef MK_MULTI
#define MK_MULTI 0
#endif

#define LAS __attribute__((address_space(3)))
typedef unsigned short bf16;
typedef unsigned v4u __attribute__((ext_vector_type(4)));
typedef unsigned v2u __attribute__((ext_vector_type(2)));
typedef float f32x4 __attribute__((ext_vector_type(4)));
typedef float f32x2 __attribute__((ext_vector_type(2)));
typedef short bf16x8 __attribute__((ext_vector_type(8)));

constexpr int NB = 2, T = 16384, NTOK = NB * T, D = 1024, DEPTH = 2;
constexpr int NPROJ = 7168;
constexpr int NPROJ_SRC = 7176;
constexpr int C_Q = 0, C_K = 512, C_V = 1024, C_Z = 1536, C_XC = 2048, C_GB = 2560, C_GC = 3072, C_QM = 3584, C_GL = 4096;
constexpr int NMEM = 256, NE = 32, TOPK = 4, DFF = 1024;
constexpr int NSLOT_MAX = 544 * 256;
constexpr float ALPHA = 1.41421356237309515f;
constexpr float LN_EPS = 1e-5f, RMS_EPS = 1e-6f;

constexpr size_t MiB = 1u << 20;
constexpr size_t WS_CTL = 0, CTL_ZERO_BYTES = 1 * MiB;
constexpr size_t WS_WIN = 1 * MiB;
constexpr size_t WS_WBR = WS_WIN + 28 * MiB;
constexpr size_t WS_WO = WS_WBR + 6 * MiB;
constexpr size_t WS_WKV = WS_WO + 4 * MiB;
constexpr size_t WS_WGU = WS_WKV + 4 * MiB;
constexpr size_t WS_WD = WS_WGU + 256 * MiB;
constexpr size_t WS_MEMB = WS_WD + 128 * MiB;
constexpr size_t WS_KVB = WS_MEMB + 1 * MiB;
constexpr size_t WS_HF = WS_KVB + 1 * MiB;
constexpr size_t WS_HB = WS_HF + 128 * MiB;
constexpr size_t WS_AB = WS_HB + 64 * MiB;
constexpr size_t WS_R1 = WS_AB + 1 * MiB;
constexpr size_t WS_XS = WS_R1, WS_HBUF = WS_R1 + 272 * MiB;
constexpr size_t WS_KN = WS_R1 + 544 * MiB;
constexpr size_t WS_QN = WS_KN + 32 * MiB;
constexpr size_t WS_VV = WS_QN + 32 * MiB;
constexpr size_t WS_GS = WS_VV + 32 * MiB;
constexpr size_t WS_ATF = WS_GS + 2 * MiB;
constexpr size_t WS_BC = WS_ATF + 64 * MiB;
constexpr size_t WS_QTF = WS_BC + 64 * MiB;
constexpr size_t WS_OL = WS_QTF + 32 * MiB;
constexpr size_t WS_ST = WS_OL + 64 * MiB;
constexpr size_t WS_CD = WS_ST + 64 * MiB;
constexpr size_t WS_UPK = WS_CD + 1 * MiB;
constexpr size_t WS_WPK = WS_UPK + 32 * MiB;
constexpr size_t WS_YA = WS_WPK + 32 * MiB;
constexpr size_t WS_YB = WS_YA + 32 * MiB, WS_YM = WS_YB + 32 * MiB;
constexpr size_t WS_MF = WS_YM + 32 * MiB;
constexpr size_t WS_MB = WS_MF + 128 * MiB;
constexpr size_t WS_TOKE = WS_MB + 64 * MiB;
constexpr size_t WS_TOKW = WS_TOKE + MiB / 2;
constexpr size_t WS_TOKS = WS_TOKW + MiB / 2;
constexpr size_t WS_SLOTW = WS_TOKS + MiB / 2;
constexpr size_t WS_CNT = WS_SLOTW + 1 * MiB;
constexpr size_t WS_META = WS_CNT + MiB / 4;
constexpr size_t WS_SLOTT = WS_META + MiB / 4;
constexpr size_t WS_END = WS_SLOTT + 1 * MiB;
static_assert(WS_END <= (size_t)2048 * MiB, "workspace map exceeds 2 GiB");
#ifndef NHELP
#define NHELP 3
#endif
#ifndef HLEAD
#define HLEAD 10
#endif
constexpr int CW_PROG = 16384;
constexpr int CW_BAR = 4096;

constexpr int LDS_BYTES = 159744;
constexpr int MISC_OFF = LDS_BYTES - 256;

#define GAS __attribute__((address_space(1)))
template <class Tp> __device__ __forceinline__ Tp* as_global(Tp* p) { GAS Tp* g = (GAS Tp*)p; asm("" : "+s"(g)); return (Tp*)g; }
#define LDS_WAIT() asm volatile("s_waitcnt lgkmcnt(0)" ::: "memory")
#define VM_WAIT() asm volatile("s_waitcnt vmcnt(0)" ::: "memory")
__device__ __forceinline__ unsigned cvt_pk_bf16(float lo, float hi) { unsigned r; asm volatile("v_cvt_pk_bf16_f32 %0, %1, %2" : "=v"(r) : "v"(lo), "v"(hi)); return r; }
__device__ __forceinline__ unsigned cvt_pk_bf16_n(float lo, float hi) { unsigned r; asm volatile("v_cvt_pk_bf16_f32 %0, %1, %2\n\ts_nop 1" : "=v"(r) : "v"(lo), "v"(hi)); return r; }
typedef __bf16 bf16x2_t __attribute__((ext_vector_type(2)));
__device__ __forceinline__ unsigned cvt_pk_nat(float lo, float hi) { bf16x2_t v; v[0] = (__bf16)lo; v[1] = (__bf16)hi; return __builtin_bit_cast(unsigned, v); }
__device__ __forceinline__ float bf_lo(unsigned w) { return __uint_as_float(w << 16); }
__device__ __forceinline__ float bf_hi(unsigned w) { return __uint_as_float(w & 0xffff0000u); }
__device__ __forceinline__ float fast_rcp(float x) { return __builtin_amdgcn_rcpf(x); }
__device__ __forceinline__ float sigmoidf_(float x) { return fast_rcp(1.0f + __expf(-x)); }
__device__ __forceinline__ float siluf_(float x) { return x * sigmoidf_(x); }
__device__ __forceinline__ float dpp_f(float v, int ctrl_sel) {
    const int s = __builtin_bit_cast(int, v); int r;
    if (ctrl_sel == 0) r = __builtin_amdgcn_update_dpp(0, s, 0xB1, 0xF, 0xF, true);
    else if (ctrl_sel == 1) r = __builtin_amdgcn_update_dpp(0, s, 0x4E, 0xF, 0xF, true);
    else if (ctrl_sel == 2) r = __builtin_amdgcn_update_dpp(0, s, 0x141, 0xF, 0xF, true);
    else r = __builtin_amdgcn_update_dpp(0, s, 0x140, 0xF, 0xF, true);
    return __builtin_bit_cast(float, r);
}
__device__ __forceinline__ float row16_sum(float v) {
    v += dpp_f(v, 0); v += dpp_f(v, 1); v += dpp_f(v, 2); v += dpp_f(v, 3); return v;
}
__device__ __forceinline__ float rdlane(float v, int l) { return __builtin_bit_cast(float, __builtin_amdgcn_readlane(__builtin_bit_cast(int, v), l)); }
__device__ __forceinline__ float wave_sum(float v) { v = row16_sum(v); return (rdlane(v, 0) + rdlane(v, 16)) + (rdlane(v, 32) + rdlane(v, 48)); }
__device__ __forceinline__ float bperm(float v, int src_lane) { return __builtin_bit_cast(float, __builtin_amdgcn_ds_bpermute(src_lane << 2, __builtin_bit_cast(int, v))); }

#define XB_TMO      128
#define XB_XCNT(j)  (256  + 64 * (j))
#define XB_XSUB(j)  (1280 + 64 * (j))
#define XB_XGEN(j)  (2304 + 64 * (j))
#define XB_TOP      3328
#define XB_TOPGEN   3392
#define XCD_BAR_WORDS 3456
#define XB_SPIN_CAP (1u << 18)
__device__ __forceinline__ unsigned xb_ld(unsigned* p)              { return __hip_atomic_load(p, __ATOMIC_RELAXED, __HIP_MEMORY_SCOPE_AGENT); }
__device__ __forceinline__ unsigned xb_add(unsigned* p, unsigned v) { return __hip_atomic_fetch_add(p, v, __ATOMIC_RELAXED, __HIP_MEMORY_SCOPE_AGENT); }
__device__ __forceinline__ unsigned xb_xcc_id() { return (unsigned)__builtin_amdgcn_s_getreg((3 << 11) | 20) & 0xFu; }
#define XB_SPIN(cond, bar) do { unsigned _sp = 0; while (cond) { __builtin_amdgcn_s_sleep(1); \
    if ((++_sp & 255u) == 0u) { if (xb_ld(&(bar)[XB_TMO])) break; if (_sp > XB_SPIN_CAP) { atomicAdd(&(bar)[XB_TMO], 1u); break; } } } } while (0)
struct XcdBarrier { unsigned* bar; unsigned x; volatile LAS unsigned* st; };
__device__ __forceinline__ XcdBarrier xcd_barrier_post(unsigned* bar, volatile LAS unsigned* st) {
    XcdBarrier b; b.bar = bar; b.x = xb_xcc_id(); b.st = st;
    if (threadIdx.x == 0) (void)xb_add(&bar[XB_XCNT(b.x)], 1u);
    return b;
}
__device__ __forceinline__ void xcd_barrier_complete(unsigned* bar, unsigned x, unsigned& nloc, unsigned& nx) {
    const unsigned G = gridDim.x * gridDim.y * gridDim.z;
    unsigned sum, cnt, mine, sp = 0u;
    for (;;) {
        sum = 0u; cnt = 0u; mine = 0u;
#pragma unroll
        for (unsigned j = 0; j < 16; ++j) { const unsigned c = xb_ld(&bar[XB_XCNT(j)]); sum += c; cnt += (c > 0u) ? 1u : 0u; mine = (j == x) ? c : mine; }
        if (sum == G) break;
        __builtin_amdgcn_s_sleep(1);
        if ((++sp & 255u) == 0u) { if (xb_ld(&bar[XB_TMO])) break; if (sp > XB_SPIN_CAP) { atomicAdd(&bar[XB_TMO], 1u); break; } }
    }
    nloc = mine > 0u ? mine : 1u; nx = cnt > 0u ? cnt : 1u;
}
__device__ __forceinline__ void xcd_barrier(const XcdBarrier& b) {
    asm volatile("s_waitcnt vmcnt(0)" ::: "memory");
    __syncthreads();
    if (threadIdx.x == 0) {
        unsigned* bar = b.bar;
        __builtin_amdgcn_s_waitcnt(0);
        unsigned nloc = b.st[0], nx = b.st[1];
        if (nloc == 0u) { xcd_barrier_complete(bar, b.x, nloc, nx); b.st[0] = nloc; b.st[1] = nx; }
        const unsigned old = xb_add(&bar[XB_XSUB(b.x)], 1u);
        const unsigned gen = old / nloc;
        if (old + 1u == (gen + 1u) * nloc) {
            __builtin_amdgcn_fence(__ATOMIC_RELEASE, "agent");
            asm volatile("s_waitcnt vmcnt(0)" ::: "memory");
            const unsigned og = xb_add(&bar[XB_TOP], 1u);
            const unsigned tg = og / nx;
            if (og + 1u == (tg + 1u) * nx) xb_add(&bar[XB_TOPGEN], 1u);
            else XB_SPIN(xb_ld(&bar[XB_TOPGEN]) == tg, bar);
            __builtin_amdgcn_fence(__ATOMIC_ACQUIRE, "agent");
            xb_add(&bar[XB_XGEN(b.x)], 1u);
            asm volatile("s_waitcnt vmcnt(0)" ::: "memory");
        } else {
            XB_SPIN(xb_ld(&bar[XB_XGEN(b.x)]) == gen, bar);
            __builtin_amdgcn_fence(__ATOMIC_ACQUIRE, "agent");
            asm volatile("s_waitcnt vmcnt(0)" ::: "memory");
        }
    }
    __syncthreads();
}

namespace pg8 {
constexpr int BM = 256, BK = 64, HALF = 128, HTB = HALF * BK * 2, STAGE_BYTES = 8 * HTB, NXCD = 8, WGM = 8;
__host__ __device__ __forceinline__ int lds_byte(int r, int c) { const int st = (r >> 4) * 2 + (c >> 5), rr = r & 15, cc = c & 31, ob = rr * 64 + cc * 2; return st * 1024 + (ob ^ (((ob >> 9) & 1) << 5)); }
__host__ __device__ __forceinline__ void stage_rc(int b, int& R, int& C) { const int st = b / 1024, sb = b % 1024, swz = sb ^ (((sb >> 9) & 1) << 5); R = (st >> 1) * 16 + swz / 64; C = (st & 1) * 32 + (swz % 64) / 2; }
__host__ __device__ __forceinline__ int perm32(int rho) { const int n = rho >> 4, i = rho & 15; return 8 * (i >> 2) + 4 * n + (i & 3); }

struct Unit { int pm, pn, e; const char* a; const char* b; };

__device__ __forceinline__ void tile_map(int L, int nM, int nN, int& pm, int& pn) {
    const int nwg = nM * nN; int wgid = L;
    { const int q = nwg / NXCD, r = nwg % NXCD, xcd = wgid % NXCD, off = wgid / NXCD; wgid = (xcd < r ? xcd * (q + 1) : r * (q + 1) + (xcd - r) * q) + off; }
    const int nig = WGM * nN, gid = wgid / nig, fm = gid * WGM, gsz = (nM - fm) < WGM ? (nM - fm) : WGM;
    pm = fm + ((wgid % nig) % gsz); pn = (wgid % nig) / gsz;
}
struct SchedDense {
    const char* A; const char* B; int nM, nN, G, c; size_t tstep;
    __device__ __forceinline__ bool next(int i, Unit& u) const {
        const long L = (long)i * G + c; if (L >= (long)nM * nN) return false;
        tile_map((int)L, nM, nN, u.pm, u.pn); u.e = 0; u.a = A + (size_t)u.pm * tstep; u.b = B + (size_t)u.pn * tstep; return true; }
    __device__ __forceinline__ int row_of(int, int) const { return 0; }
};
struct SchedBranch {
    const char* A0; const char* A1; const char* A2; const char* B; size_t bstride; int nM, nN, G, c, nb, b0, b1; size_t tstep; int nmax = 1 << 30;
    __device__ __forceinline__ bool next(int i, Unit& u) const {
        const int nwg = nM * nN, j = i % nb; const long Lr = (long)(i / nb) * G + c; if (Lr >= nwg || i / nb >= nmax) return false;
        const int br = (j == 0) ? b0 : b1;
        tile_map((int)Lr, nM, nN, u.pm, u.pn); u.e = br; u.a = (br == 0 ? A0 : (br == 1 ? A1 : A2)) + (size_t)u.pm * tstep; u.b = B + (size_t)br * bstride + (size_t)u.pn * tstep; return true; }
    __device__ __forceinline__ int row_of(int, int) const { return 0; }
};
struct SchedGrouped {
    const char* A; const char* B; size_t estride; const int* tile_e; int nM, nN, G, c; size_t tstep; const int* rows;
    __device__ __forceinline__ bool next(int i, Unit& u) const {
        const long L = (long)i * G + c; if (L >= (long)nM * nN) return false;
        tile_map((int)L, nM, nN, u.pm, u.pn); u.e = __builtin_amdgcn_readfirstlane(tile_e[u.pm]); u.a = rows ? A : A + (size_t)u.pm * tstep; u.b = B + (size_t)u.e * estride + (size_t)u.pn * tstep; return true; }
    __device__ __forceinline__ int row_of(int pm, int r) const { return rows[pm * BM + r]; }
};
struct EpiStoreBf16 {
    static constexpr bool PERM = true;
    bf16* O; int ldc;
    __device__ __forceinline__ void operator()(const f32x4 (&acc)[2][2][4][2], const Unit& u, int wr, int wc, int fr, int fq) const {
        const int row0 = u.pm * BM + wr * 64 + fr, col0 = u.pn * BM + wc * 32 + 8 * fq;
#pragma unroll
        for (int ai = 0; ai < 2; ++ai)
#pragma unroll
            for (int m = 0; m < 4; ++m) { bf16* rowp = O + (size_t)(row0 + ai * HALF + m * 16) * ldc + col0;
#pragma unroll
                for (int bj = 0; bj < 2; ++bj) { const f32x4 v0 = acc[ai][bj][m][0], v1 = acc[ai][bj][m][1];
                    v4u w; w.x = cvt_pk_bf16(v0[0], v0[1]); w.y = cvt_pk_bf16(v0[2], v0[3]); w.z = cvt_pk_bf16(v1[0], v1[1]); w.w = cvt_pk_bf16(v1[2], v1[3]);
                    *(v4u*)(rowp + bj * HALF) = w; } }
    }
};
struct EpiKV {
    static constexpr bool PERM = true;
    bf16* K; bf16* VT;
    __device__ __forceinline__ void operator()(const f32x4 (&acc)[2][2][4][2], const Unit& u, int wr, int wc, int fr, int fq) const {
        const int row0 = wr * 64 + fr, colt = u.pn * BM + wc * 32 + 8 * fq;
#pragma unroll
        for (int ai = 0; ai < 2; ++ai)
#pragma unroll
            for (int m = 0; m < 4; ++m) { const int key = row0 + ai * HALF + m * 16;
#pragma unroll
                for (int bj = 0; bj < 2; ++bj) { const f32x4 v0 = acc[ai][bj][m][0], v1 = acc[ai][bj][m][1]; const int col = colt + bj * HALF;
                    v4u w; w.x = cvt_pk_bf16(v0[0], v0[1]); w.y = cvt_pk_bf16(v0[2], v0[3]); w.z = cvt_pk_bf16(v1[0], v1[1]); w.w = cvt_pk_bf16(v1[2], v1[3]);
                    if (u.pn < 2) *(v4u*)(K + (size_t)(u.pm * BM + key) * 512 + col) = w;
                    else { bf16* d = VT + ((size_t)u.pm * 512 + (col - 512)) * 256 + key;
                        d[0] = (bf16)(w.x & 0xffff); d[256] = (bf16)(w.x >> 16); d[512] = (bf16)(w.y & 0xffff); d[768] = (bf16)(w.y >> 16);
                        d[1024] = (bf16)(w.z & 0xffff); d[1280] = (bf16)(w.z >> 16); d[1536] = (bf16)(w.w & 0xffff); d[1792] = (bf16)(w.w >> 16); } } }
    }
};
struct EpiBranch {
    static constexpr bool PERM = true;
    const bf16* proj; bf16* mb; int store_br;
    __device__ __forceinline__ void operator()(const f32x4 (&acc)[2][2][4][2], const Unit& u, int wr, int wc, int fr, int fq) const {
        const int row0 = u.pm * BM + wr * 64 + fr, col0 = u.pn * BM + wc * 32 + 8 * fq; const int br = u.e; const bool accum = (br != store_br);
        const bf16* gp = proj + (size_t)row0 * NPROJ + C_GL + br * D + col0; bf16* mp = mb + (size_t)row0 * D + col0;
#pragma unroll
        for (int ai = 0; ai < 2; ++ai) {
            v4u gw[4][2], ow[4][2];
#pragma unroll
            for (int m = 0; m < 4; ++m)
#pragma unroll
                for (int bj = 0; bj < 2; ++bj) { const size_t ro = (size_t)(ai * HALF + m * 16); const int co = bj * HALF;
                    gw[m][bj] = *(const v4u*)(gp + ro * NPROJ + co); ow[m][bj] = accum ? *(const v4u*)(mp + ro * D + co) : (v4u){0u, 0u, 0u, 0u}; }
#pragma unroll
            for (int m = 0; m < 4; ++m)
#pragma unroll
                for (int bj = 0; bj < 2; ++bj) { const size_t ro = (size_t)(ai * HALF + m * 16); const int co = bj * HALF; const v4u g4 = gw[m][bj], o = ow[m][bj];
                    const f32x4 a0 = acc[ai][bj][m][0], a1 = acc[ai][bj][m][1];
                    v4u w;
                    w.x = cvt_pk_bf16(sigmoidf_(bf_lo(g4.x)) * a0[0] + bf_lo(o.x), sigmoidf_(bf_hi(g4.x)) * a0[1] + bf_hi(o.x));
                    w.y = cvt_pk_bf16(sigmoidf_(bf_lo(g4.y)) * a0[2] + bf_lo(o.y), sigmoidf_(bf_hi(g4.y)) * a0[3] + bf_hi(o.y));
                    w.z = cvt_pk_bf16(sigmoidf_(bf_lo(g4.z)) * a1[0] + bf_lo(o.z), sigmoidf_(bf_hi(g4.z)) * a1[1] + bf_hi(o.z));
                    w.w = cvt_pk_bf16(sigmoidf_(bf_lo(g4.w)) * a1[2] + bf_lo(o.w), sigmoidf_(bf_hi(g4.w)) * a1[3] + bf_hi(o.w));
                    *(v4u*)(mp + ro * D + co) = w; }
        }
    }
};
struct EpiOut {
    static constexpr bool PERM = true;
    const bf16* hb; bf16* tb;
    __device__ __forceinline__ void operator()(const f32x4 (&acc)[2][2][4][2], const Unit& u, int wr, int wc, int fr, int fq) const {
        const int row0 = u.pm * BM + wr * 64 + fr, col0 = u.pn * BM + wc * 32 + 8 * fq;
        const bf16* hp = hb + (size_t)row0 * D + col0; bf16* tp = tb + (size_t)row0 * D + col0;
#pragma unroll
        for (int ai = 0; ai < 2; ++ai) {
            v4u hw[4][2];
#pragma unroll
            for (int m = 0; m < 4; ++m)
#pragma unroll
                for (int bj = 0; bj < 2; ++bj) hw[m][bj] = *(const v4u*)(hp + (size_t)(ai * HALF + m * 16) * D + bj * HALF);
#pragma unroll
            for (int m = 0; m < 4; ++m)
#pragma unroll
                for (int bj = 0; bj < 2; ++bj) { const v4u h = hw[m][bj]; const f32x4 a0 = acc[ai][bj][m][0], a1 = acc[ai][bj][m][1];
                    v4u w; w.x = cvt_pk_bf16(bf_lo(h.x) * ALPHA + a0[0], bf_hi(h.x) * ALPHA + a0[1]); w.y = cvt_pk_bf16(bf_lo(h.y) * ALPHA + a0[2], bf_hi(h.y) * ALPHA + a0[3]);
                    w.z = cvt_pk_bf16(bf_lo(h.z) * ALPHA + a1[0], bf_hi(h.z) * ALPHA + a1[1]); w.w = cvt_pk_bf16(bf_lo(h.w) * ALPHA + a1[2], bf_hi(h.w) * ALPHA + a1[3]);
                    *(v4u*)(tp + (size_t)(ai * HALF + m * 16) * D + bj * HALF) = w; }
        }
    }
};
struct EpiSwiglu {
    static constexpr bool PERM = true;
    bf16* H; const float* bgu;
    __device__ __forceinline__ void operator()(const f32x4 (&acc)[2][2][4][2], const Unit& u, int wr, int wc, int fr, int fq) const {
        const int row0 = u.pm * BM + wr * 64 + fr, cc0 = u.pn * HALF + wc * 32 + 8 * fq;
        const float* bg = bgu + (size_t)u.e * 2048 + cc0;
        f32x4 bgv[2], buv[2];
#pragma unroll
        for (int n = 0; n < 2; ++n) { bgv[n] = *(const f32x4*)(bg + 4 * n); buv[n] = *(const f32x4*)(bg + 1024 + 4 * n); }
#pragma unroll
        for (int ai = 0; ai < 2; ++ai)
#pragma unroll
            for (int m = 0; m < 4; ++m) { float h[8];
#pragma unroll
                for (int n = 0; n < 2; ++n)
#pragma unroll
                    for (int j = 0; j < 4; ++j) { float g = acc[ai][0][m][n][j] + bgv[n][j], up = acc[ai][1][m][n][j] + buv[n][j];
                        g = fminf(g, 7.0f); up = fminf(fmaxf(up, -7.0f), 7.0f);
                        h[n * 4 + j] = (up + 1.0f) * (g * sigmoidf_(g * 1.702f)); }
                v4u w; w.x = cvt_pk_bf16(h[0], h[1]); w.y = cvt_pk_bf16(h[2], h[3]); w.z = cvt_pk_bf16(h[4], h[5]); w.w = cvt_pk_bf16(h[6], h[7]);
                *(v4u*)(H + (size_t)(row0 + ai * HALF + m * 16) * DFF + cc0) = w; }
    }
};
struct EpiDown {
    static constexpr bool PERM = true;
    bf16* Y; const float* bd; const float* slot_w;
    __device__ __forceinline__ void operator()(const f32x4 (&acc)[2][2][4][2], const Unit& u, int wr, int wc, int fr, int fq) const {
        const int row0 = u.pm * BM + wr * 64 + fr, col0 = u.pn * BM + wc * 32 + 8 * fq;
        const float* bp = bd + (size_t)u.e * D + col0;
        f32x4 bv[2][2];
#pragma unroll
        for (int bj = 0; bj < 2; ++bj)
#pragma unroll
            for (int n = 0; n < 2; ++n) bv[bj][n] = *(const f32x4*)(bp + bj * HALF + 4 * n);
#pragma unroll
        for (int ai = 0; ai < 2; ++ai)
#pragma unroll
            for (int m = 0; m < 4; ++m) { const int row = row0 + ai * HALF + m * 16; const float sw = slot_w[row]; bf16* rowp = Y + (size_t)row * D + col0;
#pragma unroll
                for (int bj = 0; bj < 2; ++bj) { const f32x4 v0 = (acc[ai][bj][m][0] + bv[bj][0]) * sw, v1 = (acc[ai][bj][m][1] + bv[bj][1]) * sw;
                    v4u w; w.x = cvt_pk_bf16(v0[0], v0[1]); w.y = cvt_pk_bf16(v0[2], v0[3]); w.z = cvt_pk_bf16(v1[0], v1[1]); w.w = cvt_pk_bf16(v1[2], v1[3]);
                    *(v4u*)(rowp + bj * HALF) = w; } }
    }
};

template <class Epi, class Sched, bool ALIGN_EPI, bool SP2, bool GATHER = false>
__device__ __forceinline__ void gemm_phase(LAS unsigned char* lds, const int K, const Sched& S, const Epi& E, int wave_id) {
    unsigned z0_ = 0u; asm volatile("" : "+s"(z0_)); int ln_ = (int)__builtin_amdgcn_mbcnt_hi(~0u, __builtin_amdgcn_mbcnt_lo(~0u, z0_)); asm volatile("" : "+v"(ln_)); asm volatile("" : "+s"(wave_id));
    const int wid = wave_id, lane = ln_, tid = wid * 64 + lane, wr = wid >> 2, wc = wid & 3, fr = lane & 15, fq = lane >> 4;
    const int nt = K / BK;
    static_assert(!GATHER || SP2, "row gather is written for the two-super-phase loop");
    unsigned voffA[2], voffB[2], gC[2]; int gR[2];
    unsigned vAc[2][2], vAn[2][2];
#define PG8_ROWS(dst, pm_) do { _Pragma("unroll") for (int h_ = 0; h_ < 2; ++h_) _Pragma("unroll") for (int i_ = 0; i_ < 2; ++i_) dst[h_][i_] = (unsigned)S.row_of(pm_, h_ * HALF + gR[i_]) * (unsigned)(K * 2) + gC[i_]; } while (0)
#define PG8_STAGE_A(bufoff, gbase, h, OFF) do { if constexpr (GATHER) { PG8_STAGE(bufoff, gbase, OFF[h]); } else { PG8_STAGE(bufoff, (gbase) + (h) * hstep, voffA); } } while (0)
#pragma unroll
    for (int i = 0; i < 2; ++i) { int R, C; stage_rc(tid * 16 + i * 8192, R, C); const int Rb = Epi::PERM ? ((R & ~31) + perm32(R & 31)) : R;
        voffA[i] = (unsigned)(R * K + C) * 2u; voffB[i] = (unsigned)(Rb * K + C) * 2u; gR[i] = R; gC[i] = (unsigned)C * 2u; }
    const size_t kstep = (size_t)(BK * 2);
    const size_t hstep = (size_t)HALF * K * 2;
    const unsigned ldsw = (unsigned)wid * 1024u;
    const int aoff = lds_byte(wr * 64 + fr, fq * 8), boff = lds_byte(wc * 32 + fr, fq * 8);
#define PG8_SA(b, h) (((b) * 2 + (h)) * HTB)
#define PG8_SB(b, h) ((4 + (b) * 2 + (h)) * HTB)
#define PG8_STAGE(bufoff, gbase, voff) do { _Pragma("unroll") for (int _i = 0; _i < 2; ++_i) \
        __builtin_amdgcn_global_load_lds((const unsigned*)((const char*)(gbase) + (voff)[_i]), (LAS unsigned*)(lds + (bufoff) + ldsw + _i * 8192), 16, 0, 0); } while (0)
#define PG8_LDA(dst, b, h) do { _Pragma("unroll") for (int m = 0; m < 4; ++m) _Pragma("unroll") for (int k = 0; k < 2; ++k) dst[m][k] = *(const LAS bf16x8*)(lds + PG8_SA(b, h) + aoff + m * 2048 + k * 1024); } while (0)
#define PG8_LDB(dst, b, h) do { _Pragma("unroll") for (int n = 0; n < 2; ++n) _Pragma("unroll") for (int k = 0; k < 2; ++k) dst[n][k] = *(const LAS bf16x8*)(lds + PG8_SB(b, h) + boff + n * 2048 + k * 1024); } while (0)
#define PG8_MMA(ai, bj, At, Bt) do { __builtin_amdgcn_s_setprio(1); _Pragma("unroll") for (int m = 0; m < 4; ++m) _Pragma("unroll") for (int n = 0; n < 2; ++n) _Pragma("unroll") for (int k = 0; k < 2; ++k) \
        acc[ai][bj][m][n] = __builtin_amdgcn_mfma_f32_16x16x32_bf16(Bt[n][k], At[m][k], acc[ai][bj][m][n], 0, 0, 0); __builtin_amdgcn_s_setprio(0); } while (0)
#define PG8_WAIT_V(n) asm volatile("s_waitcnt vmcnt(" #n ")" ::: "memory")
#define PG8_WAIT_L(n) asm volatile("s_waitcnt lgkmcnt(" #n ")" ::: "memory")
#define PG8_BAR __builtin_amdgcn_s_barrier()
#define PG8_SCHED __builtin_amdgcn_sched_barrier(0)
    Unit cur, nxt; int ui = 0;
    if (!S.next(0, cur)) return;
    f32x4 acc[2][2][4][2];
#pragma unroll
    for (int a = 0; a < 2; ++a)
#pragma unroll
        for (int b = 0; b < 2; ++b)
#pragma unroll
            for (int m = 0; m < 4; ++m)
#pragma unroll
                for (int n = 0; n < 2; ++n) acc[a][b][m][n] = (f32x4){0.f, 0.f, 0.f, 0.f};
    bf16x8 At[4][2], B0[2][2], B1[2][2];
    const char* cA = cur.a; const char* cB = cur.b;
    if constexpr (SP2) {
        if constexpr (GATHER) { PG8_ROWS(vAc, cur.pm); asm volatile("s_waitcnt vmcnt(0)" ::: "memory"); }
        PG8_STAGE(PG8_SB(0, 0), cB, voffB); PG8_STAGE(PG8_SB(0, 1), cB + hstep, voffB); PG8_STAGE_A(PG8_SA(0, 0), cA, 0, vAc); PG8_STAGE_A(PG8_SA(0, 1), cA, 1, vAc);
        if (wr == 1) PG8_BAR;
        PG8_WAIT_V(2); PG8_BAR;
        PG8_STAGE(PG8_SB(1, 0), cB + kstep, voffB); PG8_STAGE_A(PG8_SA(1, 0), cA + kstep, 0, vAc); PG8_STAGE(PG8_SB(1, 1), cB + hstep + kstep, voffB);
        PG8_WAIT_V(6); PG8_BAR;
    } else {
        PG8_STAGE(PG8_SB(0, 0), cB, voffB); PG8_STAGE(PG8_SA(0, 0), cA, voffA); PG8_STAGE(PG8_SB(0, 1), cB + hstep, voffB); PG8_STAGE(PG8_SA(0, 1), cA + hstep, voffA);
        if (wr == 1) PG8_BAR;
        PG8_WAIT_V(4); PG8_BAR;
        PG8_STAGE(PG8_SB(1, 0), cB + kstep, voffB); PG8_STAGE(PG8_SA(1, 0), cA + kstep, voffA); PG8_STAGE(PG8_SB(1, 1), cB + hstep + kstep, voffB);
        PG8_WAIT_V(6); PG8_BAR;
    }
    for (;;) {
        const bool has_next = S.next(ui + 1, nxt);
        const char* nA = has_next ? nxt.a : cA; const char* nB = has_next ? nxt.b : cB;
        if constexpr (GATHER) { if (ui == 0) { if (has_next) PG8_ROWS(vAn, nxt.pm); else { _Pragma("unroll") for (int h_ = 0; h_ < 2; ++h_) _Pragma("unroll") for (int i_ = 0; i_ < 2; ++i_) vAn[h_][i_] = vAc[h_][i_]; } } }
        for (int t = 0; t < nt; t += 2) {
            const bool last = (t == nt - 2);
            const char* a1 = cA + (size_t)(t + 1) * kstep;
            const char* a2 = last ? nA : cA + (size_t)(t + 2) * kstep; const char* b2 = last ? nB : cB + (size_t)(t + 2) * kstep;
            const char* a3 = a2 + kstep; const char* b3 = b2 + kstep;
            if constexpr (SP2) {
            unsigned o2[2][2];
            if constexpr (GATHER) { _Pragma("unroll") for (int h_ = 0; h_ < 2; ++h_) _Pragma("unroll") for (int i_ = 0; i_ < 2; ++i_) o2[h_][i_] = last ? vAn[h_][i_] : vAc[h_][i_]; }
            PG8_LDB(B0, 0, 0); PG8_LDB(B1, 0, 1); PG8_SCHED; PG8_LDA(At, 0, 0); PG8_STAGE_A(PG8_SA(1, 1), a1, 1, vAc);
            PG8_WAIT_V(8); PG8_WAIT_L(0); PG8_BAR; PG8_MMA(0, 0, At, B0); PG8_MMA(0, 1, At, B1); PG8_BAR; PG8_SCHED;
            PG8_LDA(At, 0, 1); PG8_STAGE(PG8_SB(0, 0), b2, voffB); PG8_STAGE(PG8_SB(0, 1), b2 + hstep, voffB); PG8_STAGE_A(PG8_SA(0, 0), a2, 0, o2);
            PG8_WAIT_V(8); PG8_WAIT_L(0); PG8_BAR; PG8_MMA(1, 0, At, B0); PG8_MMA(1, 1, At, B1); PG8_BAR; PG8_SCHED;
            PG8_LDB(B0, 1, 0); PG8_LDB(B1, 1, 1); PG8_SCHED; PG8_LDA(At, 1, 0); PG8_STAGE_A(PG8_SA(0, 1), a2, 1, o2);
            PG8_WAIT_V(8); PG8_WAIT_L(0); PG8_BAR; PG8_MMA(0, 0, At, B0); PG8_MMA(0, 1, At, B1); PG8_BAR; PG8_SCHED;
            PG8_LDA(At, 1, 1); PG8_STAGE(PG8_SB(1, 0), b3, voffB); PG8_STAGE(PG8_SB(1, 1), b3 + hstep, voffB); PG8_STAGE_A(PG8_SA(1, 0), a3, 0, o2);
            PG8_WAIT_V(8); PG8_WAIT_L(0); PG8_BAR; PG8_MMA(1, 0, At, B0); PG8_MMA(1, 1, At, B1); PG8_BAR; PG8_SCHED;
            } else {
            PG8_LDB(B0, 0, 0); PG8_SCHED; PG8_LDA(At, 0, 0); PG8_STAGE(PG8_SA(1, 1), a1 + hstep, voffA);
            PG8_WAIT_L(8); PG8_BAR; PG8_WAIT_L(0); PG8_MMA(0, 0, At, B0); PG8_BAR; PG8_SCHED;
            PG8_LDB(B1, 0, 1); PG8_STAGE(PG8_SB(0, 0), b2, voffB);
            PG8_BAR; PG8_WAIT_L(0); PG8_MMA(0, 1, At, B1); PG8_BAR;
            PG8_LDA(At, 0, 1); PG8_STAGE(PG8_SA(0, 0), a2, voffA);
            PG8_BAR; PG8_WAIT_L(0); PG8_MMA(1, 0, At, B0); PG8_BAR; PG8_SCHED;
            PG8_STAGE(PG8_SB(0, 1), b2 + hstep, voffB);
            PG8_WAIT_V(6); PG8_BAR; PG8_MMA(1, 1, At, B1); PG8_BAR;
            PG8_LDB(B0, 1, 0); PG8_SCHED; PG8_LDA(At, 1, 0); PG8_STAGE(PG8_SA(0, 1), a2 + hstep, voffA);
            PG8_WAIT_L(8); PG8_BAR; PG8_WAIT_L(0); PG8_MMA(0, 0, At, B0); PG8_BAR; PG8_SCHED;
            PG8_LDB(B1, 1, 1); PG8_STAGE(PG8_SB(1, 0), b3, voffB);
            PG8_BAR; PG8_WAIT_L(0); PG8_MMA(0, 1, At, B1); PG8_BAR;
            PG8_LDA(At, 1, 1); PG8_STAGE(PG8_SA(1, 0), a3, voffA);
            PG8_BAR; PG8_WAIT_L(0); PG8_MMA(1, 0, At, B0); PG8_BAR; PG8_SCHED;
            PG8_STAGE(PG8_SB(1, 1), b3 + hstep, voffB);
            PG8_WAIT_V(6); PG8_BAR; PG8_MMA(1, 1, At, B1); PG8_BAR;
            }
        }
        if constexpr (ALIGN_EPI) { if (wr == 0) PG8_BAR; }
        E(acc, cur, wr, wc, fr, fq);
        if (!has_next) break;
#pragma unroll
        for (int a = 0; a < 2; ++a)
#pragma unroll
            for (int b = 0; b < 2; ++b)
#pragma unroll
                for (int m = 0; m < 4; ++m)
#pragma unroll
                    for (int n = 0; n < 2; ++n) acc[a][b][m][n] = (f32x4){0.f, 0.f, 0.f, 0.f};
        if constexpr (GATHER) { _Pragma("unroll") for (int h_ = 0; h_ < 2; ++h_) _Pragma("unroll") for (int i_ = 0; i_ < 2; ++i_) vAc[h_][i_] = vAn[h_][i_];
            Unit nn; if (S.next(ui + 2, nn)) PG8_ROWS(vAn, nn.pm); }
        cur = nxt; cA = nA; cB = nB; ++ui;
        if constexpr (ALIGN_EPI) { if (wr == 1) PG8_BAR; }
    }
    PG8_WAIT_V(0);
    if constexpr (!ALIGN_EPI) { if (wr == 0) PG8_BAR; }
    PG8_BAR;
#undef PG8_ROWS
#undef PG8_STAGE_A
#undef PG8_SA
#undef PG8_SB
#undef PG8_STAGE
#undef PG8_LDA
#undef PG8_LDB
#undef PG8_MMA
#undef PG8_WAIT_V
#undef PG8_WAIT_L
#undef PG8_BAR
#undef PG8_SCHED
}
}

struct Args { const float* in[23]; float* out; unsigned char* ws; int ph_lo, ph_hi; };
struct Ctx {
    LAS unsigned char* lds; int tid, lane, wave, G, bid;
    const float* const* in; float* out; unsigned char* ws;
};
__device__ __forceinline__ Ctx fresh(const Ctx& F) {
    Ctx R = F; unsigned z0 = 0u; asm volatile("" : "+s"(z0)); int ln = (int)__builtin_amdgcn_mbcnt_hi(~0u, __builtin_amdgcn_mbcnt_lo(~0u, z0)); asm volatile("" : "+v"(ln));
    int wv = F.wave; asm volatile("" : "+s"(wv)); R.wave = wv; R.lane = ln; R.tid = wv * 64 + ln;
    unsigned char* w = F.ws; asm volatile("" : "+s"(w)); R.ws = as_global(w); R.out = as_global(F.out);
    int bd = F.bid, gg = F.G; asm volatile("" : "+s"(bd)); asm volatile("" : "+s"(gg)); R.bid = bd; R.G = gg;
    return R;
}
enum { I_X = 0, I_MEM, I_LN0G, I_LN0B, I_WIN, I_CONVQKV, I_CONVMIX, I_ALOG, I_DTB, I_GDNNORM, I_WMEMKV, I_WBR, I_WO, I_LN1G, I_LN1B, I_WR, I_BR, I_WGU, I_BGU, I_WD, I_BD, I_LN2G, I_LN2B };

__device__ __forceinline__ void transpose_item(const float* src, int ld, bf16* dst, int ldk, LAS float* scr, int lane) {
#pragma unroll 8
    for (int i = 0; i < 32; ++i) { const int kk = 2 * i + (lane >> 5); scr[kk * 33 + (lane & 31)] = src[(size_t)kk * ld + (lane & 31)]; }
    LDS_WAIT();
    const int c = lane & 7;
#pragma unroll
    for (int j = 0; j < 4; ++j) { const int n = (lane >> 3) + 8 * j; const LAS float* s = scr + (8 * c) * 33 + n;
        v4u o; o.x = cvt_pk_bf16(s[0 * 33], s[1 * 33]); o.y = cvt_pk_bf16(s[2 * 33], s[3 * 33]); o.z = cvt_pk_bf16(s[4 * 33], s[5 * 33]); o.w = cvt_pk_bf16(s[6 * 33], s[7 * 33]);
        *(v4u*)(dst + (size_t)n * ldk + 8 * c) = o; }
    LDS_WAIT();
}
__device__ __forceinline__ void ln_apply(f32x4 (&v)[4], const float* g, const float* b, int lane) {
    float s = 0.f;
#pragma unroll
    for (int j = 0; j < 4; ++j) s += (v[j][0] + v[j][1]) + (v[j][2] + v[j][3]);
    const float mean = wave_sum(s) * (1.f / D); float s2 = 0.f;
#pragma unroll
    for (int j = 0; j < 4; ++j) { v[j] = v[j] - mean; s2 += (v[j][0] * v[j][0] + v[j][1] * v[j][1]) + (v[j][2] * v[j][2] + v[j][3] * v[j][3]); }
    const float rstd = 1.f / sqrtf(wave_sum(s2) * (1.f / D) + LN_EPS);
#pragma unroll
    for (int j = 0; j < 4; ++j) { const f32x4 gg = *(const f32x4*)(g + 4 * lane + 256 * j), bb = *(const f32x4*)(b + 4 * lane + 256 * j); v[j] = v[j] * rstd * gg + bb; }
}
__device__ __forceinline__ void load_row_bf16(const bf16* p, f32x4 (&v)[4], int lane) {
#pragma unroll
    for (int j = 0; j < 4; ++j) { const v2u w = *(const v2u*)(p + 4 * lane + 256 * j); v[j] = (f32x4){bf_lo(w.x), bf_hi(w.x), bf_lo(w.y), bf_hi(w.y)}; }
}
__device__ __forceinline__ void store_row_f32(float* p, const f32x4 (&v)[4], int lane) {
#pragma unroll
    for (int j = 0; j < 4; ++j) *(f32x4*)(p + 4 * lane + 256 * j) = v[j];
}
__device__ __forceinline__ void store_row_bf16(bf16* p, const f32x4 (&v)[4], int lane) {
#pragma unroll
    for (int j = 0; j < 4; ++j) { v2u w; w.x = cvt_pk_bf16(v[j][0], v[j][1]); w.y = cvt_pk_bf16(v[j][2], v[j][3]); *(v2u*)(p + 4 * lane + 256 * j) = w; }
}
__device__ __forceinline__ void small_proj(const f32x4 (&v)[4], const LAS float* ws_s, float* ab_row, int lane) {
    float keep = 0.f;
#pragma unroll
    for (int c = 0; c < 8; ++c) { float p = 0.f;
#pragma unroll
        for (int j = 0; j < 4; ++j) { const f32x4 w = *(const LAS f32x4*)(ws_s + c * 1024 + 4 * lane + 256 * j); p += (v[j][0] * w[0] + v[j][1] * w[1]) + (v[j][2] * w[2] + v[j][3] * w[3]); }
        p = wave_sum(p); keep = (lane == c) ? p : keep; }
    if (lane < 8) ab_row[lane] = keep;
}
__device__ __forceinline__ void load_small_w(Ctx& F, int l, LAS float* ws_s) {
    const float* w = as_global(F.in[I_WIN]) + (size_t)l * D * NPROJ_SRC + 1536;
    for (int i = F.tid; i < 8 * 1024; i += 512) { const int k = i >> 3, c = i & 7; ws_s[c * 1024 + k] = w[(size_t)k * NPROJ_SRC + c]; }
}

constexpr int N_IN = 2 * 3584, N_BR = 6 * 256, N_O = 2 * 512, N_KV = 2 * 512, N_GU = 64 * 1024, N_D = 64 * 512;
constexpr int NITEMS = N_IN + N_BR + N_O + N_KV + N_GU + N_D;
#ifndef NDEF_PER_WAVE
#define NDEF_PER_WAVE 24
#endif
constexpr int NDEF = (256 - 32 - 8 * NHELP) * 8 * NDEF_PER_WAVE;
static_assert(NDEF <= N_GU + N_D, "deferred items must be MoE weights");
__device__ __forceinline__ void convert_items(Ctx& F, int first, int step, int begin, int end) {
    LAS float* scr = (LAS float*)(F.lds + F.wave * 8448);
    bf16* WinT = (bf16*)(F.ws + WS_WIN); bf16* WbrT = (bf16*)(F.ws + WS_WBR); bf16* WoT = (bf16*)(F.ws + WS_WO); bf16* WkvT = (bf16*)(F.ws + WS_WKV);
    bf16* WguT = (bf16*)(F.ws + WS_WGU); bf16* WdT = (bf16*)(F.ws + WS_WD);
    for (int it = begin + first; it < end; it += step) {
        int r = it;
        if (r < N_IN) { const int l = r / 3584, q = r % 3584, kb = q / 224, nb = q % 224, k0 = 64 * kb, n0 = 32 * nb, ns = n0 + (n0 >= 1536 ? 8 : 0);
            transpose_item(as_global(F.in[I_WIN]) + (size_t)l * D * NPROJ_SRC + (size_t)k0 * NPROJ_SRC + ns, NPROJ_SRC, WinT + (size_t)l * NPROJ * D + (size_t)n0 * D + k0, D, scr, F.lane); continue; }
        r -= N_IN;
        if (r < N_BR) { const int m = r / 256, q = r % 256, kb = q / 32, nb = q % 32, k0 = 64 * kb, n0 = 32 * nb;
            transpose_item(as_global(F.in[I_WBR]) + (size_t)m * 512 * D + (size_t)k0 * D + n0, D, WbrT + (size_t)m * D * 512 + (size_t)n0 * 512 + k0, 512, scr, F.lane); continue; }
        r -= N_BR;
        if (r < N_O) { const int l = r / 512, q = r % 512, kb = q / 32, nb = q % 32, k0 = 64 * kb, n0 = 32 * nb;
            transpose_item(as_global(F.in[I_WO]) + (size_t)l * D * D + (size_t)k0 * D + n0, D, WoT + (size_t)l * D * D + (size_t)n0 * D + k0, D, scr, F.lane); continue; }
        r -= N_O;
        if (r < N_KV) { const int l = r / 512, q = r % 512, kb = q / 32, nb = q % 32, k0 = 64 * kb, n0 = 32 * nb;
            transpose_item(as_global(F.in[I_WMEMKV]) + (size_t)l * D * D + (size_t)k0 * D + n0, D, WkvT + (size_t)l * D * D + (size_t)n0 * D + k0, D, scr, F.lane); continue; }
        r -= N_KV;
        if (r < N_GU) { const int m = r / 1024, q = r % 1024, kb = q / 64, nb = q % 64, k0 = 64 * kb, n0 = 32 * nb, jj = n0 / 256, r0 = n0 % 256;
            const int ns = (r0 < 128) ? (128 * jj + r0) : (1024 + 128 * jj + r0 - 128);
            transpose_item(as_global(F.in[I_WGU]) + (size_t)m * D * 2048 + (size_t)k0 * 2048 + ns, 2048, WguT + (size_t)m * 2048 * D + (size_t)n0 * D + k0, D, scr, F.lane); continue; }
        r -= N_GU;
        { const int m = r / 512, q = r % 512, kb = q / 32, nb = q % 32, k0 = 64 * kb, n0 = 32 * nb;
            transpose_item(as_global(F.in[I_WD]) + (size_t)m * D * D + (size_t)k0 * D + n0, D, WdT + (size_t)m * D * D + (size_t)n0 * D + k0, D, scr, F.lane); }
    }
}
__device__ __forceinline__ void convert_deferred(Ctx& F, int first, int step) {
    LAS float* scr = (LAS float*)(F.lds + F.wave * 8448);
    bf16* WguT = (bf16*)(F.ws + WS_WGU); bf16* WdT = (bf16*)(F.ws + WS_WD);
    for (int it = NITEMS - NDEF + first; it < NITEMS; it += step) {
        int r = it - (N_IN + N_BR + N_O + N_KV);
        if (r < N_GU) { const int m = r / 1024, q = r % 1024, kb = q / 64, nb = q % 64, k0 = 64 * kb, n0 = 32 * nb, jj = n0 / 256, r0 = n0 % 256;
            const int ns = (r0 < 128) ? (128 * jj + r0) : (1024 + 128 * jj + r0 - 128);
            transpose_item(as_global(F.in[I_WGU]) + (size_t)m * D * 2048 + (size_t)k0 * 2048 + ns, 2048, WguT + (size_t)m * 2048 * D + (size_t)n0 * D + k0, D, scr, F.lane); continue; }
        r -= N_GU;
        { const int m = r / 512, q = r % 512, kb = q / 32, nb = q % 32, k0 = 64 * kb, n0 = 32 * nb;
            transpose_item(as_global(F.in[I_WD]) + (size_t)m * D * D + (size_t)k0 * D + n0, D, WdT + (size_t)m * D * D + (size_t)n0 * D + k0, D, scr, F.lane); }
    }
}

__device__ __forceinline__ void phase_prologue(Ctx& F) {
    LAS float* ws_s = (LAS float*)(F.lds + 69632);
    const int gw = F.bid * 8 + F.wave, NGW = F.G * 8;
    convert_items(F, gw, NGW, 0, NITEMS - NDEF);
    { const f32x4* src = (const f32x4*)as_global(F.in[I_MEM]); v2u* dst = (v2u*)(F.ws + WS_MEMB);
      for (int i = F.bid * 512 + F.tid; i < NB * NMEM * D / 4; i += F.G * 512) { const f32x4 x = src[i]; v2u w; w.x = cvt_pk_bf16(x[0], x[1]); w.y = cvt_pk_bf16(x[2], x[3]); dst[i] = w; } }
    load_small_w(F, 0, ws_s);
    __syncthreads();
    bf16* hb = (bf16*)(F.ws + WS_HB); float* ab = (float*)(F.ws + WS_AB);
    for (int m = gw; m < NTOK; m += NGW) {
        f32x4 v[4]; const float* xr = as_global(F.in[I_X]) + (size_t)m * D;
#pragma unroll
        for (int j = 0; j < 4; ++j) v[j] = *(const f32x4*)(xr + 4 * F.lane + 256 * j);
        ln_apply(v, as_global(F.in[I_LN0G]), as_global(F.in[I_LN0B]), F.lane);
        store_row_bf16(hb + (size_t)m * D, v, F.lane);
        small_proj(v, ws_s, ab + (size_t)m * 8, F.lane);
    }
}

__device__ __forceinline__ void unpack8(const v4u x, float (&o)[8]) { o[0] = bf_lo(x.x); o[1] = bf_hi(x.x); o[2] = bf_lo(x.y); o[3] = bf_hi(x.y); o[4] = bf_lo(x.z); o[5] = bf_hi(x.z); o[6] = bf_lo(x.w); o[7] = bf_hi(x.w); }
__device__ __forceinline__ void conv4_silu(const v4u x0, const v4u x1, const v4u x2, const v4u x3, const LAS float* w  , float (&o)[8]) {
    float a[8], b[8], c[8], d[8]; unpack8(x0, a); unpack8(x1, b); unpack8(x2, c); unpack8(x3, d);
    const f32x4 w0l = *(const LAS f32x4*)(w), w0h = *(const LAS f32x4*)(w + 4), w1l = *(const LAS f32x4*)(w + 1536), w1h = *(const LAS f32x4*)(w + 1540);
    const f32x4 w2l = *(const LAS f32x4*)(w + 3072), w2h = *(const LAS f32x4*)(w + 3076), w3l = *(const LAS f32x4*)(w + 4608), w3h = *(const LAS f32x4*)(w + 4612);
#pragma unroll
    for (int i = 0; i < 8; ++i) { const float w0 = i < 4 ? w0l[i & 3] : w0h[i & 3], w1 = i < 4 ? w1l[i & 3] : w1h[i & 3], w2 = i < 4 ? w2l[i & 3] : w2h[i & 3], w3 = i < 4 ? w3l[i & 3] : w3h[i & 3];
        const float s = (w0 * a[i] + w1 * b[i]) + (w2 * c[i] + w3 * d[i]); o[i] = siluf_(s); }
}
__device__ __forceinline__ void phase_prep(Ctx& F, int l) {
    const bf16* proj = (const bf16*)(F.ws + WS_R1);
    LAS float* cw = (LAS float*)F.lds;
    LAS float* mw = (LAS float*)(F.lds + 4 * 1536 * 4);
    for (int i = F.tid; i < 4 * 1536; i += 512) cw[i] = as_global(F.in[I_CONVQKV])[(size_t)l * 4 * 1536 + i];
    for (int i = F.tid; i < 3 * 512; i += 512) mw[i] = as_global(F.in[I_CONVMIX])[(size_t)l * 3 * 512 + i];
    __syncthreads();
    const int lane = F.lane, c8 = lane * 8, hh = lane >> 4;
    bf16* qnb = (bf16*)(F.ws + WS_QN); bf16* knb = (bf16*)(F.ws + WS_KN); bf16* vvb = (bf16*)(F.ws + WS_VV); float* gs = (float*)(F.ws + WS_GS);
    const float* ab = (const float*)(F.ws + WS_AB); bf16* yb = (bf16*)(F.ws + WS_YB);
    const float Ah = __expf(as_global(F.in[I_ALOG])[l * 4 + hh]), dtb = as_global(F.in[I_DTB])[l * 4 + hh];
    const int gw = F.bid * 8 + F.wave, NGW = F.G * 8;
    for (int t0 = gw * 16; t0 < NTOK; t0 += NGW * 16) {
        const bool first = (t0 % T) == 0;
        const v4u z4 = {0u, 0u, 0u, 0u};
        v4u q0, q1, q2, k0, k1, k2, v0, v1, v2; float p0[8], p1[8];
        if (first) { q0 = q1 = q2 = k0 = k1 = k2 = v0 = v1 = v2 = z4;
#pragma unroll
            for (int i = 0; i < 8; ++i) { p0[i] = 0.f; p1[i] = 0.f; } }
        else {
            const bf16* r3 = proj + (size_t)(t0 - 3) * NPROJ + c8; const bf16* r2 = r3 + NPROJ; const bf16* r1 = r2 + NPROJ;
            q0 = *(const v4u*)(r3 + C_Q); q1 = *(const v4u*)(r2 + C_Q); q2 = *(const v4u*)(r1 + C_Q);
            k0 = *(const v4u*)(r3 + C_K); k1 = *(const v4u*)(r2 + C_K); k2 = *(const v4u*)(r1 + C_K);
            v0 = *(const v4u*)(r3 + C_V); v1 = *(const v4u*)(r2 + C_V); v2 = *(const v4u*)(r1 + C_V);
            float a[8], b[8]; unpack8(*(const v4u*)(r2 + C_XC), a); unpack8(*(const v4u*)(r2 + C_GC), b);
#pragma unroll
            for (int i = 0; i < 8; ++i) p0[i] = a[i] * b[i];
            unpack8(*(const v4u*)(r1 + C_XC), a); unpack8(*(const v4u*)(r1 + C_GC), b);
#pragma unroll
            for (int i = 0; i < 8; ++i) p1[i] = a[i] * b[i];
        }
        v4u nq, nk, nv, nxc, ngc, ngb; float na = 0.f, nbt = 0.f;
        { const bf16* rn = proj + (size_t)t0 * NPROJ + c8; nq = *(const v4u*)(rn + C_Q); nk = *(const v4u*)(rn + C_K); nv = *(const v4u*)(rn + C_V); nxc = *(const v4u*)(rn + C_XC); ngc = *(const v4u*)(rn + C_GC); ngb = *(const v4u*)(rn + C_GB);
          if ((lane & 15) == 0) { na = ab[(size_t)t0 * 8 + hh]; nbt = ab[(size_t)t0 * 8 + 4 + hh]; } }
        for (int i16 = 0; i16 < 16; ++i16) {
            const int tok = t0 + i16;
            const v4u q3 = nq, k3 = nk, v3 = nv, xc3 = nxc, gc3 = ngc, gb3 = ngb; const float a_in = na, bt_in = nbt;
            if (i16 < 15) { const bf16* rn = proj + (size_t)(tok + 1) * NPROJ + c8; nq = *(const v4u*)(rn + C_Q); nk = *(const v4u*)(rn + C_K); nv = *(const v4u*)(rn + C_V); nxc = *(const v4u*)(rn + C_XC); ngc = *(const v4u*)(rn + C_GC); ngb = *(const v4u*)(rn + C_GB);
                if ((lane & 15) == 0) { na = ab[(size_t)(tok + 1) * 8 + hh]; nbt = ab[(size_t)(tok + 1) * 8 + 4 + hh]; } }
            float qo[8], ko[8], vo[8];
            conv4_silu(q0, q1, q2, q3, cw + C_Q + c8, qo); conv4_silu(k0, k1, k2, k3, cw + C_K + c8, ko); conv4_silu(v0, v1, v2, v3, cw + C_V + c8, vo);
            q0 = q1; q1 = q2; q2 = q3; k0 = k1; k1 = k2; k2 = k3; v0 = v1; v1 = v2; v2 = v3;
            float sq = 0.f, sk = 0.f;
#pragma unroll
            for (int i = 0; i < 8; ++i) { sq += qo[i] * qo[i]; sk += ko[i] * ko[i]; }
            sq = row16_sum(sq); sk = row16_sum(sk);
            const float rq = (1.f / sqrtf(sq + RMS_EPS)) * 0.08838834764831845f, rk = 1.f / sqrtf(sk + RMS_EPS);
#pragma unroll
            for (int i = 0; i < 8; ++i) { qo[i] *= rq; ko[i] *= rk; }
            { v4u w; w.x = cvt_pk_bf16(qo[0], qo[1]); w.y = cvt_pk_bf16(qo[2], qo[3]); w.z = cvt_pk_bf16(qo[4], qo[5]); w.w = cvt_pk_bf16(qo[6], qo[7]); *(v4u*)(qnb + (size_t)tok * 512 + c8) = w; }
            { v4u w; w.x = cvt_pk_bf16(ko[0], ko[1]); w.y = cvt_pk_bf16(ko[2], ko[3]); w.z = cvt_pk_bf16(ko[4], ko[5]); w.w = cvt_pk_bf16(ko[6], ko[7]); *(v4u*)(knb + (size_t)tok * 512 + c8) = w; }
            { v4u w; w.x = cvt_pk_bf16(vo[0], vo[1]); w.y = cvt_pk_bf16(vo[2], vo[3]); w.z = cvt_pk_bf16(vo[4], vo[5]); w.w = cvt_pk_bf16(vo[6], vo[7]); *(v4u*)(vvb + (size_t)tok * 512 + c8) = w; }
            if ((lane & 15) == 0) {
                const float a = a_in + dtb, bt = bt_in;
                const float sp = a > 20.f ? a : log1pf(expf(a));
                const float g = -Ah * sp;
                *(f32x4*)(gs + ((size_t)tok * 4 + hh) * 4) = (f32x4){g, 1.f / (1.f + expf(-bt)), 0.f, 0.f};
            }
            float xa[8], ga[8], gbv[8], p2[8]; unpack8(xc3, xa); unpack8(gc3, ga); unpack8(gb3, gbv);
            const f32x4 m0l = *(const LAS f32x4*)(mw + c8), m0h = *(const LAS f32x4*)(mw + c8 + 4), m1l = *(const LAS f32x4*)(mw + 512 + c8), m1h = *(const LAS f32x4*)(mw + 512 + c8 + 4);
            const f32x4 m2l = *(const LAS f32x4*)(mw + 1024 + c8), m2h = *(const LAS f32x4*)(mw + 1024 + c8 + 4);
            float yo[8];
#pragma unroll
            for (int i = 0; i < 8; ++i) { p2[i] = xa[i] * ga[i];
                const float w0 = i < 4 ? m0l[i & 3] : m0h[i & 3], w1 = i < 4 ? m1l[i & 3] : m1h[i & 3], w2 = i < 4 ? m2l[i & 3] : m2h[i & 3];
                yo[i] = gbv[i] * ((w0 * p0[i] + w1 * p1[i]) + w2 * p2[i]); p0[i] = p1[i]; p1[i] = p2[i]; }
            v4u w; w.x = cvt_pk_bf16(yo[0], yo[1]); w.y = cvt_pk_bf16(yo[2], yo[3]); w.z = cvt_pk_bf16(yo[4], yo[5]); w.w = cvt_pk_bf16(yo[6], yo[7]);
            *(v4u*)(yb + (size_t)tok * 512 + c8) = w;
        }
    }
}

#define MFMA16(a, b, c) __builtin_amdgcn_mfma_f32_16x16x32_bf16(a, b, c, 0, 0, 0)
__device__ __forceinline__ bf16x8 pack8(const f32x4 a, const f32x4 b) { v4u w; w.x = cvt_pk_nat(a[0], a[1]); w.y = cvt_pk_nat(a[2], a[3]); w.z = cvt_pk_nat(b[0], b[1]); w.w = cvt_pk_nat(b[2], b[3]); return __builtin_bit_cast(bf16x8, w); }
__device__ __forceinline__ v2u pack4(const f32x4 a) { v2u w; w.x = cvt_pk_nat(a[0], a[1]); w.y = cvt_pk_nat(a[2], a[3]); return w; }
constexpr int GA_PITCH = 72, GA_WAVE_BYTES = 19456;
constexpr int NCHUNK = NB * 4 * (T / 64);

__device__ __forceinline__ void gdn_kend_products(const LAS bf16* XA, const LAS bf16* XB, const LAS float* sE, const v4u* UPK, const v4u* WPK, int ci, int lane, v2u* BC, v4u* ATF) {
    const int fr = lane & 15, fq = lane >> 4;
    bf16x8 ke[8][2];
#pragma unroll
    for (int mt = 0; mt < 8; ++mt)
#pragma unroll
        for (int s = 0; s < 2; ++s) { const LAS bf16* p = (mt < 4 ? XA : XB) + (16 * (mt & 3) + fr) * GA_PITCH + 32 * s + 4 * fq;
            const v2u lo = *(const LAS v2u*)p, hi = *(const LAS v2u*)(p + 16); const f32x4 e0 = *(const LAS f32x4*)(sE + 32 * s + 4 * fq), e1 = *(const LAS f32x4*)(sE + 32 * s + 16 + 4 * fq);
            ke[mt][s] = pack8((f32x4){bf_lo(lo.x) * e0[0], bf_hi(lo.x) * e0[1], bf_lo(lo.y) * e0[2], bf_hi(lo.y) * e0[3]}, (f32x4){bf_lo(hi.x) * e1[0], bf_hi(hi.x) * e1[1], bf_lo(hi.y) * e1[2], bf_hi(hi.y) * e1[3]}); }
#pragma unroll 4
    for (int ne = 0; ne < 8; ++ne) {
        const bf16x8 u0 = __builtin_bit_cast(bf16x8, (UPK + ((size_t)ci * 16 + 2 * ne) * 64)[(unsigned)lane]), u1 = __builtin_bit_cast(bf16x8, (UPK + ((size_t)ci * 16 + 2 * ne + 1) * 64)[(unsigned)lane]);
#pragma unroll
        for (int mt = 0; mt < 8; ++mt) { f32x4 acc = (f32x4){0.f, 0.f, 0.f, 0.f}; acc = MFMA16(ke[mt][0], u0, acc); acc = MFMA16(ke[mt][1], u1, acc);
            (BC + ((size_t)(ci * 8 + ne) * 8 + mt) * 64)[(unsigned)lane] = pack4(acc); } }
#pragma unroll 2
    for (int sp = 0; sp < 4; ++sp) {
        const bf16x8 w00 = __builtin_bit_cast(bf16x8, (WPK + ((size_t)ci * 16 + 4 * sp) * 64)[(unsigned)lane]), w01 = __builtin_bit_cast(bf16x8, (WPK + ((size_t)ci * 16 + 4 * sp + 1) * 64)[(unsigned)lane]);
        const bf16x8 w10 = __builtin_bit_cast(bf16x8, (WPK + ((size_t)ci * 16 + 4 * sp + 2) * 64)[(unsigned)lane]), w11 = __builtin_bit_cast(bf16x8, (WPK + ((size_t)ci * 16 + 4 * sp + 3) * 64)[(unsigned)lane]);
#pragma unroll
        for (int mt = 0; mt < 8; ++mt) { f32x4 d0 = (f32x4){0.f, 0.f, 0.f, 0.f}, d1 = (f32x4){0.f, 0.f, 0.f, 0.f};
            d0 = MFMA16(w00, ke[mt][0], d0); d0 = MFMA16(w01, ke[mt][1], d0); d1 = MFMA16(w10, ke[mt][0], d1); d1 = MFMA16(w11, ke[mt][1], d1);
            (ATF + ((size_t)(ci * 8 + mt) * 4 + sp) * 64)[(unsigned)lane] = __builtin_bit_cast(v4u, pack8(-d0, -d1)); } }
}
__device__ __forceinline__ void xb_store_pair(LAS bf16* XB, int r0, unsigned w, int lane) {
    const unsigned send = (lane & 1) ? (w & 0xffffu) : (w >> 16);
    const unsigned recv = (unsigned)__builtin_amdgcn_update_dpp(0, (int)send, 0xB1, 0xF, 0xF, true);
    const unsigned outw = (lane & 1) ? (recv | (w & 0xffff0000u)) : ((w & 0xffffu) | (recv << 16));
    *(LAS unsigned*)(XB + (r0 + (lane & 1)) * GA_PITCH + (lane & ~1)) = outw;
}
__device__ __forceinline__ void gdn_fill_kT(const bf16* KN, LAS bf16* XB, int tok0, int h, int half, int lane) {
    const bf16* kbase = KN + (size_t)tok0 * 512 + h * 128 + half * 64; const unsigned lo = (unsigned)lane * 512u;
    asm volatile("s_waitcnt lgkmcnt(0)" ::: "memory");
#pragma unroll
    for (int c = 0; c < 8; ++c) { const v4u x = *(const v4u*)((kbase + 8 * c) + lo);
        xb_store_pair(XB, 8 * c, x.x, lane); xb_store_pair(XB, 8 * c + 2, x.y, lane); xb_store_pair(XB, 8 * c + 4, x.z, lane); xb_store_pair(XB, 8 * c + 6, x.w, lane); }
    asm volatile("s_waitcnt lgkmcnt(0)" ::: "memory");
}
__device__ __forceinline__ void phase_gdn_a(Ctx& F) {
    const int lane = F.lane, fr = lane & 15, fq = lane >> 4;
    LAS unsigned char* wl = F.lds + F.wave * GA_WAVE_BYTES;
    LAS bf16* Ts = (LAS bf16*)wl; LAS bf16* XB = (LAS bf16*)(wl + 9216);
    LAS float* gcv = (LAS float*)(wl + 18432); LAS float* sKp = gcv + 64; LAS float* sE = gcv + 128; LAS float* bev = gcv + 192;
    const bf16* KN = (const bf16*)(F.ws + WS_KN); const bf16* QN = (const bf16*)(F.ws + WS_QN); const bf16* VV = (const bf16*)(F.ws + WS_VV); const float* gs = (const float*)(F.ws + WS_GS);
    v2u* BC = (v2u*)(F.ws + WS_BC); v4u* ATF = (v4u*)(F.ws + WS_ATF); v4u* QTF = (v4u*)(F.ws + WS_QTF); v2u* OL = (v2u*)(F.ws + WS_OL); float* CD = (float*)(F.ws + WS_CD);
    v4u* UPK = (v4u*)(F.ws + WS_UPK); v4u* WPK = (v4u*)(F.ws + WS_WPK);
    { const int b = F.bid >> 7, h = F.wave & 3, n = 2 * (F.bid & 127) + (F.wave >> 2);
        const int bh = b * 4 + h, ci = bh * 256 + n, tok0 = b * T + n * 64;
        const f32x2 gb = *(const f32x2*)((gs + ((size_t)tok0 * 4 + h) * 4) + (unsigned)lane * 16u);
        float gc = gb.x; const float be = gb.y;
#pragma unroll
        for (int off = 1; off < 64; off <<= 1) { const float t = bperm(gc, (lane - off) & 63); gc += (lane >= off) ? t : 0.f; }
        const float gl = rdlane(gc, 63);
        gcv[lane] = gc; sKp[lane] = be * __expf(gc); sE[lane] = __expf(gl - gc); bev[lane] = be;
        if (lane == 0) CD[ci] = __expf(gl);
        asm volatile("s_waitcnt lgkmcnt(0)" ::: "memory");
        {
            bf16x8 kf[4][4];
#pragma unroll
            for (int t = 0; t < 4; ++t)
#pragma unroll
                for (int s = 0; s < 4; ++s) kf[t][s] = *(const bf16x8*)((KN + (size_t)(tok0 + 16 * t) * 512 + h * 128 + 32 * s) + ((unsigned)fr * 512u + 8u * (unsigned)fq));
            float gcj[4];
#pragma unroll
            for (int t = 0; t < 4; ++t) gcj[t] = gcv[16 * t + fr];
            LAS float* Nc = (LAS float*)wl;
#pragma unroll
            for (int t = 0; t < 4; ++t) { const f32x4 gci = *(const LAS f32x4*)(gcv + 16 * t + 4 * fq), bei = *(const LAS f32x4*)(bev + 16 * t + 4 * fq);
#pragma unroll
                for (int u = 0; u <= t; ++u) {
                    f32x4 acc = (f32x4){0.f, 0.f, 0.f, 0.f};
#pragma unroll
                    for (int s = 0; s < 4; ++s) acc = MFMA16(kf[t][s], kf[u][s], acc);
                    f32x4 nv;
#pragma unroll
                    for (int r = 0; r < 4; ++r) { const int i = 16 * t + 4 * fq + r, j = 16 * u + fr; const float v = bei[r] * acc[r] * __expf(fminf(gci[r] - gcj[u], 0.f)); nv[r] = (i > j) ? v : 0.f; }
                    *(LAS f32x4*)(Nc + (16 * u + fr) * 64 + 16 * t + 4 * fq) = nv;
                } }
        }
        asm volatile("s_waitcnt lgkmcnt(0)" ::: "memory");
        {
            float x[64];
#pragma unroll
            for (int c = 63; c >= 0; --c) { float a = (lane == c) ? 1.f : 0.f, a1 = 0.f, a2 = 0.f, a3 = 0.f;
#pragma unroll
                for (int k4 = ((c + 1) & ~3); k4 < 64; k4 += 4) { const f32x4 nv = *(const LAS f32x4*)((const LAS float*)wl + c * 64 + k4);
                    if (k4 + 0 > c) a -= x[k4 + 0] * nv[0]; if (k4 + 1 > c) a1 -= x[k4 + 1] * nv[1]; if (k4 + 2 > c) a2 -= x[k4 + 2] * nv[2]; if (k4 + 3 > c) a3 -= x[k4 + 3] * nv[3]; }
                a = (a + a1) + (a2 + a3);
                asm volatile("" : "+v"(a) :: "memory");
                x[c] = a; }
#pragma unroll
            for (int q8 = 0; q8 < 8; ++q8) { v4u w; w.x = cvt_pk_nat(x[8 * q8], x[8 * q8 + 1]); w.y = cvt_pk_nat(x[8 * q8 + 2], x[8 * q8 + 3]); w.z = cvt_pk_nat(x[8 * q8 + 4], x[8 * q8 + 5]); w.w = cvt_pk_nat(x[8 * q8 + 6], x[8 * q8 + 7]);
                *(LAS v4u*)(Ts + lane * GA_PITCH + 8 * q8) = w; }
        }
        asm volatile("s_waitcnt lgkmcnt(0)" ::: "memory");
        {
            bf16x8 tsf[4][2];
#pragma unroll
            for (int t = 0; t < 4; ++t)
#pragma unroll
                for (int s = 0; s < 2; ++s) tsf[t][s] = *(const LAS bf16x8*)(Ts + (16 * t + fr) * GA_PITCH + 32 * s + 8 * fq);
#pragma unroll 1
            for (int half = 0; half < 2; ++half) {
                const bf16* vbase = VV + (size_t)tok0 * 512 + h * 128 + half * 64; const unsigned vlo = (unsigned)lane * 512u;
#pragma unroll
                for (int c = 0; c < 8; ++c) { float f[8]; unpack8(*(const v4u*)((vbase + 8 * c) + vlo), f);
#pragma unroll
                    for (int i2 = 0; i2 < 4; ++i2) xb_store_pair(XB, 8 * c + 2 * i2, cvt_pk_nat(f[2 * i2] * be, f[2 * i2 + 1] * be), lane); }
                asm volatile("s_waitcnt lgkmcnt(0)" ::: "memory");
#pragma unroll
                for (int nl = 0; nl < 4; ++nl) { const bf16x8 b0 = *(const LAS bf16x8*)(XB + (16 * nl + fr) * GA_PITCH + 8 * fq), b1 = *(const LAS bf16x8*)(XB + (16 * nl + fr) * GA_PITCH + 32 + 8 * fq);
                    f32x4 ut[4];
#pragma unroll
                    for (int t = 0; t < 4; ++t) { f32x4 acc = (f32x4){0.f, 0.f, 0.f, 0.f}; acc = MFMA16(tsf[t][0], b0, acc); if (t >= 2) acc = MFMA16(tsf[t][1], b1, acc); ut[t] = acc; }
                    (UPK + ((size_t)ci * 16 + 2 * (half * 4 + nl)) * 64)[(unsigned)lane] = __builtin_bit_cast(v4u, pack8(ut[0], ut[1]));
                    (UPK + ((size_t)ci * 16 + 2 * (half * 4 + nl) + 1) * 64)[(unsigned)lane] = __builtin_bit_cast(v4u, pack8(ut[2], ut[3])); }
                asm volatile("s_waitcnt lgkmcnt(0)" ::: "memory");
            }
#pragma unroll 1
            for (int half = 0; half < 2; ++half) {
                gdn_fill_kT(KN, XB, tok0, h, half, lane);
#pragma unroll
                for (int nl = 0; nl < 4; ++nl) { bf16x8 kp[2];
#pragma unroll
                    for (int s = 0; s < 2; ++s) { const v4u raw = *(const LAS v4u*)(XB + (16 * nl + fr) * GA_PITCH + 32 * s + 8 * fq); const f32x4 c0 = *(const LAS f32x4*)(sKp + 32 * s + 8 * fq), c1 = *(const LAS f32x4*)(sKp + 32 * s + 8 * fq + 4);
                        kp[s] = pack8((f32x4){bf_lo(raw.x) * c0[0], bf_hi(raw.x) * c0[1], bf_lo(raw.y) * c0[2], bf_hi(raw.y) * c0[3]}, (f32x4){bf_lo(raw.z) * c1[0], bf_hi(raw.z) * c1[1], bf_lo(raw.w) * c1[2], bf_hi(raw.w) * c1[3]}); }
                    f32x4 wt[4];
#pragma unroll
                    for (int t = 0; t < 4; ++t) { f32x4 acc = (f32x4){0.f, 0.f, 0.f, 0.f}; acc = MFMA16(tsf[t][0], kp[0], acc); if (t >= 2) acc = MFMA16(tsf[t][1], kp[1], acc); wt[t] = acc; }
                    (WPK + ((size_t)ci * 16 + 2 * (half * 4 + nl)) * 64)[(unsigned)lane] = __builtin_bit_cast(v4u, pack8(wt[0], wt[1]));
                    (WPK + ((size_t)ci * 16 + 2 * (half * 4 + nl) + 1) * 64)[(unsigned)lane] = __builtin_bit_cast(v4u, pack8(wt[2], wt[3])); }
                asm volatile("s_waitcnt lgkmcnt(0)" ::: "memory");
            }
        }
        asm volatile("s_waitcnt vmcnt(0)" ::: "memory");
        gdn_fill_kT(KN, Ts, tok0, h, 0, lane);
        gdn_kend_products(Ts, XB, sE, UPK, WPK, ci, lane, BC, ATF);
        asm volatile("s_waitcnt lgkmcnt(0)" ::: "memory");
        bf16x8 qkpk[4][2];
        {
            bf16x8 kf[4][4];
#pragma unroll
            for (int t = 0; t < 4; ++t)
#pragma unroll
                for (int s = 0; s < 4; ++s) kf[t][s] = *(const bf16x8*)((KN + (size_t)(tok0 + 16 * t) * 512 + h * 128 + 32 * s) + ((unsigned)fr * 512u + 8u * (unsigned)fq));
#pragma unroll
            for (int t = 0; t < 4; ++t) { bf16x8 qf[4]; const float gct = gcv[16 * t + fr];
#pragma unroll
                for (int s = 0; s < 4; ++s) qf[s] = *(const bf16x8*)((QN + (size_t)(tok0 + 16 * t) * 512 + h * 128 + 32 * s) + ((unsigned)fr * 512u + 8u * (unsigned)fq));
                f32x4 tl[4];
#pragma unroll
                for (int u = 0; u < 4; ++u) { tl[u] = (f32x4){0.f, 0.f, 0.f, 0.f}; if (u > t) continue;
                    const f32x4 gcu = *(const LAS f32x4*)(gcv + 16 * u + 4 * fq);
                    f32x4 acc = (f32x4){0.f, 0.f, 0.f, 0.f};
#pragma unroll
                    for (int s = 0; s < 4; ++s) acc = MFMA16(kf[u][s], qf[s], acc);
#pragma unroll
                    for (int r = 0; r < 4; ++r) { const int i = 16 * t + fr, j = 16 * u + 4 * fq + r; const float v = acc[r] * __expf(fminf(gct - gcu[r], 0.f)); tl[u][r] = (i >= j) ? v : 0.f; } }
                qkpk[t][0] = pack8(tl[0], tl[1]); qkpk[t][1] = pack8(tl[2], tl[3]); }
        }
        asm volatile("s_waitcnt lgkmcnt(0)" ::: "memory");
#pragma unroll 2
        for (int sp = 0; sp < 4; ++sp) {
            const bf16x8 w00 = __builtin_bit_cast(bf16x8, (WPK + ((size_t)ci * 16 + 4 * sp) * 64)[(unsigned)lane]), w01 = __builtin_bit_cast(bf16x8, (WPK + ((size_t)ci * 16 + 4 * sp + 1) * 64)[(unsigned)lane]);
            const bf16x8 w10 = __builtin_bit_cast(bf16x8, (WPK + ((size_t)ci * 16 + 4 * sp + 2) * 64)[(unsigned)lane]), w11 = __builtin_bit_cast(bf16x8, (WPK + ((size_t)ci * 16 + 4 * sp + 3) * 64)[(unsigned)lane]);
#pragma unroll
            for (int t = 0; t < 4; ++t) { const float egi = __expf(gcv[16 * t + fr]); f32x4 dd[2];
#pragma unroll
                for (int hh = 0; hh < 2; ++hh) { f32x4 acc = (f32x4){0.f, 0.f, 0.f, 0.f}; acc = MFMA16(hh ? w10 : w00, qkpk[t][0], acc); if (t >= 2) acc = MFMA16(hh ? w11 : w01, qkpk[t][1], acc);
                    const v2u q4 = *(const v2u*)((QN + (size_t)(tok0 + 16 * t) * 512 + h * 128) + ((unsigned)fr * 512u + 4u * (unsigned)fq + 16u * (unsigned)(2 * sp + hh)));
                    dd[hh] = (f32x4){bf_lo(q4.x) * egi - acc[0], bf_hi(q4.x) * egi - acc[1], bf_lo(q4.y) * egi - acc[2], bf_hi(q4.y) * egi - acc[3]}; }
                (QTF + ((size_t)(ci * 4 + t) * 4 + sp) * 64)[(unsigned)lane] = __builtin_bit_cast(v4u, pack8(dd[0], dd[1])); } }
#pragma unroll 4
        for (int et = 0; et < 8; ++et) {
            const bf16x8 u0 = __builtin_bit_cast(bf16x8, (UPK + ((size_t)ci * 16 + 2 * et) * 64)[(unsigned)lane]), u1 = __builtin_bit_cast(bf16x8, (UPK + ((size_t)ci * 16 + 2 * et + 1) * 64)[(unsigned)lane]);
#pragma unroll
            for (int t = 0; t < 4; ++t) { f32x4 acc = (f32x4){0.f, 0.f, 0.f, 0.f}; acc = MFMA16(u0, qkpk[t][0], acc); if (t >= 2) acc = MFMA16(u1, qkpk[t][1], acc);
                (OL + ((size_t)(ci * 8 + et) * 4 + t) * 64)[(unsigned)lane] = pack4(acc); } }
    }
}
__device__ __forceinline__ void phase_gdn_b_helper(Ctx& F, int epoch, int bh, int h) {
    const v4u* at = (const v4u*)(F.ws + WS_ATF) + (size_t)bh * 256 * 2048 + F.tid;
    const v4u* bc = (const v4u*)(F.ws + WS_BC) + (size_t)bh * 256 * 2048 + F.tid;
    unsigned* prog = (unsigned*)(F.ws + WS_CTL) + CW_PROG + bh * 64; const unsigned pbase = (unsigned)epoch * 1024u + 1u;
    v4u acc = (v4u){0u, 0u, 0u, 0u}; v4u d0[8], d1[8];
#pragma unroll
    for (int j = 0; j < 8; ++j) { d0[j] = (v4u){0u, 0u, 0u, 0u}; d1[j] = (v4u){0u, 0u, 0u, 0u}; }
#define HP_WAIT(n_) do { if ((n_) >= HLEAD) { const unsigned want_ = pbase + (unsigned)((n_) - HLEAD); unsigned spins_ = 0; \
        while ((unsigned)__builtin_amdgcn_readfirstlane((int)__hip_atomic_load(prog, __ATOMIC_RELAXED, __HIP_MEMORY_SCOPE_AGENT)) < want_ && ++spins_ < (1u << 18)) __builtin_amdgcn_s_sleep(1); } } while (0)
#define HP_LOAD(d, n_) do { const v4u* a_ = at + (size_t)(n_) * 2048; const v4u* b_ = bc + (size_t)(n_) * 2048; \
        _Pragma("unroll") for (int j = 0; j < 4; ++j) { d[j] = a_[512 * j]; d[4 + j] = b_[512 * j]; } } while (0)
#define HP_USE(d) do { _Pragma("unroll") for (int j = 0; j < 8; ++j) { acc.x ^= d[j].x; acc.y ^= d[j].y; acc.z ^= d[j].z; acc.w ^= d[j].w; } } while (0)
    for (int n = h; n < 256; n += 2 * NHELP) {
        HP_WAIT(n); HP_USE(d0); HP_LOAD(d0, n);
        if (n + NHELP < 256) { HP_WAIT(n + NHELP); HP_USE(d1); HP_LOAD(d1, n + NHELP); }
    }
    HP_USE(d0); HP_USE(d1);
    asm volatile("" :: "v"(acc.x), "v"(acc.y), "v"(acc.z), "v"(acc.w));
#undef HP_WAIT
#undef HP_LOAD
#undef HP_USE
}
#ifndef B_OLDMAP
#define BH_OF(bid) ((bid) & 7)
#define SL_OF(bid) ((bid) >> 3)
#else
#define BH_OF(bid) ((bid) >> 2)
#define SL_OF(bid) ((bid) & 3)
#endif
__device__ __forceinline__ void phase_gdn_b(Ctx& F, int epoch, int bvar) {
    const int bh = BH_OF(F.bid), sl = SL_OF(F.bid), w = F.wave, lane = F.lane, fr = lane & 15, fq = lane >> 4;
    const v4u* ATF = (const v4u*)(F.ws + WS_ATF); const v2u* BC = (const v2u*)(F.ws + WS_BC); const float* CD = (const float*)(F.ws + WS_CD); bf16* ST = (bf16*)(F.ws + WS_ST);
    LAS unsigned char* xb = F.lds;
    const int cbase = bh * 256;
    unsigned* prog = (unsigned*)(F.ws + WS_CTL) + CW_PROG + bh * 64; const unsigned pbase = (unsigned)epoch * 1024u + 1u; const bool pub = (sl == 0) && (w == 0) && (lane == 0);
    f32x4 S[2]; S[0] = (f32x4){0.f, 0.f, 0.f, 0.f}; S[1] = (f32x4){0.f, 0.f, 0.f, 0.f};
    constexpr int RD = 6;
    v4u afr[RD][4]; v2u bcr[RD][2]; float cdr[RD];
#define GB_LOAD(k, n_) do { const int cc_ = (n_) < 256 ? (n_) : 255; const size_t ci_ = (size_t)(cbase + cc_); \
        _Pragma("unroll") for (int s_ = 0; s_ < 4; ++s_) afr[k][s_] = (ATF + ((ci_ * 8 + w) * 4 + s_) * 64)[(unsigned)lane]; \
        _Pragma("unroll") for (int n2_ = 0; n2_ < 2; ++n2_) bcr[k][n2_] = (BC + ((ci_ * 8 + 2 * sl + n2_) * 8 + w) * 64)[(unsigned)lane]; \
        cdr[k] = CD[ci_]; } while (0)
#pragma unroll
    for (int k = 0; k < RD; ++k) GB_LOAD(k, k);
    _Pragma("unroll") for (int k = 0; k < RD; ++k) asm volatile("" :: "v"(afr[k][0]), "v"(afr[k][1]), "v"(afr[k][2]), "v"(afr[k][3]), "v"(bcr[k][0]), "v"(bcr[k][1]), "v"(cdr[k]));
#define GB_STEP(k, n_, LOADNEXT) do { const int n = (n_), par = (k) & 1; const size_t ci = (size_t)(cbase + n); \
            if (NHELP > 0 && pub) __hip_atomic_store(prog, pbase + (unsigned)n, __ATOMIC_RELAXED, __HIP_MEMORY_SCOPE_AGENT);     \
            _Pragma("unroll") for (int nt = 0; nt < 2; ++nt) { const v2u p = pack4(S[nt]); \
                *(LAS v2u*)(xb + par * 8192 + ((nt * 4 + (w >> 1)) * 64 + lane) * 16 + (w & 1) * 8) = p; \
                if (!(bvar & 1)) ((v2u*)ST + ((ci * 8 + w) * 8 + 2 * sl + nt) * 64)[(unsigned)lane] = p; }     \
            asm volatile("s_waitcnt lgkmcnt(0)" ::: "memory"); __builtin_amdgcn_s_barrier(); asm volatile("" ::: "memory"); \
            bf16x8 sf[2][4]; \
            _Pragma("unroll") for (int nt = 0; nt < 2; ++nt) \
                _Pragma("unroll") for (int s = 0; s < 4; ++s) sf[nt][s] = *(const LAS bf16x8*)(xb + par * 8192 + ((nt * 4 + s) * 64 + lane) * 16); \
              \
            asm volatile("" : "+v"(cdr[k]));     \
            const float cdk = __builtin_bit_cast(float, __builtin_amdgcn_readfirstlane(__builtin_bit_cast(int, cdr[k]))); \
            _Pragma("unroll") for (int nt = 0; nt < 2; ++nt) { const v2u bw = bcr[k][nt]; f32x4 acc = S[nt] * cdk + (f32x4){bf_lo(bw.x), bf_hi(bw.x), bf_lo(bw.y), bf_hi(bw.y)}; \
                f32x4 acc2 = (f32x4){0.f, 0.f, 0.f, 0.f};                      \
                acc = MFMA16(__builtin_bit_cast(bf16x8, afr[k][0]), sf[nt][0], acc); acc2 = MFMA16(__builtin_bit_cast(bf16x8, afr[k][1]), sf[nt][1], acc2); \
                acc = MFMA16(__builtin_bit_cast(bf16x8, afr[k][2]), sf[nt][2], acc); acc2 = MFMA16(__builtin_bit_cast(bf16x8, afr[k][3]), sf[nt][3], acc2); \
                S[nt] = acc + acc2; } \
            if (LOADNEXT && !(bvar & 2)) GB_LOAD(k, n + RD); } while (0)
    for (int n0 = 0; n0 + RD <= 256; n0 += RD) {
#pragma unroll
        for (int k = 0; k < RD; ++k) GB_STEP(k, n0 + k, true);
    }
#pragma unroll
    for (int k = 0; k < 256 % RD; ++k) GB_STEP(k, 256 / RD * RD + k, false);
#undef GB_STEP
#undef GB_LOAD
}
__device__ __forceinline__ void phase_gdn_c(Ctx& F, int l) {
    const int lane = F.lane, fr = lane & 15, fq = lane >> 4;
    const v4u* QTF = (const v4u*)(F.ws + WS_QTF); const v2u* OL = (const v2u*)(F.ws + WS_OL); const bf16* ST = (const bf16*)(F.ws + WS_ST);
    const bf16* proj = (const bf16*)(F.ws + WS_R1); bf16* ya = (bf16*)(F.ws + WS_YA); const float* gnp = as_global(F.in[I_GDNNORM]) + (size_t)l * 128;
    { const int ci = F.bid * 8 + F.wave;
        const int bh = ci >> 8, n = ci & 255, b = bh >> 2, h = bh & 3, tok0 = b * T + n * 64;
        bf16x8 qt[4][4];
#pragma unroll
        for (int t = 0; t < 4; ++t)
#pragma unroll
            for (int s = 0; s < 4; ++s) qt[t][s] = __builtin_bit_cast(bf16x8, (QTF + ((size_t)(ci * 4 + t) * 4 + s) * 64)[(unsigned)lane]);
        f32x4 o[8][4];
#pragma unroll
        for (int et = 0; et < 8; ++et) {
#pragma unroll
            for (int t = 0; t < 4; ++t) { const v2u ow = (OL + ((size_t)(ci * 8 + et) * 4 + t) * 64)[(unsigned)lane]; o[et][t] = (f32x4){bf_lo(ow.x), bf_hi(ow.x), bf_lo(ow.y), bf_hi(ow.y)}; }
#pragma unroll
            for (int s = 0; s < 4; ++s) { const v2u lo = ((const v2u*)ST + (((size_t)ci * 8 + 2 * s) * 8 + et) * 64)[(unsigned)lane], hi = ((const v2u*)ST + (((size_t)ci * 8 + 2 * s + 1) * 8 + et) * 64)[(unsigned)lane];
                v4u aw; aw.x = lo.x; aw.y = lo.y; aw.z = hi.x; aw.w = hi.y; const bf16x8 a = __builtin_bit_cast(bf16x8, aw);
#pragma unroll
                for (int t = 0; t < 4; ++t) o[et][t] = MFMA16(a, qt[t][s], o[et][t]); }
        }
        LAS bf16* slab = (LAS bf16*)(F.lds + F.wave * (64 * 136 * 2));
#pragma unroll
        for (int t = 0; t < 4; ++t) { float ss = 0.f;
#pragma unroll
            for (int et = 0; et < 8; ++et) ss += (o[et][t][0] * o[et][t][0] + o[et][t][1] * o[et][t][1]) + (o[et][t][2] * o[et][t][2] + o[et][t][3] * o[et][t][3]);
            ss += bperm(ss, lane ^ 16); ss += bperm(ss, lane ^ 32);
            const float sc = 1.f / sqrtf(ss * (1.f / 128.f) + RMS_EPS);
#pragma unroll
            for (int et = 0; et < 8; ++et) *(LAS v2u*)(slab + (16 * t + fr) * 136 + 16 * et + 4 * fq) = pack4(o[et][t] * sc); }
        asm volatile("s_waitcnt lgkmcnt(0)" ::: "memory");
        { const int rr = lane >> 4, cc = (lane & 15) * 8;
          const f32x4 g0 = *(const f32x4*)(gnp + cc), g1 = *(const f32x4*)(gnp + cc + 4);
#pragma unroll 2
          for (int p = 0; p < 16; ++p) { const int i = 4 * p + rr;
              const v4u ov = *(const LAS v4u*)(slab + i * 136 + cc);
              const v4u zv = *(const v4u*)((proj + (size_t)tok0 * NPROJ + C_Z + h * 128) + ((unsigned)i * (unsigned)NPROJ + (unsigned)cc));
              float of[8], zf[8]; unpack8(ov, of); unpack8(zv, zf);
              v4u w; w.x = cvt_pk_nat(of[0] * g0[0] * siluf_(zf[0]), of[1] * g0[1] * siluf_(zf[1])); w.y = cvt_pk_nat(of[2] * g0[2] * siluf_(zf[2]), of[3] * g0[3] * siluf_(zf[3]));
              w.z = cvt_pk_nat(of[4] * g1[0] * siluf_(zf[4]), of[5] * g1[1] * siluf_(zf[5])); w.w = cvt_pk_nat(of[6] * g1[2] * siluf_(zf[6]), of[7] * g1[3] * siluf_(zf[7]));
              *(v4u*)((ya + (size_t)tok0 * 512 + h * 128) + ((unsigned)i * 512u + (unsigned)cc)) = w; } }
    }
}
constexpr int XK_PITCH = 136, XV_PITCH = 264;
__device__ __forceinline__ void phase_xattn(Ctx& F, int first, int stride) {
    const bf16* proj = (const bf16*)(F.ws + WS_R1); const bf16* kvb = (const bf16*)(F.ws + WS_KVB); const bf16* vtb = (const bf16*)(F.ws + WS_KVB + 512 * 1024); bf16* ym = (bf16*)(F.ws + WS_YM);
    LAS bf16* Ks = (LAS bf16*)F.lds; LAS bf16* VTs = (LAS bf16*)(F.lds + 256 * XK_PITCH * 2);
    const int NU = NB * 4 * (T / 512);
    for (int unit = first; unit < NU; unit += stride) {
        const int qt = unit % (T / 512), bh = unit / (T / 512), b = bh >> 2, head = bh & 3;
        int lane = F.lane; asm volatile("" : "+v"(lane));
        const int fr = lane & 15, fq = lane >> 4, tid_l = F.wave * 64 + lane;
        __syncthreads();
        for (int it = 0; it < 8; ++it) { const int idx = it * 512 + tid_l, key = idx >> 4, ch = idx & 15;
            const v4u kx = *(const v4u*)((kvb + (size_t)(b * NMEM) * 512 + head * 128) + ((unsigned)key * 512u + (unsigned)ch * 8u)); *(LAS v4u*)(Ks + key * XK_PITCH + ch * 8) = kx;
            const int e = idx >> 5, kc = idx & 31;
            const v4u vx = *(const v4u*)((vtb + (size_t)((b * 4 + head) * 128) * 256) + ((unsigned)e * 256u + (unsigned)kc * 8u)); *(LAS v4u*)(VTs + e * XV_PITCH + kc * 8) = vx; }
        __syncthreads();
#pragma unroll 1
        for (int qi = 0; qi < 2; ++qi) {
            const int tok0 = b * T + qt * 512 + F.wave * 64 + qi * 32;
            bf16x8 qf[2][4];
#pragma unroll
            for (int g = 0; g < 2; ++g)
#pragma unroll
                for (int s = 0; s < 4; ++s) qf[g][s] = *(const bf16x8*)((proj + (size_t)(tok0 + g * 16) * NPROJ + C_QM + head * 128 + 32 * s) + ((unsigned)fr * (unsigned)NPROJ + 8u * (unsigned)fq));
            f32x4 sc[2][16];
#pragma unroll
            for (int kt = 0; kt < 16; ++kt) {
                sc[0][kt] = (f32x4){0.f, 0.f, 0.f, 0.f}; sc[1][kt] = (f32x4){0.f, 0.f, 0.f, 0.f};
#pragma unroll
                for (int s = 0; s < 4; ++s) { const bf16x8 kf = *(const LAS bf16x8*)(Ks + (kt * 16 + fr) * XK_PITCH + 32 * s + 8 * fq);
                    sc[0][kt] = __builtin_amdgcn_mfma_f32_16x16x32_bf16(kf, qf[0][s], sc[0][kt], 0, 0, 0);
                    sc[1][kt] = __builtin_amdgcn_mfma_f32_16x16x32_bf16(kf, qf[1][s], sc[1][kt], 0, 0, 0); }
            }
            bf16x8 pf[2][8]; float inv[2];
#pragma unroll
            for (int g = 0; g < 2; ++g) {
                float mx = -3.0e38f;
#pragma unroll
                for (int kt = 0; kt < 16; ++kt) mx = fmaxf(mx, fmaxf(fmaxf(sc[g][kt][0], sc[g][kt][1]), fmaxf(sc[g][kt][2], sc[g][kt][3])));
                mx = fmaxf(mx, bperm(mx, lane ^ 16)); mx = fmaxf(mx, bperm(mx, lane ^ 32));
                float sum = 0.f;
#pragma unroll
                for (int kt = 0; kt < 16; ++kt)
#pragma unroll
                    for (int r = 0; r < 4; ++r) { const float p = __expf((sc[g][kt][r] - mx) * 0.08838834764831845f); sc[g][kt][r] = p; sum += p; }
                sum += bperm(sum, lane ^ 16); sum += bperm(sum, lane ^ 32);
                inv[g] = 1.f / sum;
#pragma unroll
                for (int ks = 0; ks < 8; ++ks) { v4u w; w.x = cvt_pk_bf16_n(sc[g][2 * ks][0], sc[g][2 * ks][1]); w.y = cvt_pk_bf16_n(sc[g][2 * ks][2], sc[g][2 * ks][3]);
                    w.z = cvt_pk_bf16_n(sc[g][2 * ks + 1][0], sc[g][2 * ks + 1][1]); w.w = cvt_pk_bf16_n(sc[g][2 * ks + 1][2], sc[g][2 * ks + 1][3]); pf[g][ks] = __builtin_bit_cast(bf16x8, w); }
            }
#pragma unroll
            for (int et = 0; et < 8; ++et) {
                f32x4 o0 = (f32x4){0.f, 0.f, 0.f, 0.f}, o1 = (f32x4){0.f, 0.f, 0.f, 0.f};
#pragma unroll
                for (int ks = 0; ks < 8; ++ks) { const LAS bf16* vp = VTs + (et * 16 + fr) * XV_PITCH + 32 * ks + 4 * fq;
                    const v2u lo = *(const LAS v2u*)vp, hi = *(const LAS v2u*)(vp + 16); v4u w; w.x = lo.x; w.y = lo.y; w.z = hi.x; w.w = hi.y; const bf16x8 vf = __builtin_bit_cast(bf16x8, w);
                    o0 = __builtin_amdgcn_mfma_f32_16x16x32_bf16(vf, pf[0][ks], o0, 0, 0, 0);
                    o1 = __builtin_amdgcn_mfma_f32_16x16x32_bf16(vf, pf[1][ks], o1, 0, 0, 0); }
                o0 = o0 * inv[0]; o1 = o1 * inv[1];
                v2u w0, w1; w0.x = cvt_pk_bf16_n(o0[0], o0[1]); w0.y = cvt_pk_bf16_n(o0[2], o0[3]); w1.x = cvt_pk_bf16_n(o1[0], o1[1]); w1.y = cvt_pk_bf16_n(o1[2], o1[3]);
                *(v2u*)((ym + (size_t)tok0 * 512 + head * 128 + et * 16) + ((unsigned)fr * 512u + 4u * (unsigned)fq)) = w0;
                *(v2u*)((ym + (size_t)(tok0 + 16) * 512 + head * 128 + et * 16) + ((unsigned)fr * 512u + 4u * (unsigned)fq)) = w1;
            }
        }
    }
}

constexpr int TPW = NTOK / 256;
constexpr int WR_PITCH = 1028;
__device__ __forceinline__ int dpp_i(int s, int ctrl_sel) {
    if (ctrl_sel == 0) return __builtin_amdgcn_update_dpp(0, s, 0xB1, 0xF, 0xF, true);
    if (ctrl_sel == 1) return __builtin_amdgcn_update_dpp(0, s, 0x4E, 0xF, 0xF, true);
    if (ctrl_sel == 2) return __builtin_amdgcn_update_dpp(0, s, 0x141, 0xF, 0xF, true);
    return __builtin_amdgcn_update_dpp(0, s, 0x140, 0xF, 0xF, true);
}
__device__ __forceinline__ void phase_ln1_router(Ctx& F, int l) {
    LAS float* wr_s = (LAS float*)F.lds;
    LAS int* hist = (LAS int*)(F.lds + 32 * WR_PITCH * 4);
    const float* wrp = as_global(F.in[I_WR]) + (size_t)l * D * NE;
    { const int e = F.tid & 31, kg = F.tid >> 5;
      for (int k = kg * 64; k < kg * 64 + 64; k += 4) { f32x4 w; w[0] = wrp[(size_t)(k + 0) * NE + e]; w[1] = wrp[(size_t)(k + 1) * NE + e]; w[2] = wrp[(size_t)(k + 2) * NE + e]; w[3] = wrp[(size_t)(k + 3) * NE + e];
          *(LAS f32x4*)(wr_s + e * WR_PITCH + k) = w; } }
    if (F.tid < 32) hist[F.tid] = 0;
    __syncthreads();
    const bf16* tb = (const bf16*)(F.ws + WS_HF); bf16* hb = (bf16*)(F.ws + WS_HB);
    int* tok_e = (int*)(F.ws + WS_TOKE); float* tok_w = (float*)(F.ws + WS_TOKW);
    const float* brp = as_global(F.in[I_BR]) + (size_t)l * NE;
    const int lane = F.lane, fr = lane & 15, q = lane >> 4;
    const int tok_base = F.bid * TPW + F.wave * 16;
    const size_t rowoff = (size_t)(tok_base + fr) * D + 8 * q;
    float s = 0.f, s2 = 0.f;
#pragma unroll 8
    for (int c = 0; c < 32; ++c) { float x[8]; unpack8(*(const v4u*)(tb + rowoff + 32 * c), x);
#pragma unroll
        for (int i = 0; i < 8; ++i) { s += x[i]; s2 += x[i] * x[i]; } }
    s += bperm(s, lane ^ 16); s += bperm(s, lane ^ 32); s2 += bperm(s2, lane ^ 16); s2 += bperm(s2, lane ^ 32);
    const float mean = s * (1.f / D);
    const float rstd = 1.f / sqrtf(fmaxf(s2 * (1.f / D) - mean * mean, 0.f) + LN_EPS);
    const float* gp = as_global(F.in[I_LN1G]) + (size_t)l * D + 8 * q; const float* bp = as_global(F.in[I_LN1B]) + (size_t)l * D + 8 * q;
    const LAS float* w0p = wr_s + fr * WR_PITCH + 8 * q; const LAS float* w1p = wr_s + (16 + fr) * WR_PITCH + 8 * q;
    f32x4 acc0 = (f32x4){0.f, 0.f, 0.f, 0.f}, acc1 = (f32x4){0.f, 0.f, 0.f, 0.f};
#pragma unroll 2
    for (int c = 0; c < 32; ++c) {
        float x[8]; unpack8(*(const v4u*)(tb + rowoff + 32 * c), x);
        const f32x4 g0 = *(const f32x4*)(gp + 32 * c), g1 = *(const f32x4*)(gp + 32 * c + 4), b0 = *(const f32x4*)(bp + 32 * c), b1 = *(const f32x4*)(bp + 32 * c + 4);
        float h[8];
#pragma unroll
        for (int i = 0; i < 4; ++i) { h[i] = (x[i] - mean) * rstd * g0[i] + b0[i]; h[4 + i] = (x[4 + i] - mean) * rstd * g1[i] + b1[i]; }
        const f32x4 wa0 = *(const LAS f32x4*)(w0p + 32 * c), wa1 = *(const LAS f32x4*)(w0p + 32 * c + 4), wb0 = *(const LAS f32x4*)(w1p + 32 * c), wb1 = *(const LAS f32x4*)(w1p + 32 * c + 4);
#pragma unroll
        for (int i = 0; i < 4; ++i) { acc0 = __builtin_amdgcn_mfma_f32_16x16x4f32(h[i], wa0[i], acc0, 0, 0, 0); acc1 = __builtin_amdgcn_mfma_f32_16x16x4f32(h[i], wb0[i], acc1, 0, 0, 0); }
#pragma unroll
        for (int i = 0; i < 4; ++i) { acc0 = __builtin_amdgcn_mfma_f32_16x16x4f32(h[4 + i], wa1[i], acc0, 0, 0, 0); acc1 = __builtin_amdgcn_mfma_f32_16x16x4f32(h[4 + i], wb1[i], acc1, 0, 0, 0); }
        v4u w; w.x = cvt_pk_nat(h[0], h[1]); w.y = cvt_pk_nat(h[2], h[3]); w.z = cvt_pk_nat(h[4], h[5]); w.w = cvt_pk_nat(h[6], h[7]);
        *(v4u*)(hb + rowoff + 32 * c) = w;
        asm volatile("" ::: "memory");
    }
    const float be0 = brp[fr], be1 = brp[16 + fr];
#pragma unroll
    for (int r = 0; r < 4; ++r) {
        float v0 = acc0[r] + be0, v1 = acc1[r] + be1; float val[4]; int idx[4];
#pragma unroll
        for (int kk = 0; kk < 4; ++kk) {
            const bool use1 = v1 > v0; float bv = use1 ? v1 : v0; int bi = use1 ? 16 + fr : fr;
#pragma unroll
            for (int st = 0; st < 4; ++st) { const float ov = dpp_f(bv, st); const int oi = dpp_i(bi, st); const bool take = (ov > bv) || (ov == bv && oi < bi); bv = take ? ov : bv; bi = take ? oi : bi; }
            val[kk] = bv; idx[kk] = bi;
            v0 = (bi == fr) ? -3.0e38f : v0; v1 = (bi == 16 + fr) ? -3.0e38f : v1;
        }
        const float e1 = __expf(val[1] - val[0]), e2 = __expf(val[2] - val[0]), e3 = __expf(val[3] - val[0]); const float inv = 1.f / (1.f + e1 + e2 + e3);
        if (fr == 0) { const size_t t4 = (size_t)(tok_base + 4 * q + r) * 4;
            *(int4*)(tok_e + t4) = make_int4(idx[0], idx[1], idx[2], idx[3]); *(f32x4*)(tok_w + t4) = (f32x4){inv, e1 * inv, e2 * inv, e3 * inv};
            atomicAdd((int*)&hist[idx[0]], 1); atomicAdd((int*)&hist[idx[1]], 1); atomicAdd((int*)&hist[idx[2]], 1); atomicAdd((int*)&hist[idx[3]], 1); }
    }
    __syncthreads();
    if (F.tid < 32) ((int*)(F.ws + WS_CNT))[F.bid * 32 + F.tid] = hist[F.tid];
}

__device__ __forceinline__ void phase_assign(Ctx& F) {
    LAS int* part_tot = (LAS int*)F.lds;
    LAS int* part_bef = part_tot + 512;
    LAS int* tot_s = part_bef + 512; LAS int* bef_s = tot_s + 32; LAS int* pstart_s = bef_s + 32;
    LAS int* cntw = pstart_s + 32;
    const int* cnt = (const int*)(F.ws + WS_CNT); int* meta = (int*)(F.ws + WS_META);
    const int* tok_e = (const int*)(F.ws + WS_TOKE); const float* tok_w = (const float*)(F.ws + WS_TOKW);
    int* tok_slot = (int*)(F.ws + WS_TOKS); float* slot_w = (float*)(F.ws + WS_SLOTW);
    const int lane = F.lane;
    const int n = F.tid, my_e = tok_e[(size_t)F.bid * TPW * 4 + n]; const float my_w = tok_w[(size_t)F.bid * TPW * 4 + n];
    int my_rank = 0, my_cnt = 0;
    const unsigned long long lt = (1ull << lane) - 1ull;
#pragma unroll
    for (int e = 0; e < 32; ++e) { const unsigned long long m = __ballot(my_e == e); my_rank = (my_e == e) ? __popcll(m & lt) : my_rank; my_cnt = (lane == e) ? __popcll(m) : my_cnt; }
    if (lane < 32) cntw[F.wave * 32 + lane] = my_cnt;
    { const int e = F.tid & 31, part = F.tid >> 5; const int per = (F.G + 15) / 16; int c[16];
#pragma unroll
      for (int j = 0; j < 16; ++j) { const int w = part * per + j; c[j] = (j < per && w < F.G) ? cnt[w * 32 + e] : 0; }
      int tot = 0, bef = 0;
#pragma unroll
      for (int j = 0; j < 16; ++j) { tot += c[j]; bef += (part * per + j < F.bid) ? c[j] : 0; }
      part_tot[part * 32 + e] = tot; part_bef[part * 32 + e] = bef; }
    __syncthreads();
    if (F.tid < 32) { int tot = 0, bef = 0;
#pragma unroll
        for (int p = 0; p < 16; ++p) { tot += part_tot[p * 32 + F.tid]; bef += part_bef[p * 32 + F.tid]; }
        tot_s[F.tid] = tot;
        const int pc = ((tot + 255) >> 8) << 8; int incl = pc;
#pragma unroll
        for (int off = 1; off < 32; off <<= 1) { const int t = __builtin_amdgcn_ds_bpermute(((lane - off) & 63) << 2, incl); incl += (lane >= off) ? t : 0; }
        const int ps = incl - pc; pstart_s[F.tid] = ps; bef_s[F.tid] = ps + bef;
        if (F.bid == 0) { for (int tt = ps >> 8; tt < (ps + pc) >> 8; ++tt) meta[64 + tt] = F.tid; if (F.tid == 31) meta[0] = (ps + pc) >> 8; } }
    __syncthreads();
    int pre = 0;
    for (int w = 0; w < F.wave; ++w) pre += cntw[w * 32 + my_e];
    const int slot = bef_s[my_e] + pre + my_rank;
    { const int tok = F.bid * TPW + (n >> 2); tok_slot[(size_t)tok * 4 + (n & 3)] = slot; slot_w[slot] = my_w; ((int*)(F.ws + WS_SLOTT))[slot] = tok; }
    if (F.bid == 0 && F.tid < 32) { const int tot = tot_s[F.tid], ps = pstart_s[F.tid], pe = ps + (((tot + 255) >> 8) << 8); int* st = (int*)(F.ws + WS_SLOTT);
        for (int s2 = ps + tot; s2 < pe; ++s2) st[s2] = 0; }
}

__device__ __forceinline__ void phase_combine_ln2(Ctx& F, int l) {
    LAS float* ws_s = (LAS float*)F.lds;
    if (l + 1 < DEPTH) { load_small_w(F, l + 1, ws_s); }
    __syncthreads();
    bf16* hb = (bf16*)(F.ws + WS_HB); float* ab = (float*)(F.ws + WS_AB);
    const bf16* Y = (const bf16*)(F.ws + WS_XS); const int* tok_slot = (const int*)(F.ws + WS_TOKS);
    const int lane = F.lane, gw = F.bid * 8 + F.wave, NGW = F.G * 8;
    for (int tok = gw; tok < NTOK; tok += NGW) {
        f32x4 v[4]; load_row_bf16(hb + (size_t)tok * D, v, lane);
#pragma unroll
        for (int j = 0; j < 4; ++j) v[j] = v[j] * ALPHA;
#pragma unroll
        for (int kk = 0; kk < 4; ++kk) { const int slot = tok_slot[(size_t)tok * 4 + kk]; const bf16* yr = Y + (size_t)slot * D;
#pragma unroll
            for (int j = 0; j < 4; ++j) { const v2u w = *(const v2u*)(yr + 4 * lane + 256 * j); v[j][0] += bf_lo(w.x); v[j][1] += bf_hi(w.x); v[j][2] += bf_lo(w.y); v[j][3] += bf_hi(w.y); } }
        ln_apply(v, as_global(F.in[I_LN2G]) + (size_t)l * D, as_global(F.in[I_LN2B]) + (size_t)l * D, lane);
        if (l + 1 < DEPTH) { store_row_bf16(hb + (size_t)tok * D, v, lane); small_proj(v, ws_s, ab + (size_t)tok * 8, lane); }
        else store_row_f32(F.out + (size_t)tok * D, v, lane);
    }
}


#define PHASE_FN __device__ __forceinline__
PHASE_FN void g_inproj(LAS unsigned char* lds, unsigned char* ws, int l, int G, int bid, int wave) { asm volatile("" : "+s"(ws)); ws = as_global(ws); asm volatile("" : "+s"(G)); asm volatile("" : "+s"(bid)); asm volatile("" : "+s"(l));
    pg8::SchedDense S{(const char*)(ws + WS_HB), (const char*)(ws + WS_WIN) + (size_t)l * NPROJ * D * 2, NTOK / 256, NPROJ / 256, G, bid, (size_t)256 * D * 2};
    pg8::EpiStoreBf16 E{(bf16*)(ws + WS_R1), NPROJ};
    pg8::gemm_phase<pg8::EpiStoreBf16, pg8::SchedDense, true, true>(lds, D, S, E, wave);
}
PHASE_FN void g_kvproj(LAS unsigned char* lds, unsigned char* ws, int l, int G, int bid, int wave) { asm volatile("" : "+s"(ws)); ws = as_global(ws); asm volatile("" : "+s"(G)); asm volatile("" : "+s"(bid)); asm volatile("" : "+s"(l));
    pg8::SchedDense S{(const char*)(ws + WS_MEMB), (const char*)(ws + WS_WKV) + (size_t)l * D * D * 2, NB * NMEM / 256, D / 256, G, bid, (size_t)256 * D * 2};
    pg8::EpiKV E{(bf16*)(ws + WS_KVB), (bf16*)(ws + WS_KVB + 512 * 1024)};
    pg8::gemm_phase<pg8::EpiKV, pg8::SchedDense, true, true>(lds, D, S, E, wave);
}
#ifndef XT
#define XT 2
#endif
constexpr int CW_XDONE = 20480;
PHASE_FN void g_side_branch(LAS unsigned char* lds, unsigned char* ws, int l, int nside, int sidx, int wave, int br) { asm volatile("" : "+s"(ws)); ws = as_global(ws); asm volatile("" : "+s"(nside)); asm volatile("" : "+s"(sidx)); asm volatile("" : "+s"(l)); asm volatile("" : "+s"(br));
    const bool xw = sidx < 64;
    pg8::SchedBranch S{(const char*)(ws + WS_YA), (const char*)(ws + WS_YB), (const char*)(ws + WS_YM), (const char*)(ws + WS_WBR) + (size_t)l * 3 * D * 512 * 2, (size_t)D * 512 * 2,
                       NTOK / 256, D / 256, xw ? 64 : nside - 64, xw ? sidx : 64 * XT + sidx - 64, 1, br, br, (size_t)256 * 512 * 2, xw ? XT : (1 << 30)};
    pg8::EpiBranch E{(const bf16*)(ws + WS_R1), (bf16*)(ws + WS_MB), 1};
    pg8::gemm_phase<pg8::EpiBranch, pg8::SchedBranch, true, true>(lds, 512, S, E, wave);
}
__device__ __forceinline__ void xdone_publish(unsigned char* ws) {
    asm volatile("s_waitcnt vmcnt(0)" ::: "memory"); __syncthreads();
    if (threadIdx.x == 0) { __builtin_amdgcn_fence(__ATOMIC_RELEASE, "agent"); asm volatile("s_waitcnt vmcnt(0)" ::: "memory");
        __hip_atomic_fetch_add((unsigned*)(ws + WS_CTL) + CW_XDONE, 1u, __ATOMIC_RELAXED, __HIP_MEMORY_SCOPE_AGENT); }
}
__device__ __forceinline__ void xdone_wait(unsigned char* ws, unsigned want) {
    asm volatile("s_waitcnt vmcnt(0)" ::: "memory"); __syncthreads();
    if (threadIdx.x == 0) { unsigned spins = 0;
        while (__hip_atomic_load((unsigned*)(ws + WS_CTL) + CW_XDONE, __ATOMIC_RELAXED, __HIP_MEMORY_SCOPE_AGENT) < want && ++spins < (1u << 22)) __builtin_amdgcn_s_sleep(8);
        __builtin_amdgcn_fence(__ATOMIC_ACQUIRE, "agent"); asm volatile("s_waitcnt vmcnt(0)" ::: "memory"); }
    __syncthreads();
}
PHASE_FN void g_branch(LAS unsigned char* lds, unsigned char* ws, int l, int G, int bid, int wave) { asm volatile("" : "+s"(ws)); ws = as_global(ws); asm volatile("" : "+s"(G)); asm volatile("" : "+s"(bid)); asm volatile("" : "+s"(l));
    pg8::SchedBranch S{(const char*)(ws + WS_YA), (const char*)(ws + WS_YB), (const char*)(ws + WS_YM), (const char*)(ws + WS_WBR) + (size_t)l * 3 * D * 512 * 2, (size_t)D * 512 * 2,
                       NTOK / 256, D / 256, G, bid, 1, 0, 0, (size_t)256 * 512 * 2};
    pg8::EpiBranch E{(const bf16*)(ws + WS_R1), (bf16*)(ws + WS_MB), 1};
    pg8::gemm_phase<pg8::EpiBranch, pg8::SchedBranch, true, true>(lds, 512, S, E, wave);
}
PHASE_FN void g_outproj(LAS unsigned char* lds, unsigned char* ws, int l, int G, int bid, int wave) { asm volatile("" : "+s"(ws)); ws = as_global(ws); asm volatile("" : "+s"(G)); asm volatile("" : "+s"(bid)); asm volatile("" : "+s"(l));
    pg8::SchedDense S{(const char*)(ws + WS_MB), (const char*)(ws + WS_WO) + (size_t)l * D * D * 2, NTOK / 256, D / 256, G, bid, (size_t)256 * D * 2};
    pg8::EpiOut E{(const bf16*)(ws + WS_HB), (bf16*)(ws + WS_HF)};
    pg8::gemm_phase<pg8::EpiOut, pg8::SchedDense, true, true>(lds, D, S, E, wave);
}
PHASE_FN void g_gateup(LAS unsigned char* lds, unsigned char* ws, const float* bgu, int l, int G, int bid, int wave) { asm volatile("" : "+s"(ws)); ws = as_global(ws); asm volatile("" : "+s"(G)); asm volatile("" : "+s"(bid)); asm volatile("" : "+s"(l)); bgu = as_global(bgu);
    const int* meta = (const int*)(ws + WS_META); const int n_tiles = __builtin_amdgcn_readfirstlane(meta[0]);
    pg8::SchedGrouped S{(const char*)(ws + WS_HB), (const char*)(ws + WS_WGU) + (size_t)l * NE * 2048 * D * 2, (size_t)2048 * D * 2, meta + 64, n_tiles, 8, G, bid, (size_t)256 * D * 2, (const int*)(ws + WS_SLOTT)};
    pg8::EpiSwiglu E{(bf16*)(ws + WS_HBUF), bgu + (size_t)l * NE * 2048};
    pg8::gemm_phase<pg8::EpiSwiglu, pg8::SchedGrouped, true, true, true>(lds, D, S, E, wave);
}
PHASE_FN void g_down(LAS unsigned char* lds, unsigned char* ws, const float* bd, int l, int G, int bid, int wave) { asm volatile("" : "+s"(ws)); ws = as_global(ws); asm volatile("" : "+s"(G)); asm volatile("" : "+s"(bid)); asm volatile("" : "+s"(l)); bd = as_global(bd);
    const int* meta = (const int*)(ws + WS_META); const int n_tiles = __builtin_amdgcn_readfirstlane(meta[0]);
    pg8::SchedGrouped S{(const char*)(ws + WS_HBUF), (const char*)(ws + WS_WD) + (size_t)l * NE * D * D * 2, (size_t)D * D * 2, meta + 64, n_tiles, 4, G, bid, (size_t)256 * D * 2, nullptr};
    pg8::EpiDown E{(bf16*)(ws + WS_XS), bd + (size_t)l * NE * D, (const float*)(ws + WS_SLOTW)};
    pg8::gemm_phase<pg8::EpiDown, pg8::SchedGrouped, true, true>(lds, D, S, E, wave);
}

constexpr int PH_PER_LAYER = 12, NPHASE = 1 + DEPTH * PH_PER_LAYER;
__global__ void __launch_bounds__(512, 2) fwd_kernel(Args args) {
    extern __shared__ __attribute__((aligned(16))) unsigned char lds_raw[];
    Ctx F;
    F.lds = (LAS unsigned char*)lds_raw; F.tid = 0; F.lane = 0; F.wave = __builtin_amdgcn_readfirstlane((int)threadIdx.x >> 6); F.G = gridDim.x; F.bid = blockIdx.x;
    F.in = args.in; F.out = args.out; F.ws = args.ws;
    volatile LAS unsigned* MISC = (volatile LAS unsigned*)(F.lds + MISC_OFF);
    if (threadIdx.x < 64) MISC[threadIdx.x] = 0u;
    __syncthreads();
    const int lo = args.ph_lo, hi = args.ph_hi;
#define REP_BRANCH g_branch
#ifdef AMP_BID
#define AMP_BEGIN() const unsigned long long amp_t0_ = __builtin_amdgcn_s_memrealtime()
#define AMP_END() do { if (exp_ && F.bid == AMP_BID) { __syncthreads(); const unsigned long long t1_ = __builtin_amdgcn_s_memrealtime(); while (__builtin_amdgcn_s_memrealtime() - t1_ < (unsigned long long)AMP * (t1_ - amp_t0_)) __builtin_amdgcn_s_sleep(8); } } while (0)
#else
#define AMP_BEGIN() do {} while (0)
#define AMP_END() do {} while (0)
#endif
#ifndef XA_LO
#define XA_LO 128
#endif
#ifndef BVAR
#define BVAR 0
#endif
#ifndef REP_MODE
#define REP_MODE 0
#endif
#ifndef REP_PH
#define REP_PH -1
#define REP_N 0
#endif
#define NREP(k) (((k) == REP_PH) ? 1 + REP_N : 1)
#if MK_MULTI
#define GRID_BAR() do { } while (0)
#else
    XcdBarrier bar = xcd_barrier_post((unsigned*)(F.ws + WS_CTL) + CW_BAR, MISC + 8);
#define GRID_BAR() xcd_barrier(bar)
#endif
#define IN(k) (lo <= (k) && (k) < hi)
#define SEAM(k) do { if (IN(k) && IN((k) + 1)) GRID_BAR(); } while (0)

    if (IN(0)) { for (int rep_ = 0; rep_ < ((REP_PH == 100) ? 1 + REP_N : 1); ++rep_) { if (rep_) GRID_BAR(); { Ctx P = fresh(F); phase_prologue(P); } } } SEAM(0);

#define LAYER_PHASES(l) do { const int p0 = 1 + (l) * PH_PER_LAYER; \
        if (IN(p0 + 0)) { for (int rep_ = 0; rep_ < NREP(0); ++rep_) { if (rep_) GRID_BAR(); g_inproj(F.lds, F.ws, l, F.G, F.bid, F.wave); } } SEAM(p0 + 0); \
        if (IN(p0 + 1)) { for (int rep_ = 0; rep_ < NREP(1); ++rep_) { if (rep_) GRID_BAR(); g_kvproj(F.lds, F.ws, l, F.G, F.bid, F.wave); __syncthreads(); { Ctx P = fresh(F); phase_prep(P, l); } asm volatile("s_waitcnt vmcnt(0)" ::: "memory"); __syncthreads(); { Ctx P = fresh(F); phase_gdn_a(P); } } }   \
        SEAM(p0 + 2); \
        if (IN(p0 + 3)) { for (int rep_ = 0; rep_ < NREP(3); ++rep_) { if (rep_) GRID_BAR(); __syncthreads(); { Ctx P = fresh(F); const bool exp_ = rep_ + 1 < NREP(3); const int mode_ = exp_ ? REP_MODE : 0; const int epoch_ = (l) * NREP(3) + rep_; AMP_BEGIN(); if (P.bid < 32) { if (mode_ != 2) phase_gdn_b(P, epoch_, exp_ ? BVAR : 0); } else if (P.bid < 32 + 8 * NHELP) { if (mode_ != 2) phase_gdn_b_helper(P, epoch_, P.bid & 7, (P.bid - 32) >> 3); } else if (mode_ != 1) { const int sidx_ = P.bid - 32 - 8 * NHELP, nside_ = P.G - 32 - 8 * NHELP; phase_xattn(P, sidx_, nside_); if (sidx_ < 64) xdone_publish(F.ws); __syncthreads(); _Pragma("unroll 1") for (int br_ = 1; br_ <= 2; ++br_) { if (br_ == 2) xdone_wait(F.ws, 64u * (unsigned)(epoch_ + 1)); g_side_branch(F.lds, F.ws, l, nside_, sidx_, F.wave, br_); } if (l == 0 && !exp_ && NDEF > 0) { __syncthreads(); Ctx Q = fresh(F); convert_deferred(Q, sidx_ * 8 + Q.wave, nside_ * 8); } } AMP_END(); } } } SEAM(p0 + 3); \
        if (IN(p0 + 4)) { for (int rep_ = 0; rep_ < NREP(4); ++rep_) { if (rep_) GRID_BAR(); __syncthreads(); { Ctx P = fresh(F); phase_gdn_c(P, l); } } } SEAM(p0 + 4); \
        if (IN(p0 + 5)) { for (int rep_ = 0; rep_ < NREP(5); ++rep_) { if (rep_) GRID_BAR(); __syncthreads(); if (rep_ == 0) g_branch(F.lds, F.ws, l, F.G, F.bid, F.wave); else REP_BRANCH(F.lds, F.ws, l, F.G, F.bid, F.wave); } } SEAM(p0 + 5); \
        if (IN(p0 + 6)) { for (int rep_ = 0; rep_ < NREP(6); ++rep_) { if (rep_) GRID_BAR(); g_outproj(F.lds, F.ws, l, F.G, F.bid, F.wave); } } SEAM(p0 + 6); \
        if (IN(p0 + 7)) { for (int rep_ = 0; rep_ < NREP(7); ++rep_) { if (rep_) GRID_BAR(); __syncthreads(); { Ctx P = fresh(F); phase_ln1_router(P, l); } } } SEAM(p0 + 7); \
        if (IN(p0 + 8)) { for (int rep_ = 0; rep_ < NREP(8); ++rep_) { if (rep_) GRID_BAR(); __syncthreads(); { Ctx P = fresh(F); phase_assign(P); } } } SEAM(p0 + 8); \
        if (IN(p0 + 9)) { for (int rep_ = 0; rep_ < NREP(9); ++rep_) { if (rep_) GRID_BAR(); __syncthreads(); g_gateup(F.lds, F.ws, as_global(F.in[I_BGU]), l, F.G, F.bid, F.wave); } } SEAM(p0 + 9); \
        if (IN(p0 + 10)) { for (int rep_ = 0; rep_ < NREP(10); ++rep_) { if (rep_) GRID_BAR(); g_down(F.lds, F.ws, as_global(F.in[I_BD]), l, F.G, F.bid, F.wave); } } SEAM(p0 + 10); \
        if (IN(p0 + 11)) { for (int rep_ = 0; rep_ < NREP(11); ++rep_) { if (rep_) GRID_BAR(); __syncthreads(); { Ctx P = fresh(F); phase_combine_ln2(P, l); } } } SEAM(p0 + 11); \
    } while (0)
    LAYER_PHASES(0);
    LAYER_PHASES(1);
#undef LAYER_PHASES
#undef IN
#undef SEAM
#undef GRID_BAR
}

extern "C" void kernel_launch(void* const* d_in, const int* in_sizes, int n_in, void* d_out, int out_size, void* d_ws, size_t ws_size, hipStream_t stream) {
    static int grid = 0;
    if (grid == 0) {
        if (n_in != 23 || out_size != NTOK * D || ws_size < WS_END) { fprintf(stderr, "kernel_launch: unexpected problem (n_in %d, out %d, ws %zu < %zu)\n", n_in, out_size, ws_size, (size_t)WS_END); grid = -1; return; }
        if (hipFuncSetAttribute((const void*)fwd_kernel, hipFuncAttributeMaxDynamicSharedMemorySize, LDS_BYTES) != hipSuccess) { fprintf(stderr, "kernel_launch: hipFuncSetAttribute failed\n"); grid = -1; return; }
        int per_cu = 0;
        if (hipOccupancyMaxActiveBlocksPerMultiprocessor(&per_cu, (const void*)fwd_kernel, 512, LDS_BYTES) != hipSuccess || per_cu < 1) fprintf(stderr, "kernel_launch: occupancy query reports %d\n", per_cu);
        (void)hipGetLastError();
        grid = 256;
    }
    if (grid < 0) return;
    (void)hipMemsetAsync((char*)d_ws + WS_CTL, 0, CTL_ZERO_BYTES, stream);
    Args a{};
    for (int i = 0; i < 23; ++i) a.in[i] = (const float*)d_in[i];
    a.out = (float*)d_out; a.ws = (unsigned char*)d_ws;
#if MK_MULTI
    for (int p = 0; p < NPHASE; ++p) { a.ph_lo = p; a.ph_hi = p + 1; hipLaunchKernelGGL(fwd_kernel, dim3(grid), dim3(512), LDS_BYTES, stream, a); }
#else
    a.ph_lo = 0; a.ph_hi = NPHASE;
    hipLaunchKernelGGL(fwd_kernel, dim3(grid), dim3(512), LDS_BYTES, stream, a);
#endif
}
```

```cpp
#include <hip/hip_runtime.h>
#include <cstdio>
#include <cstdint>

#ifndef MK_MULTI
#define MK_MULTI 0
#endif

#define LAS __attribute__((address_space(3)))
typedef unsigned short bf16;
typedef unsigned v4u __attribute__((ext_vector_type(4)));
typedef unsigned v2u __attribute__((ext_vector_type(2)));
typedef float f32x4 __attribute__((ext_vector_type(4)));
typedef float f32x2 __attribute__((ext_vector_type(2)));
typedef short bf16x8 __attribute__((ext_vector_type(8)));

constexpr int NB = 2, T = 16384, NTOK = NB * T, D = 1024, DEPTH = 2;
constexpr int NPROJ = 7168;
constexpr int NPROJ_SRC = 7176;
constexpr int C_Q = 0, C_K = 512, C_V = 1024, C_Z = 1536, C_XC = 2048, C_GB = 2560, C_GC = 3072, C_QM = 3584, C_GL = 4096;
constexpr int NMEM = 256, NE = 32, TOPK = 4, DFF = 1024;
constexpr int NSLOT_MAX = 544 * 256;
constexpr float ALPHA = 1.41421356237309515f;
constexpr float LN_EPS = 1e-5f, RMS_EPS = 1e-6f;

constexpr size_t MiB = 1u << 20;
constexpr size_t WS_CTL = 0, CTL_ZERO_BYTES = 1 * MiB;
constexpr size_t WS_WIN = 1 * MiB;
constexpr size_t WS_WBR = WS_WIN + 28 * MiB;
constexpr size_t WS_WO = WS_WBR + 6 * MiB;
constexpr size_t WS_WKV = WS_WO + 4 * MiB;
constexpr size_t WS_WGU = WS_WKV + 4 * MiB;
constexpr size_t WS_WD = WS_WGU + 256 * MiB;
constexpr size_t WS_MEMB = WS_WD + 128 * MiB;
constexpr size_t WS_KVB = WS_MEMB + 1 * MiB;
constexpr size_t WS_HF = WS_KVB + 1 * MiB;
constexpr size_t WS_HB = WS_HF + 128 * MiB;
constexpr size_t WS_AB = WS_HB + 64 * MiB;
constexpr size_t WS_R1 = WS_AB + 1 * MiB;
constexpr size_t WS_XS = WS_R1, WS_HBUF = WS_R1 + 272 * MiB;
constexpr size_t WS_KN = WS_R1 + 544 * MiB;
constexpr size_t WS_QN = WS_KN + 32 * MiB;
constexpr size_t WS_VV = WS_QN + 32 * MiB;
constexpr size_t WS_GS = WS_VV + 32 * MiB;
constexpr size_t WS_ATF = WS_GS + 2 * MiB;
constexpr size_t WS_BC = WS_ATF + 64 * MiB;
constexpr size_t WS_QTF = WS_BC + 64 * MiB;
constexpr size_t WS_OL = WS_QTF + 32 * MiB;
constexpr size_t WS_ST = WS_OL + 64 * MiB;
constexpr size_t WS_CD = WS_ST + 64 * MiB;
constexpr size_t WS_UPK = WS_CD + 1 * MiB;
constexpr size_t WS_WPK = WS_UPK + 32 * MiB;
constexpr size_t WS_YA = WS_WPK + 32 * MiB;
constexpr size_t WS_YB = WS_YA + 32 * MiB, WS_YM = WS_YB + 32 * MiB;
constexpr size_t WS_MF = WS_YM + 32 * MiB;
constexpr size_t WS_MB = WS_MF + 128 * MiB;
constexpr size_t WS_TOKE = WS_MB + 64 * MiB;
constexpr size_t WS_TOKW = WS_TOKE + MiB / 2;
constexpr size_t WS_TOKS = WS_TOKW + MiB / 2;
constexpr size_t WS_SLOTW = WS_TOKS + MiB / 2;
constexpr size_t WS_CNT = WS_SLOTW + 1 * MiB;
constexpr size_t WS_META = WS_CNT + MiB / 4;
constexpr size_t WS_SLOTT = WS_META + MiB / 4;
constexpr size_t WS_END = WS_SLOTT + 1 * MiB;
static_assert(WS_END <= (size_t)2048 * MiB, "workspace map exceeds 2 GiB");
#ifndef NHELP
#define NHELP 4
#endif
#ifndef HLEAD
#define HLEAD 14
#endif
constexpr int CW_PROG = 16384;
constexpr int CW_BAR = 4096;

constexpr int LDS_BYTES = 159744;
constexpr int MISC_OFF = LDS_BYTES - 256;

#define GAS __attribute__((address_space(1)))
template <class Tp> __device__ __forceinline__ Tp* as_global(Tp* p) { GAS Tp* g = (GAS Tp*)p; asm("" : "+s"(g)); return (Tp*)g; }
#define LDS_WAIT() asm volatile("s_waitcnt lgkmcnt(0)" ::: "memory")
#define VM_WAIT() asm volatile("s_waitcnt vmcnt(0)" ::: "memory")
__device__ __forceinline__ unsigned cvt_pk_bf16(float lo, float hi) { unsigned r; asm volatile("v_cvt_pk_bf16_f32 %0, %1, %2" : "=v"(r) : "v"(lo), "v"(hi)); return r; }
__device__ __forceinline__ unsigned cvt_pk_bf16_n(float lo, float hi) { unsigned r; asm volatile("v_cvt_pk_bf16_f32 %0, %1, %2\n\ts_nop 1" : "=v"(r) : "v"(lo), "v"(hi)); return r; }
typedef __bf16 bf16x2_t __attribute__((ext_vector_type(2)));
__device__ __forceinline__ unsigned cvt_pk_nat(float lo, float hi) { bf16x2_t v; v[0] = (__bf16)lo; v[1] = (__bf16)hi; return __builtin_bit_cast(unsigned, v); }
__device__ __forceinline__ float bf_lo(unsigned w) { return __uint_as_float(w << 16); }
__device__ __forceinline__ float bf_hi(unsigned w) { return __uint_as_float(w & 0xffff0000u); }
__device__ __forceinline__ float fast_rcp(float x) { return __builtin_amdgcn_rcpf(x); }
__device__ __forceinline__ float sigmoidf_(float x) { return fast_rcp(1.0f + __expf(-x)); }
__device__ __forceinline__ float siluf_(float x) { return x * sigmoidf_(x); }
__device__ __forceinline__ float dpp_f(float v, int ctrl_sel) {
    const int s = __builtin_bit_cast(int, v); int r;
    if (ctrl_sel == 0) r = __builtin_amdgcn_update_dpp(0, s, 0xB1, 0xF, 0xF, true);
    else if (ctrl_sel == 1) r = __builtin_amdgcn_update_dpp(0, s, 0x4E, 0xF, 0xF, true);
    else if (ctrl_sel == 2) r = __builtin_amdgcn_update_dpp(0, s, 0x141, 0xF, 0xF, true);
    else r = __builtin_amdgcn_update_dpp(0, s, 0x140, 0xF, 0xF, true);
    return __builtin_bit_cast(float, r);
}
__device__ __forceinline__ float row16_sum(float v) {
    v += dpp_f(v, 0); v += dpp_f(v, 1); v += dpp_f(v, 2); v += dpp_f(v, 3); return v;
}
__device__ __forceinline__ float rdlane(float v, int l) { return __builtin_bit_cast(float, __builtin_amdgcn_readlane(__builtin_bit_cast(int, v), l)); }
__device__ __forceinline__ float wave_sum(float v) { v = row16_sum(v); return (rdlane(v, 0) + rdlane(v, 16)) + (rdlane(v, 32) + rdlane(v, 48)); }
__device__ __forceinline__ float bperm(float v, int src_lane) { return __builtin_bit_cast(float, __builtin_amdgcn_ds_bpermute(src_lane << 2, __builtin_bit_cast(int, v))); }

#define XB_TMO      128
#define XB_XCNT(j)  (256  + 64 * (j))
#define XB_XSUB(j)  (1280 + 64 * (j))
#define XB_XGEN(j)  (2304 + 64 * (j))
#define XB_TOP      3328
#define XB_TOPGEN   3392
#define XCD_BAR_WORDS 3456
#define XB_SPIN_CAP (1u << 18)
__device__ __forceinline__ unsigned xb_ld(unsigned* p)              { return __hip_atomic_load(p, __ATOMIC_RELAXED, __HIP_MEMORY_SCOPE_AGENT); }
__device__ __forceinline__ unsigned xb_add(unsigned* p, unsigned v) { return __hip_atomic_fetch_add(p, v, __ATOMIC_RELAXED, __HIP_MEMORY_SCOPE_AGENT); }
__device__ __forceinline__ unsigned xb_xcc_id() { return (unsigned)__builtin_amdgcn_s_getreg((3 << 11) | 20) & 0xFu; }
#define XB_SPIN(cond, bar) do { unsigned _sp = 0; while (cond) { __builtin_amdgcn_s_sleep(1); \
    if ((++_sp & 255u) == 0u) { if (xb_ld(&(bar)[XB_TMO])) break; if (_sp > XB_SPIN_CAP) { atomicAdd(&(bar)[XB_TMO], 1u); break; } } } } while (0)
struct XcdBarrier { unsigned* bar; unsigned x; volatile LAS unsigned* st; };
__device__ __forceinline__ XcdBarrier xcd_barrier_post(unsigned* bar, volatile LAS unsigned* st) {
    XcdBarrier b; b.bar = bar; b.x = xb_xcc_id(); b.st = st;
    if (threadIdx.x == 0) (void)xb_add(&bar[XB_XCNT(b.x)], 1u);
    return b;
}
__device__ __forceinline__ void xcd_barrier_complete(unsigned* bar, unsigned x, unsigned& nloc, unsigned& nx) {
    const unsigned G = gridDim.x * gridDim.y * gridDim.z;
    unsigned sum, cnt, mine, sp = 0u;
    for (;;) {
        sum = 0u; cnt = 0u; mine = 0u;
#pragma unroll
        for (unsigned j = 0; j < 16; ++j) { const unsigned c = xb_ld(&bar[XB_XCNT(j)]); sum += c; cnt += (c > 0u) ? 1u : 0u; mine = (j == x) ? c : mine; }
        if (sum == G) break;
        __builtin_amdgcn_s_sleep(1);
        if ((++sp & 255u) == 0u) { if (xb_ld(&bar[XB_TMO])) break; if (sp > XB_SPIN_CAP) { atomicAdd(&bar[XB_TMO], 1u); break; } }
    }
    nloc = mine > 0u ? mine : 1u; nx = cnt > 0u ? cnt : 1u;
}
__device__ __forceinline__ void xcd_barrier(const XcdBarrier& b) {
    asm volatile("s_waitcnt vmcnt(0)" ::: "memory");
    __syncthreads();
    if (threadIdx.x == 0) {
        unsigned* bar = b.bar;
        __builtin_amdgcn_s_waitcnt(0);
        unsigned nloc = b.st[0], nx = b.st[1];
        if (nloc == 0u) { xcd_barrier_complete(bar, b.x, nloc, nx); b.st[0] = nloc; b.st[1] = nx; }
        const unsigned old = xb_add(&bar[XB_XSUB(b.x)], 1u);
        const unsigned gen = old / nloc;
        if (old + 1u == (gen + 1u) * nloc) {
            __builtin_amdgcn_fence(__ATOMIC_RELEASE, "agent");
            asm volatile("s_waitcnt vmcnt(0)" ::: "memory");
            const unsigned og = xb_add(&bar[XB_TOP], 1u);
            const unsigned tg = og / nx;
            if (og + 1u == (tg + 1u) * nx) xb_add(&bar[XB_TOPGEN], 1u);
            else XB_SPIN(xb_ld(&bar[XB_TOPGEN]) == tg, bar);
            __builtin_amdgcn_fence(__ATOMIC_ACQUIRE, "agent");
            xb_add(&bar[XB_XGEN(b.x)], 1u);
            asm volatile("s_waitcnt vmcnt(0)" ::: "memory");
        } else {
            XB_SPIN(xb_ld(&bar[XB_XGEN(b.x)]) == gen, bar);
            __builtin_amdgcn_fence(__ATOMIC_ACQUIRE, "agent");
            asm volatile("s_waitcnt vmcnt(0)" ::: "memory");
        }
    }
    __syncthreads();
}

namespace pg8 {
constexpr int BM = 256, BK = 64, HALF = 128, HTB = HALF * BK * 2, STAGE_BYTES = 8 * HTB, NXCD = 8, WGM = 8;
__host__ __device__ __forceinline__ int lds_byte(int r, int c) { const int st = (r >> 4) * 2 + (c >> 5), rr = r & 15, cc = c & 31, ob = rr * 64 + cc * 2; return st * 1024 + (ob ^ (((ob >> 9) & 1) << 5)); }
__host__ __device__ __forceinline__ void stage_rc(int b, int& R, int& C) { const int st = b / 1024, sb = b % 1024, swz = sb ^ (((sb >> 9) & 1) << 5); R = (st >> 1) * 16 + swz / 64; C = (st & 1) * 32 + (swz % 64) / 2; }
__host__ __device__ __forceinline__ int perm32(int rho) { const int n = rho >> 4, i = rho & 15; return 8 * (i >> 2) + 4 * n + (i & 3); }

struct Unit { int pm, pn, e; const char* a; const char* b; };

__device__ __forceinline__ void tile_map(int L, int nM, int nN, int& pm, int& pn) {
    const int nwg = nM * nN; int wgid = L;
    { const int q = nwg / NXCD, r = nwg % NXCD, xcd = wgid % NXCD, off = wgid / NXCD; wgid = (xcd < r ? xcd * (q + 1) : r * (q + 1) + (xcd - r) * q) + off; }
    const int nig = WGM * nN, gid = wgid / nig, fm = gid * WGM, gsz = (nM - fm) < WGM ? (nM - fm) : WGM;
    pm = fm + ((wgid % nig) % gsz); pn = (wgid % nig) / gsz;
}
struct SchedDense {
    const char* A; const char* B; int nM, nN, G, c; size_t tstep;
    __device__ __forceinline__ bool next(int i, Unit& u) const {
        const long L = (long)i * G + c; if (L >= (long)nM * nN) return false;
        tile_map((int)L, nM, nN, u.pm, u.pn); u.e = 0; u.a = A + (size_t)u.pm * tstep; u.b = B + (size_t)u.pn * tstep; return true; }
    __device__ __forceinline__ int row_of(int, int) const { return 0; }
};
struct SchedBranch {
    const char* A0; const char* A1; const char* A2; const char* B; size_t bstride; int nM, nN, G, c, nb, b0, b1; size_t tstep; int nmax = 1 << 30;
    __device__ __forceinline__ bool next(int i, Unit& u) const {
        const int nwg = nM * nN, j = i % nb; const long Lr = (long)(i / nb) * G + c; if (Lr >= nwg || i / nb >= nmax) return false;
        const int br = (j == 0) ? b0 : b1;
        tile_map((int)Lr, nM, nN, u.pm, u.pn); u.e = br; u.a = (br == 0 ? A0 : (br == 1 ? A1 : A2)) + (size_t)u.pm * tstep; u.b = B + (size_t)br * bstride + (size_t)u.pn * tstep; return true; }
    __device__ __forceinline__ int row_of(int, int) const { return 0; }
};
struct SchedGrouped {
    const char* A; const char* B; size_t estride; const int* tile_e; int nM, nN, G, c; size_t tstep; const int* rows;
    __device__ __forceinline__ bool next(int i, Unit& u) const {
        const long L = (long)i * G + c; if (L >= (long)nM * nN) return false;
        tile_map((int)L, nM, nN, u.pm, u.pn); u.e = __builtin_amdgcn_readfirstlane(tile_e[u.pm]); u.a = rows ? A : A + (size_t)u.pm * tstep; u.b = B + (size_t)u.e * estride + (size_t)u.pn * tstep; return true; }
    __device__ __forceinline__ int row_of(int pm, int r) const { return rows[pm * BM + r]; }
};
struct EpiStoreBf16 {
    static constexpr bool PERM = true;
    bf16* O; int ldc;
    __device__ __forceinline__ void operator()(const f32x4 (&acc)[2][2][4][2], const Unit& u, int wr, int wc, int fr, int fq) const {
        const int row0 = u.pm * BM + wr * 64 + fr, col0 = u.pn * BM + wc * 32 + 8 * fq;
#pragma unroll
        for (int ai = 0; ai < 2; ++ai)
#pragma unroll
            for (int m = 0; m < 4; ++m) { bf16* rowp = O + (size_t)(row0 + ai * HALF + m * 16) * ldc + col0;
#pragma unroll
                for (int bj = 0; bj < 2; ++bj) { const f32x4 v0 = acc[ai][bj][m][0], v1 = acc[ai][bj][m][1];
                    v4u w; w.x = cvt_pk_bf16(v0[0], v0[1]); w.y = cvt_pk_bf16(v0[2], v0[3]); w.z = cvt_pk_bf16(v1[0], v1[1]); w.w = cvt_pk_bf16(v1[2], v1[3]);
                    *(v4u*)(rowp + bj * HALF) = w; } }
    }
};
struct EpiKV {
    static constexpr bool PERM = true;
    bf16* K; bf16* VT;
    __device__ __forceinline__ void operator()(const f32x4 (&acc)[2][2][4][2], const Unit& u, int wr, int wc, int fr, int fq) const {
        const int row0 = wr * 64 + fr, colt = u.pn * BM + wc * 32 + 8 * fq;
#pragma unroll
        for (int ai = 0; ai < 2; ++ai)
#pragma unroll
            for (int m = 0; m < 4; ++m) { const int key = row0 + ai * HALF + m * 16;
#pragma unroll
                for (int bj = 0; bj < 2; ++bj) { const f32x4 v0 = acc[ai][bj][m][0], v1 = acc[ai][bj][m][1]; const int col = colt + bj * HALF;
                    v4u w; w.x = cvt_pk_bf16(v0[0], v0[1]); w.y = cvt_pk_bf16(v0[2], v0[3]); w.z = cvt_pk_bf16(v1[0], v1[1]); w.w = cvt_pk_bf16(v1[2], v1[3]);
                    if (u.pn < 2) *(v4u*)(K + (size_t)(u.pm * BM + key) * 512 + col) = w;
                    else { bf16* d = VT + ((size_t)u.pm * 512 + (col - 512)) * 256 + key;
                        d[0] = (bf16)(w.x & 0xffff); d[256] = (bf16)(w.x >> 16); d[512] = (bf16)(w.y & 0xffff); d[768] = (bf16)(w.y >> 16);
                        d[1024] = (bf16)(w.z & 0xffff); d[1280] = (bf16)(w.z >> 16); d[1536] = (bf16)(w.w & 0xffff); d[1792] = (bf16)(w.w >> 16); } } }
    }
};
struct EpiBranch {
    static constexpr bool PERM = true;
    const bf16* proj; bf16* mb; int store_br;
    __device__ __forceinline__ void operator()(const f32x4 (&acc)[2][2][4][2], const Unit& u, int wr, int wc, int fr, int fq) const {
        const int row0 = u.pm * BM + wr * 64 + fr, col0 = u.pn * BM + wc * 32 + 8 * fq; const int br = u.e; const bool accum = (br != store_br);
        const bf16* gp = proj + (size_t)row0 * NPROJ + C_GL + br * D + col0; bf16* mp = mb + (size_t)row0 * D + col0;
#pragma unroll
        for (int ai = 0; ai < 2; ++ai) {
            v4u gw[4][2], ow[4][2];
#pragma unroll
            for (int m = 0; m < 4; ++m)
#pragma unroll
                for (int bj = 0; bj < 2; ++bj) { const size_t ro = (size_t)(ai * HALF + m * 16); const int co = bj * HALF;
                    gw[m][bj] = *(const v4u*)(gp + ro * NPROJ + co); ow[m][bj] = accum ? *(const v4u*)(mp + ro * D + co) : (v4u){0u, 0u, 0u, 0u}; }
#pragma unroll
            for (int m = 0; m < 4; ++m)
#pragma unroll
                for (int bj = 0; bj < 2; ++bj) { const size_t ro = (size_t)(ai * HALF + m * 16); const int co = bj * HALF; const v4u g4 = gw[m][bj], o = ow[m][bj];
                    const f32x4 a0 = acc[ai][bj][m][0], a1 = acc[ai][bj][m][1];
                    v4u w;
                    w.x = cvt_pk_bf16(sigmoidf_(bf_lo(g4.x)) * a0[0] + bf_lo(o.x), sigmoidf_(bf_hi(g4.x)) * a0[1] + bf_hi(o.x));
                    w.y = cvt_pk_bf16(sigmoidf_(bf_lo(g4.y)) * a0[2] + bf_lo(o.y), sigmoidf_(bf_hi(g4.y)) * a0[3] + bf_hi(o.y));
                    w.z = cvt_pk_bf16(sigmoidf_(bf_lo(g4.z)) * a1[0] + bf_lo(o.z), sigmoidf_(bf_hi(g4.z)) * a1[1] + bf_hi(o.z));
                    w.w = cvt_pk_bf16(sigmoidf_(bf_lo(g4.w)) * a1[2] + bf_lo(o.w), sigmoidf_(bf_hi(g4.w)) * a1[3] + bf_hi(o.w));
                    *(v4u*)(mp + ro * D + co) = w; }
        }
    }
};
struct EpiOut {
    static constexpr bool PERM = true;
    const bf16* hb; bf16* tb;
    __device__ __forceinline__ void operator()(const f32x4 (&acc)[2][2][4][2], const Unit& u, int wr, int wc, int fr, int fq) const {
        const int row0 = u.pm * BM + wr * 64 + fr, col0 = u.pn * BM + wc * 32 + 8 * fq;
        const bf16* hp = hb + (size_t)row0 * D + col0; bf16* tp = tb + (size_t)row0 * D + col0;
#pragma unroll
        for (int ai = 0; ai < 2; ++ai) {
            v4u hw[4][2];
#pragma unroll
            for (int m = 0; m < 4; ++m)
#pragma unroll
                for (int bj = 0; bj < 2; ++bj) hw[m][bj] = *(const v4u*)(hp + (size_t)(ai * HALF + m * 16) * D + bj * HALF);
#pragma unroll
            for (int m = 0; m < 4; ++m)
#pragma unroll
                for (int bj = 0; bj < 2; ++bj) { const v4u h = hw[m][bj]; const f32x4 a0 = acc[ai][bj][m][0], a1 = acc[ai][bj][m][1];
                    v4u w; w.x = cvt_pk_bf16(bf_lo(h.x) * ALPHA + a0[0], bf_hi(h.x) * ALPHA + a0[1]); w.y = cvt_pk_bf16(bf_lo(h.y) * ALPHA + a0[2], bf_hi(h.y) * ALPHA + a0[3]);
                    w.z = cvt_pk_bf16(bf_lo(h.z) * ALPHA + a1[0], bf_hi(h.z) * ALPHA + a1[1]); w.w = cvt_pk_bf16(bf_lo(h.w) * ALPHA + a1[2], bf_hi(h.w) * ALPHA + a1[3]);
                    *(v4u*)(tp + (size_t)(ai * HALF + m * 16) * D + bj * HALF) = w; }
        }
    }
};
struct EpiSwiglu {
    static constexpr bool PERM = true;
    bf16* H; const float* bgu;
    __device__ __forceinline__ void operator()(const f32x4 (&acc)[2][2][4][2], const Unit& u, int wr, int wc, int fr, int fq) const {
        const int row0 = u.pm * BM + wr * 64 + fr, cc0 = u.pn * HALF + wc * 32 + 8 * fq;
        const float* bg = bgu + (size_t)u.e * 2048 + cc0;
        f32x4 bgv[2], buv[2];
#pragma unroll
        for (int n = 0; n < 2; ++n) { bgv[n] = *(const f32x4*)(bg + 4 * n); buv[n] = *(const f32x4*)(bg + 1024 + 4 * n); }
#pragma unroll
        for (int ai = 0; ai < 2; ++ai)
#pragma unroll
            for (int m = 0; m < 4; ++m) { float h[8];
#pragma unroll
                for (int n = 0; n < 2; ++n)
#pragma unroll
                    for (int j = 0; j < 4; ++j) { float g = acc[ai][0][m][n][j] + bgv[n][j], up = acc[ai][1][m][n][j] + buv[n][j];
                        g = fminf(g, 7.0f); up = fminf(fmaxf(up, -7.0f), 7.0f);
                        h[n * 4 + j] = (up + 1.0f) * (g * sigmoidf_(g * 1.702f)); }
                v4u w; w.x = cvt_pk_bf16(h[0], h[1]); w.y = cvt_pk_bf16(h[2], h[3]); w.z = cvt_pk_bf16(h[4], h[5]); w.w = cvt_pk_bf16(h[6], h[7]);
                *(v4u*)(H + (size_t)(row0 + ai * HALF + m * 16) * DFF + cc0) = w; }
    }
};
struct EpiDown {
    static constexpr bool PERM = true;
    bf16* Y; const float* bd; const float* slot_w;
    __device__ __forceinline__ void operator()(const f32x4 (&acc)[2][2][4][2], const Unit& u, int wr, int wc, int fr, int fq) const {
        const int row0 = u.pm * BM + wr * 64 + fr, col0 = u.pn * BM + wc * 32 + 8 * fq;
        const float* bp = bd + (size_t)u.e * D + col0;
        f32x4 bv[2][2];
#pragma unroll
        for (int bj = 0; bj < 2; ++bj)
#pragma unroll
            for (int n = 0; n < 2; ++n) bv[bj][n] = *(const f32x4*)(bp + bj * HALF + 4 * n);
#pragma unroll
        for (int ai = 0; ai < 2; ++ai)
#pragma unroll
            for (int m = 0; m < 4; ++m) { const int row = row0 + ai * HALF + m * 16; const float sw = slot_w[row]; bf16* rowp = Y + (size_t)row * D + col0;
#pragma unroll
                for (int bj = 0; bj < 2; ++bj) { const f32x4 v0 = (acc[ai][bj][m][0] + bv[bj][0]) * sw, v1 = (acc[ai][bj][m][1] + bv[bj][1]) * sw;
                    v4u w; w.x = cvt_pk_bf16(v0[0], v0[1]); w.y = cvt_pk_bf16(v0[2], v0[3]); w.z = cvt_pk_bf16(v1[0], v1[1]); w.w = cvt_pk_bf16(v1[2], v1[3]);
                    *(v4u*)(rowp + bj * HALF) = w; } }
    }
};

template <class Epi, class Sched, bool ALIGN_EPI, bool SP2, bool GATHER = false>
__device__ __forceinline__ void gemm_phase(LAS unsigned char* lds, const int K, const Sched& S, const Epi& E, int wave_id) {
    unsigned z0_ = 0u; asm volatile("" : "+s"(z0_)); int ln_ = (int)__builtin_amdgcn_mbcnt_hi(~0u, __builtin_amdgcn_mbcnt_lo(~0u, z0_)); asm volatile("" : "+v"(ln_)); asm volatile("" : "+s"(wave_id));
    const int wid = wave_id, lane = ln_, tid = wid * 64 + lane, wr = wid >> 2, wc = wid & 3, fr = lane & 15, fq = lane >> 4;
    const int nt = K / BK;
    static_assert(!GATHER || SP2, "row gather is written for the two-super-phase loop");
    unsigned voffA[2], voffB[2], gC[2]; int gR[2];
    unsigned vAc[2][2], vAn[2][2];
#define PG8_ROWS(dst, pm_) do { _Pragma("unroll") for (int h_ = 0; h_ < 2; ++h_) _Pragma("unroll") for (int i_ = 0; i_ < 2; ++i_) dst[h_][i_] = (unsigned)S.row_of(pm_, h_ * HALF + gR[i_]) * (unsigned)(K * 2) + gC[i_]; } while (0)
#define PG8_STAGE_A(bufoff, gbase, h, OFF) do { if constexpr (GATHER) { PG8_STAGE(bufoff, gbase, OFF[h]); } else { PG8_STAGE(bufoff, (gbase) + (h) * hstep, voffA); } } while (0)
#pragma unroll
    for (int i = 0; i < 2; ++i) { int R, C; stage_rc(tid * 16 + i * 8192, R, C); const int Rb = Epi::PERM ? ((R & ~31) + perm32(R & 31)) : R;
        voffA[i] = (unsigned)(R * K + C) * 2u; voffB[i] = (unsigned)(Rb * K + C) * 2u; gR[i] = R; gC[i] = (unsigned)C * 2u; }
    const size_t kstep = (size_t)(BK * 2);
    const size_t hstep = (size_t)HALF * K * 2;
    const unsigned ldsw = (unsigned)wid * 1024u;
    const int aoff = lds_byte(wr * 64 + fr, fq * 8), boff = lds_byte(wc * 32 + fr, fq * 8);
#define PG8_SA(b, h) (((b) * 2 + (h)) * HTB)
#define PG8_SB(b, h) ((4 + (b) * 2 + (h)) * HTB)
#define PG8_STAGE(bufoff, gbase, voff) do { _Pragma("unroll") for (int _i = 0; _i < 2; ++_i) \
        __builtin_amdgcn_global_load_lds((const unsigned*)((const char*)(gbase) + (voff)[_i]), (LAS unsigned*)(lds + (bufoff) + ldsw + _i * 8192), 16, 0, 0); } while (0)
#define PG8_LDA(dst, b, h) do { _Pragma("unroll") for (int m = 0; m < 4; ++m) _Pragma("unroll") for (int k = 0; k < 2; ++k) dst[m][k] = *(const LAS bf16x8*)(lds + PG8_SA(b, h) + aoff + m * 2048 + k * 1024); } while (0)
#define PG8_LDB(dst, b, h) do { _Pragma("unroll") for (int n = 0; n < 2; ++n) _Pragma("unroll") for (int k = 0; k < 2; ++k) dst[n][k] = *(const LAS bf16x8*)(lds + PG8_SB(b, h) + boff + n * 2048 + k * 1024); } while (0)
#define PG8_MMA(ai, bj, At, Bt) do { __builtin_amdgcn_s_setprio(1); _Pragma("unroll") for (int m = 0; m < 4; ++m) _Pragma("unroll") for (int n = 0; n < 2; ++n) _Pragma("unroll") for (int k = 0; k < 2; ++k) \
        acc[ai][bj][m][n] = __builtin_amdgcn_mfma_f32_16x16x32_bf16(Bt[n][k], At[m][k], acc[ai][bj][m][n], 0, 0, 0); __builtin_amdgcn_s_setprio(0); } while (0)
#define PG8_WAIT_V(n) asm volatile("s_waitcnt vmcnt(" #n ")" ::: "memory")
#define PG8_WAIT_L(n) asm volatile("s_waitcnt lgkmcnt(" #n ")" ::: "memory")
#define PG8_BAR __builtin_amdgcn_s_barrier()
#define PG8_SCHED __builtin_amdgcn_sched_barrier(0)
    Unit cur, nxt; int ui = 0;
    if (!S.next(0, cur)) return;
    f32x4 acc[2][2][4][2];
#pragma unroll
    for (int a = 0; a < 2; ++a)
#pragma unroll
        for (int b = 0; b < 2; ++b)
#pragma unroll
            for (int m = 0; m < 4; ++m)
#pragma unroll
                for (int n = 0; n < 2; ++n) acc[a][b][m][n] = (f32x4){0.f, 0.f, 0.f, 0.f};
    bf16x8 At[4][2], B0[2][2], B1[2][2];
    const char* cA = cur.a; const char* cB = cur.b;
    if constexpr (SP2) {
        if constexpr (GATHER) { PG8_ROWS(vAc, cur.pm); asm volatile("s_waitcnt vmcnt(0)" ::: "memory"); }
        PG8_STAGE(PG8_SB(0, 0), cB, voffB); PG8_STAGE(PG8_SB(0, 1), cB + hstep, voffB); PG8_STAGE_A(PG8_SA(0, 0), cA, 0, vAc); PG8_STAGE_A(PG8_SA(0, 1), cA, 1, vAc);
        if (wr == 1) PG8_BAR;
        PG8_WAIT_V(2); PG8_BAR;
        PG8_STAGE(PG8_SB(1, 0), cB + kstep, voffB); PG8_STAGE_A(PG8_SA(1, 0), cA + kstep, 0, vAc); PG8_STAGE(PG8_SB(1, 1), cB + hstep + kstep, voffB);
        PG8_WAIT_V(6); PG8_BAR;
    } else {
        PG8_STAGE(PG8_SB(0, 0), cB, voffB); PG8_STAGE(PG8_SA(0, 0), cA, voffA); PG8_STAGE(PG8_SB(0, 1), cB + hstep, voffB); PG8_STAGE(PG8_SA(0, 1), cA + hstep, voffA);
        if (wr == 1) PG8_BAR;
        PG8_WAIT_V(4); PG8_BAR;
        PG8_STAGE(PG8_SB(1, 0), cB + kstep, voffB); PG8_STAGE(PG8_SA(1, 0), cA + kstep, voffA); PG8_STAGE(PG8_SB(1, 1), cB + hstep + kstep, voffB);
        PG8_WAIT_V(6); PG8_BAR;
    }
    for (;;) {
        const bool has_next = S.next(ui + 1, nxt);
        const char* nA = has_next ? nxt.a : cA; const char* nB = has_next ? nxt.b : cB;
        if constexpr (GATHER) { if (ui == 0) { if (has_next) PG8_ROWS(vAn, nxt.pm); else { _Pragma("unroll") for (int h_ = 0; h_ < 2; ++h_) _Pragma("unroll") for (int i_ = 0; i_ < 2; ++i_) vAn[h_][i_] = vAc[h_][i_]; } } }
        for (int t = 0; t < nt; t += 2) {
            const bool last = (t == nt - 2);
            const char* a1 = cA + (size_t)(t + 1) * kstep;
            const char* a2 = last ? nA : cA + (size_t)(t + 2) * kstep; const char* b2 = last ? nB : cB + (size_t)(t + 2) * kstep;
            const char* a3 = a2 + kstep; const char* b3 = b2 + kstep;
            if constexpr (SP2) {
            unsigned o2[2][2];
            if constexpr (GATHER) { _Pragma("unroll") for (int h_ = 0; h_ < 2; ++h_) _Pragma("unroll") for (int i_ = 0; i_ < 2; ++i_) o2[h_][i_] = last ? vAn[h_][i_] : vAc[h_][i_]; }
            PG8_LDB(B0, 0, 0); PG8_LDB(B1, 0, 1); PG8_SCHED; PG8_LDA(At, 0, 0); PG8_STAGE_A(PG8_SA(1, 1), a1, 1, vAc);
            PG8_WAIT_V(8); PG8_WAIT_L(0); PG8_BAR; PG8_MMA(0, 0, At, B0); PG8_MMA(0, 1, At, B1); PG8_BAR; PG8_SCHED;
            PG8_LDA(At, 0, 1); PG8_STAGE(PG8_SB(0, 0), b2, voffB); PG8_STAGE(PG8_SB(0, 1), b2 + hstep, voffB); PG8_STAGE_A(PG8_SA(0, 0), a2, 0, o2);
            PG8_WAIT_V(8); PG8_WAIT_L(0); PG8_BAR; PG8_MMA(1, 0, At, B0); PG8_MMA(1, 1, At, B1); PG8_BAR; PG8_SCHED;
            PG8_LDB(B0, 1, 0); PG8_LDB(B1, 1, 1); PG8_SCHED; PG8_LDA(At, 1, 0); PG8_STAGE_A(PG8_SA(0, 1), a2, 1, o2);
            PG8_WAIT_V(8); PG8_WAIT_L(0); PG8_BAR; PG8_MMA(0, 0, At, B0); PG8_MMA(0, 1, At, B1); PG8_BAR; PG8_SCHED;
            PG8_LDA(At, 1, 1); PG8_STAGE(PG8_SB(1, 0), b3, voffB); PG8_STAGE(PG8_SB(1, 1), b3 + hstep, voffB); PG8_STAGE_A(PG8_SA(1, 0), a3, 0, o2);
            PG8_WAIT_V(8); PG8_WAIT_L(0); PG8_BAR; PG8_MMA(1, 0, At, B0); PG8_MMA(1, 1, At, B1); PG8_BAR; PG8_SCHED;
            } else {
            PG8_LDB(B0, 0, 0); PG8_SCHED; PG8_LDA(At, 0, 0); PG8_STAGE(PG8_SA(1, 1), a1 + hstep, voffA);
            PG8_WAIT_L(8); PG8_BAR; PG8_WAIT_L(0); PG8_MMA(0, 0, At, B0); PG8_BAR; PG8_SCHED;
            PG8_LDB(B1, 0, 1); PG8_STAGE(PG8_SB(0, 0), b2, voffB);
            PG8_BAR; PG8_WAIT_L(0); PG8_MMA(0, 1, At, B1); PG8_BAR;
            PG8_LDA(At, 0, 1); PG8_STAGE(PG8_SA(0, 0), a2, voffA);
            PG8_BAR; PG8_WAIT_L(0); PG8_MMA(1, 0, At, B0); PG8_BAR; PG8_SCHED;
            PG8_STAGE(PG8_SB(0, 1), b2 + hstep, voffB);
            PG8_WAIT_V(6); PG8_BAR; PG8_MMA(1, 1, At, B1); PG8_BAR;
            PG8_LDB(B0, 1, 0); PG8_SCHED; PG8_LDA(At, 1, 0); PG8_STAGE(PG8_SA(0, 1), a2 + hstep, voffA);
            PG8_WAIT_L(8); PG8_BAR; PG8_WAIT_L(0); PG8_MMA(0, 0, At, B0); PG8_BAR; PG8_SCHED;
            PG8_LDB(B1, 1, 1); PG8_STAGE(PG8_SB(1, 0), b3, voffB);
            PG8_BAR; PG8_WAIT_L(0); PG8_MMA(0, 1, At, B1); PG8_BAR;
            PG8_LDA(At, 1, 1); PG8_STAGE(PG8_SA(1, 0), a3, voffA);
            PG8_BAR; PG8_WAIT_L(0); PG8_MMA(1, 0, At, B0); PG8_BAR; PG8_SCHED;
            PG8_STAGE(PG8_SB(1, 1), b3 + hstep, voffB);
            PG8_WAIT_V(6); PG8_BAR; PG8_MMA(1, 1, At, B1); PG8_BAR;
            }
        }
        if constexpr (ALIGN_EPI) { if (wr == 0) PG8_BAR; }
        E(acc, cur, wr, wc, fr, fq);
        if (!has_next) break;
#pragma unroll
        for (int a = 0; a < 2; ++a)
#pragma unroll
            for (int b = 0; b < 2; ++b)
#pragma unroll
                for (int m = 0; m < 4; ++m)
#pragma unroll
                    for (int n = 0; n < 2; ++n) acc[a][b][m][n] = (f32x4){0.f, 0.f, 0.f, 0.f};
        if constexpr (GATHER) { _Pragma("unroll") for (int h_ = 0; h_ < 2; ++h_) _Pragma("unroll") for (int i_ = 0; i_ < 2; ++i_) vAc[h_][i_] = vAn[h_][i_];
            Unit nn; if (S.next(ui + 2, nn)) PG8_ROWS(vAn, nn.pm); }
        cur = nxt; cA = nA; cB = nB; ++ui;
        if constexpr (ALIGN_EPI) { if (wr == 1) PG8_BAR; }
    }
    PG8_WAIT_V(0);
    if constexpr (!ALIGN_EPI) { if (wr == 0) PG8_BAR; }
    PG8_BAR;
#undef PG8_ROWS
#undef PG8_STAGE_A
#undef PG8_SA
#undef PG8_SB
#undef PG8_STAGE
#undef PG8_LDA
#undef PG8_LDB
#undef PG8_MMA
#undef PG8_WAIT_V
#undef PG8_WAIT_L
#undef PG8_BAR
#undef PG8_SCHED
}
}

struct Args { const float* in[23]; float* out; unsigned char* ws; int ph_lo, ph_hi; };
struct Ctx {
    LAS unsigned char* lds; int tid, lane, wave, G, bid;
    const float* const* in; float* out; unsigned char* ws;
};
__device__ __forceinline__ Ctx fresh(const Ctx& F) {
    Ctx R = F; unsigned z0 = 0u; asm volatile("" : "+s"(z0)); int ln = (int)__builtin_amdgcn_mbcnt_hi(~0u, __builtin_amdgcn_mbcnt_lo(~0u, z0)); asm volatile("" : "+v"(ln));
    int wv = F.wave; asm volatile("" : "+s"(wv)); R.wave = wv; R.lane = ln; R.tid = wv * 64 + ln;
    unsigned char* w = F.ws; asm volatile("" : "+s"(w)); R.ws = as_global(w); R.out = as_global(F.out);
    int bd = F.bid, gg = F.G; asm volatile("" : "+s"(bd)); asm volatile("" : "+s"(gg)); R.bid = bd; R.G = gg;
    return R;
}
enum { I_X = 0, I_MEM, I_LN0G, I_LN0B, I_WIN, I_CONVQKV, I_CONVMIX, I_ALOG, I_DTB, I_GDNNORM, I_WMEMKV, I_WBR, I_WO, I_LN1G, I_LN1B, I_WR, I_BR, I_WGU, I_BGU, I_WD, I_BD, I_LN2G, I_LN2B };

__device__ __forceinline__ void transpose_item(const float* src, int ld, bf16* dst, int ldk, LAS float* scr, int lane) {
#pragma unroll 8
    for (int i = 0; i < 32; ++i) { const int kk = 2 * i + (lane >> 5); scr[kk * 33 + (lane & 31)] = src[(size_t)kk * ld + (lane & 31)]; }
    LDS_WAIT();
    const int c = lane & 7;
#pragma unroll
    for (int j = 0; j < 4; ++j) { const int n = (lane >> 3) + 8 * j; const LAS float* s = scr + (8 * c) * 33 + n;
        v4u o; o.x = cvt_pk_bf16(s[0 * 33], s[1 * 33]); o.y = cvt_pk_bf16(s[2 * 33], s[3 * 33]); o.z = cvt_pk_bf16(s[4 * 33], s[5 * 33]); o.w = cvt_pk_bf16(s[6 * 33], s[7 * 33]);
        *(v4u*)(dst + (size_t)n * ldk + 8 * c) = o; }
    LDS_WAIT();
}
__device__ __forceinline__ void ln_apply(f32x4 (&v)[4], const float* g, const float* b, int lane) {
    float s = 0.f;
#pragma unroll
    for (int j = 0; j < 4; ++j) s += (v[j][0] + v[j][1]) + (v[j][2] + v[j][3]);
    const float mean = wave_sum(s) * (1.f / D); float s2 = 0.f;
#pragma unroll
    for (int j = 0; j < 4; ++j) { v[j] = v[j] - mean; s2 += (v[j][0] * v[j][0] + v[j][1] * v[j][1]) + (v[j][2] * v[j][2] + v[j][3] * v[j][3]); }
    const float rstd = 1.f / sqrtf(wave_sum(s2) * (1.f / D) + LN_EPS);
#pragma unroll
    for (int j = 0; j < 4; ++j) { const f32x4 gg = *(const f32x4*)(g + 4 * lane + 256 * j), bb = *(const f32x4*)(b + 4 * lane + 256 * j); v[j] = v[j] * rstd * gg + bb; }
}
__device__ __forceinline__ void load_row_bf16(const bf16* p, f32x4 (&v)[4], int lane) {
#pragma unroll
    for (int j = 0; j < 4; ++j) { const v2u w = *(const v2u*)(p + 4 * lane + 256 * j); v[j] = (f32x4){bf_lo(w.x), bf_hi(w.x), bf_lo(w.y), bf_hi(w.y)}; }
}
__device__ __forceinline__ void store_row_f32(float* p, const f32x4 (&v)[4], int lane) {
#pragma unroll
    for (int j = 0; j < 4; ++j) *(f32x4*)(p + 4 * lane + 256 * j) = v[j];
}
__device__ __forceinline__ void store_row_bf16(bf16* p, const f32x4 (&v)[4], int lane) {
#pragma unroll
    for (int j = 0; j < 4; ++j) { v2u w; w.x = cvt_pk_bf16(v[j][0], v[j][1]); w.y = cvt_pk_bf16(v[j][2], v[j][3]); *(v2u*)(p + 4 * lane + 256 * j) = w; }
}
__device__ __forceinline__ void small_proj(const f32x4 (&v)[4], const LAS float* ws_s, float* ab_row, int lane) {
    float keep = 0.f;
#pragma unroll
    for (int c = 0; c < 8; ++c) { float p = 0.f;
#pragma unroll
        for (int j = 0; j < 4; ++j) { const f32x4 w = *(const LAS f32x4*)(ws_s + c * 1024 + 4 * lane + 256 * j); p += (v[j][0] * w[0] + v[j][1] * w[1]) + (v[j][2] * w[2] + v[j][3] * w[3]); }
        p = wave_sum(p); keep = (lane == c) ? p : keep; }
    if (lane < 8) ab_row[lane] = keep;
}
__device__ __forceinline__ void load_small_w(Ctx& F, int l, LAS float* ws_s) {
    const float* w = as_global(F.in[I_WIN]) + (size_t)l * D * NPROJ_SRC + 1536;
    for (int i = F.tid; i < 8 * 1024; i += 512) { const int k = i >> 3, c = i & 7; ws_s[c * 1024 + k] = w[(size_t)k * NPROJ_SRC + c]; }
}

constexpr int N_IN = 2 * 3584, N_BR = 6 * 256, N_O = 2 * 512, N_KV = 2 * 512, N_GU = 64 * 1024, N_D = 64 * 512;
constexpr int NITEMS = N_IN + N_BR + N_O + N_KV + N_GU + N_D;
#ifndef NDEF_PER_WAVE
#define NDEF_PER_WAVE 24
#endif
constexpr int NDEF = (256 - 32 - 8 * NHELP) * 8 * NDEF_PER_WAVE;
static_assert(NDEF <= N_GU + N_D, "deferred items must be MoE weights");
__device__ __forceinline__ void convert_items(Ctx& F, int first, int step, int begin, int end) {
    LAS float* scr = (LAS float*)(F.lds + F.wave * 8448);
    bf16* WinT = (bf16*)(F.ws + WS_WIN); bf16* WbrT = (bf16*)(F.ws + WS_WBR); bf16* WoT = (bf16*)(F.ws + WS_WO); bf16* WkvT = (bf16*)(F.ws + WS_WKV);
    bf16* WguT = (bf16*)(F.ws + WS_WGU); bf16* WdT = (bf16*)(F.ws + WS_WD);
    for (int it = begin + first; it < end; it += step) {
        int r = it;
        if (r < N_IN) { const int l = r / 3584, q = r % 3584, kb = q / 224, nb = q % 224, k0 = 64 * kb, n0 = 32 * nb, ns = n0 + (n0 >= 1536 ? 8 : 0);
            transpose_item(as_global(F.in[I_WIN]) + (size_t)l * D * NPROJ_SRC + (size_t)k0 * NPROJ_SRC + ns, NPROJ_SRC, WinT + (size_t)l * NPROJ * D + (size_t)n0 * D + k0, D, scr, F.lane); continue; }
        r -= N_IN;
        if (r < N_BR) { const int m = r / 256, q = r % 256, kb = q / 32, nb = q % 32, k0 = 64 * kb, n0 = 32 * nb;
            transpose_item(as_global(F.in[I_WBR]) + (size_t)m * 512 * D + (size_t)k0 * D + n0, D, WbrT + (size_t)m * D * 512 + (size_t)n0 * 512 + k0, 512, scr, F.lane); continue; }
        r -= N_BR;
        if (r < N_O) { const int l = r / 512, q = r % 512, kb = q / 32, nb = q % 32, k0 = 64 * kb, n0 = 32 * nb;
            transpose_item(as_global(F.in[I_WO]) + (size_t)l * D * D + (size_t)k0 * D + n0, D, WoT + (size_t)l * D * D + (size_t)n0 * D + k0, D, scr, F.lane); continue; }
        r -= N_O;
        if (r < N_KV) { const int l = r / 512, q = r % 512, kb = q / 32, nb = q % 32, k0 = 64 * kb, n0 = 32 * nb;
            transpose_item(as_global(F.in[I_WMEMKV]) + (size_t)l * D * D + (size_t)k0 * D + n0, D, WkvT + (size_t)l * D * D + (size_t)n0 * D + k0, D, scr, F.lane); continue; }
        r -= N_KV;
        if (r < N_GU) { const int m = r / 1024, q = r % 1024, kb = q / 64, nb = q % 64, k0 = 64 * kb, n0 = 32 * nb, jj = n0 / 256, r0 = n0 % 256;
            const int ns = (r0 < 128) ? (128 * jj + r0) : (1024 + 128 * jj + r0 - 128);
            transpose_item(as_global(F.in[I_WGU]) + (size_t)m * D * 2048 + (size_t)k0 * 2048 + ns, 2048, WguT + (size_t)m * 2048 * D + (size_t)n0 * D + k0, D, scr, F.lane); continue; }
        r -= N_GU;
        { const int m = r / 512, q = r % 512, kb = q / 32, nb = q % 32, k0 = 64 * kb, n0 = 32 * nb;
            transpose_item(as_global(F.in[I_WD]) + (size_t)m * D * D + (size_t)k0 * D + n0, D, WdT + (size_t)m * D * D + (size_t)n0 * D + k0, D, scr, F.lane); }
    }
}
__device__ __forceinline__ void convert_deferred(Ctx& F, int first, int step) {
    LAS float* scr = (LAS float*)(F.lds + F.wave * 8448);
    bf16* WguT = (bf16*)(F.ws + WS_WGU); bf16* WdT = (bf16*)(F.ws + WS_WD);
    for (int it = NITEMS - NDEF + first; it < NITEMS; it += step) {
        int r = it - (N_IN + N_BR + N_O + N_KV);
        if (r < N_GU) { const int m = r / 1024, q = r % 1024, kb = q / 64, nb = q % 64, k0 = 64 * kb, n0 = 32 * nb, jj = n0 / 256, r0 = n0 % 256;
            const int ns = (r0 < 128) ? (128 * jj + r0) : (1024 + 128 * jj + r0 - 128);
            transpose_item(as_global(F.in[I_WGU]) + (size_t)m * D * 2048 + (size_t)k0 * 2048 + ns, 2048, WguT + (size_t)m * 2048 * D + (size_t)n0 * D + k0, D, scr, F.lane); continue; }
        r -= N_GU;
        { const int m = r / 512, q = r % 512, kb = q / 32, nb = q % 32, k0 = 64 * kb, n0 = 32 * nb;
            transpose_item(as_global(F.in[I_WD]) + (size_t)m * D * D + (size_t)k0 * D + n0, D, WdT + (size_t)m * D * D + (size_t)n0 * D + k0, D, scr, F.lane); }
    }
}

__device__ __forceinline__ void phase_prologue(Ctx& F) {
    LAS float* ws_s = (LAS float*)(F.lds + 69632);
    const int gw = F.bid * 8 + F.wave, NGW = F.G * 8;
    convert_items(F, gw, NGW, 0, NITEMS - NDEF);
    { const f32x4* src = (const f32x4*)as_global(F.in[I_MEM]); v2u* dst = (v2u*)(F.ws + WS_MEMB);
      for (int i = F.bid * 512 + F.tid; i < NB * NMEM * D / 4; i += F.G * 512) { const f32x4 x = src[i]; v2u w; w.x = cvt_pk_bf16(x[0], x[1]); w.y = cvt_pk_bf16(x[2], x[3]); dst[i] = w; } }
    load_small_w(F, 0, ws_s);
    __syncthreads();
    bf16* hb = (bf16*)(F.ws + WS_HB); float* ab = (float*)(F.ws + WS_AB);
    for (int m = gw; m < NTOK; m += NGW) {
        f32x4 v[4]; const float* xr = as_global(F.in[I_X]) + (size_t)m * D;
#pragma unroll
        for (int j = 0; j < 4; ++j) v[j] = *(const f32x4*)(xr + 4 * F.lane + 256 * j);
        ln_apply(v, as_global(F.in[I_LN0G]), as_global(F.in[I_LN0B]), F.lane);
        store_row_bf16(hb + (size_t)m * D, v, F.lane);
        small_proj(v, ws_s, ab + (size_t)m * 8, F.lane);
    }
}

__device__ __forceinline__ void unpack8(const v4u x, float (&o)[8]) { o[0] = bf_lo(x.x); o[1] = bf_hi(x.x); o[2] = bf_lo(x.y); o[3] = bf_hi(x.y); o[4] = bf_lo(x.z); o[5] = bf_hi(x.z); o[6] = bf_lo(x.w); o[7] = bf_hi(x.w); }
__device__ __forceinline__ void conv4_silu(const v4u x0, const v4u x1, const v4u x2, const v4u x3, const LAS float* w  , float (&o)[8]) {
    float a[8], b[8], c[8], d[8]; unpack8(x0, a); unpack8(x1, b); unpack8(x2, c); unpack8(x3, d);
    const f32x4 w0l = *(const LAS f32x4*)(w), w0h = *(const LAS f32x4*)(w + 4), w1l = *(const LAS f32x4*)(w + 1536), w1h = *(const LAS f32x4*)(w + 1540);
    const f32x4 w2l = *(const LAS f32x4*)(w + 3072), w2h = *(const LAS f32x4*)(w + 3076), w3l = *(const LAS f32x4*)(w + 4608), w3h = *(const LAS f32x4*)(w + 4612);
#pragma unroll
    for (int i = 0; i < 8; ++i) { const float w0 = i < 4 ? w0l[i & 3] : w0h[i & 3], w1 = i < 4 ? w1l[i & 3] : w1h[i & 3], w2 = i < 4 ? w2l[i & 3] : w2h[i & 3], w3 = i < 4 ? w3l[i & 3] : w3h[i & 3];
        const float s = (w0 * a[i] + w1 * b[i]) + (w2 * c[i] + w3 * d[i]); o[i] = siluf_(s); }
}
__device__ __forceinline__ void phase_prep(Ctx& F, int l) {
    const bf16* proj = (const bf16*)(F.ws + WS_R1);
    LAS float* cw = (LAS float*)F.lds;
    LAS float* mw = (LAS float*)(F.lds + 4 * 1536 * 4);
    for (int i = F.tid; i < 4 * 1536; i += 512) cw[i] = as_global(F.in[I_CONVQKV])[(size_t)l * 4 * 1536 + i];
    for (int i = F.tid; i < 3 * 512; i += 512) mw[i] = as_global(F.in[I_CONVMIX])[(size_t)l * 3 * 512 + i];
    __syncthreads();
    const int lane = F.lane, c8 = lane * 8, hh = lane >> 4;
    bf16* qnb = (bf16*)(F.ws + WS_QN); bf16* knb = (bf16*)(F.ws + WS_KN); bf16* vvb = (bf16*)(F.ws + WS_VV); float* gs = (float*)(F.ws + WS_GS);
    const float* ab = (const float*)(F.ws + WS_AB); bf16* yb = (bf16*)(F.ws + WS_YB);
    const float Ah = __expf(as_global(F.in[I_ALOG])[l * 4 + hh]), dtb = as_global(F.in[I_DTB])[l * 4 + hh];
    const int gw = F.bid * 8 + F.wave, NGW = F.G * 8;
    for (int t0 = gw * 16; t0 < NTOK; t0 += NGW * 16) {
        const bool first = (t0 % T) == 0;
        const v4u z4 = {0u, 0u, 0u, 0u};
        v4u q0, q1, q2, k0, k1, k2, v0, v1, v2; float p0[8], p1[8];
        if (first) { q0 = q1 = q2 = k0 = k1 = k2 = v0 = v1 = v2 = z4;
#pragma unroll
            for (int i = 0; i < 8; ++i) { p0[i] = 0.f; p1[i] = 0.f; } }
        else {
            const bf16* r3 = proj + (size_t)(t0 - 3) * NPROJ + c8; const bf16* r2 = r3 + NPROJ; const bf16* r1 = r2 + NPROJ;
            q0 = *(const v4u*)(r3 + C_Q); q1 = *(const v4u*)(r2 + C_Q); q2 = *(const v4u*)(r1 + C_Q);
            k0 = *(const v4u*)(r3 + C_K); k1 = *(const v4u*)(r2 + C_K); k2 = *(const v4u*)(r1 + C_K);
            v0 = *(const v4u*)(r3 + C_V); v1 = *(const v4u*)(r2 + C_V); v2 = *(const v4u*)(r1 + C_V);
            float a[8], b[8]; unpack8(*(const v4u*)(r2 + C_XC), a); unpack8(*(const v4u*)(r2 + C_GC), b);
#pragma unroll
            for (int i = 0; i < 8; ++i) p0[i] = a[i] * b[i];
            unpack8(*(const v4u*)(r1 + C_XC), a); unpack8(*(const v4u*)(r1 + C_GC), b);
#pragma unroll
            for (int i = 0; i < 8; ++i) p1[i] = a[i] * b[i];
        }
        v4u nq, nk, nv, nxc, ngc, ngb; float na = 0.f, nbt = 0.f;
        { const bf16* rn = proj + (size_t)t0 * NPROJ + c8; nq = *(const v4u*)(rn + C_Q); nk = *(const v4u*)(rn + C_K); nv = *(const v4u*)(rn + C_V); nxc = *(const v4u*)(rn + C_XC); ngc = *(const v4u*)(rn + C_GC); ngb = *(const v4u*)(rn + C_GB);
          if ((lane & 15) == 0) { na = ab[(size_t)t0 * 8 + hh]; nbt = ab[(size_t)t0 * 8 + 4 + hh]; } }
        for (int i16 = 0; i16 < 16; ++i16) {
            const int tok = t0 + i16;
            const v4u q3 = nq, k3 = nk, v3 = nv, xc3 = nxc, gc3 = ngc, gb3 = ngb; const float a_in = na, bt_in = nbt;
            if (i16 < 15) { const bf16* rn = proj + (size_t)(tok + 1) * NPROJ + c8; nq = *(const v4u*)(rn + C_Q); nk = *(const v4u*)(rn + C_K); nv = *(const v4u*)(rn + C_V); nxc = *(const v4u*)(rn + C_XC); ngc = *(const v4u*)(rn + C_GC); ngb = *(const v4u*)(rn + C_GB);
                if ((lane & 15) == 0) { na = ab[(size_t)(tok + 1) * 8 + hh]; nbt = ab[(size_t)(tok + 1) * 8 + 4 + hh]; } }
            float qo[8], ko[8], vo[8];
            conv4_silu(q0, q1, q2, q3, cw + C_Q + c8, qo); conv4_silu(k0, k1, k2, k3, cw + C_K + c8, ko); conv4_silu(v0, v1, v2, v3, cw + C_V + c8, vo);
            q0 = q1; q1 = q2; q2 = q3; k0 = k1; k1 = k2; k2 = k3; v0 = v1; v1 = v2; v2 = v3;
            float sq = 0.f, sk = 0.f;
#pragma unroll
            for (int i = 0; i < 8; ++i) { sq += qo[i] * qo[i]; sk += ko[i] * ko[i]; }
            sq = row16_sum(sq); sk = row16_sum(sk);
            const float rq = (1.f / sqrtf(sq + RMS_EPS)) * 0.08838834764831845f, rk = 1.f / sqrtf(sk + RMS_EPS);
#pragma unroll
            for (int i = 0; i < 8; ++i) { qo[i] *= rq; ko[i] *= rk; }
            { v4u w; w.x = cvt_pk_bf16(qo[0], qo[1]); w.y = cvt_pk_bf16(qo[2], qo[3]); w.z = cvt_pk_bf16(qo[4], qo[5]); w.w = cvt_pk_bf16(qo[6], qo[7]); *(v4u*)(qnb + (size_t)tok * 512 + c8) = w; }
            { v4u w; w.x = cvt_pk_bf16(ko[0], ko[1]); w.y = cvt_pk_bf16(ko[2], ko[3]); w.z = cvt_pk_bf16(ko[4], ko[5]); w.w = cvt_pk_bf16(ko[6], ko[7]); *(v4u*)(knb + (size_t)tok * 512 + c8) = w; }
            { v4u w; w.x = cvt_pk_bf16(vo[0], vo[1]); w.y = cvt_pk_bf16(vo[2], vo[3]); w.z = cvt_pk_bf16(vo[4], vo[5]); w.w = cvt_pk_bf16(vo[6], vo[7]); *(v4u*)(vvb + (size_t)tok * 512 + c8) = w; }
            if ((lane & 15) == 0) {
                const float a = a_in + dtb, bt = bt_in;
                const float sp = a > 20.f ? a : log1pf(expf(a));
                const float g = -Ah * sp;
                *(f32x4*)(gs + ((size_t)tok * 4 + hh) * 4) = (f32x4){g, 1.f / (1.f + expf(-bt)), 0.f, 0.f};
            }
            float xa[8], ga[8], gbv[8], p2[8]; unpack8(xc3, xa); unpack8(gc3, ga); unpack8(gb3, gbv);
            const f32x4 m0l = *(const LAS f32x4*)(mw + c8), m0h = *(const LAS f32x4*)(mw + c8 + 4), m1l = *(const LAS f32x4*)(mw + 512 + c8), m1h = *(const LAS f32x4*)(mw + 512 + c8 + 4);
            const f32x4 m2l = *(const LAS f32x4*)(mw + 1024 + c8), m2h = *(const LAS f32x4*)(mw + 1024 + c8 + 4);
            float yo[8];
#pragma unroll
            for (int i = 0; i < 8; ++i) { p2[i] = xa[i] * ga[i];
                const float w0 = i < 4 ? m0l[i & 3] : m0h[i & 3], w1 = i < 4 ? m1l[i & 3] : m1h[i & 3], w2 = i < 4 ? m2l[i & 3] : m2h[i & 3];
                yo[i] = gbv[i] * ((w0 * p0[i] + w1 * p1[i]) + w2 * p2[i]); p0[i] = p1[i]; p1[i] = p2[i]; }
            v4u w; w.x = cvt_pk_bf16(yo[0], yo[1]); w.y = cvt_pk_bf16(yo[2], yo[3]); w.z = cvt_pk_bf16(yo[4], yo[5]); w.w = cvt_pk_bf16(yo[6], yo[7]);
            *(v4u*)(yb + (size_t)tok * 512 + c8) = w;
        }
    }
}

#define MFMA16(a, b, c) __builtin_amdgcn_mfma_f32_16x16x32_bf16(a, b, c, 0, 0, 0)
__device__ __forceinline__ bf16x8 pack8(const f32x4 a, const f32x4 b) { v4u w; w.x = cvt_pk_nat(a[0], a[1]); w.y = cvt_pk_nat(a[2], a[3]); w.z = cvt_pk_nat(b[0], b[1]); w.w = cvt_pk_nat(b[2], b[3]); return __builtin_bit_cast(bf16x8, w); }
__device__ __forceinline__ v2u pack4(const f32x4 a) { v2u w; w.x = cvt_pk_nat(a[0], a[1]); w.y = cvt_pk_nat(a[2], a[3]); return w; }
constexpr int GA_PITCH = 72, GA_WAVE_BYTES = 19456;
constexpr int NCHUNK = NB * 4 * (T / 64);

__device__ __forceinline__ void gdn_kend_products(const LAS bf16* XA, const LAS bf16* XB, const LAS float* sE, const v4u* UPK, const v4u* WPK, int ci, int lane, v2u* BC, v4u* ATF) {
    const int fr = lane & 15, fq = lane >> 4;
    bf16x8 ke[8][2];
#pragma unroll
    for (int mt = 0; mt < 8; ++mt)
#pragma unroll
        for (int s = 0; s < 2; ++s) { const LAS bf16* p = (mt < 4 ? XA : XB) + (16 * (mt & 3) + fr) * GA_PITCH + 32 * s + 4 * fq;
            const v2u lo = *(const LAS v2u*)p, hi = *(const LAS v2u*)(p + 16); const f32x4 e0 = *(const LAS f32x4*)(sE + 32 * s + 4 * fq), e1 = *(const LAS f32x4*)(sE + 32 * s + 16 + 4 * fq);
            ke[mt][s] = pack8((f32x4){bf_lo(lo.x) * e0[0], bf_hi(lo.x) * e0[1], bf_lo(lo.y) * e0[2], bf_hi(lo.y) * e0[3]}, (f32x4){bf_lo(hi.x) * e1[0], bf_hi(hi.x) * e1[1], bf_lo(hi.y) * e1[2], bf_hi(hi.y) * e1[3]}); }
#pragma unroll 4
    for (int ne = 0; ne < 8; ++ne) {
        const bf16x8 u0 = __builtin_bit_cast(bf16x8, (UPK + ((size_t)ci * 16 + 2 * ne) * 64)[(unsigned)lane]), u1 = __builtin_bit_cast(bf16x8, (UPK + ((size_t)ci * 16 + 2 * ne + 1) * 64)[(unsigned)lane]);
#pragma unroll
        for (int mt = 0; mt < 8; ++mt) { f32x4 acc = (f32x4){0.f, 0.f, 0.f, 0.f}; acc = MFMA16(ke[mt][0], u0, acc); acc = MFMA16(ke[mt][1], u1, acc);
            (BC + ((size_t)(ci * 8 + ne) * 8 + mt) * 64)[(unsigned)lane] = pack4(acc); } }
#pragma unroll 2
    for (int sp = 0; sp < 4; ++sp) {
        const bf16x8 w00 = __builtin_bit_cast(bf16x8, (WPK + ((size_t)ci * 16 + 4 * sp) * 64)[(unsigned)lane]), w01 = __builtin_bit_cast(bf16x8, (WPK + ((size_t)ci * 16 + 4 * sp + 1) * 64)[(unsigned)lane]);
        const bf16x8 w10 = __builtin_bit_cast(bf16x8, (WPK + ((size_t)ci * 16 + 4 * sp + 2) * 64)[(unsigned)lane]), w11 = __builtin_bit_cast(bf16x8, (WPK + ((size_t)ci * 16 + 4 * sp + 3) * 64)[(unsigned)lane]);
#pragma unroll
        for (int mt = 0; mt < 8; ++mt) { f32x4 d0 = (f32x4){0.f, 0.f, 0.f, 0.f}, d1 = (f32x4){0.f, 0.f, 0.f, 0.f};
            d0 = MFMA16(w00, ke[mt][0], d0); d0 = MFMA16(w01, ke[mt][1], d0); d1 = MFMA16(w10, ke[mt][0], d1); d1 = MFMA16(w11, ke[mt][1], d1);
            (ATF + ((size_t)(ci * 8 + mt) * 4 + sp) * 64)[(unsigned)lane] = __builtin_bit_cast(v4u, pack8(-d0, -d1)); } }
}
__device__ __forceinline__ void xb_store_pair(LAS bf16* XB, int r0, unsigned w, int lane) {
    const unsigned send = (lane & 1) ? (w & 0xffffu) : (w >> 16);
    const unsigned recv = (unsigned)__builtin_amdgcn_update_dpp(0, (int)send, 0xB1, 0xF, 0xF, true);
    const unsigned outw = (lane & 1) ? (recv | (w & 0xffff0000u)) : ((w & 0xffffu) | (recv << 16));
    *(LAS unsigned*)(XB + (r0 + (lane & 1)) * GA_PITCH + (lane & ~1)) = outw;
}
__device__ __forceinline__ void gdn_fill_kT(const bf16* KN, LAS bf16* XB, int tok0, int h, int half, int lane) {
    const bf16* kbase = KN + (size_t)tok0 * 512 + h * 128 + half * 64; const unsigned lo = (unsigned)lane * 512u;
    asm volatile("s_waitcnt lgkmcnt(0)" ::: "memory");
#pragma unroll
    for (int c = 0; c < 8; ++c) { const v4u x = *(const v4u*)((kbase + 8 * c) + lo);
        xb_store_pair(XB, 8 * c, x.x, lane); xb_store_pair(XB, 8 * c + 2, x.y, lane); xb_store_pair(XB, 8 * c + 4, x.z, lane); xb_store_pair(XB, 8 * c + 6, x.w, lane); }
    asm volatile("s_waitcnt lgkmcnt(0)" ::: "memory");
}
__device__ __forceinline__ void phase_gdn_a(Ctx& F) {
    const int lane = F.lane, fr = lane & 15, fq = lane >> 4;
    LAS unsigned char* wl = F.lds + F.wave * GA_WAVE_BYTES;
    LAS bf16* Ts = (LAS bf16*)wl; LAS bf16* XB = (LAS bf16*)(wl + 9216);
    LAS float* gcv = (LAS float*)(wl + 18432); LAS float* sKp = gcv + 64; LAS float* sE = gcv + 128; LAS float* bev = gcv + 192;
    const bf16* KN = (const bf16*)(F.ws + WS_KN); const bf16* QN = (const bf16*)(F.ws + WS_QN); const bf16* VV = (const bf16*)(F.ws + WS_VV); const float* gs = (const float*)(F.ws + WS_GS);
    v2u* BC = (v2u*)(F.ws + WS_BC); v4u* ATF = (v4u*)(F.ws + WS_ATF); v4u* QTF = (v4u*)(F.ws + WS_QTF); v2u* OL = (v2u*)(F.ws + WS_OL); float* CD = (float*)(F.ws + WS_CD);
    v4u* UPK = (v4u*)(F.ws + WS_UPK); v4u* WPK = (v4u*)(F.ws + WS_WPK);
    { const int b = F.bid >> 7, h = F.wave & 3, n = 2 * (F.bid & 127) + (F.wave >> 2);
        const int bh = b * 4 + h, ci = bh * 256 + n, tok0 = b * T + n * 64;
        const f32x2 gb = *(const f32x2*)((gs + ((size_t)tok0 * 4 + h) * 4) + (unsigned)lane * 16u);
        float gc = gb.x; const float be = gb.y;
#pragma unroll
        for (int off = 1; off < 64; off <<= 1) { const float t = bperm(gc, (lane - off) & 63); gc += (lane >= off) ? t : 0.f; }
        const float gl = rdlane(gc, 63);
        gcv[lane] = gc; sKp[lane] = be * __expf(gc); sE[lane] = __expf(gl - gc); bev[lane] = be;
        if (lane == 0) CD[ci] = __expf(gl);
        asm volatile("s_waitcnt lgkmcnt(0)" ::: "memory");
        {
            bf16x8 kf[4][4];
#pragma unroll
            for (int t = 0; t < 4; ++t)
#pragma unroll
                for (int s = 0; s < 4; ++s) kf[t][s] = *(const bf16x8*)((KN + (size_t)(tok0 + 16 * t) * 512 + h * 128 + 32 * s) + ((unsigned)fr * 512u + 8u * (unsigned)fq));
            float gcj[4];
#pragma unroll
            for (int t = 0; t < 4; ++t) gcj[t] = gcv[16 * t + fr];
            LAS float* Nc = (LAS float*)wl;
#pragma unroll
            for (int t = 0; t < 4; ++t) { const f32x4 gci = *(const LAS f32x4*)(gcv + 16 * t + 4 * fq), bei = *(const LAS f32x4*)(bev + 16 * t + 4 * fq);
#pragma unroll
                for (int u = 0; u <= t; ++u) {
                    f32x4 acc = (f32x4){0.f, 0.f, 0.f, 0.f};
#pragma unroll
                    for (int s = 0; s < 4; ++s) acc = MFMA16(kf[t][s], kf[u][s], acc);
                    f32x4 nv;
#pragma unroll
                    for (int r = 0; r < 4; ++r) { const int i = 16 * t + 4 * fq + r, j = 16 * u + fr; const float v = bei[r] * acc[r] * __expf(fminf(gci[r] - gcj[u], 0.f)); nv[r] = (i > j) ? v : 0.f; }
                    *(LAS f32x4*)(Nc + (16 * u + fr) * 64 + 16 * t + 4 * fq) = nv;
                } }
        }
        asm volatile("s_waitcnt lgkmcnt(0)" ::: "memory");
        {
            float x[64];
#pragma unroll
            for (int c = 63; c >= 0; --c) { float a = (lane == c) ? 1.f : 0.f, a1 = 0.f, a2 = 0.f, a3 = 0.f;
#pragma unroll
                for (int k4 = ((c + 1) & ~3); k4 < 64; k4 += 4) { const f32x4 nv = *(const LAS f32x4*)((const LAS float*)wl + c * 64 + k4);
                    if (k4 + 0 > c) a -= x[k4 + 0] * nv[0]; if (k4 + 1 > c) a1 -= x[k4 + 1] * nv[1]; if (k4 + 2 > c) a2 -= x[k4 + 2] * nv[2]; if (k4 + 3 > c) a3 -= x[k4 + 3] * nv[3]; }
                a = (a + a1) + (a2 + a3);
                asm volatile("" : "+v"(a) :: "memory");
                x[c] = a; }
#pragma unroll
            for (int q8 = 0; q8 < 8; ++q8) { v4u w; w.x = cvt_pk_nat(x[8 * q8], x[8 * q8 + 1]); w.y = cvt_pk_nat(x[8 * q8 + 2], x[8 * q8 + 3]); w.z = cvt_pk_nat(x[8 * q8 + 4], x[8 * q8 + 5]); w.w = cvt_pk_nat(x[8 * q8 + 6], x[8 * q8 + 7]);
                *(LAS v4u*)(Ts + lane * GA_PITCH + 8 * q8) = w; }
        }
        asm volatile("s_waitcnt lgkmcnt(0)" ::: "memory");
        {
            bf16x8 tsf[4][2];
#pragma unroll
            for (int t = 0; t < 4; ++t)
#pragma unroll
                for (int s = 0; s < 2; ++s) tsf[t][s] = *(const LAS bf16x8*)(Ts + (16 * t + fr) * GA_PITCH + 32 * s + 8 * fq);
#pragma unroll 1
            for (int half = 0; half < 2; ++half) {
                const bf16* vbase = VV + (size_t)tok0 * 512 + h * 128 + half * 64; const unsigned vlo = (unsigned)lane * 512u;
#pragma unroll
                for (int c = 0; c < 8; ++c) { float f[8]; unpack8(*(const v4u*)((vbase + 8 * c) + vlo), f);
#pragma unroll
                    for (int i2 = 0; i2 < 4; ++i2) xb_store_pair(XB, 8 * c + 2 * i2, cvt_pk_nat(f[2 * i2] * be, f[2 * i2 + 1] * be), lane); }
                asm volatile("s_waitcnt lgkmcnt(0)" ::: "memory");
#pragma unroll
                for (int nl = 0; nl < 4; ++nl) { const bf16x8 b0 = *(const LAS bf16x8*)(XB + (16 * nl + fr) * GA_PITCH + 8 * fq), b1 = *(const LAS bf16x8*)(XB + (16 * nl + fr) * GA_PITCH + 32 + 8 * fq);
                    f32x4 ut[4];
#pragma unroll
                    for (int t = 0; t < 4; ++t) { f32x4 acc = (f32x4){0.f, 0.f, 0.f, 0.f}; acc = MFMA16(tsf[t][0], b0, acc); if (t >= 2) acc = MFMA16(tsf[t][1], b1, acc); ut[t] = acc; }
                    (UPK + ((size_t)ci * 16 + 2 * (half * 4 + nl)) * 64)[(unsigned)lane] = __builtin_bit_cast(v4u, pack8(ut[0], ut[1]));
                    (UPK + ((size_t)ci * 16 + 2 * (half * 4 + nl) + 1) * 64)[(unsigned)lane] = __builtin_bit_cast(v4u, pack8(ut[2], ut[3])); }
                asm volatile("s_waitcnt lgkmcnt(0)" ::: "memory");
            }
#pragma unroll 1
            for (int half = 0; half < 2; ++half) {
                gdn_fill_kT(KN, XB, tok0, h, half, lane);
#pragma unroll
                for (int nl = 0; nl < 4; ++nl) { bf16x8 kp[2];
#pragma unroll
                    for (int s = 0; s < 2; ++s) { const v4u raw = *(const LAS v4u*)(XB + (16 * nl + fr) * GA_PITCH + 32 * s + 8 * fq); const f32x4 c0 = *(const LAS f32x4*)(sKp + 32 * s + 8 * fq), c1 = *(const LAS f32x4*)(sKp + 32 * s + 8 * fq + 4);
                        kp[s] = pack8((f32x4){bf_lo(raw.x) * c0[0], bf_hi(raw.x) * c0[1], bf_lo(raw.y) * c0[2], bf_hi(raw.y) * c0[3]}, (f32x4){bf_lo(raw.z) * c1[0], bf_hi(raw.z) * c1[1], bf_lo(raw.w) * c1[2], bf_hi(raw.w) * c1[3]}); }
                    f32x4 wt[4];
#pragma unroll
                    for (int t = 0; t < 4; ++t) { f32x4 acc = (f32x4){0.f, 0.f, 0.f, 0.f}; acc = MFMA16(tsf[t][0], kp[0], acc); if (t >= 2) acc = MFMA16(tsf[t][1], kp[1], acc); wt[t] = acc; }
                    (WPK + ((size_t)ci * 16 + 2 * (half * 4 + nl)) * 64)[(unsigned)lane] = __builtin_bit_cast(v4u, pack8(wt[0], wt[1]));
                    (WPK + ((size_t)ci * 16 + 2 * (half * 4 + nl) + 1) * 64)[(unsigned)lane] = __builtin_bit_cast(v4u, pack8(wt[2], wt[3])); }
                asm volatile("s_waitcnt lgkmcnt(0)" ::: "memory");
            }
        }
        asm volatile("s_waitcnt vmcnt(0)" ::: "memory");
        gdn_fill_kT(KN, Ts, tok0, h, 0, lane);
        gdn_kend_products(Ts, XB, sE, UPK, WPK, ci, lane, BC, ATF);
        asm volatile("s_waitcnt lgkmcnt(0)" ::: "memory");
        bf16x8 qkpk[4][2];
        {
            bf16x8 kf[4][4];
#pragma unroll
            for (int t = 0; t < 4; ++t)
#pragma unroll
                for (int s = 0; s < 4; ++s) kf[t][s] = *(const bf16x8*)((KN + (size_t)(tok0 + 16 * t) * 512 + h * 128 + 32 * s) + ((unsigned)fr * 512u + 8u * (unsigned)fq));
#pragma unroll
            for (int t = 0; t < 4; ++t) { bf16x8 qf[4]; const float gct = gcv[16 * t + fr];
#pragma unroll
                for (int s = 0; s < 4; ++s) qf[s] = *(const bf16x8*)((QN + (size_t)(tok0 + 16 * t) * 512 + h * 128 + 32 * s) + ((unsigned)fr * 512u + 8u * (unsigned)fq));
                f32x4 tl[4];
#pragma unroll
                for (int u = 0; u < 4; ++u) { tl[u] = (f32x4){0.f, 0.f, 0.f, 0.f}; if (u > t) continue;
                    const f32x4 gcu = *(const LAS f32x4*)(gcv + 16 * u + 4 * fq);
                    f32x4 acc = (f32x4){0.f, 0.f, 0.f, 0.f};
#pragma unroll
                    for (int s = 0; s < 4; ++s) acc = MFMA16(kf[u][s], qf[s], acc);
#pragma unroll
                    for (int r = 0; r < 4; ++r) { const int i = 16 * t + fr, j = 16 * u + 4 * fq + r; const float v = acc[r] * __expf(fminf(gct - gcu[r], 0.f)); tl[u][r] = (i >= j) ? v : 0.f; } }
                qkpk[t][0] = pack8(tl[0], tl[1]); qkpk[t][1] = pack8(tl[2], tl[3]); }
        }
        asm volatile("s_waitcnt lgkmcnt(0)" ::: "memory");
#pragma unroll 2
        for (int sp = 0; sp < 4; ++sp) {
            const bf16x8 w00 = __builtin_bit_cast(bf16x8, (WPK + ((size_t)ci * 16 + 4 * sp) * 64)[(unsigned)lane]), w01 = __builtin_bit_cast(bf16x8, (WPK + ((size_t)ci * 16 + 4 * sp + 1) * 64)[(unsigned)lane]);
            const bf16x8 w10 = __builtin_bit_cast(bf16x8, (WPK + ((size_t)ci * 16 + 4 * sp + 2) * 64)[(unsigned)lane]), w11 = __builtin_bit_cast(bf16x8, (WPK + ((size_t)ci * 16 + 4 * sp + 3) * 64)[(unsigned)lane]);
#pragma unroll
            for (int t = 0; t < 4; ++t) { const float egi = __expf(gcv[16 * t + fr]); f32x4 dd[2];
#pragma unroll
                for (int hh = 0; hh < 2; ++hh) { f32x4 acc = (f32x4){0.f, 0.f, 0.f, 0.f}; acc = MFMA16(hh ? w10 : w00, qkpk[t][0], acc); if (t >= 2) acc = MFMA16(hh ? w11 : w01, qkpk[t][1], acc);
                    const v2u q4 = *(const v2u*)((QN + (size_t)(tok0 + 16 * t) * 512 + h * 128) + ((unsigned)fr * 512u + 4u * (unsigned)fq + 16u * (unsigned)(2 * sp + hh)));
                    dd[hh] = (f32x4){bf_lo(q4.x) * egi - acc[0], bf_hi(q4.x) * egi - acc[1], bf_lo(q4.y) * egi - acc[2], bf_hi(q4.y) * egi - acc[3]}; }
                (QTF + ((size_t)(ci * 4 + t) * 4 + sp) * 64)[(unsigned)lane] = __builtin_bit_cast(v4u, pack8(dd[0], dd[1])); } }
#pragma unroll 4
        for (int et = 0; et < 8; ++et) {
            const bf16x8 u0 = __builtin_bit_cast(bf16x8, (UPK + ((size_t)ci * 16 + 2 * et) * 64)[(unsigned)lane]), u1 = __builtin_bit_cast(bf16x8, (UPK + ((size_t)ci * 16 + 2 * et + 1) * 64)[(unsigned)lane]);
#pragma unroll
            for (int t = 0; t < 4; ++t) { f32x4 acc = (f32x4){0.f, 0.f, 0.f, 0.f}; acc = MFMA16(u0, qkpk[t][0], acc); if (t >= 2) acc = MFMA16(u1, qkpk[t][1], acc);
                (OL + ((size_t)(ci * 8 + et) * 4 + t) * 64)[(unsigned)lane] = pack4(acc); } }
    }
}
__device__ __forceinline__ void phase_gdn_b_helper(Ctx& F, int epoch, int bh, int h) {
    const v4u* at = (const v4u*)(F.ws + WS_ATF) + (size_t)bh * 256 * 2048 + F.tid;
    const v4u* bc = (const v4u*)(F.ws + WS_BC) + (size_t)bh * 256 * 2048 + F.tid;
    unsigned* prog = (unsigned*)(F.ws + WS_CTL) + CW_PROG + bh * 64; const unsigned pbase = (unsigned)epoch * 1024u + 1u;
    v4u acc = (v4u){0u, 0u, 0u, 0u}; v4u d0[8], d1[8];
#pragma unroll
    for (int j = 0; j < 8; ++j) { d0[j] = (v4u){0u, 0u, 0u, 0u}; d1[j] = (v4u){0u, 0u, 0u, 0u}; }
#define HP_WAIT(n_) do { if ((n_) >= HLEAD) { const unsigned want_ = pbase + (unsigned)((n_) - HLEAD); unsigned spins_ = 0; \
        while ((unsigned)__builtin_amdgcn_readfirstlane((int)__hip_atomic_load(prog, __ATOMIC_RELAXED, __HIP_MEMORY_SCOPE_AGENT)) < want_ && ++spins_ < (1u << 18)) __builtin_amdgcn_s_sleep(1); } } while (0)
#define HP_LOAD(d, n_) do { const v4u* a_ = at + (size_t)(n_) * 2048; const v4u* b_ = bc + (size_t)(n_) * 2048; \
        _Pragma("unroll") for (int j = 0; j < 4; ++j) { d[j] = a_[512 * j]; d[4 + j] = b_[512 * j]; } } while (0)
#define HP_USE(d) do { _Pragma("unroll") for (int j = 0; j < 8; ++j) { acc.x ^= d[j].x; acc.y ^= d[j].y; acc.z ^= d[j].z; acc.w ^= d[j].w; } } while (0)
    for (int n = h; n < 256; n += 2 * NHELP) {
        HP_WAIT(n); HP_USE(d0); HP_LOAD(d0, n);
        if (n + NHELP < 256) { HP_WAIT(n + NHELP); HP_USE(d1); HP_LOAD(d1, n + NHELP); }
    }
    HP_USE(d0); HP_USE(d1);
    asm volatile("" :: "v"(acc.x), "v"(acc.y), "v"(acc.z), "v"(acc.w));
#undef HP_WAIT
#undef HP_LOAD
#undef HP_USE
}
#ifndef B_OLDMAP
#define BH_OF(bid) ((bid) & 7)
#define SL_OF(bid) ((bid) >> 3)
#else
#define BH_OF(bid) ((bid) >> 2)
#define SL_OF(bid) ((bid) & 3)
#endif
__device__ __forceinline__ void phase_gdn_b(Ctx& F, int epoch, int bvar) {
    const int bh = BH_OF(F.bid), sl = SL_OF(F.bid), w = F.wave, lane = F.lane, fr = lane & 15, fq = lane >> 4;
    const v4u* ATF = (const v4u*)(F.ws + WS_ATF); const v2u* BC = (const v2u*)(F.ws + WS_BC); const float* CD = (const float*)(F.ws + WS_CD); bf16* ST = (bf16*)(F.ws + WS_ST);
    LAS unsigned char* xb = F.lds;
    const int cbase = bh * 256;
    unsigned* prog = (unsigned*)(F.ws + WS_CTL) + CW_PROG + bh * 64; const unsigned pbase = (unsigned)epoch * 1024u + 1u; const bool pub = (sl == 0) && (w == 0) && (lane == 0);
    f32x4 S[2]; S[0] = (f32x4){0.f, 0.f, 0.f, 0.f}; S[1] = (f32x4){0.f, 0.f, 0.f, 0.f};
    constexpr int RD = 6;
    v4u afr[RD][4]; v2u bcr[RD][2]; float cdr[RD];
#define GB_LOAD(k, n_) do { const int cc_ = (n_) < 256 ? (n_) : 255; const size_t ci_ = (size_t)(cbase + cc_); \
        _Pragma("unroll") for (int s_ = 0; s_ < 4; ++s_) afr[k][s_] = (ATF + ((ci_ * 8 + w) * 4 + s_) * 64)[(unsigned)lane]; \
        _Pragma("unroll") for (int n2_ = 0; n2_ < 2; ++n2_) bcr[k][n2_] = (BC + ((ci_ * 8 + 2 * sl + n2_) * 8 + w) * 64)[(unsigned)lane]; \
        cdr[k] = CD[ci_]; } while (0)
#pragma unroll
    for (int k = 0; k < RD; ++k) GB_LOAD(k, k);
    _Pragma("unroll") for (int k = 0; k < RD; ++k) asm volatile("" :: "v"(afr[k][0]), "v"(afr[k][1]), "v"(afr[k][2]), "v"(afr[k][3]), "v"(bcr[k][0]), "v"(bcr[k][1]), "v"(cdr[k]));
#define GB_STEP(k, n_, LOADNEXT) do { const int n = (n_), par = (k) & 1; const size_t ci = (size_t)(cbase + n); \
            if (NHELP > 0 && pub) __hip_atomic_store(prog, pbase + (unsigned)n, __ATOMIC_RELAXED, __HIP_MEMORY_SCOPE_AGENT);     \
            _Pragma("unroll") for (int nt = 0; nt < 2; ++nt) { const v2u p = pack4(S[nt]); \
                *(LAS v2u*)(xb + par * 8192 + ((nt * 4 + (w >> 1)) * 64 + lane) * 16 + (w & 1) * 8) = p; \
                if (!(bvar & 1)) ((v2u*)ST + ((ci * 8 + w) * 8 + 2 * sl + nt) * 64)[(unsigned)lane] = p; }     \
            asm volatile("s_waitcnt lgkmcnt(0)" ::: "memory"); __builtin_amdgcn_s_barrier(); asm volatile("" ::: "memory"); \
            bf16x8 sf[2][4]; \
            _Pragma("unroll") for (int nt = 0; nt < 2; ++nt) \
                _Pragma("unroll") for (int s = 0; s < 4; ++s) sf[nt][s] = *(const LAS bf16x8*)(xb + par * 8192 + ((nt * 4 + s) * 64 + lane) * 16); \
              \
            asm volatile("" : "+v"(cdr[k]));     \
            const float cdk = __builtin_bit_cast(float, __builtin_amdgcn_readfirstlane(__builtin_bit_cast(int, cdr[k]))); \
            _Pragma("unroll") for (int nt = 0; nt < 2; ++nt) { const v2u bw = bcr[k][nt]; f32x4 acc = S[nt] * cdk + (f32x4){bf_lo(bw.x), bf_hi(bw.x), bf_lo(bw.y), bf_hi(bw.y)}; \
                f32x4 acc2 = (f32x4){0.f, 0.f, 0.f, 0.f};                      \
                acc = MFMA16(__builtin_bit_cast(bf16x8, afr[k][0]), sf[nt][0], acc); acc2 = MFMA16(__builtin_bit_cast(bf16x8, afr[k][1]), sf[nt][1], acc2); \
                acc = MFMA16(__builtin_bit_cast(bf16x8, afr[k][2]), sf[nt][2], acc); acc2 = MFMA16(__builtin_bit_cast(bf16x8, afr[k][3]), sf[nt][3], acc2); \
                S[nt] = acc + acc2; } \
            if (LOADNEXT && !(bvar & 2)) GB_LOAD(k, n + RD); } while (0)
    for (int n0 = 0; n0 + RD <= 256; n0 += RD) {
#pragma unroll
        for (int k = 0; k < RD; ++k) GB_STEP(k, n0 + k, true);
    }
#pragma unroll
    for (int k = 0; k < 256 % RD; ++k) GB_STEP(k, 256 / RD * RD + k, false);
#undef GB_STEP
#undef GB_LOAD
}
__device__ __forceinline__ void phase_gdn_c(Ctx& F, int l) {
    const int lane = F.lane, fr = lane & 15, fq = lane >> 4;
    const v4u* QTF = (const v4u*)(F.ws + WS_QTF); const v2u* OL = (const v2u*)(F.ws + WS_OL); const bf16* ST = (const bf16*)(F.ws + WS_ST);
    const bf16* proj = (const bf16*)(F.ws + WS_R1); bf16* ya = (bf16*)(F.ws + WS_YA); const float* gnp = as_global(F.in[I_GDNNORM]) + (size_t)l * 128;
    { const int ci = F.bid * 8 + F.wave;
        const int bh = ci >> 8, n = ci & 255, b = bh >> 2, h = bh & 3, tok0 = b * T + n * 64;
        bf16x8 qt[4][4];
#pragma unroll
        for (int t = 0; t < 4; ++t)
#pragma unroll
            for (int s = 0; s < 4; ++s) qt[t][s] = __builtin_bit_cast(bf16x8, (QTF + ((size_t)(ci * 4 + t) * 4 + s) * 64)[(unsigned)lane]);
        f32x4 o[8][4];
#pragma unroll
        for (int et = 0; et < 8; ++et) {
#pragma unroll
            for (int t = 0; t < 4; ++t) { const v2u ow = (OL + ((size_t)(ci * 8 + et) * 4 + t) * 64)[(unsigned)lane]; o[et][t] = (f32x4){bf_lo(ow.x), bf_hi(ow.x), bf_lo(ow.y), bf_hi(ow.y)}; }
#pragma unroll
            for (int s = 0; s < 4; ++s) { const v2u lo = ((const v2u*)ST + (((size_t)ci * 8 + 2 * s) * 8 + et) * 64)[(unsigned)lane], hi = ((const v2u*)ST + (((size_t)ci * 8 + 2 * s + 1) * 8 + et) * 64)[(unsigned)lane];
                v4u aw; aw.x = lo.x; aw.y = lo.y; aw.z = hi.x; aw.w = hi.y; const bf16x8 a = __builtin_bit_cast(bf16x8, aw);
#pragma unroll
                for (int t = 0; t < 4; ++t) o[et][t] = MFMA16(a, qt[t][s], o[et][t]); }
        }
        LAS bf16* slab = (LAS bf16*)(F.lds + F.wave * (64 * 136 * 2));
#pragma unroll
        for (int t = 0; t < 4; ++t) { float ss = 0.f;
#pragma unroll
            for (int et = 0; et < 8; ++et) ss += (o[et][t][0] * o[et][t][0] + o[et][t][1] * o[et][t][1]) + (o[et][t][2] * o[et][t][2] + o[et][t][3] * o[et][t][3]);
            ss += bperm(ss, lane ^ 16); ss += bperm(ss, lane ^ 32);
            const float sc = 1.f / sqrtf(ss * (1.f / 128.f) + RMS_EPS);
#pragma unroll
            for (int et = 0; et < 8; ++et) *(LAS v2u*)(slab + (16 * t + fr) * 136 + 16 * et + 4 * fq) = pack4(o[et][t] * sc); }
        asm volatile("s_waitcnt lgkmcnt(0)" ::: "memory");
        { const int rr = lane >> 4, cc = (lane & 15) * 8;
          const f32x4 g0 = *(const f32x4*)(gnp + cc), g1 = *(const f32x4*)(gnp + cc + 4);
#pragma unroll 2
          for (int p = 0; p < 16; ++p) { const int i = 4 * p + rr;
              const v4u ov = *(const LAS v4u*)(slab + i * 136 + cc);
              const v4u zv = *(const v4u*)((proj + (size_t)tok0 * NPROJ + C_Z + h * 128) + ((unsigned)i * (unsigned)NPROJ + (unsigned)cc));
              float of[8], zf[8]; unpack8(ov, of); unpack8(zv, zf);
              v4u w; w.x = cvt_pk_nat(of[0] * g0[0] * siluf_(zf[0]), of[1] * g0[1] * siluf_(zf[1])); w.y = cvt_pk_nat(of[2] * g0[2] * siluf_(zf[2]), of[3] * g0[3] * siluf_(zf[3]));
              w.z = cvt_pk_nat(of[4] * g1[0] * siluf_(zf[4]), of[5] * g1[1] * siluf_(zf[5])); w.w = cvt_pk_nat(of[6] * g1[2] * siluf_(zf[6]), of[7] * g1[3] * siluf_(zf[7]));
              *(v4u*)((ya + (size_t)tok0 * 512 + h * 128) + ((unsigned)i * 512u + (unsigned)cc)) = w; } }
    }
}
constexpr int XK_PITCH = 136, XV_PITCH = 264;
__device__ __forceinline__ void phase_xattn(Ctx& F, int first, int stride) {
    const bf16* proj = (const bf16*)(F.ws + WS_R1); const bf16* kvb = (const bf16*)(F.ws + WS_KVB); const bf16* vtb = (const bf16*)(F.ws + WS_KVB + 512 * 1024); bf16* ym = (bf16*)(F.ws + WS_YM);
    LAS bf16* Ks = (LAS bf16*)F.lds; LAS bf16* VTs = (LAS bf16*)(F.lds + 256 * XK_PITCH * 2);
    const int NU = NB * 4 * (T / 512);
    for (int unit = first; unit < NU; unit += stride) {
        const int qt = unit % (T / 512), bh = unit / (T / 512), b = bh >> 2, head = bh & 3;
        int lane = F.lane; asm volatile("" : "+v"(lane));
        const int fr = lane & 15, fq = lane >> 4, tid_l = F.wave * 64 + lane;
        __syncthreads();
        for (int it = 0; it < 8; ++it) { const int idx = it * 512 + tid_l, key = idx >> 4, ch = idx & 15;
            const v4u kx = *(const v4u*)((kvb + (size_t)(b * NMEM) * 512 + head * 128) + ((unsigned)key * 512u + (unsigned)ch * 8u)); *(LAS v4u*)(Ks + key * XK_PITCH + ch * 8) = kx;
            const int e = idx >> 5, kc = idx & 31;
            const v4u vx = *(const v4u*)((vtb + (size_t)((b * 4 + head) * 128) * 256) + ((unsigned)e * 256u + (unsigned)kc * 8u)); *(LAS v4u*)(VTs + e * XV_PITCH + kc * 8) = vx; }
        __syncthreads();
#pragma unroll 1
        for (int qi = 0; qi < 2; ++qi) {
            const int tok0 = b * T + qt * 512 + F.wave * 64 + qi * 32;
            bf16x8 qf[2][4];
#pragma unroll
            for (int g = 0; g < 2; ++g)
#pragma unroll
                for (int s = 0; s < 4; ++s) qf[g][s] = *(const bf16x8*)((proj + (size_t)(tok0 + g * 16) * NPROJ + C_QM + head * 128 + 32 * s) + ((unsigned)fr * (unsigned)NPROJ + 8u * (unsigned)fq));
            f32x4 sc[2][16];
#pragma unroll
            for (int kt = 0; kt < 16; ++kt) {
                sc[0][kt] = (f32x4){0.f, 0.f, 0.f, 0.f}; sc[1][kt] = (f32x4){0.f, 0.f, 0.f, 0.f};
#pragma unroll
                for (int s = 0; s < 4; ++s) { const bf16x8 kf = *(const LAS bf16x8*)(Ks + (kt * 16 + fr) * XK_PITCH + 32 * s + 8 * fq);
                    sc[0][kt] = __builtin_amdgcn_mfma_f32_16x16x32_bf16(kf, qf[0][s], sc[0][kt], 0, 0, 0);
                    sc[1][kt] = __builtin_amdgcn_mfma_f32_16x16x32_bf16(kf, qf[1][s], sc[1][kt], 0, 0, 0); }
            }
            bf16x8 pf[2][8]; float inv[2];
#pragma unroll
            for (int g = 0; g < 2; ++g) {
                float mx = -3.0e38f;
#pragma unroll
                for (int kt = 0; kt < 16; ++kt) mx = fmaxf(mx, fmaxf(fmaxf(sc[g][kt][0], sc[g][kt][1]), fmaxf(sc[g][kt][2], sc[g][kt][3])));
                mx = fmaxf(mx, bperm(mx, lane ^ 16)); mx = fmaxf(mx, bperm(mx, lane ^ 32));
                float sum = 0.f;
#pragma unroll
                for (int kt = 0; kt < 16; ++kt)
#pragma unroll
                    for (int r = 0; r < 4; ++r) { const float p = __expf((sc[g][kt][r] - mx) * 0.08838834764831845f); sc[g][kt][r] = p; sum += p; }
                sum += bperm(sum, lane ^ 16); sum += bperm(sum, lane ^ 32);
                inv[g] = 1.f / sum;
#pragma unroll
                for (int ks = 0; ks < 8; ++ks) { v4u w; w.x = cvt_pk_bf16_n(sc[g][2 * ks][0], sc[g][2 * ks][1]); w.y = cvt_pk_bf16_n(sc[g][2 * ks][2], sc[g][2 * ks][3]);
                    w.z = cvt_pk_bf16_n(sc[g][2 * ks + 1][0], sc[g][2 * ks + 1][1]); w.w = cvt_pk_bf16_n(sc[g][2 * ks + 1][2], sc[g][2 * ks + 1][3]); pf[g][ks] = __builtin_bit_cast(bf16x8, w); }
            }
#pragma unroll
            for (int et = 0; et < 8; ++et) {
                f32x4 o0 = (f32x4){0.f, 0.f, 0.f, 0.f}, o1 = (f32x4){0.f, 0.f, 0.f, 0.f};
#pragma unroll
                for (int ks = 0; ks < 8; ++ks) { const LAS bf16* vp = VTs + (et * 16 + fr) * XV_PITCH + 32 * ks + 4 * fq;
                    const v2u lo = *(const LAS v2u*)vp, hi = *(const LAS v2u*)(vp + 16); v4u w; w.x = lo.x; w.y = lo.y; w.z = hi.x; w.w = hi.y; const bf16x8 vf = __builtin_bit_cast(bf16x8, w);
                    o0 = __builtin_amdgcn_mfma_f32_16x16x32_bf16(vf, pf[0][ks], o0, 0, 0, 0);
                    o1 = __builtin_amdgcn_mfma_f32_16x16x32_bf16(vf, pf[1][ks], o1, 0, 0, 0); }
                o0 = o0 * inv[0]; o1 = o1 * inv[1];
                v2u w0, w1; w0.x = cvt_pk_bf16_n(o0[0], o0[1]); w0.y = cvt_pk_bf16_n(o0[2], o0[3]); w1.x = cvt_pk_bf16_n(o1[0], o1[1]); w1.y = cvt_pk_bf16_n(o1[2], o1[3]);
                *(v2u*)((ym + (size_t)tok0 * 512 + head * 128 + et * 16) + ((unsigned)fr * 512u + 4u * (unsigned)fq)) = w0;
                *(v2u*)((ym + (size_t)(tok0 + 16) * 512 + head * 128 + et * 16) + ((unsigned)fr * 512u + 4u * (unsigned)fq)) = w1;
            }
        }
    }
}

constexpr int TPW = NTOK / 256;
constexpr int WR_PITCH = 1028;
__device__ __forceinline__ int dpp_i(int s, int ctrl_sel) {
    if (ctrl_sel == 0) return __builtin_amdgcn_update_dpp(0, s, 0xB1, 0xF, 0xF, true);
    if (ctrl_sel == 1) return __builtin_amdgcn_update_dpp(0, s, 0x4E, 0xF, 0xF, true);
    if (ctrl_sel == 2) return __builtin_amdgcn_update_dpp(0, s, 0x141, 0xF, 0xF, true);
    return __builtin_amdgcn_update_dpp(0, s, 0x140, 0xF, 0xF, true);
}
__device__ __forceinline__ void phase_ln1_router(Ctx& F, int l) {
    LAS float* wr_s = (LAS float*)F.lds;
    LAS int* hist = (LAS int*)(F.lds + 32 * WR_PITCH * 4);
    const float* wrp = as_global(F.in[I_WR]) + (size_t)l * D * NE;
    { const int e = F.tid & 31, kg = F.tid >> 5;
      for (int k = kg * 64; k < kg * 64 + 64; k += 4) { f32x4 w; w[0] = wrp[(size_t)(k + 0) * NE + e]; w[1] = wrp[(size_t)(k + 1) * NE + e]; w[2] = wrp[(size_t)(k + 2) * NE + e]; w[3] = wrp[(size_t)(k + 3) * NE + e];
          *(LAS f32x4*)(wr_s + e * WR_PITCH + k) = w; } }
    if (F.tid < 32) hist[F.tid] = 0;
    __syncthreads();
    const bf16* tb = (const bf16*)(F.ws + WS_HF); bf16* hb = (bf16*)(F.ws + WS_HB);
    int* tok_e = (int*)(F.ws + WS_TOKE); float* tok_w = (float*)(F.ws + WS_TOKW);
    const float* brp = as_global(F.in[I_BR]) + (size_t)l * NE;
    const int lane = F.lane, fr = lane & 15, q = lane >> 4;
    const int tok_base = F.bid * TPW + F.wave * 16;
    const size_t rowoff = (size_t)(tok_base + fr) * D + 8 * q;
    float s = 0.f, s2 = 0.f;
#pragma unroll 8
    for (int c = 0; c < 32; ++c) { float x[8]; unpack8(*(const v4u*)(tb + rowoff + 32 * c), x);
#pragma unroll
        for (int i = 0; i < 8; ++i) { s += x[i]; s2 += x[i] * x[i]; } }
    s += bperm(s, lane ^ 16); s += bperm(s, lane ^ 32); s2 += bperm(s2, lane ^ 16); s2 += bperm(s2, lane ^ 32);
    const float mean = s * (1.f / D);
    const float rstd = 1.f / sqrtf(fmaxf(s2 * (1.f / D) - mean * mean, 0.f) + LN_EPS);
    const float* gp = as_global(F.in[I_LN1G]) + (size_t)l * D + 8 * q; const float* bp = as_global(F.in[I_LN1B]) + (size_t)l * D + 8 * q;
    const LAS float* w0p = wr_s + fr * WR_PITCH + 8 * q; const LAS float* w1p = wr_s + (16 + fr) * WR_PITCH + 8 * q;
    f32x4 acc0 = (f32x4){0.f, 0.f, 0.f, 0.f}, acc1 = (f32x4){0.f, 0.f, 0.f, 0.f};
#pragma unroll 2
    for (int c = 0; c < 32; ++c) {
        float x[8]; unpack8(*(const v4u*)(tb + rowoff + 32 * c), x);
        const f32x4 g0 = *(const f32x4*)(gp + 32 * c), g1 = *(const f32x4*)(gp + 32 * c + 4), b0 = *(const f32x4*)(bp + 32 * c), b1 = *(const f32x4*)(bp + 32 * c + 4);
        float h[8];
#pragma unroll
        for (int i = 0; i < 4; ++i) { h[i] = (x[i] - mean) * rstd * g0[i] + b0[i]; h[4 + i] = (x[4 + i] - mean) * rstd * g1[i] + b1[i]; }
        const f32x4 wa0 = *(const LAS f32x4*)(w0p + 32 * c), wa1 = *(const LAS f32x4*)(w0p + 32 * c + 4), wb0 = *(const LAS f32x4*)(w1p + 32 * c), wb1 = *(const LAS f32x4*)(w1p + 32 * c + 4);
#pragma unroll
        for (int i = 0; i < 4; ++i) { acc0 = __builtin_amdgcn_mfma_f32_16x16x4f32(h[i], wa0[i], acc0, 0, 0, 0); acc1 = __builtin_amdgcn_mfma_f32_16x16x4f32(h[i], wb0[i], acc1, 0, 0, 0); }
#pragma unroll
        for (int i = 0; i < 4; ++i) { acc0 = __builtin_amdgcn_mfma_f32_16x16x4f32(h[4 + i], wa1[i], acc0, 0, 0, 0); acc1 = __builtin_amdgcn_mfma_f32_16x16x4f32(h[4 + i], wb1[i], acc1, 0, 0, 0); }
        v4u w; w.x = cvt_pk_nat(h[0], h[1]); w.y = cvt_pk_nat(h[2], h[3]); w.z = cvt_pk_nat(h[4], h[5]); w.w = cvt_pk_nat(h[6], h[7]);
        *(v4u*)(hb + rowoff + 32 * c) = w;
        asm volatile("" ::: "memory");
    }
    const float be0 = brp[fr], be1 = brp[16 + fr];
#pragma unroll
    for (int r = 0; r < 4; ++r) {
        float v0 = acc0[r] + be0, v1 = acc1[r] + be1; float val[4]; int idx[4];
#pragma unroll
        for (int kk = 0; kk < 4; ++kk) {
            const bool use1 = v1 > v0; float bv = use1 ? v1 : v0; int bi = use1 ? 16 + fr : fr;
#pragma unroll
            for (int st = 0; st < 4; ++st) { const float ov = dpp_f(bv, st); const int oi = dpp_i(bi, st); const bool take = (ov > bv) || (ov == bv && oi < bi); bv = take ? ov : bv; bi = take ? oi : bi; }
            val[kk] = bv; idx[kk] = bi;
            v0 = (bi == fr) ? -3.0e38f : v0; v1 = (bi == 16 + fr) ? -3.0e38f : v1;
        }
        const float e1 = __expf(val[1] - val[0]), e2 = __expf(val[2] - val[0]), e3 = __expf(val[3] - val[0]); const float inv = 1.f / (1.f + e1 + e2 + e3);
        if (fr == 0) { const size_t t4 = (size_t)(tok_base + 4 * q + r) * 4;
            *(int4*)(tok_e + t4) = make_int4(idx[0], idx[1], idx[2], idx[3]); *(f32x4*)(tok_w + t4) = (f32x4){inv, e1 * inv, e2 * inv, e3 * inv};
            atomicAdd((int*)&hist[idx[0]], 1); atomicAdd((int*)&hist[idx[1]], 1); atomicAdd((int*)&hist[idx[2]], 1); atomicAdd((int*)&hist[idx[3]], 1); }
    }
    __syncthreads();
    if (F.tid < 32) ((int*)(F.ws + WS_CNT))[F.bid * 32 + F.tid] = hist[F.tid];
}

__device__ __forceinline__ void phase_assign(Ctx& F) {
    LAS int* part_tot = (LAS int*)F.lds;
    LAS int* part_bef = part_tot + 512;
    LAS int* tot_s = part_bef + 512; LAS int* bef_s = tot_s + 32; LAS int* pstart_s = bef_s + 32;
    LAS int* cntw = pstart_s + 32;
    const int* cnt = (const int*)(F.ws + WS_CNT); int* meta = (int*)(F.ws + WS_META);
    const int* tok_e = (const int*)(F.ws + WS_TOKE); const float* tok_w = (const float*)(F.ws + WS_TOKW);
    int* tok_slot = (int*)(F.ws + WS_TOKS); float* slot_w = (float*)(F.ws + WS_SLOTW);
    const int lane = F.lane;
    const int n = F.tid, my_e = tok_e[(size_t)F.bid * TPW * 4 + n]; const float my_w = tok_w[(size_t)F.bid * TPW * 4 + n];
    int my_rank = 0, my_cnt = 0;
    const unsigned long long lt = (1ull << lane) - 1ull;
#pragma unroll
    for (int e = 0; e < 32; ++e) { const unsigned long long m = __ballot(my_e == e); my_rank = (my_e == e) ? __popcll(m & lt) : my_rank; my_cnt = (lane == e) ? __popcll(m) : my_cnt; }
    if (lane < 32) cntw[F.wave * 32 + lane] = my_cnt;
    { const int e = F.tid & 31, part = F.tid >> 5; const int per = (F.G + 15) / 16; int c[16];
#pragma unroll
      for (int j = 0; j < 16; ++j) { const int w = part * per + j; c[j] = (j < per && w < F.G) ? cnt[w * 32 + e] : 0; }
      int tot = 0, bef = 0;
#pragma unroll
      for (int j = 0; j < 16; ++j) { tot += c[j]; bef += (part * per + j < F.bid) ? c[j] : 0; }
      part_tot[part * 32 + e] = tot; part_bef[part * 32 + e] = bef; }
    __syncthreads();
    if (F.tid < 32) { int tot = 0, bef = 0;
#pragma unroll
        for (int p = 0; p < 16; ++p) { tot += part_tot[p * 32 + F.tid]; bef += part_bef[p * 32 + F.tid]; }
        tot_s[F.tid] = tot;
        const int pc = ((tot + 255) >> 8) << 8; int incl = pc;
#pragma unroll
        for (int off = 1; off < 32; off <<= 1) { const int t = __builtin_amdgcn_ds_bpermute(((lane - off) & 63) << 2, incl); incl += (lane >= off) ? t : 0; }
        const int ps = incl - pc; pstart_s[F.tid] = ps; bef_s[F.tid] = ps + bef;
        if (F.bid == 0) { for (int tt = ps >> 8; tt < (ps + pc) >> 8; ++tt) meta[64 + tt] = F.tid; if (F.tid == 31) meta[0] = (ps + pc) >> 8; } }
    __syncthreads();
    int pre = 0;
    for (int w = 0; w < F.wave; ++w) pre += cntw[w * 32 + my_e];
    const int slot = bef_s[my_e] + pre + my_rank;
    { const int tok = F.bid * TPW + (n >> 2); tok_slot[(size_t)tok * 4 + (n & 3)] = slot; slot_w[slot] = my_w; ((int*)(F.ws + WS_SLOTT))[slot] = tok; }
    if (F.bid == 0 && F.tid < 32) { const int tot = tot_s[F.tid], ps = pstart_s[F.tid], pe = ps + (((tot + 255) >> 8) << 8); int* st = (int*)(F.ws + WS_SLOTT);
        for (int s2 = ps + tot; s2 < pe; ++s2) st[s2] = 0; }
}

__device__ __forceinline__ void phase_combine_ln2(Ctx& F, int l) {
    LAS float* ws_s = (LAS float*)F.lds;
    if (l + 1 < DEPTH) { load_small_w(F, l + 1, ws_s); }
    __syncthreads();
    bf16* hb = (bf16*)(F.ws + WS_HB); float* ab = (float*)(F.ws + WS_AB);
    const bf16* Y = (const bf16*)(F.ws + WS_XS); const int* tok_slot = (const int*)(F.ws + WS_TOKS);
    const int lane = F.lane, gw = F.bid * 8 + F.wave, NGW = F.G * 8;
    for (int tok = gw; tok < NTOK; tok += NGW) {
        f32x4 v[4]; load_row_bf16(hb + (size_t)tok * D, v, lane);
#pragma unroll
        for (int j = 0; j < 4; ++j) v[j] = v[j] * ALPHA;
#pragma unroll
        for (int kk = 0; kk < 4; ++kk) { const int slot = tok_slot[(size_t)tok * 4 + kk]; const bf16* yr = Y + (size_t)slot * D;
#pragma unroll
            for (int j = 0; j < 4; ++j) { const v2u w = *(const v2u*)(yr + 4 * lane + 256 * j); v[j][0] += bf_lo(w.x); v[j][1] += bf_hi(w.x); v[j][2] += bf_lo(w.y); v[j][3] += bf_hi(w.y); } }
        ln_apply(v, as_global(F.in[I_LN2G]) + (size_t)l * D, as_global(F.in[I_LN2B]) + (size_t)l * D, lane);
        if (l + 1 < DEPTH) { store_row_bf16(hb + (size_t)tok * D, v, lane); small_proj(v, ws_s, ab + (size_t)tok * 8, lane); }
        else store_row_f32(F.out + (size_t)tok * D, v, lane);
    }
}


#define PHASE_FN __device__ __forceinline__
PHASE_FN void g_inproj(LAS unsigned char* lds, unsigned char* ws, int l, int G, int bid, int wave) { asm volatile("" : "+s"(ws)); ws = as_global(ws); asm volatile("" : "+s"(G)); asm volatile("" : "+s"(bid)); asm volatile("" : "+s"(l));
    pg8::SchedDense S{(const char*)(ws + WS_HB), (const char*)(ws + WS_WIN) + (size_t)l * NPROJ * D * 2, NTOK / 256, NPROJ / 256, G, bid, (size_t)256 * D * 2};
    pg8::EpiStoreBf16 E{(bf16*)(ws + WS_R1), NPROJ};
    pg8::gemm_phase<pg8::EpiStoreBf16, pg8::SchedDense, true, true>(lds, D, S, E, wave);
}
PHASE_FN void g_kvproj(LAS unsigned char* lds, unsigned char* ws, int l, int G, int bid, int wave) { asm volatile("" : "+s"(ws)); ws = as_global(ws); asm volatile("" : "+s"(G)); asm volatile("" : "+s"(bid)); asm volatile("" : "+s"(l));
    pg8::SchedDense S{(const char*)(ws + WS_MEMB), (const char*)(ws + WS_WKV) + (size_t)l * D * D * 2, NB * NMEM / 256, D / 256, G, bid, (size_t)256 * D * 2};
    pg8::EpiKV E{(bf16*)(ws + WS_KVB), (bf16*)(ws + WS_KVB + 512 * 1024)};
    pg8::gemm_phase<pg8::EpiKV, pg8::SchedDense, true, true>(lds, D, S, E, wave);
}
#ifndef XT
#define XT 2
#endif
constexpr int CW_XDONE = 20480;
PHASE_FN void g_side_branch(LAS unsigned char* lds, unsigned char* ws, int l, int nside, int sidx, int wave, int br) { asm volatile("" : "+s"(ws)); ws = as_global(ws); asm volatile("" : "+s"(nside)); asm volatile("" : "+s"(sidx)); asm volatile("" : "+s"(l)); asm volatile("" : "+s"(br));
    const bool xw = sidx < 64;
    pg8::SchedBranch S{(const char*)(ws + WS_YA), (const char*)(ws + WS_YB), (const char*)(ws + WS_YM), (const char*)(ws + WS_WBR) + (size_t)l * 3 * D * 512 * 2, (size_t)D * 512 * 2,
                       NTOK / 256, D / 256, xw ? 64 : nside - 64, xw ? sidx : 64 * XT + sidx - 64, 1, br, br, (size_t)256 * 512 * 2, xw ? XT : (1 << 30)};
    pg8::EpiBranch E{(const bf16*)(ws + WS_R1), (bf16*)(ws + WS_MB), 1};
    pg8::gemm_phase<pg8::EpiBranch, pg8::SchedBranch, true, true>(lds, 512, S, E, wave);
}
__device__ __forceinline__ void xdone_publish(unsigned char* ws) {
    asm volatile("s_waitcnt vmcnt(0)" ::: "memory"); __syncthreads();
    if (threadIdx.x == 0) { __builtin_amdgcn_fence(__ATOMIC_RELEASE, "agent"); asm volatile("s_waitcnt vmcnt(0)" ::: "memory");
        __hip_atomic_fetch_add((unsigned*)(ws + WS_CTL) + CW_XDONE, 1u, __ATOMIC_RELAXED, __HIP_MEMORY_SCOPE_AGENT); }
}
__device__ __forceinline__ void xdone_wait(unsigned char* ws, unsigned want) {
    asm volatile("s_waitcnt vmcnt(0)" ::: "memory"); __syncthreads();
    if (threadIdx.x == 0) { unsigned spins = 0;
        while (__hip_atomic_load((unsigned*)(ws + WS_CTL) + CW_XDONE, __ATOMIC_RELAXED, __HIP_MEMORY_SCOPE_AGENT) < want && ++spins < (1u << 22)) __builtin_amdgcn_s_sleep(8);
        __builtin_amdgcn_fence(__ATOMIC_ACQUIRE, "agent"); asm volatile("s_waitcnt vmcnt(0)" ::: "memory"); }
    __syncthreads();
}
PHASE_FN void g_branch(LAS unsigned char* lds, unsigned char* ws, int l, int G, int bid, int wave) { asm volatile("" : "+s"(ws)); ws = as_global(ws); asm volatile("" : "+s"(G)); asm volatile("" : "+s"(bid)); asm volatile("" : "+s"(l));
    pg8::SchedBranch S{(const char*)(ws + WS_YA), (const char*)(ws + WS_YB), (const char*)(ws + WS_YM), (const char*)(ws + WS_WBR) + (size_t)l * 3 * D * 512 * 2, (size_t)D * 512 * 2,
                       NTOK / 256, D / 256, G, bid, 1, 0, 0, (size_t)256 * 512 * 2};
    pg8::EpiBranch E{(const bf16*)(ws + WS_R1), (bf16*)(ws + WS_MB), 1};
    pg8::gemm_phase<pg8::EpiBranch, pg8::SchedBranch, true, true>(lds, 512, S, E, wave);
}
PHASE_FN void g_outproj(LAS unsigned char* lds, unsigned char* ws, int l, int G, int bid, int wave) { asm volatile("" : "+s"(ws)); ws = as_global(ws); asm volatile("" : "+s"(G)); asm volatile("" : "+s"(bid)); asm volatile("" : "+s"(l));
    pg8::SchedDense S{(const char*)(ws + WS_MB), (const char*)(ws + WS_WO) + (size_t)l * D * D * 2, NTOK / 256, D / 256, G, bid, (size_t)256 * D * 2};
    pg8::EpiOut E{(const bf16*)(ws + WS_HB), (bf16*)(ws + WS_HF)};
    pg8::gemm_phase<pg8::EpiOut, pg8::SchedDense, true, true>(lds, D, S, E, wave);
}
PHASE_FN void g_gateup(LAS unsigned char* lds, unsigned char* ws, const float* bgu, int l, int G, int bid, int wave) { asm volatile("" : "+s"(ws)); ws = as_global(ws); asm volatile("" : "+s"(G)); asm volatile("" : "+s"(bid)); asm volatile("" : "+s"(l)); bgu = as_global(bgu);
    const int* meta = (const int*)(ws + WS_META); const int n_tiles = __builtin_amdgcn_readfirstlane(meta[0]);
    pg8::SchedGrouped S{(const char*)(ws + WS_HB), (const char*)(ws + WS_WGU) + (size_t)l * NE * 2048 * D * 2, (size_t)2048 * D * 2, meta + 64, n_tiles, 8, G, bid, (size_t)256 * D * 2, (const int*)(ws + WS_SLOTT)};
    pg8::EpiSwiglu E{(bf16*)(ws + WS_HBUF), bgu + (size_t)l * NE * 2048};
    pg8::gemm_phase<pg8::EpiSwiglu, pg8::SchedGrouped, true, true, true>(lds, D, S, E, wave);
}
PHASE_FN void g_down(LAS unsigned char* lds, unsigned char* ws, const float* bd, int l, int G, int bid, int wave) { asm volatile("" : "+s"(ws)); ws = as_global(ws); asm volatile("" : "+s"(G)); asm volatile("" : "+s"(bid)); asm volatile("" : "+s"(l)); bd = as_global(bd);
    const int* meta = (const int*)(ws + WS_META); const int n_tiles = __builtin_amdgcn_readfirstlane(meta[0]);
    pg8::SchedGrouped S{(const char*)(ws + WS_HBUF), (const char*)(ws + WS_WD) + (size_t)l * NE * D * D * 2, (size_t)D * D * 2, meta + 64, n_tiles, 4, G, bid, (size_t)256 * D * 2, nullptr};
    pg8::EpiDown E{(bf16*)(ws + WS_XS), bd + (size_t)l * NE * D, (const float*)(ws + WS_SLOTW)};
    pg8::gemm_phase<pg8::EpiDown, pg8::SchedGrouped, true, true>(lds, D, S, E, wave);
}

constexpr int PH_PER_LAYER = 12, NPHASE = 1 + DEPTH * PH_PER_LAYER;
__global__ void __launch_bounds__(512, 2) fwd_kernel(Args args) {
    extern __shared__ __attribute__((aligned(16))) unsigned char lds_raw[];
    Ctx F;
    F.lds = (LAS unsigned char*)lds_raw; F.tid = 0; F.lane = 0; F.wave = __builtin_amdgcn_readfirstlane((int)threadIdx.x >> 6); F.G = gridDim.x; F.bid = blockIdx.x;
    F.in = args.in; F.out = args.out; F.ws = args.ws;
    volatile LAS unsigned* MISC = (volatile LAS unsigned*)(F.lds + MISC_OFF);
    if (threadIdx.x < 64) MISC[threadIdx.x] = 0u;
    __syncthreads();
    const int lo = args.ph_lo, hi = args.ph_hi;
#define REP_BRANCH g_branch
#ifdef AMP_BID
#define AMP_BEGIN() const unsigned long long amp_t0_ = __builtin_amdgcn_s_memrealtime()
#define AMP_END() do { if (exp_ && F.bid == AMP_BID) { __syncthreads(); const unsigned long long t1_ = __builtin_amdgcn_s_memrealtime(); while (__builtin_amdgcn_s_memrealtime() - t1_ < (unsigned long long)AMP * (t1_ - amp_t0_)) __builtin_amdgcn_s_sleep(8); } } while (0)
#else
#define AMP_BEGIN() do {} while (0)
#define AMP_END() do {} while (0)
#endif
#ifndef XA_LO
#define XA_LO 128
#endif
#ifndef BVAR
#define BVAR 0
#endif
#ifndef REP_MODE
#define REP_MODE 0
#endif
#ifndef REP_PH
#define REP_PH -1
#define REP_N 0
#endif
#define NREP(k) (((k) == REP_PH) ? 1 + REP_N : 1)
#if MK_MULTI
#define GRID_BAR() do { } while (0)
#else
    XcdBarrier bar = xcd_barrier_post((unsigned*)(F.ws + WS_CTL) + CW_BAR, MISC + 8);
#define GRID_BAR() xcd_barrier(bar)
#endif
#define IN(k) (lo <= (k) && (k) < hi)
#define SEAM(k) do { if (IN(k) && IN((k) + 1)) GRID_BAR(); } while (0)

    if (IN(0)) { for (int rep_ = 0; rep_ < ((REP_PH == 100) ? 1 + REP_N : 1); ++rep_) { if (rep_) GRID_BAR(); { Ctx P = fresh(F); phase_prologue(P); } } } SEAM(0);

#define LAYER_PHASES(l) do { const int p0 = 1 + (l) * PH_PER_LAYER; \
        if (IN(p0 + 0)) { for (int rep_ = 0; rep_ < NREP(0); ++rep_) { if (rep_) GRID_BAR(); g_inproj(F.lds, F.ws, l, F.G, F.bid, F.wave); } } SEAM(p0 + 0); \
        if (IN(p0 + 1)) { for (int rep_ = 0; rep_ < NREP(1); ++rep_) { if (rep_) GRID_BAR(); g_kvproj(F.lds, F.ws, l, F.G, F.bid, F.wave); __syncthreads(); { Ctx P = fresh(F); phase_prep(P, l); } asm volatile("s_waitcnt vmcnt(0)" ::: "memory"); __syncthreads(); { Ctx P = fresh(F); phase_gdn_a(P); } } }   \
        SEAM(p0 + 2); \
        if (IN(p0 + 3)) { for (int rep_ = 0; rep_ < NREP(3); ++rep_) { if (rep_) GRID_BAR(); __syncthreads(); { Ctx P = fresh(F); const bool exp_ = rep_ + 1 < NREP(3); const int mode_ = exp_ ? REP_MODE : 0; const int epoch_ = (l) * NREP(3) + rep_; AMP_BEGIN(); if (P.bid < 32) { if (mode_ != 2) phase_gdn_b(P, epoch_, exp_ ? BVAR : 0); } else if (P.bid < 32 + 8 * NHELP) { if (mode_ != 2) phase_gdn_b_helper(P, epoch_, P.bid & 7, (P.bid - 32) >> 3); } else if (mode_ != 1) { const int sidx_ = P.bid - 32 - 8 * NHELP, nside_ = P.G - 32 - 8 * NHELP; phase_xattn(P, sidx_, nside_); if (sidx_ < 64) xdone_publish(F.ws); __syncthreads(); _Pragma("unroll 1") for (int br_ = 1; br_ <= 2; ++br_) { if (br_ == 2) xdone_wait(F.ws, 64u * (unsigned)(epoch_ + 1)); g_side_branch(F.lds, F.ws, l, nside_, sidx_, F.wave, br_); } if (l == 0 && !exp_ && NDEF > 0) { __syncthreads(); Ctx Q = fresh(F); convert_deferred(Q, sidx_ * 8 + Q.wave, nside_ * 8); } } AMP_END(); } } } SEAM(p0 + 3); \
        if (IN(p0 + 4)) { for (int rep_ = 0; rep_ < NREP(4); ++rep_) { if (rep_) GRID_BAR(); __syncthreads(); { Ctx P = fresh(F); phase_gdn_c(P, l); } } } SEAM(p0 + 4); \
        if (IN(p0 + 5)) { for (int rep_ = 0; rep_ < NREP(5); ++rep_) { if (rep_) GRID_BAR(); __syncthreads(); if (rep_ == 0) g_branch(F.lds, F.ws, l, F.G, F.bid, F.wave); else REP_BRANCH(F.lds, F.ws, l, F.G, F.bid, F.wave); } } SEAM(p0 + 5); \
        if (IN(p0 + 6)) { for (int rep_ = 0; rep_ < NREP(6); ++rep_) { if (rep_) GRID_BAR(); g_outproj(F.lds, F.ws, l, F.G, F.bid, F.wave); } } SEAM(p0 + 6); \
        if (IN(p0 + 7)) { for (int rep_ = 0; rep_ < NREP(7); ++rep_) { if (rep_) GRID_BAR(); __syncthreads(); { Ctx P = fresh(F); phase_ln1_router(P, l); } } } SEAM(p0 + 7); \
        if (IN(p0 + 8)) { for (int rep_ = 0; rep_ < NREP(8); ++rep_) { if (rep_) GRID_BAR(); __syncthreads(); { Ctx P = fresh(F); phase_assign(P); } } } SEAM(p0 + 8); \
        if (IN(p0 + 9)) { for (int rep_ = 0; rep_ < NREP(9); ++rep_) { if (rep_) GRID_BAR(); __syncthreads(); g_gateup(F.lds, F.ws, as_global(F.in[I_BGU]), l, F.G, F.bid, F.wave); } } SEAM(p0 + 9); \
        if (IN(p0 + 10)) { for (int rep_ = 0; rep_ < NREP(10); ++rep_) { if (rep_) GRID_BAR(); g_down(F.lds, F.ws, as_global(F.in[I_BD]), l, F.G, F.bid, F.wave); } } SEAM(p0 + 10); \
        if (IN(p0 + 11)) { for (int rep_ = 0; rep_ < NREP(11); ++rep_) { if (rep_) GRID_BAR(); __syncthreads(); { Ctx P = fresh(F); phase_combine_ln2(P, l); } } } SEAM(p0 + 11); \
    } while (0)
    LAYER_PHASES(0);
    LAYER_PHASES(1);
#undef LAYER_PHASES
#undef IN
#undef SEAM
#undef GRID_BAR
}

extern "C" void kernel_launch(void* const* d_in, const int* in_sizes, int n_in, void* d_out, int out_size, void* d_ws, size_t ws_size, hipStream_t stream) {
    static int grid = 0;
    if (grid == 0) {
        if (n_in != 23 || out_size != NTOK * D || ws_size < WS_END) { fprintf(stderr, "kernel_launch: unexpected problem (n_in %d, out %d, ws %zu < %zu)\n", n_in, out_size, ws_size, (size_t)WS_END); grid = -1; return; }
        if (hipFuncSetAttribute((const void*)fwd_kernel, hipFuncAttributeMaxDynamicSharedMemorySize, LDS_BYTES) != hipSuccess) { fprintf(stderr, "kernel_launch: hipFuncSetAttribute failed\n"); grid = -1; return; }
        int per_cu = 0;
        if (hipOccupancyMaxActiveBlocksPerMultiprocessor(&per_cu, (const void*)fwd_kernel, 512, LDS_BYTES) != hipSuccess || per_cu < 1) fprintf(stderr, "kernel_launch: occupancy query reports %d\n", per_cu);
        (void)hipGetLastError();
        grid = 256;
    }
    if (grid < 0) return;
    (void)hipMemsetAsync((char*)d_ws + WS_CTL, 0, CTL_ZERO_BYTES, stream);
    Args a{};
    for (int i = 0; i < 23; ++i) a.in[i] = (const float*)d_in[i];
    a.out = (float*)d_out; a.ws = (unsigned char*)d_ws;
#if MK_MULTI
    for (int p = 0; p < NPHASE; ++p) { a.ph_lo = p; a.ph_hi = p + 1; hipLaunchKernelGGL(fwd_kernel, dim3(grid), dim3(512), LDS_BYTES, stream, a); }
#else
    a.ph_lo = 0; a.ph_hi = NPHASE;
    hipLaunchKernelGGL(fwd_kernel, dim3(grid), dim3(512), LDS_BYTES, stream, a);
#endif
}
```

```cpp
#include <hip/hip_runtime.h>
#include <cstdio>
#include <cstdint>

#ifndef MK_MULTI
#define MK_MULTI 0
#endif

#define LAS __attribute__((address_space(3)))
typedef unsigned short bf16;
typedef unsigned v4u __attribute__((ext_vector_type(4)));
typedef unsigned v2u __attribute__((ext_vector_type(2)));
typedef float f32x4 __attribute__((ext_vector_type(4)));
typedef float f32x2 __attribute__((ext_vector_type(2)));
typedef short bf16x8 __attribute__((ext_vector_type(8)));

constexpr int NB = 2, T = 16384, NTOK = NB * T, D = 1024, DEPTH = 2;
constexpr int NPROJ = 7168;
constexpr int NPROJ_SRC = 7176;
constexpr int C_Q = 0, C_K = 512, C_V = 1024, C_Z = 1536, C_XC = 2048, C_GB = 2560, C_GC = 3072, C_QM = 3584, C_GL = 4096;
constexpr int NMEM = 256, NE = 32, TOPK = 4, DFF = 1024;
constexpr int NSLOT_MAX = 544 * 256;
constexpr float ALPHA = 1.41421356237309515f;
constexpr float LN_EPS = 1e-5f, RMS_EPS = 1e-6f;

constexpr size_t MiB = 1u << 20;
constexpr size_t WS_CTL = 0, CTL_ZERO_BYTES = 1 * MiB;
constexpr size_t WS_WIN = 1 * MiB;
constexpr size_t WS_WBR = WS_WIN + 28 * MiB;
constexpr size_t WS_WO = WS_WBR + 6 * MiB;
constexpr size_t WS_WKV = WS_WO + 4 * MiB;
constexpr size_t WS_WGU = WS_WKV + 4 * MiB;
constexpr size_t WS_WD = WS_WGU + 256 * MiB;
constexpr size_t WS_MEMB = WS_WD + 128 * MiB;
constexpr size_t WS_KVB = WS_MEMB + 1 * MiB;
constexpr size_t WS_HF = WS_KVB + 1 * MiB;
constexpr size_t WS_HB = WS_HF + 128 * MiB;
constexpr size_t WS_AB = WS_HB + 64 * MiB;
constexpr size_t WS_R1 = WS_AB + 1 * MiB;
constexpr size_t WS_XS = WS_R1, WS_HBUF = WS_R1 + 272 * MiB;
constexpr size_t WS_KN = WS_R1 + 544 * MiB;
constexpr size_t WS_QN = WS_KN + 32 * MiB;
constexpr size_t WS_VV = WS_QN + 32 * MiB;
constexpr size_t WS_GS = WS_VV + 32 * MiB;
constexpr size_t WS_ATF = WS_GS + 2 * MiB;
constexpr size_t WS_BC = WS_ATF + 64 * MiB;
constexpr size_t WS_QTF = WS_BC + 64 * MiB;
constexpr size_t WS_OL = WS_QTF + 32 * MiB;
constexpr size_t WS_ST = WS_OL + 64 * MiB;
constexpr size_t WS_CD = WS_ST + 64 * MiB;
constexpr size_t WS_UPK = WS_CD + 1 * MiB;
constexpr size_t WS_WPK = WS_UPK + 32 * MiB;
constexpr size_t WS_YA = WS_WPK + 32 * MiB;
constexpr size_t WS_YB = WS_YA + 32 * MiB, WS_YM = WS_YB + 32 * MiB;
constexpr size_t WS_MF = WS_YM + 32 * MiB;
constexpr size_t WS_MB = WS_MF + 128 * MiB;
constexpr size_t WS_TOKE = WS_MB + 64 * MiB;
constexpr size_t WS_TOKW = WS_TOKE + MiB / 2;
constexpr size_t WS_TOKS = WS_TOKW + MiB / 2;
constexpr size_t WS_SLOTW = WS_TOKS + MiB / 2;
constexpr size_t WS_CNT = WS_SLOTW + 1 * MiB;
constexpr size_t WS_META = WS_CNT + MiB / 4;
constexpr size_t WS_SLOTT = WS_META + MiB / 4;
constexpr size_t WS_END = WS_SLOTT + 1 * MiB;
static_assert(WS_END <= (size_t)2048 * MiB, "workspace map exceeds 2 GiB");
#ifndef NHELP
#define NHELP 4
#endif
#ifndef HLEAD
#define HLEAD 14
#endif
constexpr int CW_PROG = 16384;
constexpr int CW_BAR = 4096;

constexpr int LDS_BYTES = 159744;
constexpr int MISC_OFF = LDS_BYTES - 256;

#define GAS __attribute__((address_space(1)))
template <class Tp> __device__ __forceinline__ Tp* as_global(Tp* p) { GAS Tp* g = (GAS Tp*)p; asm("" : "+s"(g)); return (Tp*)g; }
#define LDS_WAIT() asm volatile("s_waitcnt lgkmcnt(0)" ::: "memory")
#define VM_WAIT() asm volatile("s_waitcnt vmcnt(0)" ::: "memory")
__device__ __forceinline__ unsigned cvt_pk_bf16(float lo, float hi) { unsigned r; asm volatile("v_cvt_pk_bf16_f32 %0, %1, %2" : "=v"(r) : "v"(lo), "v"(hi)); return r; }
__device__ __forceinline__ unsigned cvt_pk_bf16_n(float lo, float hi) { unsigned r; asm volatile("v_cvt_pk_bf16_f32 %0, %1, %2\n\ts_nop 1" : "=v"(r) : "v"(lo), "v"(hi)); return r; }
typedef __bf16 bf16x2_t __attribute__((ext_vector_type(2)));
__device__ __forceinline__ unsigned cvt_pk_nat(float lo, float hi) { bf16x2_t v; v[0] = (__bf16)lo; v[1] = (__bf16)hi; return __builtin_bit_cast(unsigned, v); }
__device__ __forceinline__ float bf_lo(unsigned w) { return __uint_as_float(w << 16); }
__device__ __forceinline__ float bf_hi(unsigned w) { return __uint_as_float(w & 0xffff0000u); }
__device__ __forceinline__ float fast_rcp(float x) { return __builtin_amdgcn_rcpf(x); }
__device__ __forceinline__ float sigmoidf_(float x) { return fast_rcp(1.0f + __expf(-x)); }
__device__ __forceinline__ float siluf_(float x) { return x * sigmoidf_(x); }
__device__ __forceinline__ float dpp_f(float v, int ctrl_sel) {
    const int s = __builtin_bit_cast(int, v); int r;
    if (ctrl_sel == 0) r = __builtin_amdgcn_update_dpp(0, s, 0xB1, 0xF, 0xF, true);
    else if (ctrl_sel == 1) r = __builtin_amdgcn_update_dpp(0, s, 0x4E, 0xF, 0xF, true);
    else if (ctrl_sel == 2) r = __builtin_amdgcn_update_dpp(0, s, 0x141, 0xF, 0xF, true);
    else r = __builtin_amdgcn_update_dpp(0, s, 0x140, 0xF, 0xF, true);
    return __builtin_bit_cast(float, r);
}
__device__ __forceinline__ float row16_sum(float v) {
    v += dpp_f(v, 0); v += dpp_f(v, 1); v += dpp_f(v, 2); v += dpp_f(v, 3); return v;
}
__device__ __forceinline__ float rdlane(float v, int l) { return __builtin_bit_cast(float, __builtin_amdgcn_readlane(__builtin_bit_cast(int, v), l)); }
__device__ __forceinline__ float wave_sum(float v) { v = row16_sum(v); return (rdlane(v, 0) + rdlane(v, 16)) + (rdlane(v, 32) + rdlane(v, 48)); }
__device__ __forceinline__ float bperm(float v, int src_lane) { return __builtin_bit_cast(float, __builtin_amdgcn_ds_bpermute(src_lane << 2, __builtin_bit_cast(int, v))); }

#define XB_TMO      128
#define XB_XCNT(j)  (256  + 64 * (j))
#define XB_XSUB(j)  (1280 + 64 * (j))
#define XB_XGEN(j)  (2304 + 64 * (j))
#define XB_TOP      3328
#define XB_TOPGEN   3392
#define XCD_BAR_WORDS 3456
#define XB_SPIN_CAP (1u << 18)
__device__ __forceinline__ unsigned xb_ld(unsigned* p)              { return __hip_atomic_load(p, __ATOMIC_RELAXED, __HIP_MEMORY_SCOPE_AGENT); }
__device__ __forceinline__ unsigned xb_add(unsigned* p, unsigned v) { return __hip_atomic_fetch_add(p, v, __ATOMIC_RELAXED, __HIP_MEMORY_SCOPE_AGENT); }
__device__ __forceinline__ unsigned xb_xcc_id() { return (unsigned)__builtin_amdgcn_s_getreg((3 << 11) | 20) & 0xFu; }
#define XB_SPIN(cond, bar) do { unsigned _sp = 0; while (cond) { __builtin_amdgcn_s_sleep(1); \
    if ((++_sp & 255u) == 0u) { if (xb_ld(&(bar)[XB_TMO])) break; if (_sp > XB_SPIN_CAP) { atomicAdd(&(bar)[XB_TMO], 1u); break; } } } } while (0)
struct XcdBarrier { unsigned* bar; unsigned x; volatile LAS unsigned* st; };
__device__ __forceinline__ XcdBarrier xcd_barrier_post(unsigned* bar, volatile LAS unsigned* st) {
    XcdBarrier b; b.bar = bar; b.x = xb_xcc_id(); b.st = st;
    if (threadIdx.x == 0) (void)xb_add(&bar[XB_XCNT(b.x)], 1u);
    return b;
}
__device__ __forceinline__ void xcd_barrier_complete(unsigned* bar, unsigned x, unsigned& nloc, unsigned& nx) {
    const unsigned G = gridDim.x * gridDim.y * gridDim.z;
    unsigned sum, cnt, mine, sp = 0u;
    for (;;) {
        sum = 0u; cnt = 0u; mine = 0u;
#pragma unroll
        for (unsigned j = 0; j < 16; ++j) { const unsigned c = xb_ld(&bar[XB_XCNT(j)]); sum += c; cnt += (c > 0u) ? 1u : 0u; mine = (j == x) ? c : mine; }
        if (sum == G) break;
        __builtin_amdgcn_s_sleep(1);
        if ((++sp & 255u) == 0u) { if (xb_ld(&bar[XB_TMO])) break; if (sp > XB_SPIN_CAP) { atomicAdd(&bar[XB_TMO], 1u); break; } }
    }
    nloc = mine > 0u ? mine : 1u; nx = cnt > 0u ? cnt : 1u;
}
__device__ __forceinline__ void xcd_barrier(const XcdBarrier& b) {
    asm volatile("s_waitcnt vmcnt(0)" ::: "memory");
    __syncthreads();
    if (threadIdx.x == 0) {
        unsigned* bar = b.bar;
        __builtin_amdgcn_s_waitcnt(0);
        unsigned nloc = b.st[0], nx = b.st[1];
        if (nloc == 0u) { xcd_barrier_complete(bar, b.x, nloc, nx); b.st[0] = nloc; b.st[1] = nx; }
        const unsigned old = xb_add(&bar[XB_XSUB(b.x)], 1u);
        const unsigned gen = old / nloc;
        if (old + 1u == (gen + 1u) * nloc) {
            __builtin_amdgcn_fence(__ATOMIC_RELEASE, "agent");
            asm volatile("s_waitcnt vmcnt(0)" ::: "memory");
            const unsigned og = xb_add(&bar[XB_TOP], 1u);
            const unsigned tg = og / nx;
            if (og + 1u == (tg + 1u) * nx) xb_add(&bar[XB_TOPGEN], 1u);
            else XB_SPIN(xb_ld(&bar[XB_TOPGEN]) == tg, bar);
            __builtin_amdgcn_fence(__ATOMIC_ACQUIRE, "agent");
            xb_add(&bar[XB_XGEN(b.x)], 1u);
            asm volatile("s_waitcnt vmcnt(0)" ::: "memory");
        } else {
            XB_SPIN(xb_ld(&bar[XB_XGEN(b.x)]) == gen, bar);
            __builtin_amdgcn_fence(__ATOMIC_ACQUIRE, "agent");
            asm volatile("s_waitcnt vmcnt(0)" ::: "memory");
        }
    }
    __syncthreads();
}

namespace pg8 {
constexpr int BM = 256, BK = 64, HALF = 128, HTB = HALF * BK * 2, STAGE_BYTES = 8 * HTB, NXCD = 8, WGM = 8;
__host__ __device__ __forceinline__ int lds_byte(int r, int c) { const int st = (r >> 4) * 2 + (c >> 5), rr = r & 15, cc = c & 31, ob = rr * 64 + cc * 2; return st * 1024 + (ob ^ (((ob >> 9) & 1) << 5)); }
__host__ __device__ __forceinline__ void stage_rc(int b, int& R, int& C) { const int st = b / 1024, sb = b % 1024, swz = sb ^ (((sb >> 9) & 1) << 5); R = (st >> 1) * 16 + swz / 64; C = (st & 1) * 32 + (swz % 64) / 2; }
__host__ __device__ __forceinline__ int perm32(int rho) { const int n = rho >> 4, i = rho & 15; return 8 * (i >> 2) + 4 * n + (i & 3); }

struct Unit { int pm, pn, e; const char* a; const char* b; };

__device__ __forceinline__ void tile_map(int L, int nM, int nN, int& pm, int& pn) {
    const int nwg = nM * nN; int wgid = L;
    { const int q = nwg / NXCD, r = nwg % NXCD, xcd = wgid % NXCD, off = wgid / NXCD; wgid = (xcd < r ? xcd * (q + 1) : r * (q + 1) + (xcd - r) * q) + off; }
    const int nig = WGM * nN, gid = wgid / nig, fm = gid * WGM, gsz = (nM - fm) < WGM ? (nM - fm) : WGM;
    pm = fm + ((wgid % nig) % gsz); pn = (wgid % nig) / gsz;
}
struct SchedDense {
    const char* A; const char* B; int nM, nN, G, c; size_t tstep;
    __device__ __forceinline__ bool next(int i, Unit& u) const {
        const long L = (long)i * G + c; if (L >= (long)nM * nN) return false;
        tile_map((int)L, nM, nN, u.pm, u.pn); u.e = 0; u.a = A + (size_t)u.pm * tstep; u.b = B + (size_t)u.pn * tstep; return true; }
    __device__ __forceinline__ int row_of(int, int) const { return 0; }
};
struct SchedBranch {
    const char* A0; const char* A1; const char* A2; const char* B; size_t bstride; int nM, nN, G, c, nb, b0, b1; size_t tstep; int nmax = 1 << 30;
    __device__ __forceinline__ bool next(int i, Unit& u) const {
        const int nwg = nM * nN, j = i % nb; const long Lr = (long)(i / nb) * G + c; if (Lr >= nwg || i / nb >= nmax) return false;
        const int br = (j == 0) ? b0 : b1;
        tile_map((int)Lr, nM, nN, u.pm, u.pn); u.e = br; u.a = (br == 0 ? A0 : (br == 1 ? A1 : A2)) + (size_t)u.pm * tstep; u.b = B + (size_t)br * bstride + (size_t)u.pn * tstep; return true; }
    __device__ __forceinline__ int row_of(int, int) const { return 0; }
};
struct SchedGrouped {
    const char* A; const char* B; size_t estride; const int* tile_e; int nM, nN, G, c; size_t tstep; const int* rows;
    __device__ __forceinline__ bool next(int i, Unit& u) const {
        const long L = (long)i * G + c; if (L >= (long)nM * nN) return false;
        tile_map((int)L, nM, nN, u.pm, u.pn); u.e = __builtin_amdgcn_readfirstlane(tile_e[u.pm]); u.a = rows ? A : A + (size_t)u.pm * tstep; u.b = B + (size_t)u.e * estride + (size_t)u.pn * tstep; return true; }
    __device__ __forceinline__ int row_of(int pm, int r) const { return rows[pm * BM + r]; }
};
struct EpiStoreBf16 {
    static constexpr bool PERM = true;
    bf16* O; int ldc;
    __device__ __forceinline__ void operator()(const f32x4 (&acc)[2][2][4][2], const Unit& u, int wr, int wc, int fr, int fq) const {
        const int row0 = u.pm * BM + wr * 64 + fr, col0 = u.pn * BM + wc * 32 + 8 * fq;
#pragma unroll
        for (int ai = 0; ai < 2; ++ai)
#pragma unroll
            for (int m = 0; m < 4; ++m) { bf16* rowp = O + (size_t)(row0 + ai * HALF + m * 16) * ldc + col0;
#pragma unroll
                for (int bj = 0; bj < 2; ++bj) { const f32x4 v0 = acc[ai][bj][m][0], v1 = acc[ai][bj][m][1];
                    v4u w; w.x = cvt_pk_bf16(v0[0], v0[1]); w.y = cvt_pk_bf16(v0[2], v0[3]); w.z = cvt_pk_bf16(v1[0], v1[1]); w.w = cvt_pk_bf16(v1[2], v1[3]);
                    *(v4u*)(rowp + bj * HALF) = w; } }
    }
};
struct EpiKV {
    static constexpr bool PERM = true;
    bf16* K; bf16* VT;
    __device__ __forceinline__ void operator()(const f32x4 (&acc)[2][2][4][2], const Unit& u, int wr, int wc, int fr, int fq) const {
        const int row0 = wr * 64 + fr, colt = u.pn * BM + wc * 32 + 8 * fq;
#pragma unroll
        for (int ai = 0; ai < 2; ++ai)
#pragma unroll
            for (int m = 0; m < 4; ++m) { const int key = row0 + ai * HALF + m * 16;
#pragma unroll
                for (int bj = 0; bj < 2; ++bj) { const f32x4 v0 = acc[ai][bj][m][0], v1 = acc[ai][bj][m][1]; const int col = colt + bj * HALF;
                    v4u w; w.x = cvt_pk_bf16(v0[0], v0[1]); w.y = cvt_pk_bf16(v0[2], v0[3]); w.z = cvt_pk_bf16(v1[0], v1[1]); w.w = cvt_pk_bf16(v1[2], v1[3]);
                    if (u.pn < 2) *(v4u*)(K + (size_t)(u.pm * BM + key) * 512 + col) = w;
                    else { bf16* d = VT + ((size_t)u.pm * 512 + (col - 512)) * 256 + key;
                        d[0] = (bf16)(w.x & 0xffff); d[256] = (bf16)(w.x >> 16); d[512] = (bf16)(w.y & 0xffff); d[768] = (bf16)(w.y >> 16);
                        d[1024] = (bf16)(w.z & 0xffff); d[1280] = (bf16)(w.z >> 16); d[1536] = (bf16)(w.w & 0xffff); d[1792] = (bf16)(w.w >> 16); } } }
    }
};
struct EpiBranch {
    static constexpr bool PERM = true;
    const bf16* proj; bf16* mb; int store_br;
    __device__ __forceinline__ void operator()(const f32x4 (&acc)[2][2][4][2], const Unit& u, int wr, int wc, int fr, int fq) const {
        const int row0 = u.pm * BM + wr * 64 + fr, col0 = u.pn * BM + wc * 32 + 8 * fq; const int br = u.e; const bool accum = (br != store_br);
        const bf16* gp = proj + (size_t)row0 * NPROJ + C_GL + br * D + col0; bf16* mp = mb + (size_t)row0 * D + col0;
#pragma unroll
        for (int ai = 0; ai < 2; ++ai) {
            v4u gw[4][2], ow[4][2];
#pragma unroll
            for (int m = 0; m < 4; ++m)
#pragma unroll
                for (int bj = 0; bj < 2; ++bj) { const size_t ro = (size_t)(ai * HALF + m * 16); const int co = bj * HALF;
                    gw[m][bj] = *(const v4u*)(gp + ro * NPROJ + co); ow[m][bj] = accum ? *(const v4u*)(mp + ro * D + co) : (v4u){0u, 0u, 0u, 0u}; }
#pragma unroll
            for (int m = 0; m < 4; ++m)
#pragma unroll
                for (int bj = 0; bj < 2; ++bj) { const size_t ro = (size_t)(ai * HALF + m * 16); const int co = bj * HALF; const v4u g4 = gw[m][bj], o = ow[m][bj];
                    const f32x4 a0 = acc[ai][bj][m][0], a1 = acc[ai][bj][m][1];
                    v4u w;
                    w.x = cvt_pk_bf16(sigmoidf_(bf_lo(g4.x)) * a0[0] + bf_lo(o.x), sigmoidf_(bf_hi(g4.x)) * a0[1] + bf_hi(o.x));
                    w.y = cvt_pk_bf16(sigmoidf_(bf_lo(g4.y)) * a0[2] + bf_lo(o.y), sigmoidf_(bf_hi(g4.y)) * a0[3] + bf_hi(o.y));
                    w.z = cvt_pk_bf16(sigmoidf_(bf_lo(g4.z)) * a1[0] + bf_lo(o.z), sigmoidf_(bf_hi(g4.z)) * a1[1] + bf_hi(o.z));
                    w.w = cvt_pk_bf16(sigmoidf_(bf_lo(g4.w)) * a1[2] + bf_lo(o.w), sigmoidf_(bf_hi(g4.w)) * a1[3] + bf_hi(o.w));
                    *(v4u*)(mp + ro * D + co) = w; }
        }
    }
};
struct EpiOut {
    static constexpr bool PERM = true;
    const bf16* hb; bf16* tb;
    __device__ __forceinline__ void operator()(const f32x4 (&acc)[2][2][4][2], const Unit& u, int wr, int wc, int fr, int fq) const {
        const int row0 = u.pm * BM + wr * 64 + fr, col0 = u.pn * BM + wc * 32 + 8 * fq;
        const bf16* hp = hb + (size_t)row0 * D + col0; bf16* tp = tb + (size_t)row0 * D + col0;
#pragma unroll
        for (int ai = 0; ai < 2; ++ai) {
            v4u hw[4][2];
#pragma unroll
            for (int m = 0; m < 4; ++m)
#pragma unroll
                for (int bj = 0; bj < 2; ++bj) hw[m][bj] = *(const v4u*)(hp + (size_t)(ai * HALF + m * 16) * D + bj * HALF);
#pragma unroll
            for (int m = 0; m < 4; ++m)
#pragma unroll
                for (int bj = 0; bj < 2; ++bj) { const v4u h = hw[m][bj]; const f32x4 a0 = acc[ai][bj][m][0], a1 = acc[ai][bj][m][1];
                    v4u w; w.x = cvt_pk_bf16(bf_lo(h.x) * ALPHA + a0[0], bf_hi(h.x) * ALPHA + a0[1]); w.y = cvt_pk_bf16(bf_lo(h.y) * ALPHA + a0[2], bf_hi(h.y) * ALPHA + a0[3]);
                    w.z = cvt_pk_bf16(bf_lo(h.z) * ALPHA + a1[0], bf_hi(h.z) * ALPHA + a1[1]); w.w = cvt_pk_bf16(bf_lo(h.w) * ALPHA + a1[2], bf_hi(h.w) * ALPHA + a1[3]);
                    *(v4u*)(tp + (size_t)(ai * HALF + m * 16) * D + bj * HALF) = w; }
        }
    }
};
struct EpiSwiglu {
    static constexpr bool PERM = true;
    bf16* H; const float* bgu;
    __device__ __forceinline__ void operator()(const f32x4 (&acc)[2][2][4][2], const Unit& u, int wr, int wc, int fr, int fq) const {
        const int row0 = u.pm * BM + wr * 64 + fr, cc0 = u.pn * HALF + wc * 32 + 8 * fq;
        const float* bg = bgu + (size_t)u.e * 2048 + cc0;
        f32x4 bgv[2], buv[2];
#pragma unroll
        for (int n = 0; n < 2; ++n) { bgv[n] = *(const f32x4*)(bg + 4 * n); buv[n] = *(const f32x4*)(bg + 1024 + 4 * n); }
#pragma unroll
        for (int ai = 0; ai < 2; ++ai)
#pragma unroll
            for (int m = 0; m < 4; ++m) { float h[8];
#pragma unroll
                for (int n = 0; n < 2; ++n)
#pragma unroll
                    for (int j = 0; j < 4; ++j) { float g = acc[ai][0][m][n][j] + bgv[n][j], up = acc[ai][1][m][n][j] + buv[n][j];
                        g = fminf(g, 7.0f); up = fminf(fmaxf(up, -7.0f), 7.0f);
                        h[n * 4 + j] = (up + 1.0f) * (g * sigmoidf_(g * 1.702f)); }
                v4u w; w.x = cvt_pk_bf16(h[0], h[1]); w.y = cvt_pk_bf16(h[2], h[3]); w.z = cvt_pk_bf16(h[4], h[5]); w.w = cvt_pk_bf16(h[6], h[7]);
                *(v4u*)(H + (size_t)(row0 + ai * HALF + m * 16) * DFF + cc0) = w; }
    }
};
struct EpiDown {
    static constexpr bool PERM = true;
    bf16* Y; const float* bd; const float* slot_w;
    __device__ __forceinline__ void operator()(const f32x4 (&acc)[2][2][4][2], const Unit& u, int wr, int wc, int fr, int fq) const {
        const int row0 = u.pm * BM + wr * 64 + fr, col0 = u.pn * BM + wc * 32 + 8 * fq;
        const float* bp = bd + (size_t)u.e * D + col0;
        f32x4 bv[2][2];
#pragma unroll
        for (int bj = 0; bj < 2; ++bj)
#pragma unroll
            for (int n = 0; n < 2; ++n) bv[bj][n] = *(const f32x4*)(bp + bj * HALF + 4 * n);
#pragma unroll
        for (int ai = 0; ai < 2; ++ai)
#pragma unroll
            for (int m = 0; m < 4; ++m) { const int row = row0 + ai * HALF + m * 16; const float sw = slot_w[row]; bf16* rowp = Y + (size_t)row * D + col0;
#pragma unroll
                for (int bj = 0; bj < 2; ++bj) { const f32x4 v0 = (acc[ai][bj][m][0] + bv[bj][0]) * sw, v1 = (acc[ai][bj][m][1] + bv[bj][1]) * sw;
                    v4u w; w.x = cvt_pk_bf16(v0[0], v0[1]); w.y = cvt_pk_bf16(v0[2], v0[3]); w.z = cvt_pk_bf16(v1[0], v1[1]); w.w = cvt_pk_bf16(v1[2], v1[3]);
                    *(v4u*)(rowp + bj * HALF) = w; } }
    }
};

template <class Epi, class Sched, bool ALIGN_EPI, bool SP2, bool GATHER = false>
__device__ __forceinline__ void gemm_phase(LAS unsigned char* lds, const int K, const Sched& S, const Epi& E, int wave_id) {
    unsigned z0_ = 0u; asm volatile("" : "+s"(z0_)); int ln_ = (int)__builtin_amdgcn_mbcnt_hi(~0u, __builtin_amdgcn_mbcnt_lo(~0u, z0_)); asm volatile("" : "+v"(ln_)); asm volatile("" : "+s"(wave_id));
    const int wid = wave_id, lane = ln_, tid = wid * 64 + lane, wr = wid >> 2, wc = wid & 3, fr = lane & 15, fq = lane >> 4;
    const int nt = K / BK;
    static_assert(!GATHER || SP2, "row gather is written for the two-super-phase loop");
    unsigned voffA[2], voffB[2], gC[2]; int gR[2];
    unsigned vAc[2][2], vAn[2][2];
#define PG8_ROWS(dst, pm_) do { _Pragma("unroll") for (int h_ = 0; h_ < 2; ++h_) _Pragma("unroll") for (int i_ = 0; i_ < 2; ++i_) dst[h_][i_] = (unsigned)S.row_of(pm_, h_ * HALF + gR[i_]) * (unsigned)(K * 2) + gC[i_]; } while (0)
#define PG8_STAGE_A(bufoff, gbase, h, OFF) do { if constexpr (GATHER) { PG8_STAGE(bufoff, gbase, OFF[h]); } else { PG8_STAGE(bufoff, (gbase) + (h) * hstep, voffA); } } while (0)
#pragma unroll
    for (int i = 0; i < 2; ++i) { int R, C; stage_rc(tid * 16 + i * 8192, R, C); const int Rb = Epi::PERM ? ((R & ~31) + perm32(R & 31)) : R;
        voffA[i] = (unsigned)(R * K + C) * 2u; voffB[i] = (unsigned)(Rb * K + C) * 2u; gR[i] = R; gC[i] = (unsigned)C * 2u; }
    const size_t kstep = (size_t)(BK * 2);
    const size_t hstep = (size_t)HALF * K * 2;
    const unsigned ldsw = (unsigned)wid * 1024u;
    const int aoff = lds_byte(wr * 64 + fr, fq * 8), boff = lds_byte(wc * 32 + fr, fq * 8);
#define PG8_SA(b, h) (((b) * 2 + (h)) * HTB)
#define PG8_SB(b, h) ((4 + (b) * 2 + (h)) * HTB)
#define PG8_STAGE(bufoff, gbase, voff) do { _Pragma("unroll") for (int _i = 0; _i < 2; ++_i) \
        __builtin_amdgcn_global_load_lds((const unsigned*)((const char*)(gbase) + (voff)[_i]), (LAS unsigned*)(lds + (bufoff) + ldsw + _i * 8192), 16, 0, 0); } while (0)
#define PG8_LDA(dst, b, h) do { _Pragma("unroll") for (int m = 0; m < 4; ++m) _Pragma("unroll") for (int k = 0; k < 2; ++k) dst[m][k] = *(const LAS bf16x8*)(lds + PG8_SA(b, h) + aoff + m * 2048 + k * 1024); } while (0)
#define PG8_LDB(dst, b, h) do { _Pragma("unroll") for (int n = 0; n < 2; ++n) _Pragma("unroll") for (int k = 0; k < 2; ++k) dst[n][k] = *(const LAS bf16x8*)(lds + PG8_SB(b, h) + boff + n * 2048 + k * 1024); } while (0)
#define PG8_MMA(ai, bj, At, Bt) do { __builtin_amdgcn_s_setprio(1); _Pragma("unroll") for (int m = 0; m < 4; ++m) _Pragma("unroll") for (int n = 0; n < 2; ++n) _Pragma("unroll") for (int k = 0; k < 2; ++k) \
        acc[ai][bj][m][n] = __builtin_amdgcn_mfma_f32_16x16x32_bf16(Bt[n][k], At[m][k], acc[ai][bj][m][n], 0, 0, 0); __builtin_amdgcn_s_setprio(0); } while (0)
#define PG8_WAIT_V(n) asm volatile("s_waitcnt vmcnt(" #n ")" ::: "memory")
#define PG8_WAIT_L(n) asm volatile("s_waitcnt lgkmcnt(" #n ")" ::: "memory")
#define PG8_BAR __builtin_amdgcn_s_barrier()
#define PG8_SCHED __builtin_amdgcn_sched_barrier(0)
    Unit cur, nxt; int ui = 0;
    if (!S.next(0, cur)) return;
    f32x4 acc[2][2][4][2];
#pragma unroll
    for (int a = 0; a < 2; ++a)
#pragma unroll
        for (int b = 0; b < 2; ++b)
#pragma unroll
            for (int m = 0; m < 4; ++m)
#pragma unroll
                for (int n = 0; n < 2; ++n) acc[a][b][m][n] = (f32x4){0.f, 0.f, 0.f, 0.f};
    bf16x8 At[4][2], B0[2][2], B1[2][2];
    const char* cA = cur.a; const char* cB = cur.b;
    if constexpr (SP2) {
        if constexpr (GATHER) { PG8_ROWS(vAc, cur.pm); asm volatile("s_waitcnt vmcnt(0)" ::: "memory"); }
        PG8_STAGE(PG8_SB(0, 0), cB, voffB); PG8_STAGE(PG8_SB(0, 1), cB + hstep, voffB); PG8_STAGE_A(PG8_SA(0, 0), cA, 0, vAc); PG8_STAGE_A(PG8_SA(0, 1), cA, 1, vAc);
        if (wr == 1) PG8_BAR;
        PG8_WAIT_V(2); PG8_BAR;
        PG8_STAGE(PG8_SB(1, 0), cB + kstep, voffB); PG8_STAGE_A(PG8_SA(1, 0), cA + kstep, 0, vAc); PG8_STAGE(PG8_SB(1, 1), cB + hstep + kstep, voffB);
        PG8_WAIT_V(6); PG8_BAR;
    } else {
        PG8_STAGE(PG8_SB(0, 0), cB, voffB); PG8_STAGE(PG8_SA(0, 0), cA, voffA); PG8_STAGE(PG8_SB(0, 1), cB + hstep, voffB); PG8_STAGE(PG8_SA(0, 1), cA + hstep, voffA);
        if (wr == 1) PG8_BAR;
        PG8_WAIT_V(4); PG8_BAR;
        PG8_STAGE(PG8_SB(1, 0), cB + kstep, voffB); PG8_STAGE(PG8_SA(1, 0), cA + kstep, voffA); PG8_STAGE(PG8_SB(1, 1), cB + hstep + kstep, voffB);
        PG8_WAIT_V(6); PG8_BAR;
    }
    for (;;) {
        const bool has_next = S.next(ui + 1, nxt);
        const char* nA = has_next ? nxt.a : cA; const char* nB = has_next ? nxt.b : cB;
        if constexpr (GATHER) { if (ui == 0) { if (has_next) PG8_ROWS(vAn, nxt.pm); else { _Pragma("unroll") for (int h_ = 0; h_ < 2; ++h_) _Pragma("unroll") for (int i_ = 0; i_ < 2; ++i_) vAn[h_][i_] = vAc[h_][i_]; } } }
        for (int t = 0; t < nt; t += 2) {
            const bool last = (t == nt - 2);
            const char* a1 = cA + (size_t)(t + 1) * kstep;
            const char* a2 = last ? nA : cA + (size_t)(t + 2) * kstep; const char* b2 = last ? nB : cB + (size_t)(t + 2) * kstep;
            const char* a3 = a2 + kstep; const char* b3 = b2 + kstep;
            if constexpr (SP2) {
            unsigned o2[2][2];
            if constexpr (GATHER) { _Pragma("unroll") for (int h_ = 0; h_ < 2; ++h_) _Pragma("unroll") for (int i_ = 0; i_ < 2; ++i_) o2[h_][i_] = last ? vAn[h_][i_] : vAc[h_][i_]; }
            PG8_LDB(B0, 0, 0); PG8_LDB(B1, 0, 1); PG8_SCHED; PG8_LDA(At, 0, 0); PG8_STAGE_A(PG8_SA(1, 1), a1, 1, vAc);
            PG8_WAIT_V(8); PG8_WAIT_L(0); PG8_BAR; PG8_MMA(0, 0, At, B0); PG8_MMA(0, 1, At, B1); PG8_BAR; PG8_SCHED;
            PG8_LDA(At, 0, 1); PG8_STAGE(PG8_SB(0, 0), b2, voffB); PG8_STAGE(PG8_SB(0, 1), b2 + hstep, voffB); PG8_STAGE_A(PG8_SA(0, 0), a2, 0, o2);
            PG8_WAIT_V(8); PG8_WAIT_L(0); PG8_BAR; PG8_MMA(1, 0, At, B0); PG8_MMA(1, 1, At, B1); PG8_BAR; PG8_SCHED;
            PG8_LDB(B0, 1, 0); PG8_LDB(B1, 1, 1); PG8_SCHED; PG8_LDA(At, 1, 0); PG8_STAGE_A(PG8_SA(0, 1), a2, 1, o2);
            PG8_WAIT_V(8); PG8_WAIT_L(0); PG8_BAR; PG8_MMA(0, 0, At, B0); PG8_MMA(0, 1, At, B1); PG8_BAR; PG8_SCHED;
            PG8_LDA(At, 1, 1); PG8_STAGE(PG8_SB(1, 0), b3, voffB); PG8_STAGE(PG8_SB(1, 1), b3 + hstep, voffB); PG8_STAGE_A(PG8_SA(1, 0), a3, 0, o2);
            PG8_WAIT_V(8); PG8_WAIT_L(0); PG8_BAR; PG8_MMA(1, 0, At, B0); PG8_MMA(1, 1, At, B1); PG8_BAR; PG8_SCHED;
            } else {
            PG8_LDB(B0, 0, 0); PG8_SCHED; PG8_LDA(At, 0, 0); PG8_STAGE(PG8_SA(1, 1), a1 + hstep, voffA);
            PG8_WAIT_L(8); PG8_BAR; PG8_WAIT_L(0); PG8_MMA(0, 0, At, B0); PG8_BAR; PG8_SCHED;
            PG8_LDB(B1, 0, 1); PG8_STAGE(PG8_SB(0, 0), b2, voffB);
            PG8_BAR; PG8_WAIT_L(0); PG8_MMA(0, 1, At, B1); PG8_BAR;
            PG8_LDA(At, 0, 1); PG8_STAGE(PG8_SA(0, 0), a2, voffA);
            PG8_BAR; PG8_WAIT_L(0); PG8_MMA(1, 0, At, B0); PG8_BAR; PG8_SCHED;
            PG8_STAGE(PG8_SB(0, 1), b2 + hstep, voffB);
            PG8_WAIT_V(6); PG8_BAR; PG8_MMA(1, 1, At, B1); PG8_BAR;
            PG8_LDB(B0, 1, 0); PG8_SCHED; PG8_LDA(At, 1, 0); PG8_STAGE(PG8_SA(0, 1), a2 + hstep, voffA);
            PG8_WAIT_L(8); PG8_BAR; PG8_WAIT_L(0); PG8_MMA(0, 0, At, B0); PG8_BAR; PG8_SCHED;
            PG8_LDB(B1, 1, 1); PG8_STAGE(PG8_SB(1, 0), b3, voffB);
            PG8_BAR; PG8_WAIT_L(0); PG8_MMA(0, 1, At, B1); PG8_BAR;
            PG8_LDA(At, 1, 1); PG8_STAGE(PG8_SA(1, 0), a3, voffA);
            PG8_BAR; PG8_WAIT_L(0); PG8_MMA(1, 0, At, B0); PG8_BAR; PG8_SCHED;
            PG8_STAGE(PG8_SB(1, 1), b3 + hstep, voffB);
            PG8_WAIT_V(6); PG8_BAR; PG8_MMA(1, 1, At, B1); PG8_BAR;
            }
        }
        if constexpr (ALIGN_EPI) { if (wr == 0) PG8_BAR; }
        E(acc, cur, wr, wc, fr, fq);
        if (!has_next) break;
#pragma unroll
        for (int a = 0; a < 2; ++a)
#pragma unroll
            for (int b = 0; b < 2; ++b)
#pragma unroll
                for (int m = 0; m < 4; ++m)
#pragma unroll
                    for (int n = 0; n < 2; ++n) acc[a][b][m][n] = (f32x4){0.f, 0.f, 0.f, 0.f};
        if constexpr (GATHER) { _Pragma("unroll") for (int h_ = 0; h_ < 2; ++h_) _Pragma("unroll") for (int i_ = 0; i_ < 2; ++i_) vAc[h_][i_] = vAn[h_][i_];
            Unit nn; if (S.next(ui + 2, nn)) PG8_ROWS(vAn, nn.pm); }
        cur = nxt; cA = nA; cB = nB; ++ui;
        if constexpr (ALIGN_EPI) { if (wr == 1) PG8_BAR; }
    }
    PG8_WAIT_V(0);
    if constexpr (!ALIGN_EPI) { if (wr == 0) PG8_BAR; }
    PG8_BAR;
#undef PG8_ROWS
#undef PG8_STAGE_A
#undef PG8_SA
#undef PG8_SB
#undef PG8_STAGE
#undef PG8_LDA
#undef PG8_LDB
#undef PG8_MMA
#undef PG8_WAIT_V
#undef PG8_WAIT_L
#undef PG8_BAR
#undef PG8_SCHED
}
}

struct Args { const float* in[23]; float* out; unsigned char* ws; int ph_lo, ph_hi; };
struct Ctx {
    LAS unsigned char* lds; int tid, lane, wave, G, bid;
    const float* const* in; float* out; unsigned char* ws;
};
__device__ __forceinline__ Ctx fresh(const Ctx& F) {
    Ctx R = F; unsigned z0 = 0u; asm volatile("" : "+s"(z0)); int ln = (int)__builtin_amdgcn_mbcnt_hi(~0u, __builtin_amdgcn_mbcnt_lo(~0u, z0)); asm volatile("" : "+v"(ln));
    int wv = F.wave; asm volatile("" : "+s"(wv)); R.wave = wv; R.lane = ln; R.tid = wv * 64 + ln;
    unsigned char* w = F.ws; asm volatile("" : "+s"(w)); R.ws = as_global(w); R.out = as_global(F.out);
    int bd = F.bid, gg = F.G; asm volatile("" : "+s"(bd)); asm volatile("" : "+s"(gg)); R.bid = bd; R.G = gg;
    return R;
}
enum { I_X = 0, I_MEM, I_LN0G, I_LN0B, I_WIN, I_CONVQKV, I_CONVMIX, I_ALOG, I_DTB, I_GDNNORM, I_WMEMKV, I_WBR, I_WO, I_LN1G, I_LN1B, I_WR, I_BR, I_WGU, I_BGU, I_WD, I_BD, I_LN2G, I_LN2B };

__device__ __forceinline__ void transpose_item(const float* src, int ld, bf16* dst, int ldk, LAS float* scr, int lane) {
#pragma unroll 8
    for (int i = 0; i < 32; ++i) { const int kk = 2 * i + (lane >> 5); scr[kk * 33 + (lane & 31)] = src[(size_t)kk * ld + (lane & 31)]; }
    LDS_WAIT();
    const int c = lane & 7;
#pragma unroll
    for (int j = 0; j < 4; ++j) { const int n = (lane >> 3) + 8 * j; const LAS float* s = scr + (8 * c) * 33 + n;
        v4u o; o.x = cvt_pk_bf16(s[0 * 33], s[1 * 33]); o.y = cvt_pk_bf16(s[2 * 33], s[3 * 33]); o.z = cvt_pk_bf16(s[4 * 33], s[5 * 33]); o.w = cvt_pk_bf16(s[6 * 33], s[7 * 33]);
        *(v4u*)(dst + (size_t)n * ldk + 8 * c) = o; }
    LDS_WAIT();
}
__device__ __forceinline__ void ln_apply(f32x4 (&v)[4], const float* g, const float* b, int lane) {
    float s = 0.f;
#pragma unroll
    for (int j = 0; j < 4; ++j) s += (v[j][0] + v[j][1]) + (v[j][2] + v[j][3]);
    const float mean = wave_sum(s) * (1.f / D); float s2 = 0.f;
#pragma unroll
    for (int j = 0; j < 4; ++j) { v[j] = v[j] - mean; s2 += (v[j][0] * v[j][0] + v[j][1] * v[j][1]) + (v[j][2] * v[j][2] + v[j][3] * v[j][3]); }
    const float rstd = 1.f / sqrtf(wave_sum(s2) * (1.f / D) + LN_EPS);
#pragma unroll
    for (int j = 0; j < 4; ++j) { const f32x4 gg = *(const f32x4*)(g + 4 * lane + 256 * j), bb = *(const f32x4*)(b + 4 * lane + 256 * j); v[j] = v[j] * rstd * gg + bb; }
}
__device__ __forceinline__ void load_row_bf16(const bf16* p, f32x4 (&v)[4], int lane) {
#pragma unroll
    for (int j = 0; j < 4; ++j) { const v2u w = *(const v2u*)(p + 4 * lane + 256 * j); v[j] = (f32x4){bf_lo(w.x), bf_hi(w.x), bf_lo(w.y), bf_hi(w.y)}; }
}
__device__ __forceinline__ void store_row_f32(float* p, const f32x4 (&v)[4], int lane) {
#pragma unroll
    for (int j = 0; j < 4; ++j) *(f32x4*)(p + 4 * lane + 256 * j) = v[j];
}
__device__ __forceinline__ void store_row_bf16(bf16* p, const f32x4 (&v)[4], int lane) {
#pragma unroll
    for (int j = 0; j < 4; ++j) { v2u w; w.x = cvt_pk_bf16(v[j][0], v[j][1]); w.y = cvt_pk_bf16(v[j][2], v[j][3]); *(v2u*)(p + 4 * lane + 256 * j) = w; }
}
__device__ __forceinline__ void small_proj(const f32x4 (&v)[4], const LAS float* ws_s, float* ab_row, int lane) {
    float keep = 0.f;
#pragma unroll
    for (int c = 0; c < 8; ++c) { float p = 0.f;
#pragma unroll
        for (int j = 0; j < 4; ++j) { const f32x4 w = *(const LAS f32x4*)(ws_s + c * 1024 + 4 * lane + 256 * j); p += (v[j][0] * w[0] + v[j][1] * w[1]) + (v[j][2] * w[2] + v[j][3] * w[3]); }
        p = wave_sum(p); keep = (lane == c) ? p : keep; }
    if (lane < 8) ab_row[lane] = keep;
}
__device__ __forceinline__ void load_small_w(Ctx& F, int l, LAS float* ws_s) {
    const float* w = as_global(F.in[I_WIN]) + (size_t)l * D * NPROJ_SRC + 1536;
    for (int i = F.tid; i < 8 * 1024; i += 512) { const int k = i >> 3, c = i & 7; ws_s[c * 1024 + k] = w[(size_t)k * NPROJ_SRC + c]; }
}

constexpr int N_IN = 2 * 3584, N_BR = 6 * 256, N_O = 2 * 512, N_KV = 2 * 512, N_GU = 64 * 1024, N_D = 64 * 512;
constexpr int NITEMS = N_IN + N_BR + N_O + N_KV + N_GU + N_D;
#ifndef NDEF_PER_WAVE
#define NDEF_PER_WAVE 24
#endif
constexpr int NDEF = (256 - 32 - 8 * NHELP) * 8 * NDEF_PER_WAVE;
static_assert(NDEF <= N_GU + N_D, "deferred items must be MoE weights");
__device__ __forceinline__ void convert_items(Ctx& F, int first, int step, int begin, int end) {
    LAS float* scr = (LAS float*)(F.lds + F.wave * 8448);
    bf16* WinT = (bf16*)(F.ws + WS_WIN); bf16* WbrT = (bf16*)(F.ws + WS_WBR); bf16* WoT = (bf16*)(F.ws + WS_WO); bf16* WkvT = (bf16*)(F.ws + WS_WKV);
    bf16* WguT = (bf16*)(F.ws + WS_WGU); bf16* WdT = (bf16*)(F.ws + WS_WD);
    for (int it = begin + first; it < end; it += step) {
        int r = it;
        if (r < N_IN) { const int l = r / 3584, q = r % 3584, kb = q / 224, nb = q % 224, k0 = 64 * kb, n0 = 32 * nb, ns = n0 + (n0 >= 1536 ? 8 : 0);
            transpose_item(as_global(F.in[I_WIN]) + (size_t)l * D * NPROJ_SRC + (size_t)k0 * NPROJ_SRC + ns, NPROJ_SRC, WinT + (size_t)l * NPROJ * D + (size_t)n0 * D + k0, D, scr, F.lane); continue; }
        r -= N_IN;
        if (r < N_BR) { const int m = r / 256, q = r % 256, kb = q / 32, nb = q % 32, k0 = 64 * kb, n0 = 32 * nb;
            transpose_item(as_global(F.in[I_WBR]) + (size_t)m * 512 * D + (size_t)k0 * D + n0, D, WbrT + (size_t)m * D * 512 + (size_t)n0 * 512 + k0, 512, scr, F.lane); continue; }
        r -= N_BR;
        if (r < N_O) { const int l = r / 512, q = r % 512, kb = q / 32, nb = q % 32, k0 = 64 * kb, n0 = 32 * nb;
            transpose_item(as_global(F.in[I_WO]) + (size_t)l * D * D + (size_t)k0 * D + n0, D, WoT + (size_t)l * D * D + (size_t)n0 * D + k0, D, scr, F.lane); continue; }
        r -= N_O;
        if (r < N_KV) { const int l = r / 512, q = r % 512, kb = q / 32, nb = q % 32, k0 = 64 * kb, n0 = 32 * nb;
            transpose_item(as_global(F.in[I_WMEMKV]) + (size_t)l * D * D + (size_t)k0 * D + n0, D, WkvT + (size_t)l * D * D + (size_t)n0 * D + k0, D, scr, F.lane); continue; }
        r -= N_KV;
        if (r < N_GU) { const int m = r / 1024, q = r % 1024, kb = q / 64, nb = q % 64, k0 = 64 * kb, n0 = 32 * nb, jj = n0 / 256, r0 = n0 % 256;
            const int ns = (r0 < 128) ? (128 * jj + r0) : (1024 + 128 * jj + r0 - 128);
            transpose_item(as_global(F.in[I_WGU]) + (size_t)m * D * 2048 + (size_t)k0 * 2048 + ns, 2048, WguT + (size_t)m * 2048 * D + (size_t)n0 * D + k0, D, scr, F.lane); continue; }
        r -= N_GU;
        { const int m = r / 512, q = r % 512, kb = q / 32, nb = q % 32, k0 = 64 * kb, n0 = 32 * nb;
            transpose_item(as_global(F.in[I_WD]) + (size_t)m * D * D + (size_t)k0 * D + n0, D, WdT + (size_t)m * D * D + (size_t)n0 * D + k0, D, scr, F.lane); }
    }
}
__device__ __forceinline__ void convert_deferred(Ctx& F, int first, int step) {
    LAS float* scr = (LAS float*)(F.lds + F.wave * 8448);
    bf16* WguT = (bf16*)(F.ws + WS_WGU); bf16* WdT = (bf16*)(F.ws + WS_WD);
    for (int it = NITEMS - NDEF + first; it < NITEMS; it += step) {
        int r = it - (N_IN + N_BR + N_O + N_KV);
        if (r < N_GU) { const int m = r / 1024, q = r % 1024, kb = q / 64, nb = q % 64, k0 = 64 * kb, n0 = 32 * nb, jj = n0 / 256, r0 = n0 % 256;
            const int ns = (r0 < 128) ? (128 * jj + r0) : (1024 + 128 * jj + r0 - 128);
            transpose_item(as_global(F.in[I_WGU]) + (size_t)m * D * 2048 + (size_t)k0 * 2048 + ns, 2048, WguT + (size_t)m * 2048 * D + (size_t)n0 * D + k0, D, scr, F.lane); continue; }
        r -= N_GU;
        { const int m = r / 512, q = r % 512, kb = q / 32, nb = q % 32, k0 = 64 * kb, n0 = 32 * nb;
            transpose_item(as_global(F.in[I_WD]) + (size_t)m * D * D + (size_t)k0 * D + n0, D, WdT + (size_t)m * D * D + (size_t)n0 * D + k0, D, scr, F.lane); }
    }
}

__device__ __forceinline__ void phase_prologue(Ctx& F) {
    LAS float* ws_s = (LAS float*)(F.lds + 69632);
    const int gw = F.bid * 8 + F.wave, NGW = F.G * 8;
    convert_items(F, gw, NGW, 0, NITEMS - NDEF);
    { const f32x4* src = (const f32x4*)as_global(F.in[I_MEM]); v2u* dst = (v2u*)(F.ws + WS_MEMB);
      for (int i = F.bid * 512 + F.tid; i < NB * NMEM * D / 4; i += F.G * 512) { const f32x4 x = src[i]; v2u w; w.x = cvt_pk_bf16(x[0], x[1]); w.y = cvt_pk_bf16(x[2], x[3]); dst[i] = w; } }
    load_small_w(F, 0, ws_s);
    __syncthreads();
    bf16* hb = (bf16*)(F.ws + WS_HB); float* ab = (float*)(F.ws + WS_AB);
    for (int m = gw; m < NTOK; m += NGW) {
        f32x4 v[4]; const float* xr = as_global(F.in[I_X]) + (size_t)m * D;
#pragma unroll
        for (int j = 0; j < 4; ++j) v[j] = *(const f32x4*)(xr + 4 * F.lane + 256 * j);
        ln_apply(v, as_global(F.in[I_LN0G]), as_global(F.in[I_LN0B]), F.lane);
        store_row_bf16(hb + (size_t)m * D, v, F.lane);
        small_proj(v, ws_s, ab + (size_t)m * 8, F.lane);
    }
}

__device__ __forceinline__ void unpack8(const v4u x, float (&o)[8]) { o[0] = bf_lo(x.x); o[1] = bf_hi(x.x); o[2] = bf_lo(x.y); o[3] = bf_hi(x.y); o[4] = bf_lo(x.z); o[5] = bf_hi(x.z); o[6] = bf_lo(x.w); o[7] = bf_hi(x.w); }
__device__ __forceinline__ void conv4_silu(const v4u x0, const v4u x1, const v4u x2, const v4u x3, const LAS float* w  , float (&o)[8]) {
    float a[8], b[8], c[8], d[8]; unpack8(x0, a); unpack8(x1, b); unpack8(x2, c); unpack8(x3, d);
    const f32x4 w0l = *(const LAS f32x4*)(w), w0h = *(const LAS f32x4*)(w + 4), w1l = *(const LAS f32x4*)(w + 1536), w1h = *(const LAS f32x4*)(w + 1540);
    const f32x4 w2l = *(const LAS f32x4*)(w + 3072), w2h = *(const LAS f32x4*)(w + 3076), w3l = *(const LAS f32x4*)(w + 4608), w3h = *(const LAS f32x4*)(w + 4612);
#pragma unroll
    for (int i = 0; i < 8; ++i) { const float w0 = i < 4 ? w0l[i & 3] : w0h[i & 3], w1 = i < 4 ? w1l[i & 3] : w1h[i & 3], w2 = i < 4 ? w2l[i & 3] : w2h[i & 3], w3 = i < 4 ? w3l[i & 3] : w3h[i & 3];
        const float s = (w0 * a[i] + w1 * b[i]) + (w2 * c[i] + w3 * d[i]); o[i] = siluf_(s); }
}
__device__ __forceinline__ void phase_prep(Ctx& F, int l) {
    const bf16* proj = (const bf16*)(F.ws + WS_R1);
    LAS float* cw = (LAS float*)F.lds;
    LAS float* mw = (LAS float*)(F.lds + 4 * 1536 * 4);
    for (int i = F.tid; i < 4 * 1536; i += 512) cw[i] = as_global(F.in[I_CONVQKV])[(size_t)l * 4 * 1536 + i];
    for (int i = F.tid; i < 3 * 512; i += 512) mw[i] = as_global(F.in[I_CONVMIX])[(size_t)l * 3 * 512 + i];
    __syncthreads();
    const int lane = F.lane, c8 = lane * 8, hh = lane >> 4;
    bf16* qnb = (bf16*)(F.ws + WS_QN); bf16* knb = (bf16*)(F.ws + WS_KN); bf16* vvb = (bf16*)(F.ws + WS_VV); float* gs = (float*)(F.ws + WS_GS);
    const float* ab = (const float*)(F.ws + WS_AB); bf16* yb = (bf16*)(F.ws + WS_YB);
    const float Ah = __expf(as_global(F.in[I_ALOG])[l * 4 + hh]), dtb = as_global(F.in[I_DTB])[l * 4 + hh];
    const int gw = F.bid * 8 + F.wave, NGW = F.G * 8;
    for (int t0 = gw * 16; t0 < NTOK; t0 += NGW * 16) {
        const bool first = (t0 % T) == 0;
        const v4u z4 = {0u, 0u, 0u, 0u};
        v4u q0, q1, q2, k0, k1, k2, v0, v1, v2; float p0[8], p1[8];
        if (first) { q0 = q1 = q2 = k0 = k1 = k2 = v0 = v1 = v2 = z4;
#pragma unroll
            for (int i = 0; i < 8; ++i) { p0[i] = 0.f; p1[i] = 0.f; } }
        else {
            const bf16* r3 = proj + (size_t)(t0 - 3) * NPROJ + c8; const bf16* r2 = r3 + NPROJ; const bf16* r1 = r2 + NPROJ;
            q0 = *(const v4u*)(r3 + C_Q); q1 = *(const v4u*)(r2 + C_Q); q2 = *(const v4u*)(r1 + C_Q);
            k0 = *(const v4u*)(r3 + C_K); k1 = *(const v4u*)(r2 + C_K); k2 = *(const v4u*)(r1 + C_K);
            v0 = *(const v4u*)(r3 + C_V); v1 = *(const v4u*)(r2 + C_V); v2 = *(const v4u*)(r1 + C_V);
            float a[8], b[8]; unpack8(*(const v4u*)(r2 + C_XC), a); unpack8(*(const v4u*)(r2 + C_GC), b);
#pragma unroll
            for (int i = 0; i < 8; ++i) p0[i] = a[i] * b[i];
            unpack8(*(const v4u*)(r1 + C_XC), a); unpack8(*(const v4u*)(r1 + C_GC), b);
#pragma unroll
            for (int i = 0; i < 8; ++i) p1[i] = a[i] * b[i];
        }
        v4u nq, nk, nv, nxc, ngc, ngb; float na = 0.f, nbt = 0.f;
        { const bf16* rn = proj + (size_t)t0 * NPROJ + c8; nq = *(const v4u*)(rn + C_Q); nk = *(const v4u*)(rn + C_K); nv = *(const v4u*)(rn + C_V); nxc = *(const v4u*)(rn + C_XC); ngc = *(const v4u*)(rn + C_GC); ngb = *(const v4u*)(rn + C_GB);
          if ((lane & 15) == 0) { na = ab[(size_t)t0 * 8 + hh]; nbt = ab[(size_t)t0 * 8 + 4 + hh]; } }
        for (int i16 = 0; i16 < 16; ++i16) {
            const int tok = t0 + i16;
            const v4u q3 = nq, k3 = nk, v3 = nv, xc3 = nxc, gc3 = ngc, gb3 = ngb; const float a_in = na, bt_in = nbt;
            if (i16 < 15) { const bf16* rn = proj + (size_t)(tok + 1) * NPROJ + c8; nq = *(const v4u*)(rn + C_Q); nk = *(const v4u*)(rn + C_K); nv = *(const v4u*)(rn + C_V); nxc = *(const v4u*)(rn + C_XC); ngc = *(const v4u*)(rn + C_GC); ngb = *(const v4u*)(rn + C_GB);
                if ((lane & 15) == 0) { na = ab[(size_t)(tok + 1) * 8 + hh]; nbt = ab[(size_t)(tok + 1) * 8 + 4 + hh]; } }
            float qo[8], ko[8], vo[8];
            conv4_silu(q0, q1, q2, q3, cw + C_Q + c8, qo); conv4_silu(k0, k1, k2, k3, cw + C_K + c8, ko); conv4_silu(v0, v1, v2, v3, cw + C_V + c8, vo);
            q0 = q1; q1 = q2; q2 = q3; k0 = k1; k1 = k2; k2 = k3; v0 = v1; v1 = v2; v2 = v3;
            float sq = 0.f, sk = 0.f;
#pragma unroll
            for (int i = 0; i < 8; ++i) { sq += qo[i] * qo[i]; sk += ko[i] * ko[i]; }
            sq = row16_sum(sq); sk = row16_sum(sk);
            const float rq = (1.f / sqrtf(sq + RMS_EPS)) * 0.08838834764831845f, rk = 1.f / sqrtf(sk + RMS_EPS);
#pragma unroll
            for (int i = 0; i < 8; ++i) { qo[i] *= rq; ko[i] *= rk; }
            { v4u w; w.x = cvt_pk_bf16(qo[0], qo[1]); w.y = cvt_pk_bf16(qo[2], qo[3]); w.z = cvt_pk_bf16(qo[4], qo[5]); w.w = cvt_pk_bf16(qo[6], qo[7]); *(v4u*)(qnb + (size_t)tok * 512 + c8) = w; }
            { v4u w; w.x = cvt_pk_bf16(ko[0], ko[1]); w.y = cvt_pk_bf16(ko[2], ko[3]); w.z = cvt_pk_bf16(ko[4], ko[5]); w.w = cvt_pk_bf16(ko[6], ko[7]); *(v4u*)(knb + (size_t)tok * 512 + c8) = w; }
            { v4u w; w.x = cvt_pk_bf16(vo[0], vo[1]); w.y = cvt_pk_bf16(vo[2], vo[3]); w.z = cvt_pk_bf16(vo[4], vo[5]); w.w = cvt_pk_bf16(vo[6], vo[7]); *(v4u*)(vvb + (size_t)tok * 512 + c8) = w; }
            if ((lane & 15) == 0) {
                const float a = a_in + dtb, bt = bt_in;
                const float sp = a > 20.f ? a : log1pf(expf(a));
                const float g = -Ah * sp;
                *(f32x4*)(gs + ((size_t)tok * 4 + hh) * 4) = (f32x4){g, 1.f / (1.f + expf(-bt)), 0.f, 0.f};
            }
            float xa[8], ga[8], gbv[8], p2[8]; unpack8(xc3, xa); unpack8(gc3, ga); unpack8(gb3, gbv);
            const f32x4 m0l = *(const LAS f32x4*)(mw + c8), m0h = *(const LAS f32x4*)(mw + c8 + 4), m1l = *(const LAS f32x4*)(mw + 512 + c8), m1h = *(const LAS f32x4*)(mw + 512 + c8 + 4);
            const f32x4 m2l = *(const LAS f32x4*)(mw + 1024 + c8), m2h = *(const LAS f32x4*)(mw + 1024 + c8 + 4);
            float yo[8];
#pragma unroll
            for (int i = 0; i < 8; ++i) { p2[i] = xa[i] * ga[i];
                const float w0 = i < 4 ? m0l[i & 3] : m0h[i & 3], w1 = i < 4 ? m1l[i & 3] : m1h[i & 3], w2 = i < 4 ? m2l[i & 3] : m2h[i & 3];
                yo[i] = gbv[i] * ((w0 * p0[i] + w1 * p1[i]) + w2 * p2[i]); p0[i] = p1[i]; p1[i] = p2[i]; }
            v4u w; w.x = cvt_pk_bf16(yo[0], yo[1]); w.y = cvt_pk_bf16(yo[2], yo[3]); w.z = cvt_pk_bf16(yo[4], yo[5]); w.w = cvt_pk_bf16(yo[6], yo[7]);
            *(v4u*)(yb + (size_t)tok * 512 + c8) = w;
        }
    }
}

#define MFMA16(a, b, c) __builtin_amdgcn_mfma_f32_16x16x32_bf16(a, b, c, 0, 0, 0)
__device__ __forceinline__ bf16x8 pack8(const f32x4 a, const f32x4 b) { v4u w; w.x = cvt_pk_nat(a[0], a[1]); w.y = cvt_pk_nat(a[2], a[3]); w.z = cvt_pk_nat(b[0], b[1]); w.w = cvt_pk_nat(b[2], b[3]); return __builtin_bit_cast(bf16x8, w); }
__device__ __forceinline__ v2u pack4(const f32x4 a) { v2u w; w.x = cvt_pk_nat(a[0], a[1]); w.y = cvt_pk_nat(a[2], a[3]); return w; }
constexpr int GA_PITCH = 72, GA_WAVE_BYTES = 19456;
constexpr int NCHUNK = NB * 4 * (T / 64);

__device__ __forceinline__ void gdn_kend_products(const LAS bf16* XA, const LAS bf16* XB, const LAS float* sE, const v4u* UPK, const v4u* WPK, int ci, int lane, v2u* BC, v4u* ATF) {
    const int fr = lane & 15, fq = lane >> 4;
    bf16x8 ke[8][2];
#pragma unroll
    for (int mt = 0; mt < 8; ++mt)
#pragma unroll
        for (int s = 0; s < 2; ++s) { const LAS bf16* p = (mt < 4 ? XA : XB) + (16 * (mt & 3) + fr) * GA_PITCH + 32 * s + 4 * fq;
            const v2u lo = *(const LAS v2u*)p, hi = *(const LAS v2u*)(p + 16); const f32x4 e0 = *(const LAS f32x4*)(sE + 32 * s + 4 * fq), e1 = *(const LAS f32x4*)(sE + 32 * s + 16 + 4 * fq);
            ke[mt][s] = pack8((f32x4){bf_lo(lo.x) * e0[0], bf_hi(lo.x) * e0[1], bf_lo(lo.y) * e0[2], bf_hi(lo.y) * e0[3]}, (f32x4){bf_lo(hi.x) * e1[0], bf_hi(hi.x) * e1[1], bf_lo(hi.y) * e1[2], bf_hi(hi.y) * e1[3]}); }
#pragma unroll 4
    for (int ne = 0; ne < 8; ++ne) {
        const bf16x8 u0 = __builtin_bit_cast(bf16x8, (UPK + ((size_t)ci * 16 + 2 * ne) * 64)[(unsigned)lane]), u1 = __builtin_bit_cast(bf16x8, (UPK + ((size_t)ci * 16 + 2 * ne + 1) * 64)[(unsigned)lane]);
#pragma unroll
        for (int mt = 0; mt < 8; ++mt) { f32x4 acc = (f32x4){0.f, 0.f, 0.f, 0.f}; acc = MFMA16(ke[mt][0], u0, acc); acc = MFMA16(ke[mt][1], u1, acc);
            (BC + ((size_t)(ci * 8 + ne) * 8 + mt) * 64)[(unsigned)lane] = pack4(acc); } }
#pragma unroll 2
    for (int sp = 0; sp < 4; ++sp) {
        const bf16x8 w00 = __builtin_bit_cast(bf16x8, (WPK + ((size_t)ci * 16 + 4 * sp) * 64)[(unsigned)lane]), w01 = __builtin_bit_cast(bf16x8, (WPK + ((size_t)ci * 16 + 4 * sp + 1) * 64)[(unsigned)lane]);
        const bf16x8 w10 = __builtin_bit_cast(bf16x8, (WPK + ((size_t)ci * 16 + 4 * sp + 2) * 64)[(unsigned)lane]), w11 = __builtin_bit_cast(bf16x8, (WPK + ((size_t)ci * 16 + 4 * sp + 3) * 64)[(unsigned)lane]);
#pragma unroll
        for (int mt = 0; mt < 8; ++mt) { f32x4 d0 = (f32x4){0.f, 0.f, 0.f, 0.f}, d1 = (f32x4){0.f, 0.f, 0.f, 0.f};
            d0 = MFMA16(w00, ke[mt][0], d0); d0 = MFMA16(w01, ke[mt][1], d0); d1 = MFMA16(w10, ke[mt][0], d1); d1 = MFMA16(w11, ke[mt][1], d1);
            (ATF + ((size_t)(ci * 8 + mt) * 4 + sp) * 64)[(unsigned)lane] = __builtin_bit_cast(v4u, pack8(-d0, -d1)); } }
}
__device__ __forceinline__ void xb_store_pair(LAS bf16* XB, int r0, unsigned w, int lane) {
    const unsigned send = (lane & 1) ? (w & 0xffffu) : (w >> 16);
    const unsigned recv = (unsigned)__builtin_amdgcn_update_dpp(0, (int)send, 0xB1, 0xF, 0xF, true);
    const unsigned outw = (lane & 1) ? (recv | (w & 0xffff0000u)) : ((w & 0xffffu) | (recv << 16));
    *(LAS unsigned*)(XB + (r0 + (lane & 1)) * GA_PITCH + (lane & ~1)) = outw;
}
__device__ __forceinline__ void gdn_fill_kT(const bf16* KN, LAS bf16* XB, int tok0, int h, int half, int lane) {
    const bf16* kbase = KN + (size_t)tok0 * 512 + h * 128 + half * 64; const unsigned lo = (unsigned)lane * 512u;
    asm volatile("s_waitcnt lgkmcnt(0)" ::: "memory");
#pragma unroll
    for (int c = 0; c < 8; ++c) { const v4u x = *(const v4u*)((kbase + 8 * c) + lo);
        xb_store_pair(XB, 8 * c, x.x, lane); xb_store_pair(XB, 8 * c + 2, x.y, lane); xb_store_pair(XB, 8 * c + 4, x.z, lane); xb_store_pair(XB, 8 * c + 6, x.w, lane); }
    asm volatile("s_waitcnt lgkmcnt(0)" ::: "memory");
}
__device__ __forceinline__ void phase_gdn_a(Ctx& F) {
    const int lane = F.lane, fr = lane & 15, fq = lane >> 4;
    LAS unsigned char* wl = F.lds + F.wave * GA_WAVE_BYTES;
    LAS bf16* Ts = (LAS bf16*)wl; LAS bf16* XB = (LAS bf16*)(wl + 9216);
    LAS float* gcv = (LAS float*)(wl + 18432); LAS float* sKp = gcv + 64; LAS float* sE = gcv + 128; LAS float* bev = gcv + 192;
    const bf16* KN = (const bf16*)(F.ws + WS_KN); const bf16* QN = (const bf16*)(F.ws + WS_QN); const bf16* VV = (const bf16*)(F.ws + WS_VV); const float* gs = (const float*)(F.ws + WS_GS);
    v2u* BC = (v2u*)(F.ws + WS_BC); v4u* ATF = (v4u*)(F.ws + WS_ATF); v4u* QTF = (v4u*)(F.ws + WS_QTF); v2u* OL = (v2u*)(F.ws + WS_OL); float* CD = (float*)(F.ws + WS_CD);
    v4u* UPK = (v4u*)(F.ws + WS_UPK); v4u* WPK = (v4u*)(F.ws + WS_WPK);
    { const int b = F.bid >> 7, h = F.wave & 3, n = 2 * (F.bid & 127) + (F.wave >> 2);
        const int bh = b * 4 + h, ci = bh * 256 + n, tok0 = b * T + n * 64;
        const f32x2 gb = *(const f32x2*)((gs + ((size_t)tok0 * 4 + h) * 4) + (unsigned)lane * 16u);
        float gc = gb.x; const float be = gb.y;
#pragma unroll
        for (int off = 1; off < 64; off <<= 1) { const float t = bperm(gc, (lane - off) & 63); gc += (lane >= off) ? t : 0.f; }
        const float gl = rdlane(gc, 63);
        gcv[lane] = gc; sKp[lane] = be * __expf(gc); sE[lane] = __expf(gl - gc); bev[lane] = be;
        if (lane == 0) CD[ci] = __expf(gl);
        asm volatile("s_waitcnt lgkmcnt(0)" ::: "memory");
        {
            bf16x8 kf[4][4];
#pragma unroll
            for (int t = 0; t < 4; ++t)
#pragma unroll
                for (int s = 0; s < 4; ++s) kf[t][s] = *(const bf16x8*)((KN + (size_t)(tok0 + 16 * t) * 512 + h * 128 + 32 * s) + ((unsigned)fr * 512u + 8u * (unsigned)fq));
            float gcj[4];
#pragma unroll
            for (int t = 0; t < 4; ++t) gcj[t] = gcv[16 * t + fr];
            LAS float* Nc = (LAS float*)wl;
#pragma unroll
            for (int t = 0; t < 4; ++t) { const f32x4 gci = *(const LAS f32x4*)(gcv + 16 * t + 4 * fq), bei = *(const LAS f32x4*)(bev + 16 * t + 4 * fq);
#pragma unroll
                for (int u = 0; u <= t; ++u) {
                    f32x4 acc = (f32x4){0.f, 0.f, 0.f, 0.f};
#pragma unroll
                    for (int s = 0; s < 4; ++s) acc = MFMA16(kf[t][s], kf[u][s], acc);
                    f32x4 nv;
#pragma unroll
                    for (int r = 0; r < 4; ++r) { const int i = 16 * t + 4 * fq + r, j = 16 * u + fr; const float v = bei[r] * acc[r] * __expf(fminf(gci[r] - gcj[u], 0.f)); nv[r] = (i > j) ? v : 0.f; }
                    *(LAS f32x4*)(Nc + (16 * u + fr) * 64 + 16 * t + 4 * fq) = nv;
                } }
        }
        asm volatile("s_waitcnt lgkmcnt(0)" ::: "memory");
        {
            float x[64];
#pragma unroll
            for (int c = 63; c >= 0; --c) { float a = (lane == c) ? 1.f : 0.f, a1 = 0.f, a2 = 0.f, a3 = 0.f;
#pragma unroll
                for (int k4 = ((c + 1) & ~3); k4 < 64; k4 += 4) { const f32x4 nv = *(const LAS f32x4*)((const LAS float*)wl + c * 64 + k4);
                    if (k4 + 0 > c) a -= x[k4 + 0] * nv[0]; if (k4 + 1 > c) a1 -= x[k4 + 1] * nv[1]; if (k4 + 2 > c) a2 -= x[k4 + 2] * nv[2]; if (k4 + 3 > c) a3 -= x[k4 + 3] * nv[3]; }
                a = (a + a1) + (a2 + a3);
                asm volatile("" : "+v"(a) :: "memory");
                x[c] = a; }
#pragma unroll
            for (int q8 = 0; q8 < 8; ++q8) { v4u w; w.x = cvt_pk_nat(x[8 * q8], x[8 * q8 + 1]); w.y = cvt_pk_nat(x[8 * q8 + 2], x[8 * q8 + 3]); w.z = cvt_pk_nat(x[8 * q8 + 4], x[8 * q8 + 5]); w.w = cvt_pk_nat(x[8 * q8 + 6], x[8 * q8 + 7]);
                *(LAS v4u*)(Ts + lane * GA_PITCH + 8 * q8) = w; }
        }
        asm volatile("s_waitcnt lgkmcnt(0)" ::: "memory");
        {
            bf16x8 tsf[4][2];
#pragma unroll
            for (int t = 0; t < 4; ++t)
#pragma unroll
                for (int s = 0; s < 2; ++s) tsf[t][s] = *(const LAS bf16x8*)(Ts + (16 * t + fr) * GA_PITCH + 32 * s + 8 * fq);
#pragma unroll 1
            for (int half = 0; half < 2; ++half) {
                const bf16* vbase = VV + (size_t)tok0 * 512 + h * 128 + half * 64; const unsigned vlo = (unsigned)lane * 512u;
#pragma unroll
                for (int c = 0; c < 8; ++c) { float f[8]; unpack8(*(const v4u*)((vbase + 8 * c) + vlo), f);
#pragma unroll
                    for (int i2 = 0; i2 < 4; ++i2) xb_store_pair(XB, 8 * c + 2 * i2, cvt_pk_nat(f[2 * i2] * be, f[2 * i2 + 1] * be), lane); }
                asm volatile("s_waitcnt lgkmcnt(0)" ::: "memory");
#pragma unroll
                for (int nl = 0; nl < 4; ++nl) { const bf16x8 b0 = *(const LAS bf16x8*)(XB + (16 * nl + fr) * GA_PITCH + 8 * fq), b1 = *(const LAS bf16x8*)(XB + (16 * nl + fr) * GA_PITCH + 32 + 8 * fq);
                    f32x4 ut[4];
#pragma unroll
                    for (int t = 0; t < 4; ++t) { f32x4 acc = (f32x4){0.f, 0.f, 0.f, 0.f}; acc = MFMA16(tsf[t][0], b0, acc); if (t >= 2) acc = MFMA16(tsf[t][1], b1, acc); ut[t] = acc; }
                    (UPK + ((size_t)ci * 16 + 2 * (half * 4 + nl)) * 64)[(unsigned)lane] = __builtin_bit_cast(v4u, pack8(ut[0], ut[1]));
                    (UPK + ((size_t)ci * 16 + 2 * (half * 4 + nl) + 1) * 64)[(unsigned)lane] = __builtin_bit_cast(v4u, pack8(ut[2], ut[3])); }
                asm volatile("s_waitcnt lgkmcnt(0)" ::: "memory");
            }
#pragma unroll 1
            for (int half = 0; half < 2; ++half) {
                gdn_fill_kT(KN, XB, tok0, h, half, lane);
#pragma unroll
                for (int nl = 0; nl < 4; ++nl) { bf16x8 kp[2];
#pragma unroll
                    for (int s = 0; s < 2; ++s) { const v4u raw = *(const LAS v4u*)(XB + (16 * nl + fr) * GA_PITCH + 32 * s + 8 * fq); const f32x4 c0 = *(const LAS f32x4*)(sKp + 32 * s + 8 * fq), c1 = *(const LAS f32x4*)(sKp + 32 * s + 8 * fq + 4);
                        kp[s] = pack8((f32x4){bf_lo(raw.x) * c0[0], bf_hi(raw.x) * c0[1], bf_lo(raw.y) * c0[2], bf_hi(raw.y) * c0[3]}, (f32x4){bf_lo(raw.z) * c1[0], bf_hi(raw.z) * c1[1], bf_lo(raw.w) * c1[2], bf_hi(raw.w) * c1[3]}); }
                    f32x4 wt[4];
#pragma unroll
                    for (int t = 0; t < 4; ++t) { f32x4 acc = (f32x4){0.f, 0.f, 0.f, 0.f}; acc = MFMA16(tsf[t][0], kp[0], acc); if (t >= 2) acc = MFMA16(tsf[t][1], kp[1], acc); wt[t] = acc; }
                    (WPK + ((size_t)ci * 16 + 2 * (half * 4 + nl)) * 64)[(unsigned)lane] = __builtin_bit_cast(v4u, pack8(wt[0], wt[1]));
                    (WPK + ((size_t)ci * 16 + 2 * (half * 4 + nl) + 1) * 64)[(unsigned)lane] = __builtin_bit_cast(v4u, pack8(wt[2], wt[3])); }
                asm volatile("s_waitcnt lgkmcnt(0)" ::: "memory");
            }
        }
        asm volatile("s_waitcnt vmcnt(0)" ::: "memory");
        gdn_fill_kT(KN, Ts, tok0, h, 0, lane);
        gdn_kend_products(Ts, XB, sE, UPK, WPK, ci, lane, BC, ATF);
        asm volatile("s_waitcnt lgkmcnt(0)" ::: "memory");
        bf16x8 qkpk[4][2];
        {
            bf16x8 kf[4][4];
#pragma unroll
            for (int t = 0; t < 4; ++t)
#pragma unroll
                for (int s = 0; s < 4; ++s) kf[t][s] = *(const bf16x8*)((KN + (size_t)(tok0 + 16 * t) * 512 + h * 128 + 32 * s) + ((unsigned)fr * 512u + 8u * (unsigned)fq));
#pragma unroll
            for (int t = 0; t < 4; ++t) { bf16x8 qf[4]; const float gct = gcv[16 * t + fr];
#pragma unroll
                for (int s = 0; s < 4; ++s) qf[s] = *(const bf16x8*)((QN + (size_t)(tok0 + 16 * t) * 512 + h * 128 + 32 * s) + ((unsigned)fr * 512u + 8u * (unsigned)fq));
                f32x4 tl[4];
#pragma unroll
                for (int u = 0; u < 4; ++u) { tl[u] = (f32x4){0.f, 0.f, 0.f, 0.f}; if (u > t) continue;
                    const f32x4 gcu = *(const LAS f32x4*)(gcv + 16 * u + 4 * fq);
                    f32x4 acc = (f32x4){0.f, 0.f, 0.f, 0.f};
#pragma unroll
                    for (int s = 0; s < 4; ++s) acc = MFMA16(kf[u][s], qf[s], acc);
#pragma unroll
                    for (int r = 0; r < 4; ++r) { const int i = 16 * t + fr, j = 16 * u + 4 * fq + r; const float v = acc[r] * __expf(fminf(gct - gcu[r], 0.f)); tl[u][r] = (i >= j) ? v : 0.f; } }
                qkpk[t][0] = pack8(tl[0], tl[1]); qkpk[t][1] = pack8(tl[2], tl[3]); }
        }
        asm volatile("s_waitcnt lgkmcnt(0)" ::: "memory");
#pragma unroll 2
        for (int sp = 0; sp < 4; ++sp) {
            const bf16x8 w00 = __builtin_bit_cast(bf16x8, (WPK + ((size_t)ci * 16 + 4 * sp) * 64)[(unsigned)lane]), w01 = __builtin_bit_cast(bf16x8, (WPK + ((size_t)ci * 16 + 4 * sp + 1) * 64)[(unsigned)lane]);
            const bf16x8 w10 = __builtin_bit_cast(bf16x8, (WPK + ((size_t)ci * 16 + 4 * sp + 2) * 64)[(unsigned)lane]), w11 = __builtin_bit_cast(bf16x8, (WPK + ((size_t)ci * 16 + 4 * sp + 3) * 64)[(unsigned)lane]);
#pragma unroll
            for (int t = 0; t < 4; ++t) { const float egi = __expf(gcv[16 * t + fr]); f32x4 dd[2];
#pragma unroll
                for (int hh = 0; hh < 2; ++hh) { f32x4 acc = (f32x4){0.f, 0.f, 0.f, 0.f}; acc = MFMA16(hh ? w10 : w00, qkpk[t][0], acc); if (t >= 2) acc = MFMA16(hh ? w11 : w01, qkpk[t][1], acc);
                    const v2u q4 = *(const v2u*)((QN + (size_t)(tok0 + 16 * t) * 512 + h * 128) + ((unsigned)fr * 512u + 4u * (unsigned)fq + 16u * (unsigned)(2 * sp + hh)));
                    dd[hh] = (f32x4){bf_lo(q4.x) * egi - acc[0], bf_hi(q4.x) * egi - acc[1], bf_lo(q4.y) * egi - acc[2], bf_hi(q4.y) * egi - acc[3]}; }
                (QTF + ((size_t)(ci * 4 + t) * 4 + sp) * 64)[(unsigned)lane] = __builtin_bit_cast(v4u, pack8(dd[0], dd[1])); } }
#pragma unroll 4
        for (int et = 0; et < 8; ++et) {
            const bf16x8 u0 = __builtin_bit_cast(bf16x8, (UPK + ((size_t)ci * 16 + 2 * et) * 64)[(unsigned)lane]), u1 = __builtin_bit_cast(bf16x8, (UPK + ((size_t)ci * 16 + 2 * et + 1) * 64)[(unsigned)lane]);
#pragma unroll
            for (int t = 0; t < 4; ++t) { f32x4 acc = (f32x4){0.f, 0.f, 0.f, 0.f}; acc = MFMA16(u0, qkpk[t][0], acc); if (t >= 2) acc = MFMA16(u1, qkpk[t][1], acc);
                (OL + ((size_t)(ci * 8 + et) * 4 + t) * 64)[(unsigned)lane] = pack4(acc); } }
    }
}
__device__ __forceinline__ void phase_gdn_b_helper(Ctx& F, int epoch, int bh, int h) {
    const v4u* at = (const v4u*)(F.ws + WS_ATF) + (size_t)bh * 256 * 2048 + F.tid;
    const v4u* bc = (const v4u*)(F.ws + WS_BC) + (size_t)bh * 256 * 2048 + F.tid;
    unsigned* prog = (unsigned*)(F.ws + WS_CTL) + CW_PROG + bh * 64; const unsigned pbase = (unsigned)epoch * 1024u + 1u;
    v4u acc = (v4u){0u, 0u, 0u, 0u}; v4u d0[8], d1[8];
#pragma unroll
    for (int j = 0; j < 8; ++j) { d0[j] = (v4u){0u, 0u, 0u, 0u}; d1[j] = (v4u){0u, 0u, 0u, 0u}; }
#define HP_WAIT(n_) do { if ((n_) >= HLEAD) { const unsigned want_ = pbase + (unsigned)((n_) - HLEAD); unsigned spins_ = 0; \
        while ((unsigned)__builtin_amdgcn_readfirstlane((int)__hip_atomic_load(prog, __ATOMIC_RELAXED, __HIP_MEMORY_SCOPE_AGENT)) < want_ && ++spins_ < (1u << 18)) __builtin_amdgcn_s_sleep(1); } } while (0)
#define HP_LOAD(d, n_) do { const v4u* a_ = at + (size_t)(n_) * 2048; const v4u* b_ = bc + (size_t)(n_) * 2048; \
        _Pragma("unroll") for (int j = 0; j < 4; ++j) { d[j] = a_[512 * j]; d[4 + j] = b_[512 * j]; } } while (0)
#define HP_USE(d) do { _Pragma("unroll") for (int j = 0; j < 8; ++j) { acc.x ^= d[j].x; acc.y ^= d[j].y; acc.z ^= d[j].z; acc.w ^= d[j].w; } } while (0)
    for (int n = h; n < 256; n += 2 * NHELP) {
        HP_WAIT(n); HP_USE(d0); HP_LOAD(d0, n);
        if (n + NHELP < 256) { HP_WAIT(n + NHELP); HP_USE(d1); HP_LOAD(d1, n + NHELP); }
    }
    HP_USE(d0); HP_USE(d1);
    asm volatile("" :: "v"(acc.x), "v"(acc.y), "v"(acc.z), "v"(acc.w));
#undef HP_WAIT
#undef HP_LOAD
#undef HP_USE
}
#ifndef B_OLDMAP
#define BH_OF(bid) ((bid) & 7)
#define SL_OF(bid) ((bid) >> 3)
#else
#define BH_OF(bid) ((bid) >> 2)
#define SL_OF(bid) ((bid) & 3)
#endif
__device__ __forceinline__ void phase_gdn_b(Ctx& F, int epoch, int bvar) {
    const int bh = BH_OF(F.bid), sl = SL_OF(F.bid), w = F.wave, lane = F.lane, fr = lane & 15, fq = lane >> 4;
    const v4u* ATF = (const v4u*)(F.ws + WS_ATF); const v2u* BC = (const v2u*)(F.ws + WS_BC); const float* CD = (const float*)(F.ws + WS_CD); bf16* ST = (bf16*)(F.ws + WS_ST);
    LAS unsigned char* xb = F.lds;
    const int cbase = bh * 256;
    unsigned* prog = (unsigned*)(F.ws + WS_CTL) + CW_PROG + bh * 64; const unsigned pbase = (unsigned)epoch * 1024u + 1u; const bool pub = (sl == 0) && (w == 0) && (lane == 0);
    f32x4 S[2]; S[0] = (f32x4){0.f, 0.f, 0.f, 0.f}; S[1] = (f32x4){0.f, 0.f, 0.f, 0.f};
    constexpr int RD = 6;
    v4u afr[RD][4]; v2u bcr[RD][2]; float cdr[RD];
#define GB_LOAD(k, n_) do { const int cc_ = (n_) < 256 ? (n_) : 255; const size_t ci_ = (size_t)(cbase + cc_); \
        _Pragma("unroll") for (int s_ = 0; s_ < 4; ++s_) afr[k][s_] = (ATF + ((ci_ * 8 + w) * 4 + s_) * 64)[(unsigned)lane]; \
        _Pragma("unroll") for (int n2_ = 0; n2_ < 2; ++n2_) bcr[k][n2_] = (BC + ((ci_ * 8 + 2 * sl + n2_) * 8 + w) * 64)[(unsigned)lane]; \
        cdr[k] = CD[ci_]; } while (0)
#pragma unroll
    for (int k = 0; k < RD; ++k) GB_LOAD(k, k);
    _Pragma("unroll") for (int k = 0; k < RD; ++k) asm volatile("" :: "v"(afr[k][0]), "v"(afr[k][1]), "v"(afr[k][2]), "v"(afr[k][3]), "v"(bcr[k][0]), "v"(bcr[k][1]), "v"(cdr[k]));
#define GB_STEP(k, n_, LOADNEXT) do { const int n = (n_), par = (k) & 1; const size_t ci = (size_t)(cbase + n); \
            if (NHELP > 0 && pub) __hip_atomic_store(prog, pbase + (unsigned)n, __ATOMIC_RELAXED, __HIP_MEMORY_SCOPE_AGENT);     \
            _Pragma("unroll") for (int nt = 0; nt < 2; ++nt) { const v2u p = pack4(S[nt]); \
                *(LAS v2u*)(xb + par * 8192 + ((nt * 4 + (w >> 1)) * 64 + lane) * 16 + (w & 1) * 8) = p; \
                if (!(bvar & 1)) ((v2u*)ST + ((ci * 8 + w) * 8 + 2 * sl + nt) * 64)[(unsigned)lane] = p; }     \
            asm volatile("s_waitcnt lgkmcnt(0)" ::: "memory"); __builtin_amdgcn_s_barrier(); asm volatile("" ::: "memory"); \
            bf16x8 sf[2][4]; \
            _Pragma("unroll") for (int nt = 0; nt < 2; ++nt) \
                _Pragma("unroll") for (int s = 0; s < 4; ++s) sf[nt][s] = *(const LAS bf16x8*)(xb + par * 8192 + ((nt * 4 + s) * 64 + lane) * 16); \
              \
            asm volatile("" : "+v"(cdr[k]));     \
            const float cdk = __builtin_bit_cast(float, __builtin_amdgcn_readfirstlane(__builtin_bit_cast(int, cdr[k]))); \
            _Pragma("unroll") for (int nt = 0; nt < 2; ++nt) { const v2u bw = bcr[k][nt]; f32x4 acc = S[nt] * cdk + (f32x4){bf_lo(bw.x), bf_hi(bw.x), bf_lo(bw.y), bf_hi(bw.y)}; \
                f32x4 acc2 = (f32x4){0.f, 0.f, 0.f, 0.f};                      \
                acc = MFMA16(__builtin_bit_cast(bf16x8, afr[k][0]), sf[nt][0], acc); acc2 = MFMA16(__builtin_bit_cast(bf16x8, afr[k][1]), sf[nt][1], acc2); \
                acc = MFMA16(__builtin_bit_cast(bf16x8, afr[k][2]), sf[nt][2], acc); acc2 = MFMA16(__builtin_bit_cast(bf16x8, afr[k][3]), sf[nt][3], acc2); \
                S[nt] = acc + acc2; } \
            if (LOADNEXT && !(bvar & 2)) GB_LOAD(k, n + RD); } while (0)
    for (int n0 = 0; n0 + RD <= 256; n0 += RD) {
#pragma unroll
        for (int k = 0; k < RD; ++k) GB_STEP(k, n0 + k, true);
    }
#pragma unroll
    for (int k = 0; k < 256 % RD; ++k) GB_STEP(k, 256 / RD * RD + k, false);
#undef GB_STEP
#undef GB_LOAD
}
__device__ __forceinline__ void phase_gdn_c(Ctx& F, int l) {
    const int lane = F.lane, fr = lane & 15, fq = lane >> 4;
    const v4u* QTF = (const v4u*)(F.ws + WS_QTF); const v2u* OL = (const v2u*)(F.ws + WS_OL); const bf16* ST = (const bf16*)(F.ws + WS_ST);
    const bf16* proj = (const bf16*)(F.ws + WS_R1); bf16* ya = (bf16*)(F.ws + WS_YA); const float* gnp = as_global(F.in[I_GDNNORM]) + (size_t)l * 128;
    { const int ci = F.bid * 8 + F.wave;
        const int bh = ci >> 8, n = ci & 255, b = bh >> 2, h = bh & 3, tok0 = b * T + n * 64;
        bf16x8 qt[4][4];
#pragma unroll
        for (int t = 0; t < 4; ++t)
#pragma unroll
            for (int s = 0; s < 4; ++s) qt[t][s] = __builtin_bit_cast(bf16x8, (QTF + ((size_t)(ci * 4 + t) * 4 + s) * 64)[(unsigned)lane]);
        f32x4 o[8][4];
#pragma unroll
        for (int et = 0; et < 8; ++et) {
#pragma unroll
            for (int t = 0; t < 4; ++t) { const v2u ow = (OL + ((size_t)(ci * 8 + et) * 4 + t) * 64)[(unsigned)lane]; o[et][t] = (f32x4){bf_lo(ow.x), bf_hi(ow.x), bf_lo(ow.y), bf_hi(ow.y)}; }
#pragma unroll
            for (int s = 0; s < 4; ++s) { const v2u lo = ((const v2u*)ST + (((size_t)ci * 8 + 2 * s) * 8 + et) * 64)[(unsigned)lane], hi = ((const v2u*)ST + (((size_t)ci * 8 + 2 * s + 1) * 8 + et) * 64)[(unsigned)lane];
                v4u aw; aw.x = lo.x; aw.y = lo.y; aw.z = hi.x; aw.w = hi.y; const bf16x8 a = __builtin_bit_cast(bf16x8, aw);
#pragma unroll
                for (int t = 0; t < 4; ++t) o[et][t] = MFMA16(a, qt[t][s], o[et][t]); }
        }
        LAS bf16* slab = (LAS bf16*)(F.lds + F.wave * (64 * 136 * 2));
#pragma unroll
        for (int t = 0; t < 4; ++t) { float ss = 0.f;
#pragma unroll
            for (int et = 0; et < 8; ++et) ss += (o[et][t][0] * o[et][t][0] + o[et][t][1] * o[et][t][1]) + (o[et][t][2] * o[et][t][2] + o[et][t][3] * o[et][t][3]);
            ss += bperm(ss, lane ^ 16); ss += bperm(ss, lane ^ 32);
            const float sc = 1.f / sqrtf(ss * (1.f / 128.f) + RMS_EPS);
#pragma unroll
            for (int et = 0; et < 8; ++et) *(LAS v2u*)(slab + (16 * t + fr) * 136 + 16 * et + 4 * fq) = pack4(o[et][t] * sc); }
        asm volatile("s_waitcnt lgkmcnt(0)" ::: "memory");
        { const int rr = lane >> 4, cc = (lane & 15) * 8;
          const f32x4 g0 = *(const f32x4*)(gnp + cc), g1 = *(const f32x4*)(gnp + cc + 4);
#pragma unroll 2
          for (int p = 0; p < 16; ++p) { const int i = 4 * p + rr;
              const v4u ov = *(const LAS v4u*)(slab + i * 136 + cc);
              const v4u zv = *(const v4u*)((proj + (size_t)tok0 * NPROJ + C_Z + h * 128) + ((unsigned)i * (unsigned)NPROJ + (unsigned)cc));
              float of[8], zf[8]; unpack8(ov, of); unpack8(zv, zf);
              v4u w; w.x = cvt_pk_nat(of[0] * g0[0] * siluf_(zf[0]), of[1] * g0[1] * siluf_(zf[1])); w.y = cvt_pk_nat(of[2] * g0[2] * siluf_(zf[2]), of[3] * g0[3] * siluf_(zf[3]));
              w.z = cvt_pk_nat(of[4] * g1[0] * siluf_(zf[4]), of[5] * g1[1] * siluf_(zf[5])); w.w = cvt_pk_nat(of[6] * g1[2] * siluf_(zf[6]), of[7] * g1[3] * siluf_(zf[7]));
              *(v4u*)((ya + (size_t)tok0 * 512 + h * 128) + ((unsigned)i * 512u + (unsigned)cc)) = w; } }
    }
}
constexpr int XK_PITCH = 136, XV_PITCH = 264;
__device__ __forceinline__ void phase_xattn(Ctx& F, int first, int stride) {
    const bf16* proj = (const bf16*)(F.ws + WS_R1); const bf16* kvb = (const bf16*)(F.ws + WS_KVB); const bf16* vtb = (const bf16*)(F.ws + WS_KVB + 512 * 1024); bf16* ym = (bf16*)(F.ws + WS_YM);
    LAS bf16* Ks = (LAS bf16*)F.lds; LAS bf16* VTs = (LAS bf16*)(F.lds + 256 * XK_PITCH * 2);
    const int NU = NB * 4 * (T / 512);
    for (int unit = first; unit < NU; unit += stride) {
        const int qt = unit % (T / 512), bh = unit / (T / 512), b = bh >> 2, head = bh & 3;
        int lane = F.lane; asm volatile("" : "+v"(lane));
        const int fr = lane & 15, fq = lane >> 4, tid_l = F.wave * 64 + lane;
        __syncthreads();
        for (int it = 0; it < 8; ++it) { const int idx = it * 512 + tid_l, key = idx >> 4, ch = idx & 15;
            const v4u kx = *(const v4u*)((kvb + (size_t)(b * NMEM) * 512 + head * 128) + ((unsigned)key * 512u + (unsigned)ch * 8u)); *(LAS v4u*)(Ks + key * XK_PITCH + ch * 8) = kx;
            const int e = idx >> 5, kc = idx & 31;
            const v4u vx = *(const v4u*)((vtb + (size_t)((b * 4 + head) * 128) * 256) + ((unsigned)e * 256u + (unsigned)kc * 8u)); *(LAS v4u*)(VTs + e * XV_PITCH + kc * 8) = vx; }
        __syncthreads();
#pragma unroll 1
        for (int qi = 0; qi < 2; ++qi) {
            const int tok0 = b * T + qt * 512 + F.wave * 64 + qi * 32;
            bf16x8 qf[2][4];
#pragma unroll
            for (int g = 0; g < 2; ++g)
#pragma unroll
                for (int s = 0; s < 4; ++s) qf[g][s] = *(const bf16x8*)((proj + (size_t)(tok0 + g * 16) * NPROJ + C_QM + head * 128 + 32 * s) + ((unsigned)fr * (unsigned)NPROJ + 8u * (unsigned)fq));
            f32x4 sc[2][16];
#pragma unroll
            for (int kt = 0; kt < 16; ++kt) {
                sc[0][kt] = (f32x4){0.f, 0.f, 0.f, 0.f}; sc[1][kt] = (f32x4){0.f, 0.f, 0.f, 0.f};
#pragma unroll
                for (int s = 0; s < 4; ++s) { const bf16x8 kf = *(const LAS bf16x8*)(Ks + (kt * 16 + fr) * XK_PITCH + 32 * s + 8 * fq);
                    sc[0][kt] = __builtin_amdgcn_mfma_f32_16x16x32_bf16(kf, qf[0][s], sc[0][kt], 0, 0, 0);
                    sc[1][kt] = __builtin_amdgcn_mfma_f32_16x16x32_bf16(kf, qf[1][s], sc[1][kt], 0, 0, 0); }
            }
            bf16x8 pf[2][8]; float inv[2];
#pragma unroll
            for (int g = 0; g < 2; ++g) {
                float mx = -3.0e38f;
#pragma unroll
                for (int kt = 0; kt < 16; ++kt) mx = fmaxf(mx, fmaxf(fmaxf(sc[g][kt][0], sc[g][kt][1]), fmaxf(sc[g][kt][2], sc[g][kt][3])));
                mx = fmaxf(mx, bperm(mx, lane ^ 16)); mx = fmaxf(mx, bperm(mx, lane ^ 32));
                float sum = 0.f;
#pragma unroll
                for (int kt = 0; kt < 16; ++kt)
#pragma unroll
                    for (int r = 0; r < 4; ++r) { const float p = __expf((sc[g][kt][r] - mx) * 0.08838834764831845f); sc[g][kt][r] = p; sum += p; }
                sum += bperm(sum, lane ^ 16); sum += bperm(sum, lane ^ 32);
                inv[g] = 1.f / sum;
#pragma unroll
                for (int ks = 0; ks < 8; ++ks) { v4u w; w.x = cvt_pk_bf16_n(sc[g][2 * ks][0], sc[g][2 * ks][1]); w.y = cvt_pk_bf16_n(sc[g][2 * ks][2], sc[g][2 * ks][3]);
                    w.z = cvt_pk_bf16_n(sc[g][2 * ks + 1][0], sc[g][2 * ks + 1][1]); w.w = cvt_pk_bf16_n(sc[g][2 * ks + 1][2], sc[g][2 * ks + 1][3]); pf[g][ks] = __builtin_bit_cast(bf16x8, w); }
            }
#pragma unroll
            for (int et = 0; et < 8; ++et) {
                f32x4 o0 = (f32x4){0.f, 0.f, 0.f, 0.f}, o1 = (f32x4){0.f, 0.f, 0.f, 0.f};
#pragma unroll
                for (int ks = 0; ks < 8; ++ks) { const LAS bf16* vp = VTs + (et * 16 + fr) * XV_PITCH + 32 * ks + 4 * fq;
                    const v2u lo = *(const LAS v2u*)vp, hi = *(const LAS v2u*)(vp + 16); v4u w; w.x = lo.x; w.y = lo.y; w.z = hi.x; w.w = hi.y; const bf16x8 vf = __builtin_bit_cast(bf16x8, w);
                    o0 = __builtin_amdgcn_mfma_f32_16x16x32_bf16(vf, pf[0][ks], o0, 0, 0, 0);
                    o1 = __builtin_amdgcn_mfma_f32_16x16x32_bf16(vf, pf[1][ks], o1, 0, 0, 0); }
                o0 = o0 * inv[0]; o1 = o1 * inv[1];
                v2u w0, w1; w0.x = cvt_pk_bf16_n(o0[0], o0[1]); w0.y = cvt_pk_bf16_n(o0[2], o0[3]); w1.x = cvt_pk_bf16_n(o1[0], o1[1]); w1.y = cvt_pk_bf16_n(o1[2], o1[3]);
                *(v2u*)((ym + (size_t)tok0 * 512 + head * 128 + et * 16) + ((unsigned)fr * 512u + 4u * (unsigned)fq)) = w0;
                *(v2u*)((ym + (size_t)(tok0 + 16) * 512 + head * 128 + et * 16) + ((unsigned)fr * 512u + 4u * (unsigned)fq)) = w1;
            }
        }
    }
}

constexpr int TPW = NTOK / 256;
constexpr int WR_PITCH = 1028;
__device__ __forceinline__ int dpp_i(int s, int ctrl_sel) {
    if (ctrl_sel == 0) return __builtin_amdgcn_update_dpp(0, s, 0xB1, 0xF, 0xF, true);
    if (ctrl_sel == 1) return __builtin_amdgcn_update_dpp(0, s, 0x4E, 0xF, 0xF, true);
    if (ctrl_sel == 2) return __builtin_amdgcn_update_dpp(0, s, 0x141, 0xF, 0xF, true);
    return __builtin_amdgcn_update_dpp(0, s, 0x140, 0xF, 0xF, true);
}
__device__ __forceinline__ void phase_ln1_router(Ctx& F, int l) {
    LAS float* wr_s = (LAS float*)F.lds;
    LAS int* hist = (LAS int*)(F.lds + 32 * WR_PITCH * 4);
    const float* wrp = as_global(F.in[I_WR]) + (size_t)l * D * NE;
    { const int e = F.tid & 31, kg = F.tid >> 5;
      f32x4 wv[16];
#pragma unroll
      for (int j = 0; j < 16; ++j) { const int k = kg * 64 + 4 * j; wv[j][0] = wrp[(size_t)(k + 0) * NE + e]; wv[j][1] = wrp[(size_t)(k + 1) * NE + e]; wv[j][2] = wrp[(size_t)(k + 2) * NE + e]; wv[j][3] = wrp[(size_t)(k + 3) * NE + e]; }
#pragma unroll
      for (int j = 0; j < 16; ++j) *(LAS f32x4*)(wr_s + e * WR_PITCH + kg * 64 + 4 * j) = wv[j]; }
    LAS float* gb_s = (LAS float*)(F.lds + 32 * WR_PITCH * 4 + 256);
    for (int i = F.tid; i < 2 * D; i += 512) gb_s[i] = (i < D) ? as_global(F.in[I_LN1G])[(size_t)l * D + i] : as_global(F.in[I_LN1B])[(size_t)l * D + i - D];
    if (F.tid < 32) hist[F.tid] = 0;
    __syncthreads();
    const bf16* tb = (const bf16*)(F.ws + WS_HF); bf16* hb = (bf16*)(F.ws + WS_HB);
    int* tok_e = (int*)(F.ws + WS_TOKE); float* tok_w = (float*)(F.ws + WS_TOKW);
    const float* brp = as_global(F.in[I_BR]) + (size_t)l * NE;
    const int lane = F.lane, fr = lane & 15, q = lane >> 4;
    const int tok_base = F.bid * TPW + F.wave * 16;
    const size_t rowoff = (size_t)(tok_base + fr) * D + 8 * q;
    v4u xr[32];
#pragma unroll
    for (int c = 0; c < 32; ++c) xr[c] = *(const v4u*)(tb + rowoff + 32 * c);
    float s = 0.f, s2 = 0.f;
#pragma unroll
    for (int c = 0; c < 32; ++c) { float x[8]; unpack8(xr[c], x);
#pragma unroll
        for (int i = 0; i < 8; ++i) { s += x[i]; s2 += x[i] * x[i]; } }
    s += bperm(s, lane ^ 16); s += bperm(s, lane ^ 32); s2 += bperm(s2, lane ^ 16); s2 += bperm(s2, lane ^ 32);
    const float mean = s * (1.f / D);
    const float rstd = 1.f / sqrtf(fmaxf(s2 * (1.f / D) - mean * mean, 0.f) + LN_EPS);
#pragma unroll
    for (int c = 0; c < 32; ++c) asm volatile("" : "+v"(xr[c]));
    const LAS float* gp = gb_s + 8 * q; const LAS float* bp = gb_s + D + 8 * q;
    const LAS float* w0p = wr_s + fr * WR_PITCH + 8 * q; const LAS float* w1p = wr_s + (16 + fr) * WR_PITCH + 8 * q;
    f32x4 acc0 = (f32x4){0.f, 0.f, 0.f, 0.f}, acc1 = (f32x4){0.f, 0.f, 0.f, 0.f};
#pragma unroll
    for (int c = 0; c < 32; ++c) {
        float x[8]; unpack8(xr[c], x);
        const f32x4 g0 = *(const LAS f32x4*)(gp + 32 * c), g1 = *(const LAS f32x4*)(gp + 32 * c + 4), b0 = *(const LAS f32x4*)(bp + 32 * c), b1 = *(const LAS f32x4*)(bp + 32 * c + 4);
        float h[8];
#pragma unroll
        for (int i = 0; i < 4; ++i) { h[i] = (x[i] - mean) * rstd * g0[i] + b0[i]; h[4 + i] = (x[4 + i] - mean) * rstd * g1[i] + b1[i]; }
        const f32x4 wa0 = *(const LAS f32x4*)(w0p + 32 * c), wa1 = *(const LAS f32x4*)(w0p + 32 * c + 4), wb0 = *(const LAS f32x4*)(w1p + 32 * c), wb1 = *(const LAS f32x4*)(w1p + 32 * c + 4);
#pragma unroll
        for (int i = 0; i < 4; ++i) { acc0 = __builtin_amdgcn_mfma_f32_16x16x4f32(h[i], wa0[i], acc0, 0, 0, 0); acc1 = __builtin_amdgcn_mfma_f32_16x16x4f32(h[i], wb0[i], acc1, 0, 0, 0); }
#pragma unroll
        for (int i = 0; i < 4; ++i) { acc0 = __builtin_amdgcn_mfma_f32_16x16x4f32(h[4 + i], wa1[i], acc0, 0, 0, 0); acc1 = __builtin_amdgcn_mfma_f32_16x16x4f32(h[4 + i], wb1[i], acc1, 0, 0, 0); }
        v4u w; w.x = cvt_pk_nat(h[0], h[1]); w.y = cvt_pk_nat(h[2], h[3]); w.z = cvt_pk_nat(h[4], h[5]); w.w = cvt_pk_nat(h[6], h[7]);
        *(v4u*)(hb + rowoff + 32 * c) = w;
        asm volatile("" ::: "memory");
    }
    const float be0 = brp[fr], be1 = brp[16 + fr];
#pragma unroll
    for (int r = 0; r < 4; ++r) {
        float v0 = acc0[r] + be0, v1 = acc1[r] + be1; float val[4]; int idx[4];
#pragma unroll
        for (int kk = 0; kk < 4; ++kk) {
            const bool use1 = v1 > v0; float bv = use1 ? v1 : v0; int bi = use1 ? 16 + fr : fr;
#pragma unroll
            for (int st = 0; st < 4; ++st) { const float ov = dpp_f(bv, st); const int oi = dpp_i(bi, st); const bool take = (ov > bv) || (ov == bv && oi < bi); bv = take ? ov : bv; bi = take ? oi : bi; }
            val[kk] = bv; idx[kk] = bi;
            v0 = (bi == fr) ? -3.0e38f : v0; v1 = (bi == 16 + fr) ? -3.0e38f : v1;
        }
        const float e1 = __expf(val[1] - val[0]), e2 = __expf(val[2] - val[0]), e3 = __expf(val[3] - val[0]); const float inv = 1.f / (1.f + e1 + e2 + e3);
        if (fr == 0) { const size_t t4 = (size_t)(tok_base + 4 * q + r) * 4;
            *(int4*)(tok_e + t4) = make_int4(idx[0], idx[1], idx[2], idx[3]); *(f32x4*)(tok_w + t4) = (f32x4){inv, e1 * inv, e2 * inv, e3 * inv};
            atomicAdd((int*)&hist[idx[0]], 1); atomicAdd((int*)&hist[idx[1]], 1); atomicAdd((int*)&hist[idx[2]], 1); atomicAdd((int*)&hist[idx[3]], 1); }
    }
    __syncthreads();
    if (F.tid < 32) ((int*)(F.ws + WS_CNT))[F.bid * 32 + F.tid] = hist[F.tid];
}

__device__ __forceinline__ void phase_assign(Ctx& F) {
    LAS int* part_tot = (LAS int*)F.lds;
    LAS int* part_bef = part_tot + 512;
    LAS int* tot_s = part_bef + 512; LAS int* bef_s = tot_s + 32; LAS int* pstart_s = bef_s + 32;
    LAS int* cntw = pstart_s + 32;
    const int* cnt = (const int*)(F.ws + WS_CNT); int* meta = (int*)(F.ws + WS_META);
    const int* tok_e = (const int*)(F.ws + WS_TOKE); const float* tok_w = (const float*)(F.ws + WS_TOKW);
    int* tok_slot = (int*)(F.ws + WS_TOKS); float* slot_w = (float*)(F.ws + WS_SLOTW);
    const int lane = F.lane;
    const int n = F.tid, my_e = tok_e[(size_t)F.bid * TPW * 4 + n]; const float my_w = tok_w[(size_t)F.bid * TPW * 4 + n];
    int my_rank = 0, my_cnt = 0;
    const unsigned long long lt = (1ull << lane) - 1ull;
#pragma unroll
    for (int e = 0; e < 32; ++e) { const unsigned long long m = __ballot(my_e == e); my_rank = (my_e == e) ? __popcll(m & lt) : my_rank; my_cnt = (lane == e) ? __popcll(m) : my_cnt; }
    if (lane < 32) cntw[F.wave * 32 + lane] = my_cnt;
    { const int e = F.tid & 31, part = F.tid >> 5; const int per = (F.G + 15) / 16; int c[16];
#pragma unroll
      for (int j = 0; j < 16; ++j) { const int w = part * per + j; c[j] = (j < per && w < F.G) ? cnt[w * 32 + e] : 0; }
      int tot = 0, bef = 0;
#pragma unroll
      for (int j = 0; j < 16; ++j) { tot += c[j]; bef += (part * per + j < F.bid) ? c[j] : 0; }
      part_tot[part * 32 + e] = tot; part_bef[part * 32 + e] = bef; }
    __syncthreads();
    if (F.tid < 32) { int tot = 0, bef = 0;
#pragma unroll
        for (int p = 0; p < 16; ++p) { tot += part_tot[p * 32 + F.tid]; bef += part_bef[p * 32 + F.tid]; }
        tot_s[F.tid] = tot;
        const int pc = ((tot + 255) >> 8) << 8; int incl = pc;
#pragma unroll
        for (int off = 1; off < 32; off <<= 1) { const int t = __builtin_amdgcn_ds_bpermute(((lane - off) & 63) << 2, incl); incl += (lane >= off) ? t : 0; }
        const int ps = incl - pc; pstart_s[F.tid] = ps; bef_s[F.tid] = ps + bef;
        if (F.bid == 0) { for (int tt = ps >> 8; tt < (ps + pc) >> 8; ++tt) meta[64 + tt] = F.tid; if (F.tid == 31) meta[0] = (ps + pc) >> 8; } }
    __syncthreads();
    int pre = 0;
    for (int w = 0; w < F.wave; ++w) pre += cntw[w * 32 + my_e];
    const int slot = bef_s[my_e] + pre + my_rank;
    { const int tok = F.bid * TPW + (n >> 2); tok_slot[(size_t)tok * 4 + (n & 3)] = slot; slot_w[slot] = my_w; ((int*)(F.ws + WS_SLOTT))[slot] = tok; }
    if (F.bid == 0 && F.tid < 32) { const int tot = tot_s[F.tid], ps = pstart_s[F.tid], pe = ps + (((tot + 255) >> 8) << 8); int* st = (int*)(F.ws + WS_SLOTT);
        for (int s2 = ps + tot; s2 < pe; ++s2) st[s2] = 0; }
}

__device__ __forceinline__ void phase_combine_ln2(Ctx& F, int l) {
    LAS float* ws_s = (LAS float*)F.lds;
    if (l + 1 < DEPTH) { load_small_w(F, l + 1, ws_s); }
    __syncthreads();
    bf16* hb = (bf16*)(F.ws + WS_HB); float* ab = (float*)(F.ws + WS_AB);
    const bf16* Y = (const bf16*)(F.ws + WS_XS); const int* tok_slot = (const int*)(F.ws + WS_TOKS);
    const int lane = F.lane, gw = F.bid * 8 + F.wave, NGW = F.G * 8;
    for (int tok = gw; tok < NTOK; tok += NGW) {
        f32x4 v[4]; load_row_bf16(hb + (size_t)tok * D, v, lane);
#pragma unroll
        for (int j = 0; j < 4; ++j) v[j] = v[j] * ALPHA;
#pragma unroll
        for (int kk = 0; kk < 4; ++kk) { const int slot = tok_slot[(size_t)tok * 4 + kk]; const bf16* yr = Y + (size_t)slot * D;
#pragma unroll
            for (int j = 0; j < 4; ++j) { const v2u w = *(const v2u*)(yr + 4 * lane + 256 * j); v[j][0] += bf_lo(w.x); v[j][1] += bf_hi(w.x); v[j][2] += bf_lo(w.y); v[j][3] += bf_hi(w.y); } }
        ln_apply(v, as_global(F.in[I_LN2G]) + (size_t)l * D, as_global(F.in[I_LN2B]) + (size_t)l * D, lane);
        if (l + 1 < DEPTH) { store_row_bf16(hb + (size_t)tok * D, v, lane); small_proj(v, ws_s, ab + (size_t)tok * 8, lane); }
        else store_row_f32(F.out + (size_t)tok * D, v, lane);
    }
}


#define PHASE_FN __device__ __forceinline__
PHASE_FN void g_inproj(LAS unsigned char* lds, unsigned char* ws, int l, int G, int bid, int wave) { asm volatile("" : "+s"(ws)); ws = as_global(ws); asm volatile("" : "+s"(G)); asm volatile("" : "+s"(bid)); asm volatile("" : "+s"(l));
    pg8::SchedDense S{(const char*)(ws + WS_HB), (const char*)(ws + WS_WIN) + (size_t)l * NPROJ * D * 2, NTOK / 256, NPROJ / 256, G, bid, (size_t)256 * D * 2};
    pg8::EpiStoreBf16 E{(bf16*)(ws + WS_R1), NPROJ};
    pg8::gemm_phase<pg8::EpiStoreBf16, pg8::SchedDense, true, true>(lds, D, S, E, wave);
}
PHASE_FN void g_kvproj(LAS unsigned char* lds, unsigned char* ws, int l, int G, int bid, int wave) { asm volatile("" : "+s"(ws)); ws = as_global(ws); asm volatile("" : "+s"(G)); asm volatile("" : "+s"(bid)); asm volatile("" : "+s"(l));
    pg8::SchedDense S{(const char*)(ws + WS_MEMB), (const char*)(ws + WS_WKV) + (size_t)l * D * D * 2, NB * NMEM / 256, D / 256, G, bid, (size_t)256 * D * 2};
    pg8::EpiKV E{(bf16*)(ws + WS_KVB), (bf16*)(ws + WS_KVB + 512 * 1024)};
    pg8::gemm_phase<pg8::EpiKV, pg8::SchedDense, true, true>(lds, D, S, E, wave);
}
#ifndef XT
#define XT 2
#endif
constexpr int CW_XDONE = 20480;
PHASE_FN void g_side_branch(LAS unsigned char* lds, unsigned char* ws, int l, int nside, int sidx, int wave, int br) { asm volatile("" : "+s"(ws)); ws = as_global(ws); asm volatile("" : "+s"(nside)); asm volatile("" : "+s"(sidx)); asm volatile("" : "+s"(l)); asm volatile("" : "+s"(br));
    const bool xw = sidx < 64;
    pg8::SchedBranch S{(const char*)(ws + WS_YA), (const char*)(ws + WS_YB), (const char*)(ws + WS_YM), (const char*)(ws + WS_WBR) + (size_t)l * 3 * D * 512 * 2, (size_t)D * 512 * 2,
                       NTOK / 256, D / 256, xw ? 64 : nside - 64, xw ? sidx : 64 * XT + sidx - 64, 1, br, br, (size_t)256 * 512 * 2, xw ? XT : (1 << 30)};
    pg8::EpiBranch E{(const bf16*)(ws + WS_R1), (bf16*)(ws + WS_MB), 1};
    pg8::gemm_phase<pg8::EpiBranch, pg8::SchedBranch, true, true>(lds, 512, S, E, wave);
}
__device__ __forceinline__ void xdone_publish(unsigned char* ws) {
    asm volatile("s_waitcnt vmcnt(0)" ::: "memory"); __syncthreads();
    if (threadIdx.x == 0) { __builtin_amdgcn_fence(__ATOMIC_RELEASE, "agent"); asm volatile("s_waitcnt vmcnt(0)" ::: "memory");
        __hip_atomic_fetch_add((unsigned*)(ws + WS_CTL) + CW_XDONE, 1u, __ATOMIC_RELAXED, __HIP_MEMORY_SCOPE_AGENT); }
}
__device__ __forceinline__ void xdone_wait(unsigned char* ws, unsigned want) {
    asm volatile("s_waitcnt vmcnt(0)" ::: "memory"); __syncthreads();
    if (threadIdx.x == 0) { unsigned spins = 0;
        while (__hip_atomic_load((unsigned*)(ws + WS_CTL) + CW_XDONE, __ATOMIC_RELAXED, __HIP_MEMORY_SCOPE_AGENT) < want && ++spins < (1u << 22)) __builtin_amdgcn_s_sleep(8);
        __builtin_amdgcn_fence(__ATOMIC_ACQUIRE, "agent"); asm volatile("s_waitcnt vmcnt(0)" ::: "memory"); }
    __syncthreads();
}
PHASE_FN void g_branch(LAS unsigned char* lds, unsigned char* ws, int l, int G, int bid, int wave) { asm volatile("" : "+s"(ws)); ws = as_global(ws); asm volatile("" : "+s"(G)); asm volatile("" : "+s"(bid)); asm volatile("" : "+s"(l));
    pg8::SchedBranch S{(const char*)(ws + WS_YA), (const char*)(ws + WS_YB), (const char*)(ws + WS_YM), (const char*)(ws + WS_WBR) + (size_t)l * 3 * D * 512 * 2, (size_t)D * 512 * 2,
                       NTOK / 256, D / 256, G, bid, 1, 0, 0, (size_t)256 * 512 * 2};
    pg8::EpiBranch E{(const bf16*)(ws + WS_R1), (bf16*)(ws + WS_MB), 1};
    pg8::gemm_phase<pg8::EpiBranch, pg8::SchedBranch, true, true>(lds, 512, S, E, wave);
}
PHASE_FN void g_outproj(LAS unsigned char* lds, unsigned char* ws, int l, int G, int bid, int wave) { asm volatile("" : "+s"(ws)); ws = as_global(ws); asm volatile("" : "+s"(G)); asm volatile("" : "+s"(bid)); asm volatile("" : "+s"(l));
    pg8::SchedDense S{(const char*)(ws + WS_MB), (const char*)(ws + WS_WO) + (size_t)l * D * D * 2, NTOK / 256, D / 256, G, bid, (size_t)256 * D * 2};
    pg8::EpiOut E{(const bf16*)(ws + WS_HB), (bf16*)(ws + WS_HF)};
    pg8::gemm_phase<pg8::EpiOut, pg8::SchedDense, true, true>(lds, D, S, E, wave);
}
PHASE_FN void g_gateup(LAS unsigned char* lds, unsigned char* ws, const float* bgu, int l, int G, int bid, int wave) { asm volatile("" : "+s"(ws)); ws = as_global(ws); asm volatile("" : "+s"(G)); asm volatile("" : "+s"(bid)); asm volatile("" : "+s"(l)); bgu = as_global(bgu);
    const int* meta = (const int*)(ws + WS_META); const int n_tiles = __builtin_amdgcn_readfirstlane(meta[0]);
    pg8::SchedGrouped S{(const char*)(ws + WS_HB), (const char*)(ws + WS_WGU) + (size_t)l * NE * 2048 * D * 2, (size_t)2048 * D * 2, meta + 64, n_tiles, 8, G, bid, (size_t)256 * D * 2, (const int*)(ws + WS_SLOTT)};
    pg8::EpiSwiglu E{(bf16*)(ws + WS_HBUF), bgu + (size_t)l * NE * 2048};
    pg8::gemm_phase<pg8::EpiSwiglu, pg8::SchedGrouped, true, true, true>(lds, D, S, E, wave);
}
PHASE_FN void g_down(LAS unsigned char* lds, unsigned char* ws, const float* bd, int l, int G, int bid, int wave) { asm volatile("" : "+s"(ws)); ws = as_global(ws); asm volatile("" : "+s"(G)); asm volatile("" : "+s"(bid)); asm volatile("" : "+s"(l)); bd = as_global(bd);
    const int* meta = (const int*)(ws + WS_META); const int n_tiles = __builtin_amdgcn_readfirstlane(meta[0]);
    pg8::SchedGrouped S{(const char*)(ws + WS_HBUF), (const char*)(ws + WS_WD) + (size_t)l * NE * D * D * 2, (size_t)D * D * 2, meta + 64, n_tiles, 4, G, bid, (size_t)256 * D * 2, nullptr};
    pg8::EpiDown E{(bf16*)(ws + WS_XS), bd + (size_t)l * NE * D, (const float*)(ws + WS_SLOTW)};
    pg8::gemm_phase<pg8::EpiDown, pg8::SchedGrouped, true, true>(lds, D, S, E, wave);
}

constexpr int PH_PER_LAYER = 12, NPHASE = 1 + DEPTH * PH_PER_LAYER;
__global__ void __launch_bounds__(512, 2) fwd_kernel(Args args) {
    extern __shared__ __attribute__((aligned(16))) unsigned char lds_raw[];
    Ctx F;
    F.lds = (LAS unsigned char*)lds_raw; F.tid = 0; F.lane = 0; F.wave = __builtin_amdgcn_readfirstlane((int)threadIdx.x >> 6); F.G = gridDim.x; F.bid = blockIdx.x;
    F.in = args.in; F.out = args.out; F.ws = args.ws;
    volatile LAS unsigned* MISC = (volatile LAS unsigned*)(F.lds + MISC_OFF);
    if (threadIdx.x < 64) MISC[threadIdx.x] = 0u;
    __syncthreads();
    const int lo = args.ph_lo, hi = args.ph_hi;
#define REP_BRANCH g_branch
#ifdef AMP_BID
#define AMP_BEGIN() const unsigned long long amp_t0_ = __builtin_amdgcn_s_memrealtime()
#define AMP_END() do { if (exp_ && F.bid == AMP_BID) { __syncthreads(); const unsigned long long t1_ = __builtin_amdgcn_s_memrealtime(); while (__builtin_amdgcn_s_memrealtime() - t1_ < (unsigned long long)AMP * (t1_ - amp_t0_)) __builtin_amdgcn_s_sleep(8); } } while (0)
#else
#define AMP_BEGIN() do {} while (0)
#define AMP_END() do {} while (0)
#endif
#ifndef XA_LO
#define XA_LO 128
#endif
#ifndef BVAR
#define BVAR 0
#endif
#ifndef REP_MODE
#define REP_MODE 0
#endif
#ifndef REP_PH
#define REP_PH -1
#define REP_N 0
#endif
#define NREP(k) (((k) == REP_PH) ? 1 + REP_N : 1)
#if MK_MULTI
#define GRID_BAR() do { } while (0)
#else
    XcdBarrier bar = xcd_barrier_post((unsigned*)(F.ws + WS_CTL) + CW_BAR, MISC + 8);
#define GRID_BAR() xcd_barrier(bar)
#endif
#define IN(k) (lo <= (k) && (k) < hi)
#define SEAM(k) do { if (IN(k) && IN((k) + 1)) GRID_BAR(); } while (0)

    if (IN(0)) { for (int rep_ = 0; rep_ < ((REP_PH == 100) ? 1 + REP_N : 1); ++rep_) { if (rep_) GRID_BAR(); { Ctx P = fresh(F); phase_prologue(P); } } } SEAM(0);

#define LAYER_PHASES(l) do { const int p0 = 1 + (l) * PH_PER_LAYER; \
        if (IN(p0 + 0)) { for (int rep_ = 0; rep_ < NREP(0); ++rep_) { if (rep_) GRID_BAR(); g_inproj(F.lds, F.ws, l, F.G, F.bid, F.wave); } } SEAM(p0 + 0); \
        if (IN(p0 + 1)) { for (int rep_ = 0; rep_ < NREP(1); ++rep_) { if (rep_) GRID_BAR(); g_kvproj(F.lds, F.ws, l, F.G, F.bid, F.wave); __syncthreads(); { Ctx P = fresh(F); phase_prep(P, l); } asm volatile("s_waitcnt vmcnt(0)" ::: "memory"); __syncthreads(); { Ctx P = fresh(F); phase_gdn_a(P); } } }   \
        SEAM(p0 + 2); \
        if (IN(p0 + 3)) { for (int rep_ = 0; rep_ < NREP(3); ++rep_) { if (rep_) GRID_BAR(); __syncthreads(); { Ctx P = fresh(F); const bool exp_ = rep_ + 1 < NREP(3); const int mode_ = exp_ ? REP_MODE : 0; const int epoch_ = (l) * NREP(3) + rep_; AMP_BEGIN(); if (P.bid < 32) { if (mode_ != 2) phase_gdn_b(P, epoch_, exp_ ? BVAR : 0); } else if (P.bid < 32 + 8 * NHELP) { if (mode_ != 2) phase_gdn_b_helper(P, epoch_, P.bid & 7, (P.bid - 32) >> 3); } else if (mode_ != 1) { const int sidx_ = P.bid - 32 - 8 * NHELP, nside_ = P.G - 32 - 8 * NHELP; phase_xattn(P, sidx_, nside_); if (sidx_ < 64) xdone_publish(F.ws); __syncthreads(); _Pragma("unroll 1") for (int br_ = 1; br_ <= 2; ++br_) { if (br_ == 2) xdone_wait(F.ws, 64u * (unsigned)(epoch_ + 1)); g_side_branch(F.lds, F.ws, l, nside_, sidx_, F.wave, br_); } if (l == 0 && !exp_ && NDEF > 0) { __syncthreads(); Ctx Q = fresh(F); convert_deferred(Q, sidx_ * 8 + Q.wave, nside_ * 8); } } AMP_END(); } } } SEAM(p0 + 3); \
        if (IN(p0 + 4)) { for (int rep_ = 0; rep_ < NREP(4); ++rep_) { if (rep_) GRID_BAR(); __syncthreads(); { Ctx P = fresh(F); phase_gdn_c(P, l); } } } SEAM(p0 + 4); \
        if (IN(p0 + 5)) { for (int rep_ = 0; rep_ < NREP(5); ++rep_) { if (rep_) GRID_BAR(); __syncthreads(); if (rep_ == 0) g_branch(F.lds, F.ws, l, F.G, F.bid, F.wave); else REP_BRANCH(F.lds, F.ws, l, F.G, F.bid, F.wave); } } SEAM(p0 + 5); \
        if (IN(p0 + 6)) { for (int rep_ = 0; rep_ < NREP(6); ++rep_) { if (rep_) GRID_BAR(); g_outproj(F.lds, F.ws, l, F.G, F.bid, F.wave); } } SEAM(p0 + 6); \
        if (IN(p0 + 7)) { for (int rep_ = 0; rep_ < NREP(7); ++rep_) { if (rep_) GRID_BAR(); __syncthreads(); { Ctx P = fresh(F); phase_ln1_router(P, l); } } } SEAM(p0 + 7); \
        if (IN(p0 + 8)) { for (int rep_ = 0; rep_ < NREP(8); ++rep_) { if (rep_) GRID_BAR(); __syncthreads(); { Ctx P = fresh(F); phase_assign(P); } } } SEAM(p0 + 8); \
        if (IN(p0 + 9)) { for (int rep_ = 0; rep_ < NREP(9); ++rep_) { if (rep_) GRID_BAR(); __syncthreads(); g_gateup(F.lds, F.ws, as_global(F.in[I_BGU]), l, F.G, F.bid, F.wave); } } SEAM(p0 + 9); \
        if (IN(p0 + 10)) { for (int rep_ = 0; rep_ < NREP(10); ++rep_) { if (rep_) GRID_BAR(); g_down(F.lds, F.ws, as_global(F.in[I_BD]), l, F.G, F.bid, F.wave); } } SEAM(p0 + 10); \
        if (IN(p0 + 11)) { for (int rep_ = 0; rep_ < NREP(11); ++rep_) { if (rep_) GRID_BAR(); __syncthreads(); { Ctx P = fresh(F); phase_combine_ln2(P, l); } } } SEAM(p0 + 11); \
    } while (0)
    LAYER_PHASES(0);
    LAYER_PHASES(1);
#undef LAYER_PHASES
#undef IN
#undef SEAM
#undef GRID_BAR
}

extern "C" void kernel_launch(void* const* d_in, const int* in_sizes, int n_in, void* d_out, int out_size, void* d_ws, size_t ws_size, hipStream_t stream) {
    static int grid = 0;
    if (grid == 0) {
        if (n_in != 23 || out_size != NTOK * D || ws_size < WS_END) { fprintf(stderr, "kernel_launch: unexpected problem (n_in %d, out %d, ws %zu < %zu)\n", n_in, out_size, ws_size, (size_t)WS_END); grid = -1; return; }
        if (hipFuncSetAttribute((const void*)fwd_kernel, hipFuncAttributeMaxDynamicSharedMemorySize, LDS_BYTES) != hipSuccess) { fprintf(stderr, "kernel_launch: hipFuncSetAttribute failed\n"); grid = -1; return; }
        int per_cu = 0;
        if (hipOccupancyMaxActiveBlocksPerMultiprocessor(&per_cu, (const void*)fwd_kernel, 512, LDS_BYTES) != hipSuccess || per_cu < 1) fprintf(stderr, "kernel_launch: occupancy query reports %d\n", per_cu);
        (void)hipGetLastError();
        grid = 256;
    }
    if (grid < 0) return;
    (void)hipMemsetAsync((char*)d_ws + WS_CTL, 0, CTL_ZERO_BYTES, stream);
    Args a{};
    for (int i = 0; i < 23; ++i) a.in[i] = (const float*)d_in[i];
    a.out = (float*)d_out; a.ws = (unsigned char*)d_ws;
#if MK_MULTI
    for (int p = 0; p < NPHASE; ++p) { a.ph_lo = p; a.ph_hi = p + 1; hipLaunchKernelGGL(fwd_kernel, dim3(grid), dim3(512), LDS_BYTES, stream, a); }
#else
    a.ph_lo = 0; a.ph_hi = NPHASE;
    hipLaunchKernelGGL(fwd_kernel, dim3(grid), dim3(512), LDS_BYTES, stream, a);
#endif
}
```
